# Optimizing an MI355X kernel written in HIP

```python
import math
import jax, jax.numpy as jnp
from jax import lax
import numpy as np

D_MODEL = 1024
BATCH = 2
SEQ = 8192
DEPTH = 2

N_EVEN = (DEPTH + 1) // 2
N_ODD = DEPTH // 2

LRU_WIDTH = D_MODEL // 2
LRU_BLOCKS = 8
LRU_BLOCK_DIM = LRU_WIDTH // LRU_BLOCKS
LRU_CONV = 4
LRU_C = 8.0

ATT_HEADS = 8
ATT_HEAD_DIM = (D_MODEL // 2) // ATT_HEADS
ATT_WIDTH = ATT_HEADS * ATT_HEAD_DIM
DILATED_PATTERNS = ((128, 1), (512, 4), (2048, 16))
ATT_SPAN = max(w for w, _ in DILATED_PATTERNS)
ROPE_THETA = 500000.0
ROPE_DIM = ATT_HEAD_DIM // 4

S5_WIDTH = D_MODEL // 2
S5_GROUP = 16
S5_GROUPS = S5_WIDTH // S5_GROUP
S5_STATE = 64

GLA_HEADS = 4
GLA_DK = (D_MODEL // 4) // GLA_HEADS
GLA_DV = (D_MODEL // 2) // GLA_HEADS
GLA_LOWRANK = 16
GLA_TAU = 16.0
GLA_CHUNK = 64

D_FF = 3 * D_MODEL
FFN_CONV = 3

EPS = 1e-6
NEG_INF = -1e30

EVEN_COLS = (LRU_WIDTH, LRU_WIDTH, ATT_WIDTH, ATT_WIDTH, ATT_WIDTH)
ODD_COLS = (S5_WIDTH, GLA_HEADS * GLA_DK, GLA_HEADS * GLA_DK,
            GLA_HEADS * GLA_DV, GLA_HEADS * GLA_DV, GLA_LOWRANK)

kernel_name = "hybrid_lru_dilated_s5_gla_block"


def split_cols(t, widths):
    idx = [int(i) for i in np.cumsum(widths)[:-1]]
    return jnp.split(t, idx, axis=-1)


def rmsnorm(x, g):
    xf = x.astype(jnp.float32)
    y = xf * lax.rsqrt(jnp.mean(xf * xf, axis=-1, keepdims=True) + EPS)
    return y.astype(x.dtype) * g


def causal_dwconv(x, w, b):
    K = w.shape[0]
    S = x.shape[1]
    xp = jnp.pad(x, ((0, 0), (K - 1, 0), (0, 0)))
    return sum(xp[:, j:j + S] * w[j] for j in range(K)) + b


def rope_tables(S):
    pos = jnp.arange(S, dtype=jnp.float32)
    inv = ROPE_THETA ** (-jnp.arange(0, ROPE_DIM, 2, dtype=jnp.float32) / ROPE_DIM)
    ang = pos[:, None] * inv[None, :]
    return jnp.cos(ang), jnp.sin(ang)


def apply_partial_rope(x, cos, sin):
    half = ROPE_DIM // 2
    c = cos[None, :, None, :].astype(x.dtype)
    s = sin[None, :, None, :].astype(x.dtype)
    x1, x2, rest = x[..., :half], x[..., half:ROPE_DIM], x[..., ROPE_DIM:]
    return jnp.concatenate([x1 * c - x2 * s, x2 * c + x1 * s, rest], axis=-1)


def _linear_combine(left, right):
    a1, b1 = left
    a2, b2 = right
    return a1 * a2, a2 * b1 + b2


def _complex_combine(left, right):
    ar1, ai1, br1, bi1 = left
    ar2, ai2, br2, bi2 = right
    return (ar1 * ar2 - ai1 * ai2, ar1 * ai2 + ai1 * ar2,
            ar2 * br1 - ai2 * bi1 + br2, ar2 * bi1 + ai2 * br1 + bi2)


def rg_lru(x, ga_w, ga_b, gx_w, gx_b, lam):
    B, S, W = x.shape
    xb = x.reshape(B, S, LRU_BLOCKS, LRU_BLOCK_DIM)
    r = jax.nn.sigmoid(jnp.einsum('bshi,hij->bshj', xb, ga_w).reshape(B, S, W) + ga_b)
    i = jax.nn.sigmoid(jnp.einsum('bshi,hij->bshj', xb, gx_w).reshape(B, S, W) + gx_b)
    log_a = (LRU_C * r.astype(jnp.float32)) * jax.nn.log_sigmoid(lam.astype(jnp.float32))
    a = jnp.exp(log_a)
    b = jnp.sqrt(-jnp.expm1(2.0 * log_a)) * (i * x).astype(jnp.float32)
    _, h = lax.associative_scan(_linear_combine, (a, b), axis=1)
    return h.astype(x.dtype)


def _dilated_pattern(q, k, v, dil, n_back):
    B, Sp, H, hd = q.shape
    L = Sp // dil
    nb = L // n_back
    n = n_back

    def to_sub(t):
        return t.reshape(B, L, dil, H, hd).transpose(0, 2, 1, 3, 4).reshape(B, dil, nb, n, H, hd)

    qs, ks, vs = to_sub(q), to_sub(k), to_sub(v)
    pad = ((0, 0), (0, 0), (1, 0), (0, 0), (0, 0), (0, 0))
    kb = jnp.concatenate([jnp.pad(ks, pad)[:, :, :-1], ks], axis=3)
    vb = jnp.concatenate([jnp.pad(vs, pad)[:, :, :-1], vs], axis=3)
    scores = jnp.einsum('brnqhd,brnkhd->brnhqk', qs, kb).astype(jnp.float32) * (hd ** -0.5)
    qi = jnp.arange(n)[:, None]
    ki = jnp.arange(2 * n)[None, :]
    dist = n + qi - ki
    band = (dist >= 0) & (dist <= n_back)
    valid = (jnp.arange(nb)[:, None, None] > 0) | (ki[None] >= n)
    mask = (band[None] & valid)[None, None, :, None, :, :]
    scores = jnp.where(mask, scores, NEG_INF)
    lse = jax.nn.logsumexp(scores, axis=-1)
    p = jnp.exp(scores - lse[..., None])
    out = jnp.einsum('brnhqk,brnkhd->brnqhd', p.astype(vb.dtype), vb)
    out = out.reshape(B, dil, L, H, hd).transpose(0, 2, 1, 3, 4).reshape(B, Sp, H, hd)
    lse = lse.transpose(0, 1, 2, 4, 3).reshape(B, dil, L, H).transpose(0, 2, 1, 3).reshape(B, Sp, H)
    return out, lse


def dilated_attention(q, k, v):
    B, S, H, hd = q.shape
    pad = (-S) % ATT_SPAN
    padw = ((0, 0), (0, pad), (0, 0), (0, 0))
    qp, kp, vp = jnp.pad(q, padw), jnp.pad(k, padw), jnp.pad(v, padw)
    outs, lses = [], []
    for window, dil in DILATED_PATTERNS:
        o, l = _dilated_pattern(qp, kp, vp, dil, window // dil)
        outs.append(o.astype(jnp.float32))
        lses.append(l)
    w = jax.nn.softmax(jnp.stack(lses, axis=0), axis=0)
    o = jnp.sum(w[..., None] * jnp.stack(outs, axis=0), axis=0)
    return o[:, :S].astype(q.dtype)


def s5(u, lam_re, lam_im, b_re, b_im, c_re, c_im, d, log_step):
    f32 = jnp.float32
    B, S, W = u.shape
    ug = u.astype(f32).reshape(B, S, S5_GROUPS, S5_GROUP)
    step = jnp.exp(log_step.astype(f32))[:, None]
    lr, li = lam_re.astype(f32), lam_im.astype(f32)
    mag = jnp.exp(lr * step)
    ar, ai = mag * jnp.cos(li * step), mag * jnp.sin(li * step)
    den = lr * lr + li * li
    cr = ((ar - 1.0) * lr + ai * li) / den
    ci = (ai * lr - (ar - 1.0) * li) / den
    bbr = cr[..., None] * b_re - ci[..., None] * b_im
    bbi = cr[..., None] * b_im + ci[..., None] * b_re
    bur = jnp.einsum('bsgp,gnp->bsgn', ug, bbr)
    bui = jnp.einsum('bsgp,gnp->bsgn', ug, bbi)
    shp = bur.shape
    _, _, xr, xi = lax.associative_scan(
        _complex_combine,
        (jnp.broadcast_to(ar, shp), jnp.broadcast_to(ai, shp), bur, bui), axis=1)
    y = jnp.einsum('bsgn,gpn->bsgp', xr, c_re) - jnp.einsum('bsgn,gpn->bsgp', xi, c_im)
    return (y.reshape(B, S, W) + d * u.astype(f32)).astype(u.dtype)


def gla(q, k, v, gk_lr, gk_w, gk_b, g, norm):
    f32 = jnp.float32
    B, S, H, _ = q.shape
    C = GLA_CHUNK
    nc = S // C
    log_a = jax.nn.log_sigmoid((gk_lr @ gk_w + gk_b).astype(f32)) / GLA_TAU

    def chunks(t, dim):
        return t.astype(f32).reshape(B, nc, C, H, dim).transpose(0, 3, 1, 2, 4)

    qc = chunks(q, GLA_DK) * (GLA_DK ** -0.5)
    kc = chunks(k, GLA_DK)
    vc = chunks(v, GLA_DV)
    bc = jnp.cumsum(chunks(log_a, GLA_DK), axis=3)
    b_last = bc[:, :, :, -1:, :]
    q_dec = qc * jnp.exp(bc)
    k_inv = kc * jnp.exp(-bc)
    causal = jnp.tril(jnp.ones((C, C), dtype=bool))
    att = jnp.where(causal, jnp.einsum('bhncd,bhnjd->bhncj', q_dec, k_inv), 0.0)
    o_intra = jnp.einsum('bhncj,bhnje->bhnce', att, vc)
    kv = jnp.einsum('bhncd,bhnce->nbhde', kc * jnp.exp(b_last - bc), vc)
    decay = jnp.exp(b_last[:, :, :, 0, :]).transpose(2, 0, 1, 3)

    def step(state, inp):
        dec, kv_c = inp
        return dec[..., None] * state + kv_c, state

    _, s_prev = lax.scan(step, jnp.zeros((B, H, GLA_DK, GLA_DV), f32), (decay, kv))
    o_inter = jnp.einsum('bhncd,nbhde->bhnce', q_dec, s_prev)
    o = (o_intra + o_inter).transpose(0, 2, 3, 1, 4).reshape(B, S, H, GLA_DV)
    o = rmsnorm(o, norm).reshape(B, S, H * GLA_DV).astype(g.dtype)
    return o * jax.nn.silu(g)


def even_layer(x, norm, w_in, conv_w, conv_b, ga_w, ga_b, gx_w, gx_b, lam, q_norm, k_norm, w_out, cos, sin):
    B, S, _ = x.shape
    h = rmsnorm(x, norm)
    xl, gl, q, k, v = split_cols(h @ w_in, EVEN_COLS)
    xl = causal_dwconv(xl, conv_w, conv_b)
    y_lru = rg_lru(xl, ga_w, ga_b, gx_w, gx_b, lam) * jax.nn.gelu(gl)
    q = apply_partial_rope(rmsnorm(q.reshape(B, S, ATT_HEADS, ATT_HEAD_DIM), q_norm), cos, sin)
    k = apply_partial_rope(rmsnorm(k.reshape(B, S, ATT_HEADS, ATT_HEAD_DIM), k_norm), cos, sin)
    v = v.reshape(B, S, ATT_HEADS, ATT_HEAD_DIM)
    y_att = dilated_attention(q, k, v).reshape(B, S, ATT_WIDTH)
    return x + jnp.concatenate([y_lru, y_att], axis=-1) @ w_out


def odd_layer(x, norm, w_in, lam_re, lam_im, b_re, b_im, c_re, c_im, d, log_step,
              glu_w, glu_b, gk_w, gk_b, gla_norm, w_out):
    B, S, _ = x.shape
    h = rmsnorm(x, norm)
    u, q, k, v, g, gk = split_cols(h @ w_in, ODD_COLS)
    ys = jax.nn.gelu(s5(u, lam_re, lam_im, b_re, b_im, c_re, c_im, d, log_step))
    y_s5 = ys * jax.nn.sigmoid(ys @ glu_w + glu_b)
    y_gla = gla(q.reshape(B, S, GLA_HEADS, GLA_DK), k.reshape(B, S, GLA_HEADS, GLA_DK),
                v.reshape(B, S, GLA_HEADS, GLA_DV), gk, gk_w, gk_b, g, gla_norm)
    return x + jnp.concatenate([y_s5, y_gla], axis=-1) @ w_out


def conv_ffn(x, norm, w_in, conv_w, conv_b, w_out):
    h = rmsnorm(x, norm)
    a, lin = jnp.split(h @ w_in, 2, axis=-1)
    return x + (jax.nn.gelu(causal_dwconv(a, conv_w, conv_b)) * lin) @ w_out


def setup_inputs(seed: int = 0) -> dict:
    key = jax.random.key(seed)
    keys = iter(jax.random.split(key, 64))
    f32 = jnp.float32

    def nrm(shape, scale):
        return jax.random.normal(next(keys), shape, f32) * scale

    def gain(shape):
        return 1.0 + nrm(shape, 0.02)

    NE, NO = N_EVEN, N_ODD
    inp = {}
    inp['x'] = nrm((BATCH, SEQ, D_MODEL), 1.0)
    inp['e_norm'] = gain((NE, D_MODEL))
    inp['e_w_in'] = nrm((NE, D_MODEL, sum(EVEN_COLS)), D_MODEL ** -0.5)
    inp['e_conv_w'] = nrm((NE, LRU_CONV, LRU_WIDTH), LRU_CONV ** -0.5)
    inp['e_conv_b'] = nrm((NE, LRU_WIDTH), 0.01)
    inp['e_gate_a_w'] = nrm((NE, LRU_BLOCKS, LRU_BLOCK_DIM, LRU_BLOCK_DIM), LRU_BLOCK_DIM ** -0.5)
    inp['e_gate_a_b'] = nrm((NE, LRU_WIDTH), 0.01)
    inp['e_gate_x_w'] = nrm((NE, LRU_BLOCKS, LRU_BLOCK_DIM, LRU_BLOCK_DIM), LRU_BLOCK_DIM ** -0.5)
    inp['e_gate_x_b'] = nrm((NE, LRU_WIDTH), 0.01)
    a_c = jax.random.uniform(next(keys), (NE, LRU_WIDTH), f32, 0.9, 0.999)
    p = a_c ** (1.0 / LRU_C)
    inp['e_lambda'] = jnp.log(p) - jnp.log1p(-p)
    inp['e_q_norm'] = gain((NE, ATT_HEAD_DIM))
    inp['e_k_norm'] = gain((NE, ATT_HEAD_DIM))
    inp['e_w_out'] = nrm((NE, LRU_WIDTH + ATT_WIDTH, D_MODEL), (LRU_WIDTH + ATT_WIDTH) ** -0.5)
    inp['o_norm'] = gain((NO, D_MODEL))
    inp['o_w_in'] = nrm((NO, D_MODEL, sum(ODD_COLS)), D_MODEL ** -0.5)
    inp['o_lambda_re'] = -0.5 + nrm((NO, S5_GROUPS, S5_STATE), 0.01)
    inp['o_lambda_im'] = (jnp.pi * jnp.arange(S5_STATE, dtype=f32))[None, None, :] + nrm((NO, S5_GROUPS, S5_STATE), 0.01)
    inp['o_b_re'] = nrm((NO, S5_GROUPS, S5_STATE, S5_GROUP), (2.0 * S5_GROUP) ** -0.5)
    inp['o_b_im'] = nrm((NO, S5_GROUPS, S5_STATE, S5_GROUP), (2.0 * S5_GROUP) ** -0.5)
    inp['o_c_re'] = nrm((NO, S5_GROUPS, S5_GROUP, S5_STATE), 0.5 ** 0.5)
    inp['o_c_im'] = nrm((NO, S5_GROUPS, S5_GROUP, S5_STATE), 0.5 ** 0.5)
    inp['o_d'] = nrm((NO, S5_WIDTH), 1.0)
    inp['o_log_step'] = jax.random.uniform(next(keys), (NO, S5_GROUPS), f32, math.log(0.001), math.log(0.1))
    inp['o_glu_w'] = nrm((NO, S5_WIDTH, S5_WIDTH), S5_WIDTH ** -0.5)
    inp['o_glu_b'] = nrm((NO, S5_WIDTH), 0.01)
    inp['o_gk_w'] = nrm((NO, GLA_LOWRANK, GLA_HEADS * GLA_DK), GLA_LOWRANK ** -0.5)
    inp['o_gk_b'] = nrm((NO, GLA_HEADS * GLA_DK), 0.01)
    inp['o_gla_norm'] = gain((NO, GLA_DV))
    inp['o_w_out'] = nrm((NO, S5_WIDTH + GLA_HEADS * GLA_DV, D_MODEL), (S5_WIDTH + GLA_HEADS * GLA_DV) ** -0.5)
    inp['f_norm'] = gain((DEPTH, D_MODEL))
    inp['f_w_in'] = nrm((DEPTH, D_MODEL, 2 * D_FF), D_MODEL ** -0.5)
    inp['f_conv_w'] = nrm((DEPTH, FFN_CONV, D_FF), FFN_CONV ** -0.5)
    inp['f_conv_b'] = nrm((DEPTH, D_FF), 0.01)
    inp['f_w_out'] = nrm((DEPTH, D_FF, D_MODEL), D_FF ** -0.5)
    return inp


def reference(x,
              e_norm, e_w_in, e_conv_w, e_conv_b, e_gate_a_w, e_gate_a_b, e_gate_x_w, e_gate_x_b,
              e_lambda, e_q_norm, e_k_norm, e_w_out,
              o_norm, o_w_in, o_lambda_re, o_lambda_im, o_b_re, o_b_im, o_c_re, o_c_im, o_d,
              o_log_step, o_glu_w, o_glu_b, o_gk_w, o_gk_b, o_gla_norm, o_w_out,
              f_norm, f_w_in, f_conv_w, f_conv_b, f_w_out):
    cos, sin = rope_tables(x.shape[1])
    for layer in range(DEPTH):
        i = layer // 2
        if layer % 2 == 0:
            x = even_layer(x, e_norm[i], e_w_in[i], e_conv_w[i], e_conv_b[i], e_gate_a_w[i], e_gate_a_b[i],
                           e_gate_x_w[i], e_gate_x_b[i], e_lambda[i], e_q_norm[i], e_k_norm[i], e_w_out[i],
                           cos, sin)
        else:
            x = odd_layer(x, o_norm[i], o_w_in[i], o_lambda_re[i], o_lambda_im[i], o_b_re[i], o_b_im[i],
                          o_c_re[i], o_c_im[i], o_d[i], o_log_step[i], o_glu_w[i], o_glu_b[i],
                          o_gk_w[i], o_gk_b[i], o_gla_norm[i], o_w_out[i])
        x = conv_ffn(x, f_norm[layer], f_w_in[layer], f_conv_w[layer], f_conv_b[layer], f_w_out[layer])
    return x
```

```cpp
#include <hip/hip_runtime.h>
#include <hip/hip_cooperative_groups.h>
#include <cstdio>
#include <cstdint>
namespace cg = cooperative_groups;
namespace pg8 {
#define PG8_LAS __attribute__((address_space(3)))
typedef unsigned short bf16_t;
typedef short bf16x8 __attribute__((ext_vector_type(8)));
typedef float f32x4 __attribute__((ext_vector_type(4)));
typedef unsigned u32x4 __attribute__((ext_vector_type(4)));
constexpr int BM = 256, BK = 64, HALF = 128, HTB = HALF * BK * 2  , STAGE_BYTES = 8 * HTB, NXCD = 8, WGM = 8;

__host__ __device__ __forceinline__ int lds_byte(int r, int c) { const int st = (r >> 4) * 2 + (c >> 5), rr = r & 15, cc = c & 31, ob = rr * 64 + cc * 2; return st * 1024 + (ob ^ (((ob >> 9) & 1) << 5)); }
__host__ __device__ __forceinline__ void stage_rc(int b, int& R, int& C) { const int st = b / 1024, sb = b % 1024, swz = sb ^ (((sb >> 9) & 1) << 5); R = (st >> 1) * 16 + swz / 64; C = (st & 1) * 32 + (swz % 64) / 2; }
__host__ __device__ __forceinline__ int perm32(int rho) { const int n = rho >> 4, i = rho & 15; return 8 * (i >> 2) + 4 * n + (i & 3); }

struct Unit { int pm, pn; };
struct Gemm { const bf16_t* A; const bf16_t* Bt; int M, N, K; };

struct StaticOrder {
    int nM, nN, nwg, G, c;
    __host__ __device__ void init(int M, int N, int G_, int c_) { nM = M / BM; nN = N / BM; nwg = nM * nN; G = G_; c = c_; }
    __host__ __device__ bool next(int i, Unit& u) const {
        const long L = (long)i * G + c; if (L >= nwg) return false;
        int wgid = (int)L; { const int q = nwg / NXCD, r = nwg % NXCD, xcd = wgid % NXCD, off = wgid / NXCD; wgid = (xcd < r ? xcd * (q + 1) : r * (q + 1) + (xcd - r) * q) + off; }
        const int nig = WGM * nN, gid = wgid / nig, fm = gid * WGM, gsz = (nM - fm) < WGM ? (nM - fm) : WGM;
        u.pm = fm + ((wgid % nig) % gsz); u.pn = (wgid % nig) / gsz; return true;
    }
    __device__ __forceinline__ void a_ready(const Unit&) const {}
    __device__ __forceinline__ void done(const Unit&) const {}
};

__device__ __forceinline__ unsigned cvt_pk_bf16(float lo, float hi) { unsigned r; asm volatile("v_cvt_pk_bf16_f32 %0, %1, %2" : "=v"(r) : "v"(lo), "v"(hi)); return r; }
typedef float f32x2 __attribute__((ext_vector_type(2)));
template <class Epi, class Sched, bool ALIGN_EPI = false, bool SP2 = false>
__device__ __forceinline__ void gemm_phase(PG8_LAS unsigned char* lds, const Gemm g, const Sched& S, const Epi& E) {
    const int tid = threadIdx.x, wid = __builtin_amdgcn_readfirstlane(tid >> 6), lane = tid & 63, wr = wid >> 2, wc = wid & 3, fr = lane & 15, fq = lane >> 4;
    const int K = g.K, nt = K / BK;
    unsigned voffA[2], voffB[2];
#pragma unroll
    for (int i = 0; i < 2; ++i) { int R, C; stage_rc(tid * 16 + i * 8192, R, C); const int Rb = Epi::PERM ? ((R & ~31) + perm32(R & 31)) : R;
        voffA[i] = (unsigned)(R * K + C) * 2u; voffB[i] = (unsigned)(Rb * K + C) * 2u; }
    const size_t kstep = (size_t)(BK * 2);
    const size_t hstep = (size_t)HALF * K * 2;
    const size_t tstep = 2 * hstep;
    const unsigned ldsw = (unsigned)wid * 1024u;
    const int aoff = lds_byte(wr * 64 + fr, fq * 8), boff = lds_byte(wc * 32 + fr, fq * 8);
#define PG8_SA(b, h) (((b) * 2 + (h)) * HTB)
#define PG8_SB(b, h) ((4 + (b) * 2 + (h)) * HTB)
#define PG8_STAGE(bufoff, gbase, voff) do { _Pragma("unroll") for (int _i = 0; _i < 2; ++_i) \
        __builtin_amdgcn_global_load_lds((const unsigned*)((const char*)(gbase) + (voff)[_i]), (PG8_LAS unsigned*)(lds + (bufoff) + ldsw + _i * 8192), 16, 0, 0); } while (0)
#define PG8_LDA(dst, b, h) do { _Pragma("unroll") for (int m = 0; m < 4; ++m) _Pragma("unroll") for (int k = 0; k < 2; ++k) dst[m][k] = *(const PG8_LAS bf16x8*)(lds + PG8_SA(b, h) + aoff + m * 2048 + k * 1024); } while (0)
#define PG8_LDB(dst, b, h) do { _Pragma("unroll") for (int n = 0; n < 2; ++n) _Pragma("unroll") for (int k = 0; k < 2; ++k) dst[n][k] = *(const PG8_LAS bf16x8*)(lds + PG8_SB(b, h) + boff + n * 2048 + k * 1024); } while (0)
#define PG8_MMA(ai, bj, At, Bt) do { __builtin_amdgcn_s_setprio(1); _Pragma("unroll") for (int m = 0; m < 4; ++m) _Pragma("unroll") for (int n = 0; n < 2; ++n) _Pragma("unroll") for (int k = 0; k < 2; ++k) \
        acc[ai][bj][m][n] = __builtin_amdgcn_mfma_f32_16x16x32_bf16(Bt[n][k], At[m][k], acc[ai][bj][m][n], 0, 0, 0); __builtin_amdgcn_s_setprio(0); } while (0)
#define PG8_WAIT_V(n) asm volatile("s_waitcnt vmcnt(" #n ")" ::: "memory")
#define PG8_WAIT_L(n) asm volatile("s_waitcnt lgkmcnt(" #n ")" ::: "memory")
#define PG8_BAR __builtin_amdgcn_s_barrier()
#define PG8_SCHED __builtin_amdgcn_sched_barrier(0)
    Unit cur, nxt; int ui = 0;
    if (!S.next(0, cur)) return;
    f32x4 acc[2][2][4][2];
#pragma unroll
    for (int a = 0; a < 2; ++a)
#pragma unroll
        for (int b = 0; b < 2; ++b)
#pragma unroll
            for (int m = 0; m < 4; ++m)
#pragma unroll
                for (int n = 0; n < 2; ++n) acc[a][b][m][n] = (f32x4){0.f, 0.f, 0.f, 0.f};
    bf16x8 At[4][2], B0[2][2], B1[2][2];
    const char* cA = (const char*)g.A + (size_t)cur.pm * tstep; const char* cB = (const char*)g.Bt + (size_t)cur.pn * tstep;
    S.a_ready(cur);
    if constexpr (SP2) {
        PG8_STAGE(PG8_SB(0, 0), cB, voffB); PG8_STAGE(PG8_SB(0, 1), cB + hstep, voffB); PG8_STAGE(PG8_SA(0, 0), cA, voffA); PG8_STAGE(PG8_SA(0, 1), cA + hstep, voffA);
        if (wr == 1) PG8_BAR;
        PG8_WAIT_V(2); PG8_BAR;
        PG8_STAGE(PG8_SB(1, 0), cB + kstep, voffB); PG8_STAGE(PG8_SA(1, 0), cA + kstep, voffA); PG8_STAGE(PG8_SB(1, 1), cB + hstep + kstep, voffB);
        PG8_WAIT_V(6); PG8_BAR;
    } else {
        PG8_STAGE(PG8_SB(0, 0), cB, voffB); PG8_STAGE(PG8_SA(0, 0), cA, voffA); PG8_STAGE(PG8_SB(0, 1), cB + hstep, voffB); PG8_STAGE(PG8_SA(0, 1), cA + hstep, voffA);
        if (wr == 1) PG8_BAR;
        PG8_WAIT_V(4); PG8_BAR;
        PG8_STAGE(PG8_SB(1, 0), cB + kstep, voffB); PG8_STAGE(PG8_SA(1, 0), cA + kstep, voffA); PG8_STAGE(PG8_SB(1, 1), cB + hstep + kstep, voffB);
        PG8_WAIT_V(6); PG8_BAR;
    }
    for (;;) {
        const bool has_next = S.next(ui + 1, nxt);
        const char* nA = has_next ? (const char*)g.A + (size_t)nxt.pm * tstep : cA; const char* nB = has_next ? (const char*)g.Bt + (size_t)nxt.pn * tstep : cB;
        for (int t = 0; t < nt; t += 2) {
            const bool last = (t == nt - 2);
            const char* a1 = cA + (size_t)(t + 1) * kstep;
            const char* a2 = last ? nA : cA + (size_t)(t + 2) * kstep; const char* b2 = last ? nB : cB + (size_t)(t + 2) * kstep;
            const char* a3 = a2 + kstep; const char* b3 = b2 + kstep;
            if (last && has_next) S.a_ready(nxt);
            if constexpr (SP2) {
            PG8_LDB(B0, 0, 0); PG8_LDB(B1, 0, 1); PG8_SCHED; PG8_LDA(At, 0, 0); PG8_STAGE(PG8_SA(1, 1), a1 + hstep, voffA);
            PG8_WAIT_V(8); PG8_WAIT_L(0); PG8_BAR; PG8_MMA(0, 0, At, B0); PG8_MMA(0, 1, At, B1); PG8_BAR; PG8_SCHED;
            PG8_LDA(At, 0, 1); PG8_STAGE(PG8_SB(0, 0), b2, voffB); PG8_STAGE(PG8_SB(0, 1), b2 + hstep, voffB); PG8_STAGE(PG8_SA(0, 0), a2, voffA);
            PG8_WAIT_V(8); PG8_WAIT_L(0); PG8_BAR; PG8_MMA(1, 0, At, B0); PG8_MMA(1, 1, At, B1); PG8_BAR; PG8_SCHED;
            PG8_LDB(B0, 1, 0); PG8_LDB(B1, 1, 1); PG8_SCHED; PG8_LDA(At, 1, 0); PG8_STAGE(PG8_SA(0, 1), a2 + hstep, voffA);
            PG8_WAIT_V(8); PG8_WAIT_L(0); PG8_BAR; PG8_MMA(0, 0, At, B0); PG8_MMA(0, 1, At, B1); PG8_BAR; PG8_SCHED;
            PG8_LDA(At, 1, 1); PG8_STAGE(PG8_SB(1, 0), b3, voffB); PG8_STAGE(PG8_SB(1, 1), b3 + hstep, voffB); PG8_STAGE(PG8_SA(1, 0), a3, voffA);
            PG8_WAIT_V(8); PG8_WAIT_L(0); PG8_BAR; PG8_MMA(1, 0, At, B0); PG8_MMA(1, 1, At, B1); PG8_BAR; PG8_SCHED;
            } else {
            PG8_LDB(B0, 0, 0); PG8_SCHED; PG8_LDA(At, 0, 0); PG8_STAGE(PG8_SA(1, 1), a1 + hstep, voffA);
            PG8_WAIT_L(8); PG8_BAR; PG8_WAIT_L(0); PG8_MMA(0, 0, At, B0); PG8_BAR; PG8_SCHED;
            PG8_LDB(B1, 0, 1); PG8_STAGE(PG8_SB(0, 0), b2, voffB);
            PG8_BAR; PG8_WAIT_L(0); PG8_MMA(0, 1, At, B1); PG8_BAR;
            PG8_LDA(At, 0, 1); PG8_STAGE(PG8_SA(0, 0), a2, voffA);
            PG8_BAR; PG8_WAIT_L(0); PG8_MMA(1, 0, At, B0); PG8_BAR; PG8_SCHED;
            PG8_STAGE(PG8_SB(0, 1), b2 + hstep, voffB);
            PG8_WAIT_V(6); PG8_BAR; PG8_MMA(1, 1, At, B1); PG8_BAR;
            PG8_LDB(B0, 1, 0); PG8_SCHED; PG8_LDA(At, 1, 0); PG8_STAGE(PG8_SA(0, 1), a2 + hstep, voffA);
            PG8_WAIT_L(8); PG8_BAR; PG8_WAIT_L(0); PG8_MMA(0, 0, At, B0); PG8_BAR; PG8_SCHED;
            PG8_LDB(B1, 1, 1); PG8_STAGE(PG8_SB(1, 0), b3, voffB);
            PG8_BAR; PG8_WAIT_L(0); PG8_MMA(0, 1, At, B1); PG8_BAR;
            PG8_LDA(At, 1, 1); PG8_STAGE(PG8_SA(1, 0), a3, voffA);
            PG8_BAR; PG8_WAIT_L(0); PG8_MMA(1, 0, At, B0); PG8_BAR; PG8_SCHED;
            PG8_STAGE(PG8_SB(1, 1), b3 + hstep, voffB);
            PG8_WAIT_V(6); PG8_BAR; PG8_MMA(1, 1, At, B1); PG8_BAR;
            }
        }
        if constexpr (ALIGN_EPI) { if (wr == 0) PG8_BAR; }
        if constexpr (!Epi::AFTER_DRAIN) { E(acc, cur, wr, wc, fr, fq); S.done(cur); }
        if (!has_next) break;
#pragma unroll
        for (int a = 0; a < 2; ++a)
#pragma unroll
            for (int b = 0; b < 2; ++b)
#pragma unroll
                for (int m = 0; m < 4; ++m)
#pragma unroll
                    for (int n = 0; n < 2; ++n) acc[a][b][m][n] = (f32x4){0.f, 0.f, 0.f, 0.f};
        cur = nxt; cA = nA; cB = nB; ++ui;
        if constexpr (ALIGN_EPI) { if (wr == 1) PG8_BAR; }
    }
    PG8_WAIT_V(0);
    if constexpr (!ALIGN_EPI) { if (wr == 0) PG8_BAR; }
    PG8_BAR;
    if constexpr (Epi::AFTER_DRAIN) { E.fused(acc, cur, wr, wc, fr, fq, lds, wid, lane); S.done(cur); }
#undef PG8_SA
#undef PG8_SB
#undef PG8_STAGE
#undef PG8_LDA
#undef PG8_LDB
#undef PG8_MMA
#undef PG8_WAIT_V
#undef PG8_WAIT_L
#undef PG8_BAR
#undef PG8_SCHED
}
}
namespace pg8 {
typedef unsigned u32x2 __attribute__((ext_vector_type(2)));
typedef float f32x2_t __attribute__((ext_vector_type(2))); typedef __bf16 bf16x2_t __attribute__((ext_vector_type(2)));
__device__ __forceinline__ unsigned cvtpk(float lo, float hi) { f32x2_t v = {lo, hi}; bf16x2_t b = __builtin_convertvector(v, bf16x2_t); return __builtin_bit_cast(unsigned, b); }
__device__ __forceinline__ float sigm(float x) { return 1.0f / (1.0f + __expf(-x)); }
__device__ __forceinline__ float gelu_tanh(float x) { const float u = 1.5957691216057308f * (x + 0.044715f * x * x * x); return x / (1.0f + __expf(-u)); }
__device__ __forceinline__ float bfw(unsigned w, int hi) { return __uint_as_float(hi ? (w & 0xffff0000u) : (w << 16)); }
__device__ __forceinline__ float logsig(float z) { return fminf(z, 0.f) - log1pf(__expf(-fabsf(z))); }
__device__ __forceinline__ float dpp_ror1(float v) { return __int_as_float(__builtin_amdgcn_update_dpp(0, __float_as_int(v), 0x121, 0xf, 0xf, false)); }
__device__ __forceinline__ float dpp_ror2(float v) { return __int_as_float(__builtin_amdgcn_update_dpp(0, __float_as_int(v), 0x122, 0xf, 0xf, false)); }

struct EpiProj {
    static constexpr bool PERM = true, AFTER_DRAIN = false;
    bf16_t* O; int ldc; const float* ss;
    __device__ __forceinline__ void operator()(const f32x4 (&acc)[2][2][4][2], const Unit& u, int wr, int wc, int fr, int fq) const {
        const int row0 = u.pm * BM + wr * 64 + fr, col0 = u.pn * BM + wc * 32 + 8 * fq;
#pragma unroll
        for (int ai = 0; ai < 2; ++ai)
#pragma unroll
            for (int m = 0; m < 4; ++m) {
                const int row = row0 + ai * HALF + m * 16;
                const float rs = rsqrtf(ss[row] * (1.0f / 1024.0f) + 1e-6f);
                bf16_t* rowp = O + (size_t)row * ldc + col0;
#pragma unroll
                for (int bj = 0; bj < 2; ++bj) {
                    const f32x4 v0 = acc[ai][bj][m][0] * rs, v1 = acc[ai][bj][m][1] * rs;
                    u32x4 w; w.x = cvt_pk_bf16(v0[0], v0[1]); w.y = cvt_pk_bf16(v0[2], v0[3]); w.z = cvt_pk_bf16(v1[0], v1[1]); w.w = cvt_pk_bf16(v1[2], v1[3]);
                    *(u32x4*)(rowp + bj * HALF) = w;
                }
            }
    }
};

struct EpiGates {
    static constexpr bool PERM = true, AFTER_DRAIN = false;
    const bf16_t* xc; bf16_t* loga; bf16_t* gi; const float* ga_b; const float* gx_b; const float* lam;
    __device__ __forceinline__ void operator()(const f32x4 (&acc)[2][2][4][2], const Unit& u, int wr, int wc, int fr, int fq) const {
        const int row0 = u.pm * BM + wr * 64 + fr, ch0 = u.pn * HALF + wc * 32 + 8 * fq;
        float gab[8], gxb[8], ls[8];
#pragma unroll
        for (int e = 0; e < 8; ++e) { gab[e] = ga_b[ch0 + e]; gxb[e] = gx_b[ch0 + e]; ls[e] = 8.0f * logsig(lam[ch0 + e]); }
#pragma unroll
        for (int ai = 0; ai < 2; ++ai)
#pragma unroll
            for (int m = 0; m < 4; ++m) {
                const int row = row0 + ai * HALF + m * 16;
                const u32x4 xv = *(const u32x4*)(xc + (size_t)row * 512 + ch0);
                float la[8], g[8];
#pragma unroll
                for (int n = 0; n < 2; ++n)
#pragma unroll
                    for (int e = 0; e < 4; ++e) {
                        const int idx = 4 * n + e;
                        const float r = acc[ai][0][m][n][e] + gab[idx], i = acc[ai][1][m][n][e] + gxb[idx];
                        la[idx] = sigm(r) * ls[idx];
                        g[idx] = sigm(i) * bfw(xv[idx >> 1], idx & 1);
                    }
                u32x4 w; w.x = cvt_pk_bf16(la[0], la[1]); w.y = cvt_pk_bf16(la[2], la[3]); w.z = cvt_pk_bf16(la[4], la[5]); w.w = cvt_pk_bf16(la[6], la[7]);
                *(u32x4*)(loga + (size_t)row * 512 + ch0) = w;
                u32x4 w2; w2.x = cvt_pk_bf16(g[0], g[1]); w2.y = cvt_pk_bf16(g[2], g[3]); w2.z = cvt_pk_bf16(g[4], g[5]); w2.w = cvt_pk_bf16(g[6], g[7]);
                *(u32x4*)(gi + (size_t)row * 512 + ch0) = w2;
            }
    }
};

struct EpiRes {
    static constexpr bool PERM = false, AFTER_DRAIN = false;
    const float* base; float* out; bf16_t* xb; float* ss;
    __device__ __forceinline__ void operator()(const f32x4 (&acc)[2][2][4][2], const Unit& u, int wr, int wc, int fr, int fq) const {
        const int row0 = u.pm * BM + wr * 64 + fr, col0 = u.pn * BM + wc * 32 + 4 * fq;
#pragma unroll
        for (int ai = 0; ai < 2; ++ai)
#pragma unroll
            for (int m = 0; m < 4; ++m) {
                const int row = row0 + ai * HALF + m * 16; float q = 0.f;
#pragma unroll
                for (int bj = 0; bj < 2; ++bj)
#pragma unroll
                    for (int n = 0; n < 2; ++n) {
                        const size_t off = (size_t)row * 1024 + col0 + bj * HALF + n * 16;
                        const f32x4 b = *(const f32x4*)(base + off);
                        const f32x4 o = b + acc[ai][bj][m][n];
                        *(f32x4*)(out + off) = o;
                        if (xb) { u32x2 w; w.x = cvt_pk_bf16(o[0], o[1]); w.y = cvt_pk_bf16(o[2], o[3]); *(u32x2*)(xb + off) = w; }
                        q += (o[0] * o[0] + o[1] * o[1]) + (o[2] * o[2] + o[3] * o[3]);
                    }
                if (ss) { q += __shfl_xor(q, 16); q += __shfl_xor(q, 32); if (fq == 0) atomicAdd(ss + row, q); }
            }
    }
};

struct EpiGlu {
    static constexpr bool PERM = true, AFTER_DRAIN = false;
    const bf16_t* ys; bf16_t* ycat; const float* bias;
    __device__ __forceinline__ void operator()(const f32x4 (&acc)[2][2][4][2], const Unit& u, int wr, int wc, int fr, int fq) const {
        const int row0 = u.pm * BM + wr * 64 + fr, col0 = u.pn * BM + wc * 32 + 8 * fq;
#pragma unroll
        for (int bj = 0; bj < 2; ++bj) {
            const int col = col0 + bj * HALF;
            float bs[8];
#pragma unroll
            for (int e = 0; e < 8; ++e) bs[e] = bias[col + e];
#pragma unroll
            for (int ai = 0; ai < 2; ++ai)
#pragma unroll
                for (int m = 0; m < 4; ++m) {
                    const int row = row0 + ai * HALF + m * 16;
                    const u32x4 yv = *(const u32x4*)(ys + (size_t)row * 512 + col);
                    float o[8];
#pragma unroll
                    for (int n = 0; n < 2; ++n)
#pragma unroll
                        for (int e = 0; e < 4; ++e) { const int idx = 4 * n + e; o[idx] = bfw(yv[idx >> 1], idx & 1) * sigm(acc[ai][bj][m][n][e] + bs[idx]); }
                    u32x4 w; w.x = cvt_pk_bf16(o[0], o[1]); w.y = cvt_pk_bf16(o[2], o[3]); w.z = cvt_pk_bf16(o[4], o[5]); w.w = cvt_pk_bf16(o[6], o[7]);
                    *(u32x4*)(ycat + (size_t)row * 1024 + col) = w;
                }
        }
    }
};

struct EpiFfn {
    static constexpr bool PERM = true, AFTER_DRAIN = false;
    bf16_t* U; const float* ss; const float* cw; const float* cb; float* edgeA; float* edgeL; float* tailA; PG8_LAS float* halo;
    __device__ __forceinline__ void operator()(const f32x4 (&acc)[2][2][4][2], const Unit& u, int wr, int wc, int fr, int fq) const {
        const int cl = wc * 32 + 8 * fq, ch0 = u.pn * HALF + cl;
        const int row0 = u.pm * BM + wr * 64 + fr;
        float w0[8], w1[8], w2[8], bb[8];
#pragma unroll
        for (int e = 0; e < 8; ++e) { w0[e] = cw[ch0 + e]; w1[e] = cw[3072 + ch0 + e]; w2[e] = cw[6144 + ch0 + e]; bb[e] = cb[ch0 + e]; }
        float rs[2][4];
#pragma unroll
        for (int ai = 0; ai < 2; ++ai)
#pragma unroll
            for (int m = 0; m < 4; ++m) rs[ai][m] = rsqrtf(ss[row0 + ai * HALF + m * 16] * (1.0f / 1024.0f) + 1e-6f);
        if (fr >= 14) {
#pragma unroll
            for (int ai = 0; ai < 2; ++ai) {
                PG8_LAS float* hp = halo + ((ai * 2 + wr) * 2 + (fr - 14)) * 128 + cl;
                *(PG8_LAS f32x4*)hp = acc[ai][0][3][0] * rs[ai][3];
                *(PG8_LAS f32x4*)(hp + 4) = acc[ai][0][3][1] * rs[ai][3];
            }
            if (wr == 1) {
                float* tp = tailA + (size_t)(u.pm * 2 + (fr - 14)) * 3072 + ch0;
                *(f32x4*)tp = acc[1][0][3][0] * rs[1][3]; *(f32x4*)(tp + 4) = acc[1][0][3][1] * rs[1][3];
            }
        }
        if (wr == 0 && fr < 2) {
            float* ea = edgeA + (size_t)(u.pm * 2 + fr) * 3072 + ch0; float* el = edgeL + (size_t)(u.pm * 2 + fr) * 3072 + ch0;
            *(f32x4*)ea = acc[0][0][0][0] * rs[0][0]; *(f32x4*)(ea + 4) = acc[0][0][0][1] * rs[0][0];
            *(f32x4*)el = acc[0][1][0][0] * rs[0][0]; *(f32x4*)(el + 4) = acc[0][1][0][1] * rs[0][0];
        }
        asm volatile("s_waitcnt lgkmcnt(0)" ::: "memory"); __builtin_amdgcn_s_barrier(); asm volatile("" ::: "memory");
#pragma unroll
        for (int ai = 0; ai < 2; ++ai) {
            f32x4 pv[2];
            if (ai == 0 && wr == 0) { pv[0] = (f32x4){0.f, 0.f, 0.f, 0.f}; pv[1] = pv[0]; }
            else {
                const int pai = (wr == 1) ? ai : 0, pwr = (wr == 1) ? 0 : 1;
                const PG8_LAS float* hp = halo + ((pai * 2 + pwr) * 2 + (fr & 1)) * 128 + cl;
                pv[0] = *(const PG8_LAS f32x4*)hp; pv[1] = *(const PG8_LAS f32x4*)(hp + 4);
            }
#pragma unroll
            for (int m = 0; m < 4; ++m) {
                const int row = row0 + ai * HALF + m * 16;
                f32x4 av[2]; av[0] = acc[ai][0][m][0] * rs[ai][m]; av[1] = acc[ai][0][m][1] * rs[ai][m];
                float o[8];
#pragma unroll
                for (int n = 0; n < 2; ++n)
#pragma unroll
                    for (int e = 0; e < 4; ++e) {
                        const int idx = 4 * n + e;
                        const float cur = av[n][e], prv = pv[n][e];
                        const float r1c = dpp_ror1(cur), r1p = dpp_ror1(prv), r2c = dpp_ror2(cur), r2p = dpp_ror2(prv);
                        const float t1 = (fr >= 1) ? r1c : r1p, t2 = (fr >= 2) ? r2c : r2p;
                        const float cv = w0[idx] * t2 + w1[idx] * t1 + w2[idx] * cur + bb[idx];
                        o[idx] = gelu_tanh(cv) * (acc[ai][1][m][n][e] * rs[ai][m]);
                    }
                u32x4 w; w.x = cvt_pk_bf16(o[0], o[1]); w.y = cvt_pk_bf16(o[2], o[3]); w.z = cvt_pk_bf16(o[4], o[5]); w.w = cvt_pk_bf16(o[6], o[7]);
                *(u32x4*)(U + (size_t)row * 3072 + ch0) = w;
                pv[0] = av[0]; pv[1] = av[1];
            }
        }
    }
};
}
#define LAS __attribute__((address_space(3)))
typedef unsigned short bf16;
typedef short bf16x8 __attribute__((ext_vector_type(8)));
typedef float f32x4 __attribute__((ext_vector_type(4)));
typedef unsigned u32x4 __attribute__((ext_vector_type(4)));
typedef unsigned u32x2 __attribute__((ext_vector_type(2)));
using pg8::cvt_pk_bf16; using pg8::sigm; using pg8::gelu_tanh; using pg8::bfw; using pg8::logsig;

constexpr int TT = 16384, SEQ = 8192, DM = 1024, DFF = 3072;
constexpr size_t MiB = 1u << 20;
constexpr size_t WS_SS = 0;
constexpr size_t WS_SUMA = 256 * 1024, WS_SUMB = 768 * 1024;
constexpr size_t WS_DECAY = 1280 * 1024;
constexpr size_t WS_W_EIN = 4 * MiB, WS_W_EOUT = 9 * MiB, WS_W_GATE = 11 * MiB, WS_W_FIN0 = 12 * MiB, WS_W_FIN1 = 24 * MiB, WS_W_FOUT0 = 36 * MiB, WS_W_FOUT1 = 42 * MiB;
constexpr size_t WS_W_OIN = 48 * MiB, WS_W_GLU = 53 * MiB, WS_W_OOUT = 54 * MiB, WS_S5A = 56 * MiB, WS_S5F = 62 * MiB;
constexpr size_t WS_XB = 64 * MiB;
constexpr size_t WS_LOGA = 64 * MiB, WS_GI = 80 * MiB;
constexpr size_t WS_KDT = 64 * MiB, WS_VTG = 72 * MiB, WS_SX = 88 * MiB;
constexpr size_t WS_BIG = 96 * MiB;
constexpr size_t WS_XC = 176 * MiB, WS_KVS = 168 * MiB;
constexpr size_t WS_YCAT = 192 * MiB;
constexpr size_t WS_XLOC = 224 * MiB;
constexpr size_t WS_EDGEA = 240 * MiB, WS_EDGEL = 242 * MiB, WS_TAILA = 244 * MiB;
constexpr size_t WS_END = 256 * MiB;
constexpr int P0LD = 2560, P1LD = 2304;
constexpr int LDS_BYTES = 147456, HALO_OFF = 131072 + 1024;

__device__ __forceinline__ float wave_sum(float v) {
#pragma unroll
    for (int o = 1; o < 64; o <<= 1) v += __shfl_xor(v, o);
    return v;
}
__device__ __forceinline__ float bf2f(bf16 b) { return __uint_as_float((unsigned)b << 16); }
__device__ __forceinline__ bf16 f2bf(float f) { return (bf16)(cvt_pk_bf16(f, 0.f) & 0xffffu); }
__device__ __forceinline__ f32x4 mfma16(bf16x8 a, bf16x8 b, f32x4 c) { return __builtin_amdgcn_mfma_f32_16x16x32_bf16(a, b, c, 0, 0, 0); }
__device__ __forceinline__ bf16x8 ld8(const bf16* p) { return *(const bf16x8*)p; }
__device__ __forceinline__ void unpack8(u32x4 v, float* f) {
#pragma unroll
    for (int i = 0; i < 4; ++i) { f[2 * i] = __uint_as_float(v[i] << 16); f[2 * i + 1] = __uint_as_float(v[i] & 0xffff0000u); }
}
__device__ __forceinline__ u32x4 pack8(const float* f) { u32x4 w; w.x = cvt_pk_bf16(f[0], f[1]); w.y = cvt_pk_bf16(f[2], f[3]); w.z = cvt_pk_bf16(f[4], f[5]); w.w = cvt_pk_bf16(f[6], f[7]); return w; }

struct Ctx { int tid, lane, wave, gw, ngw, gtid, ngt; LAS unsigned char* lds; };

__device__ __forceinline__ void tr_item(const float* W, int ldw, int nsrc, const float* gk, bf16* WT, int ldt, int k0, int n0, int dst_row0, LAS float* scr, int lane) {
#pragma unroll 8
    for (int i = 0; i < 32; ++i) {
        const int kk = 2 * i + (lane >> 5), n = n0 + (lane & 31);
        float v = (n < nsrc) ? W[(size_t)(k0 + kk) * ldw + n] : 0.f;
        if (gk) v *= gk[k0 + kk];
        scr[kk * 33 + (lane & 31)] = v;
    }
    asm volatile("s_waitcnt lgkmcnt(0)" ::: "memory");
    const int c = lane & 7;
#pragma unroll
    for (int j = 0; j < 4; ++j) {
        const int n = (lane >> 3) + 8 * j; const LAS float* s = scr + (8 * c) * 33 + n;
        u32x4 o; o.x = cvt_pk_bf16(s[0], s[33]); o.y = cvt_pk_bf16(s[66], s[99]); o.z = cvt_pk_bf16(s[132], s[165]); o.w = cvt_pk_bf16(s[198], s[231]);
        *(u32x4*)(WT + (size_t)(dst_row0 + n) * ldt + k0 + 8 * c) = o;
    }
    asm volatile("s_waitcnt lgkmcnt(0)" ::: "memory");
}

struct S5P { float m, th, cr, ci; };
__device__ __forceinline__ S5P s5_params(const float* lam_re, const float* lam_im, const float* log_step, int g, int n) {
    const float step = expf(log_step[g]), lr = lam_re[g * 64 + n], li = lam_im[g * 64 + n];
    S5P p; p.m = lr * step; p.th = li * step;
    float sn, cs; sincosf(p.th, &sn, &cs);
    const float mag = expf(p.m), ar = mag * cs, ai = mag * sn, den = lr * lr + li * li;
    p.cr = ((ar - 1.0f) * lr + ai * li) / den; p.ci = (ai * lr - (ar - 1.0f) * li) / den;
    return p;
}
__device__ __forceinline__ void s5_pow(const S5P& p, float tau, float& pr, float& pi) {
    float sn, cs; sincosf(p.th * tau, &sn, &cs); const float mag = expf(p.m * tau); pr = mag * cs; pi = mag * sn;
}

__device__ __forceinline__ void phase_prologue(const Ctx& c, const float* const* in, unsigned char* ws) {
    LAS float* scr = (LAS float*)(c.lds + c.wave * 16384);
    constexpr int I_EIN = 16 * 80, I_EOUT = 16 * 32, I_FIN = 16 * 192, I_FOUT = 48 * 32, I_OIN = 16 * 72, I_GLU = 8 * 16, I_OOUT = 16 * 32;
    constexpr int NITEMS = I_EIN + I_EOUT + 2 * I_FIN + 2 * I_FOUT + I_OIN + I_GLU + I_OOUT;
    for (int it = c.gw; it < NITEMS; it += c.ngw) {
        int r = it;
        if (r < I_EIN) { const int kb = r / 80, nb = r % 80; tr_item(in[2], 2560, 2560, in[1], (bf16*)(ws + WS_W_EIN), 1024, 64 * kb, 32 * nb, 32 * nb, scr, c.lane); continue; } r -= I_EIN;
        if (r < I_EOUT) { const int kb = r / 32, nb = r % 32; tr_item(in[12], 1024, 1024, nullptr, (bf16*)(ws + WS_W_EOUT), 1024, 64 * kb, 32 * nb, 32 * nb, scr, c.lane); continue; } r -= I_EOUT;
        if (r < 2 * I_FIN) { const int l = r / I_FIN; r %= I_FIN; const int kb = r / 192, nb = r % 192, n0 = 32 * nb;
            const int dst = (n0 < 3072) ? (256 * (n0 / 128) + (n0 % 128)) : (256 * ((n0 - 3072) / 128) + 128 + ((n0 - 3072) % 128));
            tr_item(in[30] + (size_t)l * 1024 * 6144, 6144, 6144, in[29] + l * 1024, (bf16*)(ws + (l ? WS_W_FIN1 : WS_W_FIN0)), 1024, 64 * kb, n0, dst, scr, c.lane); continue; } r -= 2 * I_FIN;
        if (r < 2 * I_FOUT) { const int l = r / I_FOUT; r %= I_FOUT; const int kb = r / 32, nb = r % 32;
            tr_item(in[33] + (size_t)l * 3072 * 1024, 1024, 1024, nullptr, (bf16*)(ws + (l ? WS_W_FOUT1 : WS_W_FOUT0)), 3072, 64 * kb, 32 * nb, 32 * nb, scr, c.lane); continue; } r -= 2 * I_FOUT;
        if (r < I_OIN) { const int kb = r / 72, nb = r % 72; tr_item(in[14], 2064, 2064, in[13], (bf16*)(ws + WS_W_OIN), 1024, 64 * kb, 32 * nb, 32 * nb, scr, c.lane); continue; } r -= I_OIN;
        if (r < I_GLU) { const int kb = r / 16, nb = r % 16; tr_item(in[23], 512, 512, nullptr, (bf16*)(ws + WS_W_GLU), 512, 64 * kb, 32 * nb, 32 * nb, scr, c.lane); continue; } r -= I_GLU;
        { const int kb = r / 32, nb = r % 32; tr_item(in[28], 1024, 1024, nullptr, (bf16*)(ws + WS_W_OOUT), 1024, 64 * kb, 32 * nb, 32 * nb, scr, c.lane); }
    }
    {
        const float* x = in[0]; bf16* xb = (bf16*)(ws + WS_XB); float* ss = (float*)(ws + WS_SS);
        for (int m = c.gw; m < TT; m += c.ngw) {
            const f32x4* xr = (const f32x4*)(x + (size_t)m * DM) + c.lane; float s = 0.f;
            u32x2* o8 = (u32x2*)(xb + (size_t)m * DM) + c.lane;
#pragma unroll
            for (int j = 0; j < 4; ++j) { const f32x4 v = xr[64 * j]; s += (v.x * v.x + v.y * v.y) + (v.z * v.z + v.w * v.w); u32x2 w; w.x = cvt_pk_bf16(v.x, v.y); w.y = cvt_pk_bf16(v.z, v.w); o8[64 * j] = w; }
            s = wave_sum(s);
            if (c.lane == 0) ss[m] = s;
        }
        for (int i = c.gtid; i < 3 * TT; i += c.ngt) ss[TT + i] = 0.f;
    }
    {
        bf16* G = (bf16*)(ws + WS_W_GATE);
        for (int i = c.gtid; i < 1024 * 512; i += c.ngt) {
            const int R = i >> 9, k = i & 511, pn = R >> 8, half = (R >> 7) & 1, ch = 128 * pn + (R & 127), h = ch >> 6, j = ch & 63;
            float v = 0.f;
            if ((k >> 6) == h) v = (half ? in[7] : in[5])[(h * 64 + (k & 63)) * 64 + j];
            G[i] = f2bf(v);
        }
    }
    {
        const float *lam_re = in[15], *lam_im = in[16], *b_re = in[17], *b_im = in[18], *c_re = in[19], *c_im = in[20], *lstep = in[22];
        bf16* AM = (bf16*)(ws + WS_S5A);
        bf16* FM = (bf16*)(ws + WS_S5F);
        for (int i = c.gtid; i < 32 * 16 * 256; i += c.ngt) {
            const int g = i >> 12, tau = (i >> 8) & 15, p = (i >> 4) & 15, pp = i & 15;
            float acc = 0.f;
            for (int n = 0; n < 64; ++n) {
                const S5P sp = s5_params(lam_re, lam_im, lstep, g, n);
                float pr, pi; s5_pow(sp, (float)tau, pr, pi);
                const float br = b_re[(g * 64 + n) * 16 + pp], bi = b_im[(g * 64 + n) * 16 + pp];
                const float bbr = sp.cr * br - sp.ci * bi, bbi = sp.cr * bi + sp.ci * br;
                const float wr_ = pr * bbr - pi * bbi, wi_ = pr * bbi + pi * bbr;
                acc += c_re[(g * 16 + p) * 64 + n] * wr_ - c_im[(g * 16 + p) * 64 + n] * wi_;
            }
            const bf16 kv = f2bf(acc);
            bf16* Ag = AM + (size_t)g * 256 * 384;
            for (int t = tau; t < 16; ++t) Ag[(t * 16 + p) * 384 + (t - tau) * 16 + pp] = kv;
            if (tau >= 1) for (int t = 0; t + tau < 16; ++t) Ag[(t * 16 + p) * 384 + (t + tau) * 16 + pp] = 0;
        }
        for (int i = c.gtid; i < 32 * 16 * 16 * 64; i += c.ngt) {
            const int g = i >> 14, t = (i >> 10) & 15, p = (i >> 6) & 15, n = i & 63;
            const S5P sp = s5_params(lam_re, lam_im, lstep, g, n);
            float pr, pi; s5_pow(sp, (float)(t + 1), pr, pi);
            const float cr_ = c_re[(g * 16 + p) * 64 + n], ci_ = c_im[(g * 16 + p) * 64 + n];
            bf16* row = AM + ((size_t)g * 256 + t * 16 + p) * 384 + 256;
            row[n] = f2bf(cr_ * pr - ci_ * pi);
            row[64 + n] = f2bf(-(cr_ * pi + ci_ * pr));
        }
        for (int i = c.gtid; i < 32 * 64 * 256; i += c.ngt) {
            const int g = i >> 14, n = (i >> 8) & 63, s = (i >> 4) & 15, pp = i & 15;
            const S5P sp = s5_params(lam_re, lam_im, lstep, g, n);
            float pr, pi; s5_pow(sp, (float)(15 - s), pr, pi);
            const float br = b_re[(g * 64 + n) * 16 + pp], bi = b_im[(g * 64 + n) * 16 + pp];
            const float bbr = sp.cr * br - sp.ci * bi, bbi = sp.cr * bi + sp.ci * br;
            FM[((size_t)g * 128 + n) * 256 + s * 16 + pp] = f2bf(pr * bbr - pi * bbi);
            FM[((size_t)g * 128 + 64 + n) * 256 + s * 16 + pp] = f2bf(pr * bbi + pi * bbr);
        }
    }
}

__device__ __forceinline__ void vt_item(const bf16* src, int pitch, int coloff, int hd, int nh, bf16* dst, int sh, int item, int lane) {
    const int cgp = item & 1023; int r = item >> 10; const int nblk = hd >> 6, dblk = r % nblk, bh = r / nblk, b = bh / nh, h = bh % nh;
    const int d = dblk * 64 + lane, Ld = SEQ >> sh;
    const bf16* s = src + (size_t)b * SEQ * pitch + coloff + h * hd + d;
    unsigned short v[8];
#pragma unroll
    for (int i = 0; i < 8; ++i) { const int col = cgp * 8 + i, rres = col / Ld, l = col - rres * Ld, t = (l << sh) + rres; v[i] = s[(size_t)t * pitch]; }
    u32x4 w; w.x = v[0] | ((unsigned)v[1] << 16); w.y = v[2] | ((unsigned)v[3] << 16); w.z = v[4] | ((unsigned)v[5] << 16); w.w = v[6] | ((unsigned)v[7] << 16);
    *(u32x4*)(dst + ((size_t)bh * hd + d) * SEQ + cgp * 8) = w;
}

__device__ __forceinline__ void phase_prep0(const Ctx& c, const float* const* in, unsigned char* ws, float* dout) {
    bf16* P0 = (bf16*)(ws + WS_BIG); bf16* XC = (bf16*)(ws + WS_XC);
    const float* cw = in[3]; const float* cbias = in[4];
    for (int i = c.gtid; i < TT * 64; i += c.ngt) {
        const int t = i >> 6, c0 = (i & 63) * 8, tl = t & (SEQ - 1);
        float acc[8];
#pragma unroll
        for (int e = 0; e < 8; ++e) acc[e] = cbias[c0 + e];
#pragma unroll
        for (int j = 0; j < 4; ++j) {
            if (tl - 3 + j >= 0) {
                float v[8]; unpack8(*(const u32x4*)(P0 + (size_t)(t - 3 + j) * P0LD + c0), v);
#pragma unroll
                for (int e = 0; e < 8; ++e) acc[e] += cw[j * 512 + c0 + e] * v[e];
            }
        }
        *(u32x4*)(XC + (size_t)t * 512 + c0) = pack8(acc);
    }
    for (int it = c.gw; it < 2 * TT; it += c.ngw) {
        const int t = it >> 1, which = it & 1, sub = c.lane & 7;
        bf16* p = P0 + (size_t)t * P0LD + 1024 + which * 512 + c.lane * 8;
        float v[8]; unpack8(*(const u32x4*)p, v);
        float s = 0.f;
#pragma unroll
        for (int e = 0; e < 8; ++e) s += v[e] * v[e];
        s += __shfl_xor(s, 1); s += __shfl_xor(s, 2); s += __shfl_xor(s, 4);
        const float rs = rsqrtf(s * (1.0f / 64.0f) + 1e-6f);
        const float* gn = (which ? in[11] : in[10]) + sub * 8;
#pragma unroll
        for (int e = 0; e < 8; ++e) v[e] = v[e] * rs * gn[e];
        float oth[8];
#pragma unroll
        for (int e = 0; e < 8; ++e) oth[e] = __shfl_xor(v[e], 1);
        if (sub < 2) {
            const float pos = (float)(t & (SEQ - 1));
#pragma unroll
            for (int e = 0; e < 8; ++e) {
                const float inv = powf(500000.0f, -(float)e * 0.125f);
                float sn, cs; sincosf(pos * inv, &sn, &cs);
                v[e] = (sub == 0) ? (v[e] * cs - oth[e] * sn) : (v[e] * cs + oth[e] * sn);
            }
        }
        *(u32x4*)p = pack8(v);
    }
    bf16* VT3 = (bf16*)dout;
    for (int it = c.gw; it < 3 * 16 * 1024; it += c.ngw) {
        const int p = it / (16 * 1024), r = it % (16 * 1024);
        vt_item(P0, P0LD, 2048, 64, 8, VT3 + (size_t)p * (16 * 64 * SEQ), 2 * p, r, c.lane);
    }
}

__device__ __forceinline__ void attn_item(const bf16* P0, const bf16* VT3, bf16* ycat, int item, int lane) {
    const int lb = item & 31, r16 = (item >> 5) & 15, h = (item >> 9) & 7, b = item >> 12;
    const int qi = lane & 15, g = lane >> 4;
    const int tq = r16 + 16 * (16 * lb + qi);
    const bf16* qrow = P0 + (size_t)(b * SEQ + tq) * P0LD + 1024 + h * 64;
    const bf16x8 qf0 = ld8(qrow + 8 * g), qf1 = ld8(qrow + 32 + 8 * g);
    f32x4 o[4];
#pragma unroll
    for (int dt = 0; dt < 4; ++dt) o[dt] = (f32x4){0.f, 0.f, 0.f, 0.f};
    float m = -1e30f, l = 0.f;
    const float cs = 0.125f * 1.4426950408889634f;
    const int rho_off = 8 * (qi >> 2) + (qi & 3);
    for (int p = 0; p < 3; ++p) {
        const int sh = 2 * p, rres = r16 & ((1 << sh) - 1), Ld = SEQ >> sh;
        const int lq = tq >> sh, lq0 = (r16 + 256 * lb) >> sh, lq15 = (r16 + 256 * lb + 240) >> sh;
        int sb0 = lq0 - 128; if (sb0 < 0) sb0 = 0; sb0 &= ~31;
        const int sbend = lq15 & ~31;
        const bf16* kbase = P0 + (size_t)(b * SEQ + rres) * P0LD + 1536 + h * 64 + 8 * g;
        const bf16* vbase = VT3 + (size_t)p * (16 * 64 * SEQ) + ((size_t)((b * 8 + h) * 64 + qi)) * SEQ + rres * Ld + 8 * g;
        for (int sb = sb0; sb <= sbend; sb += 32) {
            const bf16* kx = kbase + ((size_t)(sb + rho_off) << sh) * P0LD;
            const bf16* ky = kx + ((size_t)4 << sh) * P0LD;
            const bf16x8 kx0 = ld8(kx), kx1 = ld8(kx + 32), ky0 = ld8(ky), ky1 = ld8(ky + 32);
            bf16x8 vf[4];
#pragma unroll
            for (int dt = 0; dt < 4; ++dt) vf[dt] = ld8(vbase + (size_t)dt * 16 * SEQ + sb);
            f32x4 sx = mfma16(kx0, qf0, (f32x4){0.f, 0.f, 0.f, 0.f}); sx = mfma16(kx1, qf1, sx);
            f32x4 sy = mfma16(ky0, qf0, (f32x4){0.f, 0.f, 0.f, 0.f}); sy = mfma16(ky1, qf1, sy);
            const int kb = sb + 8 * g;
            bool vx[4], vy[4]; float mx = -1e30f;
#pragma unroll
            for (int r = 0; r < 4; ++r) {
                vx[r] = (unsigned)(lq - (kb + r)) <= 128u; vy[r] = (unsigned)(lq - (kb + 4 + r)) <= 128u;
                if (vx[r]) mx = fmaxf(mx, sx[r]);
                if (vy[r]) mx = fmaxf(mx, sy[r]);
            }
            mx = fmaxf(mx, __shfl_xor(mx, 16)); mx = fmaxf(mx, __shfl_xor(mx, 32));
            const float mn = fmaxf(m, mx), alpha = exp2f((m - mn) * cs); m = mn;
            float pe[8]; float ps = 0.f;
#pragma unroll
            for (int r = 0; r < 4; ++r) { pe[r] = vx[r] ? exp2f((sx[r] - mn) * cs) : 0.f; pe[4 + r] = vy[r] ? exp2f((sy[r] - mn) * cs) : 0.f; ps += pe[r] + pe[4 + r]; }
            l = l * alpha + ps;
            const u32x4 pw = pack8(pe);
            const bf16x8 pf = __builtin_bit_cast(bf16x8, pw);
#pragma unroll
            for (int dt = 0; dt < 4; ++dt) { o[dt] = o[dt] * alpha; o[dt] = mfma16(vf[dt], pf, o[dt]); }
        }
    }
    l += __shfl_xor(l, 16); l += __shfl_xor(l, 32);
    const float inv = 1.0f / l;
    bf16* orow = ycat + (size_t)(b * SEQ + tq) * 1024 + 512 + h * 64 + 4 * g;
#pragma unroll
    for (int dt = 0; dt < 4; ++dt) { u32x2 w; w.x = cvt_pk_bf16(o[dt][0] * inv, o[dt][1] * inv); w.y = cvt_pk_bf16(o[dt][2] * inv, o[dt][3] * inv); *(u32x2*)(orow + 16 * dt) = w; }
}

__device__ __forceinline__ void phase_lru_a(const Ctx& c, unsigned char* ws) {
    const bf16* LA = (const bf16*)(ws + WS_LOGA); const bf16* GI = (const bf16*)(ws + WS_GI);
    float* SA = (float*)(ws + WS_SUMA); float* SB = (float*)(ws + WS_SUMB);
    for (int ch = blockIdx.x; ch < 256; ch += gridDim.x) {
        const int t0 = ch * 64, cn = c.tid; float h = 0.f, P = 1.f;
#pragma unroll 8
        for (int t = 0; t < 64; ++t) {
            const float la = bf2f(LA[(size_t)(t0 + t) * 512 + cn]), gi = bf2f(GI[(size_t)(t0 + t) * 512 + cn]);
            const float a = __expf(la), bq = sqrtf(fmaxf(-expm1f(2.0f * la), 0.f)) * gi;
            h = a * h + bq; P *= a;
        }
        SA[ch * 512 + cn] = P; SB[ch * 512 + cn] = h;
    }
}
__device__ __forceinline__ void phase_lru_b(const Ctx& c, unsigned char* ws) {
    const bf16* LA = (const bf16*)(ws + WS_LOGA); const bf16* GI = (const bf16*)(ws + WS_GI);
    const float* SA = (const float*)(ws + WS_SUMA); const float* SB = (const float*)(ws + WS_SUMB);
    const bf16* P0 = (const bf16*)(ws + WS_BIG); bf16* ycat = (bf16*)(ws + WS_YCAT);
    for (int ch = blockIdx.x; ch < 256; ch += gridDim.x) {
        const int t0 = ch * 64, cn = c.tid; float h = 0.f;
        for (int j = ch & ~127; j < ch; ++j) h = SA[j * 512 + cn] * h + SB[j * 512 + cn];
#pragma unroll 8
        for (int t = 0; t < 64; ++t) {
            const float la = bf2f(LA[(size_t)(t0 + t) * 512 + cn]), gi = bf2f(GI[(size_t)(t0 + t) * 512 + cn]);
            const float a = __expf(la), bq = sqrtf(fmaxf(-expm1f(2.0f * la), 0.f)) * gi;
            h = a * h + bq;
            const float gl = bf2f(P0[(size_t)(t0 + t) * P0LD + 512 + cn]);
            ycat[(size_t)(t0 + t) * 1024 + cn] = f2bf(h * gelu_tanh(gl));
        }
    }
}

__device__ __forceinline__ void phase_fixup(const Ctx& c, unsigned char* ws, const float* cw, const float* cb) {
    const float* EA = (const float*)(ws + WS_EDGEA); const float* EL = (const float*)(ws + WS_EDGEL); const float* TA = (const float*)(ws + WS_TAILA);
    bf16* U = (bf16*)(ws + WS_BIG);
    for (int i = c.gtid; i < 64 * 3072; i += c.ngt) {
        const int pm = i / 3072, col = i % 3072;
        if ((pm & 31) == 0) continue;
        const float tm2 = TA[(size_t)((pm - 1) * 2 + 0) * 3072 + col], tm1 = TA[(size_t)((pm - 1) * 2 + 1) * 3072 + col];
        const float a0 = EA[(size_t)(pm * 2) * 3072 + col], a1 = EA[(size_t)(pm * 2 + 1) * 3072 + col];
        const float l0 = EL[(size_t)(pm * 2) * 3072 + col], l1 = EL[(size_t)(pm * 2 + 1) * 3072 + col];
        const float w0 = cw[col], w1 = cw[3072 + col], w2 = cw[6144 + col], bb = cb[col];
        U[(size_t)(pm * 256) * 3072 + col] = f2bf(gelu_tanh(w0 * tm2 + w1 * tm1 + w2 * a0 + bb) * l0);
        U[(size_t)(pm * 256 + 1) * 3072 + col] = f2bf(gelu_tanh(w0 * tm1 + w1 * a0 + w2 * a1 + bb) * l1);
    }
}
__device__ __forceinline__ void phase_gla_prep(const Ctx& c, const float* const* in, unsigned char* ws) {
    bf16* P1 = (bf16*)(ws + WS_BIG); bf16* KDT = (bf16*)(ws + WS_KDT); float* DEC = (float*)(ws + WS_DECAY);
    const float* gkw = in[25]; const float* gkb = in[26];
    for (int i = c.gtid; i < 256 * 256; i += c.ngt) {
        const int chunk = i >> 8, chn = i & 255, t0 = chunk * 64, b = chunk >> 7, h = chn >> 6, d = chn & 63;
        float w[16];
#pragma unroll
        for (int k = 0; k < 16; ++k) w[k] = gkw[k * 256 + chn];
        const float bias = gkb[chn];
        float kin[64]; float bc = 0.f;
#pragma unroll
        for (int t = 0; t < 64; ++t) {
            bf16* row = P1 + (size_t)(t0 + t) * P1LD;
            float lr[16]; unpack8(*(const u32x4*)(row + 2048), lr); unpack8(*(const u32x4*)(row + 2056), lr + 8);
            float z = bias;
#pragma unroll
            for (int k = 0; k < 16; ++k) z += lr[k] * w[k];
            bc += logsig(z) * (1.0f / 16.0f);
            const float q = bf2f(row[512 + chn]), kk = bf2f(row[768 + chn]);
            row[512 + chn] = f2bf(q * 0.125f * __expf(bc));
            kin[t] = kk * __expf(-bc);
            row[768 + chn] = f2bf(kin[t]);
        }
        const float eb = __expf(bc);
        DEC[chunk * 256 + chn] = eb;
        bf16* kd = KDT + ((size_t)((b * 4 + h) * 64 + d)) * SEQ + (t0 & (SEQ - 1));
#pragma unroll
        for (int t8 = 0; t8 < 8; ++t8) {
            float f[8];
#pragma unroll
            for (int e = 0; e < 8; ++e) f[e] = kin[t8 * 8 + e] * eb;
            *(u32x4*)(kd + t8 * 8) = pack8(f);
        }
    }
}

__device__ __forceinline__ void s5_bfrags(const bf16* P1, int g, int jb, int lane, bf16x8* bu) {
    const int jl = lane & 15, gq = lane >> 4;
#pragma unroll
    for (int ks = 0; ks < 8; ++ks) {
        const int s = 2 * ks + (gq >> 1), p0 = 8 * (gq & 1);
        bu[ks] = ld8(P1 + (size_t)((16 * jb + jl) * 16 + s) * P1LD + 16 * g + p0);
    }
}
__device__ __forceinline__ void s5a_item(const bf16* P1, const bf16* FM, float* XL, int item, int lane) {
    const int g = item >> 6, jb = item & 63, jl = lane & 15, gq = lane >> 4;
    bf16x8 bu[8]; s5_bfrags(P1, g, jb, lane, bu);
    const bf16* Fg = FM + (size_t)g * 128 * 256;
#pragma unroll
    for (int zt = 0; zt < 8; ++zt) {
        f32x4 acc = (f32x4){0.f, 0.f, 0.f, 0.f};
#pragma unroll
        for (int ks = 0; ks < 8; ++ks) acc = mfma16(ld8(Fg + (size_t)(16 * zt + jl) * 256 + 32 * ks + 8 * gq), bu[ks], acc);
        *(f32x4*)(XL + ((size_t)g * 1024 + 16 * jb + jl) * 128 + 16 * zt + 4 * gq) = acc;
    }
}
__device__ __forceinline__ void phase_s5_scan(const Ctx& c, const float* const* in, unsigned char* ws) {
    const float* XL = (const float*)(ws + WS_XLOC); bf16* SX = (bf16*)(ws + WS_SX);
    for (int i = c.gtid; i < 2 * 32 * 64; i += c.ngt) {
        const int n = i & 63, g = (i >> 6) & 31, b = i >> 11;
        const S5P sp = s5_params(in[15], in[16], in[22], g, n);
        float ar, ai; s5_pow(sp, 16.0f, ar, ai);
        float xr = 0.f, xi = 0.f;
        for (int j = 0; j < 512; ++j) {
            const size_t o = ((size_t)g * 1024 + b * 512 + j) * 128;
            SX[o + n] = f2bf(xr); SX[o + 64 + n] = f2bf(xi);
            const float lr = XL[o + n], li = XL[o + 64 + n];
            const float nr = ar * xr - ai * xi + lr, ni = ar * xi + ai * xr + li;
            xr = nr; xi = ni;
        }
    }
}
__device__ __forceinline__ void s5c_item(const bf16* P1, const bf16* AM, const bf16* SX, const float* dvec, bf16* YS, int item, int lane) {
    const int g = item >> 6, jb = item & 63, jl = lane & 15, gq = lane >> 4;
    bf16x8 bu[12]; s5_bfrags(P1, g, jb, lane, bu);
#pragma unroll
    for (int ks = 0; ks < 4; ++ks) bu[8 + ks] = ld8(SX + ((size_t)g * 1024 + 16 * jb + jl) * 128 + 32 * ks + 8 * gq);
    const bf16* Ag = AM + (size_t)g * 256 * 384;
    float dv[4];
#pragma unroll
    for (int e = 0; e < 4; ++e) dv[e] = dvec[16 * g + 4 * gq + e];
#pragma unroll 4
    for (int rt = 0; rt < 16; ++rt) {
        f32x4 acc = (f32x4){0.f, 0.f, 0.f, 0.f};
#pragma unroll
        for (int ks = 0; ks < 12; ++ks) acc = mfma16(ld8(Ag + (size_t)(16 * rt + jl) * 384 + 32 * ks + 8 * gq), bu[ks], acc);
        const size_t tok = (size_t)(16 * jb + jl) * 16 + rt;
        const u32x2 uv = *(const u32x2*)(P1 + tok * P1LD + 16 * g + 4 * gq);
        float o[4];
#pragma unroll
        for (int e = 0; e < 4; ++e) { const float y = acc[e] + dv[e] * bfw(uv[e >> 1], e & 1); o[e] = gelu_tanh(y); }
        u32x2 w; w.x = cvt_pk_bf16(o[0], o[1]); w.y = cvt_pk_bf16(o[2], o[3]);
        *(u32x2*)(YS + tok * 512 + 16 * g + 4 * gq) = w;
    }
}

__device__ __forceinline__ void gla_kv_item(const bf16* KDT, const bf16* VTG, bf16* KVS, int item, int lane) {
    const int cc = item & 127, h = (item >> 7) & 3, b = item >> 9, jl = lane & 15, gq = lane >> 4;
    const bf16* kd = KDT + ((size_t)((b * 4 + h) * 64 + jl)) * SEQ + 64 * cc + 8 * gq;
    const bf16* vt = VTG + ((size_t)((b * 4 + h) * 128 + jl)) * SEQ + 64 * cc + 8 * gq;
    bf16x8 af[4][2];
#pragma unroll
    for (int dt = 0; dt < 4; ++dt)
#pragma unroll
        for (int ks = 0; ks < 2; ++ks) af[dt][ks] = ld8(kd + (size_t)dt * 16 * SEQ + 32 * ks);
    bf16* out = KVS + ((size_t)(((b * 128 + cc) * 4 + h) * 128 + jl)) * 64 + 4 * gq;
#pragma unroll
    for (int et = 0; et < 8; ++et) {
        const bf16x8 b0 = ld8(vt + (size_t)et * 16 * SEQ), b1 = ld8(vt + (size_t)et * 16 * SEQ + 32);
#pragma unroll
        for (int dt = 0; dt < 4; ++dt) {
            f32x4 acc = mfma16(af[dt][0], b0, (f32x4){0.f, 0.f, 0.f, 0.f}); acc = mfma16(af[dt][1], b1, acc);
            u32x2 w; w.x = pg8::cvtpk(acc[0], acc[1]); w.y = pg8::cvtpk(acc[2], acc[3]);
            *(u32x2*)(out + (size_t)et * 16 * 64 + 16 * dt) = w;
        }
    }
}
__device__ __forceinline__ void phase_gla_scan(const Ctx& c, unsigned char* ws) {
    bf16* KVS = (bf16*)(ws + WS_KVS); const float* DEC = (const float*)(ws + WS_DECAY);
    for (int i = c.gtid; i < 2 * 4 * 128 * 16; i += c.ngt) {
        const int dq = i & 15, e = (i >> 4) & 127, h = (i >> 11) & 3, b = i >> 13;
        float s0 = 0.f, s1 = 0.f, s2 = 0.f, s3 = 0.f;
        for (int cc = 0; cc < 128; ++cc) {
            const int cg_ = b * 128 + cc;
            bf16* p = KVS + ((size_t)((cg_ * 4 + h) * 128 + e)) * 64 + 4 * dq;
            const u32x2 kv = *(const u32x2*)p;
            const f32x4 dc = *(const f32x4*)(DEC + cg_ * 256 + h * 64 + 4 * dq);
            u32x2 w; w.x = cvt_pk_bf16(s0, s1); w.y = cvt_pk_bf16(s2, s3); *(u32x2*)p = w;
            s0 = dc[0] * s0 + bfw(kv[0], 0); s1 = dc[1] * s1 + bfw(kv[0], 1); s2 = dc[2] * s2 + bfw(kv[1], 0); s3 = dc[3] * s3 + bfw(kv[1], 1);
        }
    }
}
__device__ __forceinline__ void gla_out_item(const bf16* P1, const bf16* VTG, const bf16* KVS, const float* gnorm, bf16* ycat, int item, int lane) {
    const int tt = item & 3, cc = (item >> 2) & 127, h = (item >> 9) & 3, b = item >> 11, jl = lane & 15, gq = lane >> 4;
    const size_t tokc = (size_t)b * SEQ + 64 * cc;
    const bf16* qrow = P1 + (tokc + 16 * tt + jl) * P1LD + 512 + h * 64 + 8 * gq;
    const bf16x8 qf0 = ld8(qrow), qf1 = ld8(qrow + 32);
    f32x4 o[8];
#pragma unroll
    for (int et = 0; et < 8; ++et) o[et] = (f32x4){0.f, 0.f, 0.f, 0.f};
    {
        const bf16* sp = KVS + ((size_t)(((b * 128 + cc) * 4 + h) * 128 + jl)) * 64 + 8 * gq;
#pragma unroll
        for (int et = 0; et < 8; ++et) { o[et] = mfma16(ld8(sp + (size_t)et * 16 * 64), qf0, o[et]); o[et] = mfma16(ld8(sp + (size_t)et * 16 * 64 + 32), qf1, o[et]); }
    }
    const int tl = 16 * tt + jl, rho_off = 8 * (jl >> 2) + (jl & 3);
    const bf16* vt = VTG + ((size_t)((b * 4 + h) * 128 + jl)) * SEQ + 64 * cc + 8 * gq;
    for (int sp_ = 0; sp_ <= (tt >> 1); ++sp_) {
        const bf16* kx = P1 + (tokc + 32 * sp_ + rho_off) * P1LD + 768 + h * 64 + 8 * gq;
        const bf16* ky = kx + (size_t)4 * P1LD;
        f32x4 sx = mfma16(ld8(kx), qf0, (f32x4){0.f, 0.f, 0.f, 0.f}); sx = mfma16(ld8(kx + 32), qf1, sx);
        f32x4 sy = mfma16(ld8(ky), qf0, (f32x4){0.f, 0.f, 0.f, 0.f}); sy = mfma16(ld8(ky + 32), qf1, sy);
        const int kb = 32 * sp_ + 8 * gq;
        float pe[8];
#pragma unroll
        for (int r = 0; r < 4; ++r) { pe[r] = (kb + r <= tl) ? sx[r] : 0.f; pe[4 + r] = (kb + 4 + r <= tl) ? sy[r] : 0.f; }
        const u32x4 pw = pack8(pe); const bf16x8 pf = __builtin_bit_cast(bf16x8, pw);
#pragma unroll
        for (int et = 0; et < 8; ++et) o[et] = mfma16(ld8(vt + (size_t)et * 16 * SEQ + 32 * sp_), pf, o[et]);
    }
    float q = 0.f;
#pragma unroll
    for (int et = 0; et < 8; ++et) q += (o[et][0] * o[et][0] + o[et][1] * o[et][1]) + (o[et][2] * o[et][2] + o[et][3] * o[et][3]);
    q += __shfl_xor(q, 16); q += __shfl_xor(q, 32);
    const float rs = rsqrtf(q * (1.0f / 128.0f) + 1e-6f);
    const bf16* grow = P1 + (tokc + tl) * P1LD + 1536 + h * 128 + 4 * gq;
    bf16* orow = ycat + (tokc + tl) * 1024 + 512 + h * 128 + 4 * gq;
#pragma unroll
    for (int et = 0; et < 8; ++et) {
        const u32x2 gv = *(const u32x2*)(grow + 16 * et);
        const f32x4 gn = *(const f32x4*)(gnorm + 16 * et + 4 * gq);
        float r[4];
#pragma unroll
        for (int e = 0; e < 4; ++e) { const float gg = bfw(gv[e >> 1], e & 1); r[e] = (o[et][e] * rs * gn[e]) * (gg * sigm(gg)); }
        u32x2 w; w.x = cvt_pk_bf16(r[0], r[1]); w.y = cvt_pk_bf16(r[2], r[3]);
        *(u32x2*)(orow + 16 * et) = w;
    }
}

struct Args { const float* in[34]; float* out; unsigned char* ws; int ph_lo, ph_hi; };
constexpr int NPHASE = 19;

template <class Epi>
__device__ __forceinline__ void run_gemm(LAS unsigned char* lds, const bf16* A, const bf16* Bt, int M, int N, int K, const Epi& E) {
    pg8::Gemm g{A, Bt, M, N, K}; pg8::StaticOrder S; S.init(M, N, (int)gridDim.x, (int)blockIdx.x);
    pg8::gemm_phase<Epi, pg8::StaticOrder, true, true>(lds, g, S, E);
}

__global__ void __launch_bounds__(512, 2) fwd_kernel(Args a) {
    extern __shared__ __attribute__((aligned(16))) unsigned char lds_raw[];
    cg::grid_group grid = cg::this_grid();
    Ctx c; c.tid = threadIdx.x; c.lane = c.tid & 63; c.wave = __builtin_amdgcn_readfirstlane(c.tid >> 6);
    c.gw = blockIdx.x * 8 + c.wave; c.ngw = gridDim.x * 8; c.gtid = blockIdx.x * 512 + c.tid; c.ngt = gridDim.x * 512;
    c.lds = (LAS unsigned char*)lds_raw;
    unsigned char* ws = a.ws; const float* const* in = a.in;
    const int lo = a.ph_lo, hi = a.ph_hi;
#define IN(k) (lo <= (k) && (k) < hi)
#define SYNC(k) do { if (IN(k) && IN((k) + 1)) grid.sync(); } while (0)
    float* ss = (float*)(ws + WS_SS);
    bf16* XB = (bf16*)(ws + WS_XB); bf16* BIG = (bf16*)(ws + WS_BIG); bf16* YCAT = (bf16*)(ws + WS_YCAT);
    LAS float* halo = (LAS float*)(c.lds + HALO_OFF);

    if (IN(0)) phase_prologue(c, in, ws);
    SYNC(0);
    if (IN(1)) { pg8::EpiProj E{BIG, P0LD, ss}; run_gemm(c.lds, XB, (const bf16*)(ws + WS_W_EIN), TT, 2560, 1024, E); }
    SYNC(1);
    if (IN(2)) phase_prep0(c, in, ws, a.out);
    SYNC(2);
    if (IN(3)) { pg8::EpiGates E{(const bf16*)(ws + WS_XC), (bf16*)(ws + WS_LOGA), (bf16*)(ws + WS_GI), in[6], in[8], in[9]};
        run_gemm(c.lds, (const bf16*)(ws + WS_XC), (const bf16*)(ws + WS_W_GATE), TT, 1024, 512, E); }
    SYNC(3);
    if (IN(4)) {
        phase_lru_a(c, ws);
        for (int it = c.gw; it < 2 * 8 * 16 * 32; it += c.ngw) attn_item(BIG, (const bf16*)a.out, YCAT, it, c.lane);
    }
    SYNC(4);
    if (IN(5)) phase_lru_b(c, ws);
    SYNC(5);
    if (IN(6)) { pg8::EpiRes E{in[0], a.out, XB, ss + TT}; run_gemm(c.lds, YCAT, (const bf16*)(ws + WS_W_EOUT), TT, 1024, 1024, E); }
    SYNC(6);
    if (IN(7)) { pg8::EpiFfn E{BIG, ss + TT, in[31], in[32], (float*)(ws + WS_EDGEA), (float*)(ws + WS_EDGEL), (float*)(ws + WS_TAILA), halo};
        run_gemm(c.lds, XB, (const bf16*)(ws + WS_W_FIN0), TT, 6144, 1024, E); }
    SYNC(7);
    if (IN(8)) phase_fixup(c, ws, in[31], in[32]);
    SYNC(8);
    if (IN(9)) { pg8::EpiRes E{a.out, a.out, XB, ss + 2 * TT}; run_gemm(c.lds, BIG, (const bf16*)(ws + WS_W_FOUT0), TT, 1024, 3072, E); }
    SYNC(9);
    if (IN(10)) { pg8::EpiProj E{BIG, P1LD, ss + 2 * TT}; run_gemm(c.lds, XB, (const bf16*)(ws + WS_W_OIN), TT, 2304, 1024, E); }
    SYNC(10);
    if (IN(11)) {
        phase_gla_prep(c, in, ws);
        for (int it = c.gw; it < 8 * 2 * 1024; it += c.ngw) vt_item(BIG, P1LD, 1024, 128, 4, (bf16*)(ws + WS_VTG), 0, it, c.lane);
        for (int it = c.gw; it < 32 * 64; it += c.ngw) s5a_item(BIG, (const bf16*)(ws + WS_S5F), (float*)(ws + WS_XLOC), it, c.lane);
    }
    SYNC(11);
    if (IN(12)) {
        phase_s5_scan(c, in, ws);
        for (int it = c.ngw - 1 - c.gw; it < 2 * 4 * 128; it += c.ngw) gla_kv_item((const bf16*)(ws + WS_KDT), (const bf16*)(ws + WS_VTG), (bf16*)(ws + WS_KVS), it, c.lane);
    }
    SYNC(12);
    if (IN(13)) {
        phase_gla_scan(c, ws);
        for (int it = c.ngw - 1 - c.gw; it < 32 * 64; it += c.ngw) s5c_item(BIG, (const bf16*)(ws + WS_S5A), (const bf16*)(ws + WS_SX), in[21], (bf16*)(ws + WS_XLOC), it, c.lane);
    }
    SYNC(13);
    if (IN(14)) {
        { pg8::EpiGlu E{(const bf16*)(ws + WS_XLOC), YCAT, in[24]}; run_gemm(c.lds, (const bf16*)(ws + WS_XLOC), (const bf16*)(ws + WS_W_GLU), TT, 512, 512, E); }
        for (int it = c.ngw - 1 - c.gw; it < 2 * 4 * 128 * 4; it += c.ngw) gla_out_item(BIG, (const bf16*)(ws + WS_VTG), (const bf16*)(ws + WS_KVS), in[27], YCAT, it, c.lane);
    }
    SYNC(14);
    if (IN(15)) { pg8::EpiRes E{a.out, a.out, XB, ss + 3 * TT}; run_gemm(c.lds, YCAT, (const bf16*)(ws + WS_W_OOUT), TT, 1024, 1024, E); }
    SYNC(15);
    if (IN(16)) { pg8::EpiFfn E{BIG, ss + 3 * TT, in[31] + 3 * 3072, in[32] + 3072, (float*)(ws + WS_EDGEA), (float*)(ws + WS_EDGEL), (float*)(ws + WS_TAILA), halo};
        run_gemm(c.lds, XB, (const bf16*)(ws + WS_W_FIN1), TT, 6144, 1024, E); }
    SYNC(16);
    if (IN(17)) phase_fixup(c, ws, in[31] + 3 * 3072, in[32] + 3072);
    SYNC(17);
    if (IN(18)) { pg8::EpiRes E{a.out, a.out, nullptr, nullptr}; run_gemm(c.lds, BIG, (const bf16*)(ws + WS_W_FOUT1), TT, 1024, 3072, E); }
#ifdef DBG_PROBE
    { grid.sync();
      const bf16* pb = (const bf16*)(ws + (size_t)DBG_B0 * MiB); const size_t nb = (size_t)(DBG_B1 - DBG_B0) * MiB / 2;
      const float* pf = (const float*)(ws + (size_t)DBG_F0 * MiB); const size_t nf = (size_t)(DBG_F1 - DBG_F0) * MiB / 4;
      for (size_t i = c.gtid; i < (size_t)TT * DM; i += c.ngt) { float s = 0.f;
          for (size_t j = i; j < nb; j += (size_t)TT * DM) s += bf2f(pb[j]);
          for (size_t j = i; j < nf; j += (size_t)TT * DM) s += pf[j];
          a.out[i] += 1e-3f * s; } }
#endif
    if (hi < 7) { grid.sync(); for (int i = c.gtid; i < TT * DM / 4; i += c.ngt) ((f32x4*)a.out)[i] = ((const f32x4*)in[0])[i]; }
#undef IN
#undef SYNC
}

#ifndef DBG_HI
#define DBG_HI NPHASE
#endif
#ifndef MK_PER_PHASE
#define MK_PER_PHASE 0
#endif
extern "C" void kernel_launch(void* const* d_in, const int* in_sizes, int n_in, void* d_out, int out_size, void* d_ws, size_t ws_size, hipStream_t stream) {
    static int grid = 0;
    if (grid == 0) {
        if (n_in != 34 || out_size != TT * DM || ws_size < WS_END) { fprintf(stderr, "kernel_launch: unexpected shapes (n_in %d out %d ws %zu)\n", n_in, out_size, ws_size); grid = -1; return; }
        int dev = 0, cus = 0, per_cu = 0;
        hipGetDevice(&dev); hipDeviceGetAttribute(&cus, hipDeviceAttributeMultiprocessorCount, dev);
        if (hipFuncSetAttribute((const void*)fwd_kernel, hipFuncAttributeMaxDynamicSharedMemorySize, LDS_BYTES) != hipSuccess) { fprintf(stderr, "kernel_launch: hipFuncSetAttribute failed\n"); grid = -1; return; }
        if (hipOccupancyMaxActiveBlocksPerMultiprocessor(&per_cu, (const void*)fwd_kernel, 512, LDS_BYTES) != hipSuccess || per_cu < 1) { fprintf(stderr, "kernel_launch: occupancy query says %d\n", per_cu); per_cu = 1; }
        (void)hipGetLastError();
        grid = cus;
        if (grid > 256) grid = 256;
    }
    if (grid < 0) return;
    Args a{};
    for (int i = 0; i < 34; ++i) a.in[i] = (const float*)d_in[i];
    a.out = (float*)d_out; a.ws = (unsigned char*)d_ws;
#if MK_PER_PHASE
    for (int p = 0; p < NPHASE; ++p) { a.ph_lo = p; a.ph_hi = p + 1; hipLaunchKernelGGL(fwd_kernel, dim3(grid), dim3(512), LDS_BYTES, stream, a); }
#else
    a.ph_lo = 0; a.ph_hi = DBG_HI;
    void* args[] = {&a};
    hipError_t e = hipLaunchCooperativeKernel((const void*)fwd_kernel, dim3(grid), dim3(512), args, LDS_BYTES, stream);
    if (e != hipSuccess) fprintf(stderr, "cooperative launch failed: %s (grid %d)\n", hipGetErrorString(e), grid);
#endif
}
```

```cpp
#include <hip/hip_runtime.h>
#include <hip/hip_cooperative_groups.h>
#include <cstdio>
#include <cstdint>
namespace cg = cooperative_groups;
namespace pg8 {
#define PG8_LAS __attribute__((address_space(3)))
typedef unsigned short bf16_t;
typedef short bf16x8 __attribute__((ext_vector_type(8)));
typedef float f32x4 __attribute__((ext_vector_type(4)));
typedef unsigned u32x4 __attribute__((ext_vector_type(4)));
constexpr int BM = 256, BK = 64, HALF = 128, HTB = HALF * BK * 2  , STAGE_BYTES = 8 * HTB, NXCD = 8, WGM = 8;

__host__ __device__ __forceinline__ int lds_byte(int r, int c) { const int st = (r >> 4) * 2 + (c >> 5), rr = r & 15, cc = c & 31, ob = rr * 64 + cc * 2; return st * 1024 + (ob ^ (((ob >> 9) & 1) << 5)); }
__host__ __device__ __forceinline__ void stage_rc(int b, int& R, int& C) { const int st = b / 1024, sb = b % 1024, swz = sb ^ (((sb >> 9) & 1) << 5); R = (st >> 1) * 16 + swz / 64; C = (st & 1) * 32 + (swz % 64) / 2; }
__host__ __device__ __forceinline__ int perm32(int rho) { const int n = rho >> 4, i = rho & 15; return 8 * (i >> 2) + 4 * n + (i & 3); }

struct Unit { int pm, pn; };
struct Gemm { const bf16_t* A; const bf16_t* Bt; int M, N, K; };

struct StaticOrder {
    int nM, nN, nwg, G, c;
    __host__ __device__ void init(int M, int N, int G_, int c_) { nM = M / BM; nN = N / BM; nwg = nM * nN; G = G_; c = c_; }
    __host__ __device__ bool next(int i, Unit& u) const {
        const long L = (long)i * G + c; if (L >= nwg) return false;
        int wgid = (int)L; { const int q = nwg / NXCD, r = nwg % NXCD, xcd = wgid % NXCD, off = wgid / NXCD; wgid = (xcd < r ? xcd * (q + 1) : r * (q + 1) + (xcd - r) * q) + off; }
        const int nig = WGM * nN, gid = wgid / nig, fm = gid * WGM, gsz = (nM - fm) < WGM ? (nM - fm) : WGM;
        u.pm = fm + ((wgid % nig) % gsz); u.pn = (wgid % nig) / gsz; return true;
    }
    __device__ __forceinline__ void a_ready(const Unit&) const {}
    __device__ __forceinline__ void done(const Unit&) const {}
};

__device__ __forceinline__ unsigned cvt_pk_bf16(float lo, float hi) { unsigned r; asm volatile("v_cvt_pk_bf16_f32 %0, %1, %2" : "=v"(r) : "v"(lo), "v"(hi)); return r; }
typedef float f32x2 __attribute__((ext_vector_type(2)));
template <class Epi, class Sched, bool ALIGN_EPI = false, bool SP2 = false>
__device__ __forceinline__ void gemm_phase(PG8_LAS unsigned char* lds, const Gemm g, const Sched& S, const Epi& E) {
    const int tid = threadIdx.x, wid = __builtin_amdgcn_readfirstlane(tid >> 6), lane = tid & 63, wr = wid >> 2, wc = wid & 3, fr = lane & 15, fq = lane >> 4;
    const int K = g.K, nt = K / BK;
    unsigned voffA[2], voffB[2];
#pragma unroll
    for (int i = 0; i < 2; ++i) { int R, C; stage_rc(tid * 16 + i * 8192, R, C); const int Rb = Epi::PERM ? ((R & ~31) + perm32(R & 31)) : R;
        voffA[i] = (unsigned)(R * K + C) * 2u; voffB[i] = (unsigned)(Rb * K + C) * 2u; }
    const size_t kstep = (size_t)(BK * 2);
    const size_t hstep = (size_t)HALF * K * 2;
    const size_t tstep = 2 * hstep;
    const unsigned ldsw = (unsigned)wid * 1024u;
    const int aoff = lds_byte(wr * 64 + fr, fq * 8), boff = lds_byte(wc * 32 + fr, fq * 8);
#define PG8_SA(b, h) (((b) * 2 + (h)) * HTB)
#define PG8_SB(b, h) ((4 + (b) * 2 + (h)) * HTB)
#define PG8_STAGE(bufoff, gbase, voff) do { _Pragma("unroll") for (int _i = 0; _i < 2; ++_i) \
        __builtin_amdgcn_global_load_lds((const unsigned*)((const char*)(gbase) + (voff)[_i]), (PG8_LAS unsigned*)(lds + (bufoff) + ldsw + _i * 8192), 16, 0, 0); } while (0)
#define PG8_LDA(dst, b, h) do { _Pragma("unroll") for (int m = 0; m < 4; ++m) _Pragma("unroll") for (int k = 0; k < 2; ++k) dst[m][k] = *(const PG8_LAS bf16x8*)(lds + PG8_SA(b, h) + aoff + m * 2048 + k * 1024); } while (0)
#define PG8_LDB(dst, b, h) do { _Pragma("unroll") for (int n = 0; n < 2; ++n) _Pragma("unroll") for (int k = 0; k < 2; ++k) dst[n][k] = *(const PG8_LAS bf16x8*)(lds + PG8_SB(b, h) + boff + n * 2048 + k * 1024); } while (0)
#define PG8_MMA(ai, bj, At, Bt) do { __builtin_amdgcn_s_setprio(1); _Pragma("unroll") for (int m = 0; m < 4; ++m) _Pragma("unroll") for (int n = 0; n < 2; ++n) _Pragma("unroll") for (int k = 0; k < 2; ++k) \
        acc[ai][bj][m][n] = __builtin_amdgcn_mfma_f32_16x16x32_bf16(Bt[n][k], At[m][k], acc[ai][bj][m][n], 0, 0, 0); __builtin_amdgcn_s_setprio(0); } while (0)
#define PG8_WAIT_V(n) asm volatile("s_waitcnt vmcnt(" #n ")" ::: "memory")
#define PG8_WAIT_L(n) asm volatile("s_waitcnt lgkmcnt(" #n ")" ::: "memory")
#define PG8_BAR __builtin_amdgcn_s_barrier()
#define PG8_SCHED __builtin_amdgcn_sched_barrier(0)
    Unit cur, nxt; int ui = 0;
    if (!S.next(0, cur)) return;
    f32x4 acc[2][2][4][2];
#pragma unroll
    for (int a = 0; a < 2; ++a)
#pragma unroll
        for (int b = 0; b < 2; ++b)
#pragma unroll
            for (int m = 0; m < 4; ++m)
#pragma unroll
                for (int n = 0; n < 2; ++n) acc[a][b][m][n] = (f32x4){0.f, 0.f, 0.f, 0.f};
    bf16x8 At[4][2], B0[2][2], B1[2][2];
    const char* cA = (const char*)g.A + (size_t)cur.pm * tstep; const char* cB = (const char*)g.Bt + (size_t)cur.pn * tstep;
    S.a_ready(cur);
    if constexpr (SP2) {
        PG8_STAGE(PG8_SB(0, 0), cB, voffB); PG8_STAGE(PG8_SB(0, 1), cB + hstep, voffB); PG8_STAGE(PG8_SA(0, 0), cA, voffA); PG8_STAGE(PG8_SA(0, 1), cA + hstep, voffA);
        if (wr == 1) PG8_BAR;
        PG8_WAIT_V(2); PG8_BAR;
        PG8_STAGE(PG8_SB(1, 0), cB + kstep, voffB); PG8_STAGE(PG8_SA(1, 0), cA + kstep, voffA); PG8_STAGE(PG8_SB(1, 1), cB + hstep + kstep, voffB);
        PG8_WAIT_V(6); PG8_BAR;
    } else {
        PG8_STAGE(PG8_SB(0, 0), cB, voffB); PG8_STAGE(PG8_SA(0, 0), cA, voffA); PG8_STAGE(PG8_SB(0, 1), cB + hstep, voffB); PG8_STAGE(PG8_SA(0, 1), cA + hstep, voffA);
        if (wr == 1) PG8_BAR;
        PG8_WAIT_V(4); PG8_BAR;
        PG8_STAGE(PG8_SB(1, 0), cB + kstep, voffB); PG8_STAGE(PG8_SA(1, 0), cA + kstep, voffA); PG8_STAGE(PG8_SB(1, 1), cB + hstep + kstep, voffB);
        PG8_WAIT_V(6); PG8_BAR;
    }
    for (;;) {
        const bool has_next = S.next(ui + 1, nxt);
        const char* nA = has_next ? (const char*)g.A + (size_t)nxt.pm * tstep : cA; const char* nB = has_next ? (const char*)g.Bt + (size_t)nxt.pn * tstep : cB;
        for (int t = 0; t < nt; t += 2) {
            const bool last = (t == nt - 2);
            const char* a1 = cA + (size_t)(t + 1) * kstep;
            const char* a2 = last ? nA : cA + (size_t)(t + 2) * kstep; const char* b2 = last ? nB : cB + (size_t)(t + 2) * kstep;
            const char* a3 = a2 + kstep; const char* b3 = b2 + kstep;
            if (last && has_next) S.a_ready(nxt);
            if constexpr (SP2) {
            PG8_LDB(B0, 0, 0); PG8_LDB(B1, 0, 1); PG8_SCHED; PG8_LDA(At, 0, 0); PG8_STAGE(PG8_SA(1, 1), a1 + hstep, voffA);
            PG8_WAIT_V(8); PG8_WAIT_L(0); PG8_BAR; PG8_MMA(0, 0, At, B0); PG8_MMA(0, 1, At, B1); PG8_BAR; PG8_SCHED;
            PG8_LDA(At, 0, 1); PG8_STAGE(PG8_SB(0, 0), b2, voffB); PG8_STAGE(PG8_SB(0, 1), b2 + hstep, voffB); PG8_STAGE(PG8_SA(0, 0), a2, voffA);
            PG8_WAIT_V(8); PG8_WAIT_L(0); PG8_BAR; PG8_MMA(1, 0, At, B0); PG8_MMA(1, 1, At, B1); PG8_BAR; PG8_SCHED;
            PG8_LDB(B0, 1, 0); PG8_LDB(B1, 1, 1); PG8_SCHED; PG8_LDA(At, 1, 0); PG8_STAGE(PG8_SA(0, 1), a2 + hstep, voffA);
            PG8_WAIT_V(8); PG8_WAIT_L(0); PG8_BAR; PG8_MMA(0, 0, At, B0); PG8_MMA(0, 1, At, B1); PG8_BAR; PG8_SCHED;
            PG8_LDA(At, 1, 1); PG8_STAGE(PG8_SB(1, 0), b3, voffB); PG8_STAGE(PG8_SB(1, 1), b3 + hstep, voffB); PG8_STAGE(PG8_SA(1, 0), a3, voffA);
            PG8_WAIT_V(8); PG8_WAIT_L(0); PG8_BAR; PG8_MMA(1, 0, At, B0); PG8_MMA(1, 1, At, B1); PG8_BAR; PG8_SCHED;
            } else {
            PG8_LDB(B0, 0, 0); PG8_SCHED; PG8_LDA(At, 0, 0); PG8_STAGE(PG8_SA(1, 1), a1 + hstep, voffA);
            PG8_WAIT_L(8); PG8_BAR; PG8_WAIT_L(0); PG8_MMA(0, 0, At, B0); PG8_BAR; PG8_SCHED;
            PG8_LDB(B1, 0, 1); PG8_STAGE(PG8_SB(0, 0), b2, voffB);
            PG8_BAR; PG8_WAIT_L(0); PG8_MMA(0, 1, At, B1); PG8_BAR;
            PG8_LDA(At, 0, 1); PG8_STAGE(PG8_SA(0, 0), a2, voffA);
            PG8_BAR; PG8_WAIT_L(0); PG8_MMA(1, 0, At, B0); PG8_BAR; PG8_SCHED;
            PG8_STAGE(PG8_SB(0, 1), b2 + hstep, voffB);
            PG8_WAIT_V(6); PG8_BAR; PG8_MMA(1, 1, At, B1); PG8_BAR;
            PG8_LDB(B0, 1, 0); PG8_SCHED; PG8_LDA(At, 1, 0); PG8_STAGE(PG8_SA(0, 1), a2 + hstep, voffA);
            PG8_WAIT_L(8); PG8_BAR; PG8_WAIT_L(0); PG8_MMA(0, 0, At, B0); PG8_BAR; PG8_SCHED;
            PG8_LDB(B1, 1, 1); PG8_STAGE(PG8_SB(1, 0), b3, voffB);
            PG8_BAR; PG8_WAIT_L(0); PG8_MMA(0, 1, At, B1); PG8_BAR;
            PG8_LDA(At, 1, 1); PG8_STAGE(PG8_SA(1, 0), a3, voffA);
            PG8_BAR; PG8_WAIT_L(0); PG8_MMA(1, 0, At, B0); PG8_BAR; PG8_SCHED;
            PG8_STAGE(PG8_SB(1, 1), b3 + hstep, voffB);
            PG8_WAIT_V(6); PG8_BAR; PG8_MMA(1, 1, At, B1); PG8_BAR;
            }
        }
        if constexpr (ALIGN_EPI) { if (wr == 0) PG8_BAR; }
        if constexpr (!Epi::AFTER_DRAIN) { E(acc, cur, wr, wc, fr, fq); S.done(cur); }
        if (!has_next) break;
#pragma unroll
        for (int a = 0; a < 2; ++a)
#pragma unroll
            for (int b = 0; b < 2; ++b)
#pragma unroll
                for (int m = 0; m < 4; ++m)
#pragma unroll
                    for (int n = 0; n < 2; ++n) acc[a][b][m][n] = (f32x4){0.f, 0.f, 0.f, 0.f};
        cur = nxt; cA = nA; cB = nB; ++ui;
        if constexpr (ALIGN_EPI) { if (wr == 1) PG8_BAR; }
    }
    PG8_WAIT_V(0);
    if constexpr (!ALIGN_EPI) { if (wr == 0) PG8_BAR; }
    PG8_BAR;
    if constexpr (Epi::AFTER_DRAIN) { E.fused(acc, cur, wr, wc, fr, fq, lds, wid, lane); S.done(cur); }
#undef PG8_SA
#undef PG8_SB
#undef PG8_STAGE
#undef PG8_LDA
#undef PG8_LDB
#undef PG8_MMA
#undef PG8_WAIT_V
#undef PG8_WAIT_L
#undef PG8_BAR
#undef PG8_SCHED
}
}
namespace pg8 {
typedef unsigned u32x2 __attribute__((ext_vector_type(2)));
typedef float f32x2_t __attribute__((ext_vector_type(2))); typedef __bf16 bf16x2_t __attribute__((ext_vector_type(2)));
__device__ __forceinline__ unsigned cvtpk(float lo, float hi) { f32x2_t v = {lo, hi}; bf16x2_t b = __builtin_convertvector(v, bf16x2_t); return __builtin_bit_cast(unsigned, b); }
__device__ __forceinline__ float sigm(float x) { return 1.0f / (1.0f + __expf(-x)); }
__device__ __forceinline__ float gelu_tanh(float x) { const float u = 1.5957691216057308f * (x + 0.044715f * x * x * x); return x / (1.0f + __expf(-u)); }
__device__ __forceinline__ float bfw(unsigned w, int hi) { return __uint_as_float(hi ? (w & 0xffff0000u) : (w << 16)); }
__device__ __forceinline__ float logsig(float z) { return fminf(z, 0.f) - log1pf(__expf(-fabsf(z))); }
__device__ __forceinline__ float dpp_ror1(float v) { return __int_as_float(__builtin_amdgcn_update_dpp(0, __float_as_int(v), 0x121, 0xf, 0xf, false)); }
__device__ __forceinline__ float dpp_ror2(float v) { return __int_as_float(__builtin_amdgcn_update_dpp(0, __float_as_int(v), 0x122, 0xf, 0xf, false)); }

struct EpiProj {
    static constexpr bool PERM = true, AFTER_DRAIN = false;
    bf16_t* O; int ldc; const float* ss;
    __device__ __forceinline__ void operator()(const f32x4 (&acc)[2][2][4][2], const Unit& u, int wr, int wc, int fr, int fq) const {
        const int row0 = u.pm * BM + wr * 64 + fr, col0 = u.pn * BM + wc * 32 + 8 * fq;
#pragma unroll
        for (int ai = 0; ai < 2; ++ai)
#pragma unroll
            for (int m = 0; m < 4; ++m) {
                const int row = row0 + ai * HALF + m * 16;
                const float rs = rsqrtf(ss[row] * (1.0f / 1024.0f) + 1e-6f);
                bf16_t* rowp = O + (size_t)row * ldc + col0;
#pragma unroll
                for (int bj = 0; bj < 2; ++bj) {
                    const f32x4 v0 = acc[ai][bj][m][0] * rs, v1 = acc[ai][bj][m][1] * rs;
                    u32x4 w; w.x = cvt_pk_bf16(v0[0], v0[1]); w.y = cvt_pk_bf16(v0[2], v0[3]); w.z = cvt_pk_bf16(v1[0], v1[1]); w.w = cvt_pk_bf16(v1[2], v1[3]);
                    *(u32x4*)(rowp + bj * HALF) = w;
                }
            }
    }
};

struct EpiGates {
    static constexpr bool PERM = true, AFTER_DRAIN = false;
    const bf16_t* xc; bf16_t* loga; bf16_t* gi; const float* ga_b; const float* gx_b; const float* lam;
    __device__ __forceinline__ void operator()(const f32x4 (&acc)[2][2][4][2], const Unit& u, int wr, int wc, int fr, int fq) const {
        const int row0 = u.pm * BM + wr * 64 + fr, ch0 = u.pn * HALF + wc * 32 + 8 * fq;
        float gab[8], gxb[8], ls[8];
#pragma unroll
        for (int e = 0; e < 8; ++e) { gab[e] = ga_b[ch0 + e]; gxb[e] = gx_b[ch0 + e]; ls[e] = 8.0f * logsig(lam[ch0 + e]); }
#pragma unroll
        for (int ai = 0; ai < 2; ++ai)
#pragma unroll
            for (int m = 0; m < 4; ++m) {
                const int row = row0 + ai * HALF + m * 16;
                const u32x4 xv = *(const u32x4*)(xc + (size_t)row * 512 + ch0);
                float la[8], g[8];
#pragma unroll
                for (int n = 0; n < 2; ++n)
#pragma unroll
                    for (int e = 0; e < 4; ++e) {
                        const int idx = 4 * n + e;
                        const float r = acc[ai][0][m][n][e] + gab[idx], i = acc[ai][1][m][n][e] + gxb[idx];
                        la[idx] = sigm(r) * ls[idx];
                        g[idx] = sigm(i) * bfw(xv[idx >> 1], idx & 1);
                    }
                u32x4 w; w.x = cvt_pk_bf16(la[0], la[1]); w.y = cvt_pk_bf16(la[2], la[3]); w.z = cvt_pk_bf16(la[4], la[5]); w.w = cvt_pk_bf16(la[6], la[7]);
                *(u32x4*)(loga + (size_t)row * 512 + ch0) = w;
                u32x4 w2; w2.x = cvt_pk_bf16(g[0], g[1]); w2.y = cvt_pk_bf16(g[2], g[3]); w2.z = cvt_pk_bf16(g[4], g[5]); w2.w = cvt_pk_bf16(g[6], g[7]);
                *(u32x4*)(gi + (size_t)row * 512 + ch0) = w2;
            }
    }
};

struct EpiRes {
    static constexpr bool PERM = false, AFTER_DRAIN = false;
    const float* base; float* out; bf16_t* xb; float* ss;
    __device__ __forceinline__ void operator()(const f32x4 (&acc)[2][2][4][2], const Unit& u, int wr, int wc, int fr, int fq) const {
        const int row0 = u.pm * BM + wr * 64 + fr, col0 = u.pn * BM + wc * 32 + 4 * fq;
#pragma unroll
        for (int ai = 0; ai < 2; ++ai)
#pragma unroll
            for (int m = 0; m < 4; ++m) {
                const int row = row0 + ai * HALF + m * 16; float q = 0.f;
#pragma unroll
                for (int bj = 0; bj < 2; ++bj)
#pragma unroll
                    for (int n = 0; n < 2; ++n) {
                        const size_t off = (size_t)row * 1024 + col0 + bj * HALF + n * 16;
                        const f32x4 b = *(const f32x4*)(base + off);
                        const f32x4 o = b + acc[ai][bj][m][n];
                        *(f32x4*)(out + off) = o;
                        if (xb) { u32x2 w; w.x = cvt_pk_bf16(o[0], o[1]); w.y = cvt_pk_bf16(o[2], o[3]); *(u32x2*)(xb + off) = w; }
                        q += (o[0] * o[0] + o[1] * o[1]) + (o[2] * o[2] + o[3] * o[3]);
                    }
                if (ss) { q += __shfl_xor(q, 16); q += __shfl_xor(q, 32); if (fq == 0) atomicAdd(ss + row, q); }
            }
    }
};

struct EpiGlu {
    static constexpr bool PERM = true, AFTER_DRAIN = false;
    const bf16_t* ys; bf16_t* ycat; const float* bias;
    __device__ __forceinline__ void operator()(const f32x4 (&acc)[2][2][4][2], const Unit& u, int wr, int wc, int fr, int fq) const {
        const int row0 = u.pm * BM + wr * 64 + fr, col0 = u.pn * BM + wc * 32 + 8 * fq;
#pragma unroll
        for (int bj = 0; bj < 2; ++bj) {
            const int col = col0 + bj * HALF;
            float bs[8];
#pragma unroll
            for (int e = 0; e < 8; ++e) bs[e] = bias[col + e];
#pragma unroll
            for (int ai = 0; ai < 2; ++ai)
#pragma unroll
                for (int m = 0; m < 4; ++m) {
                    const int row = row0 + ai * HALF + m * 16;
                    const u32x4 yv = *(const u32x4*)(ys + (size_t)row * 512 + col);
                    float o[8];
#pragma unroll
                    for (int n = 0; n < 2; ++n)
#pragma unroll
                        for (int e = 0; e < 4; ++e) { const int idx = 4 * n + e; o[idx] = bfw(yv[idx >> 1], idx & 1) * sigm(acc[ai][bj][m][n][e] + bs[idx]); }
                    u32x4 w; w.x = cvt_pk_bf16(o[0], o[1]); w.y = cvt_pk_bf16(o[2], o[3]); w.z = cvt_pk_bf16(o[4], o[5]); w.w = cvt_pk_bf16(o[6], o[7]);
                    *(u32x4*)(ycat + (size_t)row * 1024 + col) = w;
                }
        }
    }
};

struct EpiFfn {
    static constexpr bool PERM = true, AFTER_DRAIN = false;
    bf16_t* U; const float* ss; const float* cw; const float* cb; float* edgeA; float* edgeL; float* tailA; PG8_LAS float* halo;
    __device__ __forceinline__ void operator()(const f32x4 (&acc)[2][2][4][2], const Unit& u, int wr, int wc, int fr, int fq) const {
        const int cl = wc * 32 + 8 * fq, ch0 = u.pn * HALF + cl;
        const int row0 = u.pm * BM + wr * 64 + fr;
        float w0[8], w1[8], w2[8], bb[8];
#pragma unroll
        for (int e = 0; e < 8; ++e) { w0[e] = cw[ch0 + e]; w1[e] = cw[3072 + ch0 + e]; w2[e] = cw[6144 + ch0 + e]; bb[e] = cb[ch0 + e]; }
        float rs[2][4];
#pragma unroll
        for (int ai = 0; ai < 2; ++ai)
#pragma unroll
            for (int m = 0; m < 4; ++m) rs[ai][m] = rsqrtf(ss[row0 + ai * HALF + m * 16] * (1.0f / 1024.0f) + 1e-6f);
        if (fr >= 14) {
#pragma unroll
            for (int ai = 0; ai < 2; ++ai) {
                PG8_LAS float* hp = halo + ((ai * 2 + wr) * 2 + (fr - 14)) * 128 + cl;
                *(PG8_LAS f32x4*)hp = acc[ai][0][3][0] * rs[ai][3];
                *(PG8_LAS f32x4*)(hp + 4) = acc[ai][0][3][1] * rs[ai][3];
            }
            if (wr == 1) {
                float* tp = tailA + (size_t)(u.pm * 2 + (fr - 14)) * 3072 + ch0;
                *(f32x4*)tp = acc[1][0][3][0] * rs[1][3]; *(f32x4*)(tp + 4) = acc[1][0][3][1] * rs[1][3];
            }
        }
        if (wr == 0 && fr < 2) {
            float* ea = edgeA + (size_t)(u.pm * 2 + fr) * 3072 + ch0; float* el = edgeL + (size_t)(u.pm * 2 + fr) * 3072 + ch0;
            *(f32x4*)ea = acc[0][0][0][0] * rs[0][0]; *(f32x4*)(ea + 4) = acc[0][0][0][1] * rs[0][0];
            *(f32x4*)el = acc[0][1][0][0] * rs[0][0]; *(f32x4*)(el + 4) = acc[0][1][0][1] * rs[0][0];
        }
        asm volatile("s_waitcnt lgkmcnt(0)" ::: "memory"); __builtin_amdgcn_s_barrier(); asm volatile("" ::: "memory");
#pragma unroll
        for (int ai = 0; ai < 2; ++ai) {
            f32x4 pv[2];
            if (ai == 0 && wr == 0) { pv[0] = (f32x4){0.f, 0.f, 0.f, 0.f}; pv[1] = pv[0]; }
            else {
                const int pai = (wr == 1) ? ai : 0, pwr = (wr == 1) ? 0 : 1;
                const PG8_LAS float* hp = halo + ((pai * 2 + pwr) * 2 + (fr & 1)) * 128 + cl;
                pv[0] = *(const PG8_LAS f32x4*)hp; pv[1] = *(const PG8_LAS f32x4*)(hp + 4);
            }
#pragma unroll
            for (int m = 0; m < 4; ++m) {
                const int row = row0 + ai * HALF + m * 16;
                f32x4 av[2]; av[0] = acc[ai][0][m][0] * rs[ai][m]; av[1] = acc[ai][0][m][1] * rs[ai][m];
                float o[8];
#pragma unroll
                for (int n = 0; n < 2; ++n)
#pragma unroll
                    for (int e = 0; e < 4; ++e) {
                        const int idx = 4 * n + e;
                        const float cur = av[n][e], prv = pv[n][e];
                        const float r1c = dpp_ror1(cur), r1p = dpp_ror1(prv), r2c = dpp_ror2(cur), r2p = dpp_ror2(prv);
                        const float t1 = (fr >= 1) ? r1c : r1p, t2 = (fr >= 2) ? r2c : r2p;
                        const float cv = w0[idx] * t2 + w1[idx] * t1 + w2[idx] * cur + bb[idx];
                        o[idx] = gelu_tanh(cv) * (acc[ai][1][m][n][e] * rs[ai][m]);
                    }
                u32x4 w; w.x = cvt_pk_bf16(o[0], o[1]); w.y = cvt_pk_bf16(o[2], o[3]); w.z = cvt_pk_bf16(o[4], o[5]); w.w = cvt_pk_bf16(o[6], o[7]);
                *(u32x4*)(U + (size_t)row * 3072 + ch0) = w;
                pv[0] = av[0]; pv[1] = av[1];
            }
        }
    }
};
}
#define LAS __attribute__((address_space(3)))
typedef unsigned short bf16;
typedef short bf16x8 __attribute__((ext_vector_type(8)));
typedef float f32x4 __attribute__((ext_vector_type(4)));
typedef unsigned u32x4 __attribute__((ext_vector_type(4)));
typedef unsigned u32x2 __attribute__((ext_vector_type(2)));
using pg8::cvt_pk_bf16; using pg8::sigm; using pg8::gelu_tanh; using pg8::bfw; using pg8::logsig;

constexpr int TT = 16384, SEQ = 8192, DM = 1024, DFF = 3072;
constexpr size_t MiB = 1u << 20;
constexpr size_t WS_SS = 0;
constexpr size_t WS_SUMA = 256 * 1024, WS_SUMB = 768 * 1024;
constexpr size_t WS_DECAY = 1280 * 1024;
constexpr size_t WS_BARRIER = 3 * 1024 * 1024;
constexpr size_t WS_ROPE = 1536 * 1024;
constexpr size_t WS_W_EIN = 4 * MiB, WS_W_EOUT = 9 * MiB, WS_W_GATE = 11 * MiB, WS_W_FIN0 = 12 * MiB, WS_W_FIN1 = 24 * MiB, WS_W_FOUT0 = 36 * MiB, WS_W_FOUT1 = 42 * MiB;
constexpr size_t WS_W_OIN = 48 * MiB, WS_W_GLU = 53 * MiB, WS_W_OOUT = 54 * MiB, WS_S5A = 56 * MiB, WS_S5F = 62 * MiB;
constexpr size_t WS_XB = 64 * MiB;
constexpr size_t WS_LOGA = 64 * MiB, WS_GI = 80 * MiB;
constexpr size_t WS_KDT = 64 * MiB, WS_VTG = 72 * MiB, WS_SX = 88 * MiB;
constexpr size_t WS_BIG = 96 * MiB;
constexpr size_t WS_XC = 176 * MiB, WS_KVS = 168 * MiB;
constexpr size_t WS_YCAT = 192 * MiB;
constexpr size_t WS_XLOC = 224 * MiB;
constexpr size_t WS_EDGEA = 240 * MiB, WS_EDGEL = 242 * MiB, WS_TAILA = 244 * MiB;
constexpr size_t WS_END = 256 * MiB;
constexpr int P0LD = 2560, P1LD = 2304;
constexpr int LDS_BYTES = 147456, HALO_OFF = 131072 + 1024;

__device__ __forceinline__ float wave_sum(float v) {
#pragma unroll
    for (int o = 1; o < 64; o <<= 1) v += __shfl_xor(v, o);
    return v;
}
__device__ __forceinline__ float bf2f(bf16 b) { return __uint_as_float((unsigned)b << 16); }
__device__ __forceinline__ bf16 f2bf(float f) { return (bf16)(cvt_pk_bf16(f, 0.f) & 0xffffu); }
__device__ __forceinline__ f32x4 mfma16(bf16x8 a, bf16x8 b, f32x4 c) { return __builtin_amdgcn_mfma_f32_16x16x32_bf16(a, b, c, 0, 0, 0); }
__device__ __forceinline__ bf16x8 ld8(const bf16* p) { return *(const bf16x8*)p; }
__device__ __forceinline__ void unpack8(u32x4 v, float* f) {
#pragma unroll
    for (int i = 0; i < 4; ++i) { f[2 * i] = __uint_as_float(v[i] << 16); f[2 * i + 1] = __uint_as_float(v[i] & 0xffff0000u); }
}
__device__ __forceinline__ u32x4 pack8(const float* f) { u32x4 w; w.x = cvt_pk_bf16(f[0], f[1]); w.y = cvt_pk_bf16(f[2], f[3]); w.z = cvt_pk_bf16(f[4], f[5]); w.w = cvt_pk_bf16(f[6], f[7]); return w; }

struct Ctx { int tid, lane, wave, gw, ngw, gtid, ngt; LAS unsigned char* lds; };

__device__ __forceinline__ void tr_item(const float* W, int ldw, int nsrc, const float* gk, bf16* WT, int ldt, int k0, int n0, int dst_row0, LAS float* scr, int lane) {
#pragma unroll 8
    for (int i = 0; i < 32; ++i) {
        const int kk = 2 * i + (lane >> 5), n = n0 + (lane & 31);
        float v = (n < nsrc) ? W[(size_t)(k0 + kk) * ldw + n] : 0.f;
        if (gk) v *= gk[k0 + kk];
        scr[kk * 33 + (lane & 31)] = v;
    }
    asm volatile("s_waitcnt lgkmcnt(0)" ::: "memory");
    const int c = lane & 7;
#pragma unroll
    for (int j = 0; j < 4; ++j) {
        const int n = (lane >> 3) + 8 * j; const LAS float* s = scr + (8 * c) * 33 + n;
        u32x4 o; o.x = cvt_pk_bf16(s[0], s[33]); o.y = cvt_pk_bf16(s[66], s[99]); o.z = cvt_pk_bf16(s[132], s[165]); o.w = cvt_pk_bf16(s[198], s[231]);
        *(u32x4*)(WT + (size_t)(dst_row0 + n) * ldt + k0 + 8 * c) = o;
    }
    asm volatile("s_waitcnt lgkmcnt(0)" ::: "memory");
}

struct S5P { float m, th, cr, ci, ar, ai; };
__device__ __forceinline__ S5P s5_params(const float* lam_re, const float* lam_im, const float* log_step, int g, int n) {
    const float step = expf(log_step[g]), lr = lam_re[g * 64 + n], li = lam_im[g * 64 + n];
    S5P p; p.m = lr * step; p.th = li * step;
    float sn, cs; sincosf(p.th, &sn, &cs);
    const float mag = expf(p.m), ar = mag * cs, ai = mag * sn, den = lr * lr + li * li;
    p.cr = ((ar - 1.0f) * lr + ai * li) / den; p.ci = (ai * lr - (ar - 1.0f) * li) / den; p.ar = ar; p.ai = ai;
    return p;
}
__device__ __forceinline__ void s5_pow(const S5P& p, float tau, float& pr, float& pi) {
    float sn, cs; sincosf(p.th * tau, &sn, &cs); const float mag = expf(p.m * tau); pr = mag * cs; pi = mag * sn;
}

__device__ __forceinline__ void phase_prologue(const Ctx& c, const float* const* in, unsigned char* ws) {
    LAS float* scr = (LAS float*)(c.lds + c.wave * 16384);
    constexpr int I_EIN = 16 * 80, I_EOUT = 16 * 32, I_FIN = 16 * 192, I_FOUT = 48 * 32, I_OIN = 16 * 72, I_GLU = 8 * 16, I_OOUT = 16 * 32;
    constexpr int NITEMS = I_EIN + I_EOUT + 2 * I_FIN + 2 * I_FOUT + I_OIN + I_GLU + I_OOUT;
    for (int it = c.gw; it < NITEMS; it += c.ngw) {
        int r = it;
        if (r < I_EIN) { const int kb = r / 80, nb = r % 80; tr_item(in[2], 2560, 2560, in[1], (bf16*)(ws + WS_W_EIN), 1024, 64 * kb, 32 * nb, 32 * nb, scr, c.lane); continue; } r -= I_EIN;
        if (r < I_EOUT) { const int kb = r / 32, nb = r % 32; tr_item(in[12], 1024, 1024, nullptr, (bf16*)(ws + WS_W_EOUT), 1024, 64 * kb, 32 * nb, 32 * nb, scr, c.lane); continue; } r -= I_EOUT;
        if (r < 2 * I_FIN) { const int l = r / I_FIN; r %= I_FIN; const int kb = r / 192, nb = r % 192, n0 = 32 * nb;
            const int dst = (n0 < 3072) ? (256 * (n0 / 128) + (n0 % 128)) : (256 * ((n0 - 3072) / 128) + 128 + ((n0 - 3072) % 128));
            tr_item(in[30] + (size_t)l * 1024 * 6144, 6144, 6144, in[29] + l * 1024, (bf16*)(ws + (l ? WS_W_FIN1 : WS_W_FIN0)), 1024, 64 * kb, n0, dst, scr, c.lane); continue; } r -= 2 * I_FIN;
        if (r < 2 * I_FOUT) { const int l = r / I_FOUT; r %= I_FOUT; const int kb = r / 32, nb = r % 32;
            tr_item(in[33] + (size_t)l * 3072 * 1024, 1024, 1024, nullptr, (bf16*)(ws + (l ? WS_W_FOUT1 : WS_W_FOUT0)), 3072, 64 * kb, 32 * nb, 32 * nb, scr, c.lane); continue; } r -= 2 * I_FOUT;
        if (r < I_OIN) { const int kb = r / 72, nb = r % 72; tr_item(in[14], 2064, 2064, in[13], (bf16*)(ws + WS_W_OIN), 1024, 64 * kb, 32 * nb, 32 * nb, scr, c.lane); continue; } r -= I_OIN;
        if (r < I_GLU) { const int kb = r / 16, nb = r % 16; tr_item(in[23], 512, 512, nullptr, (bf16*)(ws + WS_W_GLU), 512, 64 * kb, 32 * nb, 32 * nb, scr, c.lane); continue; } r -= I_GLU;
        { const int kb = r / 32, nb = r % 32; tr_item(in[28], 1024, 1024, nullptr, (bf16*)(ws + WS_W_OOUT), 1024, 64 * kb, 32 * nb, 32 * nb, scr, c.lane); }
    }
    {
        const float* x = in[0]; bf16* xb = (bf16*)(ws + WS_XB); float* ss = (float*)(ws + WS_SS);
        for (int m = c.gw; m < TT; m += c.ngw) {
            const f32x4* xr = (const f32x4*)(x + (size_t)m * DM) + c.lane; float s = 0.f;
            u32x2* o8 = (u32x2*)(xb + (size_t)m * DM) + c.lane;
#pragma unroll
            for (int j = 0; j < 4; ++j) { const f32x4 v = xr[64 * j]; s += (v.x * v.x + v.y * v.y) + (v.z * v.z + v.w * v.w); u32x2 w; w.x = cvt_pk_bf16(v.x, v.y); w.y = cvt_pk_bf16(v.z, v.w); o8[64 * j] = w; }
            s = wave_sum(s);
            if (c.lane == 0) ss[m] = s;
        }
        for (int i = c.gtid; i < 3 * TT; i += c.ngt) ss[TT + i] = 0.f;
    }
    {
        bf16* G = (bf16*)(ws + WS_W_GATE);
        for (int i = c.gtid; i < 1024 * 512; i += c.ngt) {
            const int R = i >> 9, k = i & 511, pn = R >> 8, half = (R >> 7) & 1, ch = 128 * pn + (R & 127), h = ch >> 6, j = ch & 63;
            float v = 0.f;
            if ((k >> 6) == h) v = (half ? in[7] : in[5])[(h * 64 + (k & 63)) * 64 + j];
            G[i] = f2bf(v);
        }
    }
    {
        float* RT = (float*)(ws + WS_ROPE);
        for (int i = c.gtid; i < SEQ * 8; i += c.ngt) {
            const int pos = i >> 3, e = i & 7;
            const float inv = powf(500000.0f, -(float)e * 0.125f);
            float sn, cs; sincosf((float)pos * inv, &sn, &cs);
            RT[pos * 16 + e] = cs; RT[pos * 16 + 8 + e] = sn;
        }
    }
    {
        const float *lam_re = in[15], *lam_im = in[16], *b_re = in[17], *b_im = in[18], *c_re = in[19], *c_im = in[20], *lstep = in[22];
        bf16* AM = (bf16*)(ws + WS_S5A);
        bf16* FM = (bf16*)(ws + WS_S5F);
        for (int i = c.gtid; i < 32 * 256 * 4; i += c.ngt) {
            const int nq = i & 3, pp = (i >> 2) & 15, p = (i >> 6) & 15, g = i >> 10;
            float acc[16];
#pragma unroll
            for (int t = 0; t < 16; ++t) acc[t] = 0.f;
            for (int n = nq * 16; n < nq * 16 + 16; ++n) {
                const S5P sp = s5_params(lam_re, lam_im, lstep, g, n);
                const float br = b_re[(g * 64 + n) * 16 + pp], bi = b_im[(g * 64 + n) * 16 + pp];
                const float bbr = sp.cr * br - sp.ci * bi, bbi = sp.cr * bi + sp.ci * br;
                const float cr_ = c_re[(g * 16 + p) * 64 + n], ci_ = c_im[(g * 16 + p) * 64 + n];
                float zr = cr_ * bbr - ci_ * bbi, zi = cr_ * bbi + ci_ * bbr;
#pragma unroll
                for (int t = 0; t < 16; ++t) { acc[t] += zr; const float nr = zr * sp.ar - zi * sp.ai, ni = zr * sp.ai + zi * sp.ar; zr = nr; zi = ni; }
            }
            bf16* Ag = AM + (size_t)g * 256 * 384;
#pragma unroll
            for (int tau = 0; tau < 16; ++tau) {
                float v = acc[tau]; v += __shfl_xor(v, 1); v += __shfl_xor(v, 2);
                if ((tau & 3) == nq) {
                    const bf16 kv = f2bf(v);
                    for (int t = tau; t < 16; ++t) Ag[(t * 16 + p) * 384 + (t - tau) * 16 + pp] = kv;
                    if (tau >= 1) for (int t = 0; t + tau < 16; ++t) Ag[(t * 16 + p) * 384 + (t + tau) * 16 + pp] = 0;
                }
            }
        }
        for (int i = c.gtid; i < 32 * 16 * 16 * 64; i += c.ngt) {
            const int g = i >> 14, t = (i >> 10) & 15, p = (i >> 6) & 15, n = i & 63;
            const S5P sp = s5_params(lam_re, lam_im, lstep, g, n);
            float pr, pi; s5_pow(sp, (float)(t + 1), pr, pi);
            const float cr_ = c_re[(g * 16 + p) * 64 + n], ci_ = c_im[(g * 16 + p) * 64 + n];
            bf16* row = AM + ((size_t)g * 256 + t * 16 + p) * 384 + 256;
            row[n] = f2bf(cr_ * pr - ci_ * pi);
            row[64 + n] = f2bf(-(cr_ * pi + ci_ * pr));
        }
        for (int i = c.gtid; i < 32 * 64 * 256; i += c.ngt) {
            const int g = i >> 14, n = (i >> 8) & 63, s = (i >> 4) & 15, pp = i & 15;
            const S5P sp = s5_params(lam_re, lam_im, lstep, g, n);
            float pr, pi; s5_pow(sp, (float)(15 - s), pr, pi);
            const float br = b_re[(g * 64 + n) * 16 + pp], bi = b_im[(g * 64 + n) * 16 + pp];
            const float bbr = sp.cr * br - sp.ci * bi, bbi = sp.cr * bi + sp.ci * br;
            FM[((size_t)g * 128 + n) * 256 + s * 16 + pp] = f2bf(pr * bbr - pi * bbi);
            FM[((size_t)g * 128 + 64 + n) * 256 + s * 16 + pp] = f2bf(pr * bbi + pi * bbr);
        }
    }
}

__device__ __forceinline__ u32x4 vt_load(const bf16* src, int pitch, int coloff, int hd, int nh, int sh, int item, int lane) {
    const int cgp = item & 1023; int r = item >> 10; const int nblk = hd >> 6, dblk = r % nblk, bh = r / nblk, b = bh / nh, h = bh % nh;
    const int d = dblk * 64 + lane, Ld = SEQ >> sh;
    const bf16* s = src + (size_t)b * SEQ * pitch + coloff + h * hd + d;
    unsigned short v[8];
#pragma unroll
    for (int i = 0; i < 8; ++i) { const int col = cgp * 8 + i, rres = col / Ld, l = col - rres * Ld, t = (l << sh) + rres; v[i] = s[(size_t)t * pitch]; }
    u32x4 w; w.x = v[0] | ((unsigned)v[1] << 16); w.y = v[2] | ((unsigned)v[3] << 16); w.z = v[4] | ((unsigned)v[5] << 16); w.w = v[6] | ((unsigned)v[7] << 16);
    return w;
}
__device__ __forceinline__ void vt_store(u32x4 w, int hd, bf16* dst, int item, int lane) {
    const int cgp = item & 1023; int r = item >> 10; const int nblk = hd >> 6, dblk = r % nblk, bh = r / nblk;
    const int d = dblk * 64 + lane;
    *(u32x4*)(dst + ((size_t)bh * hd + d) * SEQ + cgp * 8) = w;
}
__device__ __forceinline__ void vt_run(const Ctx& c, const bf16* src, int pitch, int coloff, int hd, int nh, bf16* dst, int sh, int nitems) {
    for (int it0 = c.gw; it0 < nitems; it0 += 4 * c.ngw) {
        u32x4 w[4];
#pragma unroll
        for (int u = 0; u < 4; ++u) { const int it = it0 + u * c.ngw; if (it < nitems) w[u] = vt_load(src, pitch, coloff, hd, nh, sh, it, c.lane); }
#pragma unroll
        for (int u = 0; u < 4; ++u) { const int it = it0 + u * c.ngw; if (it < nitems) vt_store(w[u], hd, dst, it, c.lane); }
    }
}

__device__ __forceinline__ void phase_prep0(const Ctx& c, const float* const* in, unsigned char* ws, float* dout) {
    bf16* P0 = (bf16*)(ws + WS_BIG); bf16* XC = (bf16*)(ws + WS_XC);
    const float* cw = in[3]; const float* cbias = in[4];
    for (int i = c.gtid; i < TT * 64; i += c.ngt) {
        const int t = i >> 6, c0 = (i & 63) * 8, tl = t & (SEQ - 1);
        float acc[8];
#pragma unroll
        for (int e = 0; e < 8; ++e) acc[e] = cbias[c0 + e];
#pragma unroll
        for (int j = 0; j < 4; ++j) {
            if (tl - 3 + j >= 0) {
                float v[8]; unpack8(*(const u32x4*)(P0 + (size_t)(t - 3 + j) * P0LD + c0), v);
#pragma unroll
                for (int e = 0; e < 8; ++e) acc[e] += cw[j * 512 + c0 + e] * v[e];
            }
        }
        *(u32x4*)(XC + (size_t)t * 512 + c0) = pack8(acc);
    }
    for (int it0 = c.gw * 4; it0 < 2 * TT; it0 += c.ngw * 4) {
        const int sub = c.lane & 7;
        u32x4 raw[4];
#pragma unroll
        for (int u = 0; u < 4; ++u) { const int it = it0 + u, t = it >> 1, which = it & 1; raw[u] = *(const u32x4*)(P0 + (size_t)t * P0LD + 1024 + which * 512 + c.lane * 8); }
#pragma unroll
        for (int u = 0; u < 4; ++u) {
            const int it = it0 + u, t = it >> 1, which = it & 1;
            bf16* p = P0 + (size_t)t * P0LD + 1024 + which * 512 + c.lane * 8;
            float v[8]; unpack8(raw[u], v);
            float s = 0.f;
#pragma unroll
            for (int e = 0; e < 8; ++e) s += v[e] * v[e];
            s += __shfl_xor(s, 1); s += __shfl_xor(s, 2); s += __shfl_xor(s, 4);
            const float rs = rsqrtf(s * (1.0f / 64.0f) + 1e-6f);
            const float* gn = (which ? in[11] : in[10]) + sub * 8;
#pragma unroll
            for (int e = 0; e < 8; ++e) v[e] = v[e] * rs * gn[e];
            float oth[8];
#pragma unroll
            for (int e = 0; e < 8; ++e) oth[e] = __shfl_xor(v[e], 1);
            if (sub < 2) {
                const float* rt = (const float*)(ws + WS_ROPE) + (t & (SEQ - 1)) * 16;
                const f32x4 c0 = *(const f32x4*)rt, c1 = *(const f32x4*)(rt + 4), s0 = *(const f32x4*)(rt + 8), s1 = *(const f32x4*)(rt + 12);
#pragma unroll
                for (int e = 0; e < 8; ++e) {
                    const float cs = (e < 4) ? c0[e & 3] : c1[e & 3], sn = (e < 4) ? s0[e & 3] : s1[e & 3];
                    v[e] = (sub == 0) ? (v[e] * cs - oth[e] * sn) : (v[e] * cs + oth[e] * sn);
                }
            }
            *(u32x4*)p = pack8(v);
        }
    }
    bf16* VT3 = (bf16*)dout;
    for (int p = 0; p < 3; ++p) vt_run(c, P0, P0LD, 2048, 64, 8, VT3 + (size_t)p * (16 * 64 * SEQ), 2 * p, 16 * 1024);
}

__device__ __forceinline__ void attn_item(const bf16* P0, const bf16* VT3, bf16* ycat, int item, int lane) {
    const int lb = item & 31, r16 = (item >> 5) & 15, h = (item >> 9) & 7, b = item >> 12;
    const int qi = lane & 15, g = lane >> 4;
    const int tq = r16 + 16 * (16 * lb + qi);
    const bf16* qrow = P0 + (size_t)(b * SEQ + tq) * P0LD + 1024 + h * 64;
    const bf16x8 qf0 = ld8(qrow + 8 * g), qf1 = ld8(qrow + 32 + 8 * g);
    f32x4 o[4];
#pragma unroll
    for (int dt = 0; dt < 4; ++dt) o[dt] = (f32x4){0.f, 0.f, 0.f, 0.f};
    float m = -1e30f, l = 0.f;
    const float cs = 0.125f * 1.4426950408889634f;
    const int rho_off = 8 * (qi >> 2) + (qi & 3);
    for (int p = 0; p < 3; ++p) {
        const int sh = 2 * p, rres = r16 & ((1 << sh) - 1), Ld = SEQ >> sh;
        const int lq = tq >> sh, lq0 = (r16 + 256 * lb) >> sh, lq15 = (r16 + 256 * lb + 240) >> sh;
        int sb0 = lq0 - 128; if (sb0 < 0) sb0 = 0; sb0 &= ~31;
        const int sbend = lq15 & ~31;
        const bf16* kbase = P0 + (size_t)(b * SEQ + rres) * P0LD + 1536 + h * 64 + 8 * g;
        const bf16* vbase = VT3 + (size_t)p * (16 * 64 * SEQ) + ((size_t)((b * 8 + h) * 64 + qi)) * SEQ + rres * Ld + 8 * g;
        bf16x8 nk[4], nv[4];
        {
            const bf16* kx = kbase + ((size_t)(sb0 + rho_off) << sh) * P0LD; const bf16* ky = kx + ((size_t)4 << sh) * P0LD;
            nk[0] = ld8(kx); nk[1] = ld8(kx + 32); nk[2] = ld8(ky); nk[3] = ld8(ky + 32);
#pragma unroll
            for (int dt = 0; dt < 4; ++dt) nv[dt] = ld8(vbase + (size_t)dt * 16 * SEQ + sb0);
        }
        for (int sb = sb0; sb <= sbend; sb += 32) {
            const bf16x8 kx0 = nk[0], kx1 = nk[1], ky0 = nk[2], ky1 = nk[3];
            bf16x8 vf[4];
#pragma unroll
            for (int dt = 0; dt < 4; ++dt) vf[dt] = nv[dt];
            if (sb + 32 <= sbend) {
                const bf16* kx = kbase + ((size_t)(sb + 32 + rho_off) << sh) * P0LD; const bf16* ky = kx + ((size_t)4 << sh) * P0LD;
                nk[0] = ld8(kx); nk[1] = ld8(kx + 32); nk[2] = ld8(ky); nk[3] = ld8(ky + 32);
#pragma unroll
                for (int dt = 0; dt < 4; ++dt) nv[dt] = ld8(vbase + (size_t)dt * 16 * SEQ + sb + 32);
            }
            f32x4 sx = mfma16(kx0, qf0, (f32x4){0.f, 0.f, 0.f, 0.f}); sx = mfma16(kx1, qf1, sx);
            f32x4 sy = mfma16(ky0, qf0, (f32x4){0.f, 0.f, 0.f, 0.f}); sy = mfma16(ky1, qf1, sy);
            const int kb = sb + 8 * g;
            bool vx[4], vy[4]; float mx = -1e30f;
#pragma unroll
            for (int r = 0; r < 4; ++r) {
                vx[r] = (unsigned)(lq - (kb + r)) <= 128u; vy[r] = (unsigned)(lq - (kb + 4 + r)) <= 128u;
                if (vx[r]) mx = fmaxf(mx, sx[r]);
                if (vy[r]) mx = fmaxf(mx, sy[r]);
            }
            mx = fmaxf(mx, __shfl_xor(mx, 16)); mx = fmaxf(mx, __shfl_xor(mx, 32));
            const float mn = fmaxf(m, mx), alpha = exp2f((m - mn) * cs); m = mn;
            float pe[8]; float ps = 0.f;
#pragma unroll
            for (int r = 0; r < 4; ++r) { pe[r] = vx[r] ? exp2f((sx[r] - mn) * cs) : 0.f; pe[4 + r] = vy[r] ? exp2f((sy[r] - mn) * cs) : 0.f; ps += pe[r] + pe[4 + r]; }
            l = l * alpha + ps;
            const u32x4 pw = pack8(pe);
            const bf16x8 pf = __builtin_bit_cast(bf16x8, pw);
#pragma unroll
            for (int dt = 0; dt < 4; ++dt) { o[dt] = o[dt] * alpha; o[dt] = mfma16(vf[dt], pf, o[dt]); }
        }
    }
    l += __shfl_xor(l, 16); l += __shfl_xor(l, 32);
    const float inv = 1.0f / l;
    bf16* orow = ycat + (size_t)(b * SEQ + tq) * 1024 + 512 + h * 64 + 4 * g;
#pragma unroll
    for (int dt = 0; dt < 4; ++dt) { u32x2 w; w.x = cvt_pk_bf16(o[dt][0] * inv, o[dt][1] * inv); w.y = cvt_pk_bf16(o[dt][2] * inv, o[dt][3] * inv); *(u32x2*)(orow + 16 * dt) = w; }
}

__device__ __forceinline__ void lru_step(float la, float gi, float& h) { const float a = __expf(la), bq = sqrtf(fmaxf(-expm1f(2.0f * la), 0.f)) * gi; h = a * h + bq; }
__device__ __forceinline__ void phase_lru_a(const Ctx& c, unsigned char* ws) {
    const bf16* __restrict__ LA = (const bf16*)(ws + WS_LOGA); const bf16* __restrict__ GI = (const bf16*)(ws + WS_GI);
    float* __restrict__ SA = (float*)(ws + WS_SUMA); float* __restrict__ SB = (float*)(ws + WS_SUMB);
    for (int ch = blockIdx.x; ch < 256; ch += gridDim.x) {
        const int t0 = ch * 64, cn = c.tid; float h = 0.f, P = 0.f;
#pragma unroll 1
        for (int tb = 0; tb < 64; tb += 16) {
            float la[16], gi[16];
#pragma unroll
            for (int t = 0; t < 16; ++t) { la[t] = bf2f(LA[(size_t)(t0 + tb + t) * 512 + cn]); gi[t] = bf2f(GI[(size_t)(t0 + tb + t) * 512 + cn]); }
#pragma unroll
            for (int t = 0; t < 16; ++t) { lru_step(la[t], gi[t], h); P += la[t]; }
        }
        SA[ch * 512 + cn] = __expf(P); SB[ch * 512 + cn] = h;
    }
}
__device__ __forceinline__ void phase_lru_b(const Ctx& c, unsigned char* ws) {
    const bf16* __restrict__ LA = (const bf16*)(ws + WS_LOGA); const bf16* __restrict__ GI = (const bf16*)(ws + WS_GI);
    const float* __restrict__ SA = (const float*)(ws + WS_SUMA); const float* __restrict__ SB = (const float*)(ws + WS_SUMB);
    const bf16* __restrict__ P0 = (const bf16*)(ws + WS_BIG); bf16* __restrict__ ycat = (bf16*)(ws + WS_YCAT);
    for (int ch = blockIdx.x; ch < 256; ch += gridDim.x) {
        const int t0 = ch * 64, cn = c.tid; float h = 0.f;
        int j = ch & ~127;
        for (; j + 8 <= ch; j += 8) {
            float sa[8], sb[8];
#pragma unroll
            for (int k = 0; k < 8; ++k) { sa[k] = SA[(j + k) * 512 + cn]; sb[k] = SB[(j + k) * 512 + cn]; }
#pragma unroll
            for (int k = 0; k < 8; ++k) h = sa[k] * h + sb[k];
        }
        for (; j < ch; ++j) h = SA[j * 512 + cn] * h + SB[j * 512 + cn];
#pragma unroll 1
        for (int tb = 0; tb < 64; tb += 16) {
            float la[16], gi[16], gl[16];
#pragma unroll
            for (int t = 0; t < 16; ++t) { la[t] = bf2f(LA[(size_t)(t0 + tb + t) * 512 + cn]); gi[t] = bf2f(GI[(size_t)(t0 + tb + t) * 512 + cn]); gl[t] = bf2f(P0[(size_t)(t0 + tb + t) * P0LD + 512 + cn]); }
#pragma unroll
            for (int t = 0; t < 16; ++t) { lru_step(la[t], gi[t], h); ycat[(size_t)(t0 + tb + t) * 1024 + cn] = f2bf(h * gelu_tanh(gl[t])); }
        }
    }
}

__device__ __forceinline__ void phase_fixup(const Ctx& c, unsigned char* ws, const float* cw, const float* cb) {
    const float* EA = (const float*)(ws + WS_EDGEA); const float* EL = (const float*)(ws + WS_EDGEL); const float* TA = (const float*)(ws + WS_TAILA);
    bf16* U = (bf16*)(ws + WS_BIG);
    for (int i = c.gtid; i < 64 * 3072; i += c.ngt) {
        const int pm = i / 3072, col = i % 3072;
        if ((pm & 31) == 0) continue;
        const float tm2 = TA[(size_t)((pm - 1) * 2 + 0) * 3072 + col], tm1 = TA[(size_t)((pm - 1) * 2 + 1) * 3072 + col];
        const float a0 = EA[(size_t)(pm * 2) * 3072 + col], a1 = EA[(size_t)(pm * 2 + 1) * 3072 + col];
        const float l0 = EL[(size_t)(pm * 2) * 3072 + col], l1 = EL[(size_t)(pm * 2 + 1) * 3072 + col];
        const float w0 = cw[col], w1 = cw[3072 + col], w2 = cw[6144 + col], bb = cb[col];
        U[(size_t)(pm * 256) * 3072 + col] = f2bf(gelu_tanh(w0 * tm2 + w1 * tm1 + w2 * a0 + bb) * l0);
        U[(size_t)(pm * 256 + 1) * 3072 + col] = f2bf(gelu_tanh(w0 * tm1 + w1 * a0 + w2 * a1 + bb) * l1);
    }
}
#define XB_TMO      128
#define XB_XCNT(j)  (256  + 64 * (j))
#define XB_XSUB(j)  (1280 + 64 * (j))
#define XB_XGEN(j)  (2304 + 64 * (j))
#define XB_TOP      3328
#define XB_TOPGEN   3392
#define XCD_BAR_WORDS 3456
#define XB_SPIN_CAP (1u << 18)

__device__ __forceinline__ unsigned xb_ld(unsigned* p)              { return __hip_atomic_load(p, __ATOMIC_RELAXED, __HIP_MEMORY_SCOPE_AGENT); }
__device__ __forceinline__ unsigned xb_add(unsigned* p, unsigned v) { return __hip_atomic_fetch_add(p, v, __ATOMIC_RELAXED, __HIP_MEMORY_SCOPE_AGENT); }
__device__ __forceinline__ unsigned xb_xcc_id() { return (unsigned)__builtin_amdgcn_s_getreg((3 << 11) | 20) & 0xFu; }
#define XB_SPIN(cond, bar) do { unsigned _sp = 0; while (cond) { __builtin_amdgcn_s_sleep(1); \
    if ((++_sp & 255u) == 0u) { if (xb_ld(&(bar)[XB_TMO])) break; if (_sp > XB_SPIN_CAP) { atomicAdd(&(bar)[XB_TMO], 1u); break; } } } } while (0)

struct XcdBarrier {
    unsigned* bar; unsigned x;
    volatile LAS unsigned* st;
};

__device__ __forceinline__ XcdBarrier xcd_barrier_post(unsigned* bar, volatile LAS unsigned* st) {
    XcdBarrier b; b.bar = bar; b.x = xb_xcc_id(); b.st = st;
    if (threadIdx.x == 0) (void)xb_add(&bar[XB_XCNT(b.x)], 1u);
    return b;
}
__device__ __forceinline__ void xcd_barrier_complete(unsigned* bar, unsigned x, unsigned& nloc, unsigned& nx) {
    const unsigned G = gridDim.x * gridDim.y * gridDim.z;
    unsigned sum, cnt, mine, sp = 0u;
    for (;;) {
        sum = 0u; cnt = 0u; mine = 0u;
#pragma unroll
        for (unsigned j = 0; j < 16; ++j) { const unsigned c = xb_ld(&bar[XB_XCNT(j)]); sum += c; cnt += (c > 0u) ? 1u : 0u; mine = (j == x) ? c : mine; }
        if (sum == G) break;
        __builtin_amdgcn_s_sleep(1);
        if ((++sp & 255u) == 0u) { if (xb_ld(&bar[XB_TMO])) break; if (sp > XB_SPIN_CAP) { atomicAdd(&bar[XB_TMO], 1u); break; } }
    }
    nloc = mine > 0u ? mine : 1u; nx = cnt > 0u ? cnt : 1u;
}

__device__ __forceinline__ void xcd_barrier(const XcdBarrier& b) {
    asm volatile("s_waitcnt vmcnt(0)" ::: "memory");
    __syncthreads();
    if (threadIdx.x == 0) {
        unsigned* bar = b.bar;
        __builtin_amdgcn_s_waitcnt(0);
        unsigned nloc = b.st[0], nx = b.st[1];
        if (nloc == 0u) { xcd_barrier_complete(bar, b.x, nloc, nx); b.st[0] = nloc; b.st[1] = nx; }
        const unsigned old = xb_add(&bar[XB_XSUB(b.x)], 1u);
        const unsigned gen = old / nloc;
        if (old + 1u == (gen + 1u) * nloc) {
            __builtin_amdgcn_fence(__ATOMIC_RELEASE, "agent");
            asm volatile("s_waitcnt vmcnt(0)" ::: "memory");
            const unsigned og = xb_add(&bar[XB_TOP], 1u);
            const unsigned tg = og / nx;
            if (og + 1u == (tg + 1u) * nx) xb_add(&bar[XB_TOPGEN], 1u);
            else XB_SPIN(xb_ld(&bar[XB_TOPGEN]) == tg, bar);
            __builtin_amdgcn_fence(__ATOMIC_ACQUIRE, "agent");
            xb_add(&bar[XB_XGEN(b.x)], 1u);
            asm volatile("s_waitcnt vmcnt(0)" ::: "memory");
        } else {
            XB_SPIN(xb_ld(&bar[XB_XGEN(b.x)]) == gen, bar);
            __builtin_amdgcn_fence(__ATOMIC_ACQUIRE, "agent");
            asm volatile("s_waitcnt vmcnt(0)" ::: "memory");
        }
    }
    __syncthreads();
}
__device__ __forceinline__ void phase_gla_prep(const Ctx& c, const float* const* in, unsigned char* ws) {
    bf16* P1 = (bf16*)(ws + WS_BIG); bf16* KDT = (bf16*)(ws + WS_KDT); float* DEC = (float*)(ws + WS_DECAY);
    const float* gkw = in[25]; const float* gkb = in[26];
    for (int i = c.gtid; i < 256 * 256; i += c.ngt) {
        const int chunk = i >> 8, chn = i & 255, t0 = chunk * 64, b = chunk >> 7, h = chn >> 6, d = chn & 63;
        float w[16];
#pragma unroll
        for (int k = 0; k < 16; ++k) w[k] = gkw[k * 256 + chn];
        const float bias = gkb[chn];
        float kin[64]; float bc = 0.f;
#pragma unroll
        for (int tb = 0; tb < 64; tb += 8) {
            u32x4 l0[8], l1[8]; bf16 qv[8], kv[8];
#pragma unroll
            for (int t = 0; t < 8; ++t) { const bf16* row = P1 + (size_t)(t0 + tb + t) * P1LD; l0[t] = *(const u32x4*)(row + 2048); l1[t] = *(const u32x4*)(row + 2056); qv[t] = row[512 + chn]; kv[t] = row[768 + chn]; }
#pragma unroll
            for (int t = 0; t < 8; ++t) {
                bf16* row = P1 + (size_t)(t0 + tb + t) * P1LD;
                float lr[16]; unpack8(l0[t], lr); unpack8(l1[t], lr + 8);
                float z = bias;
#pragma unroll
                for (int k = 0; k < 16; ++k) z += lr[k] * w[k];
                bc += logsig(z) * (1.0f / 16.0f);
                row[512 + chn] = f2bf(bf2f(qv[t]) * 0.125f * __expf(bc));
                kin[tb + t] = bf2f(kv[t]) * __expf(-bc);
                row[768 + chn] = f2bf(kin[tb + t]);
            }
        }
        const float eb = __expf(bc);
        DEC[chunk * 256 + chn] = eb;
        bf16* kd = KDT + ((size_t)((b * 4 + h) * 64 + d)) * SEQ + (t0 & (SEQ - 1));
#pragma unroll
        for (int t8 = 0; t8 < 8; ++t8) {
            float f[8];
#pragma unroll
            for (int e = 0; e < 8; ++e) f[e] = kin[t8 * 8 + e] * eb;
            *(u32x4*)(kd + t8 * 8) = pack8(f);
        }
    }
}

__device__ __forceinline__ void s5_bfrags(const bf16* P1, int g, int jb, int lane, bf16x8* bu) {
    const int jl = lane & 15, gq = lane >> 4;
#pragma unroll
    for (int ks = 0; ks < 8; ++ks) {
        const int s = 2 * ks + (gq >> 1), p0 = 8 * (gq & 1);
        bu[ks] = ld8(P1 + (size_t)((16 * jb + jl) * 16 + s) * P1LD + 16 * g + p0);
    }
}
__device__ __forceinline__ void s5a_item(const bf16* P1, const bf16* FM, float* XL, int item, int lane) {
    const int g = item >> 6, jb = item & 63, jl = lane & 15, gq = lane >> 4;
    bf16x8 bu[8]; s5_bfrags(P1, g, jb, lane, bu);
    const bf16* Fg = FM + (size_t)g * 128 * 256;
#pragma unroll
    for (int zt = 0; zt < 8; ++zt) {
        f32x4 acc = (f32x4){0.f, 0.f, 0.f, 0.f};
#pragma unroll
        for (int ks = 0; ks < 8; ++ks) acc = mfma16(ld8(Fg + (size_t)(16 * zt + jl) * 256 + 32 * ks + 8 * gq), bu[ks], acc);
        *(f32x4*)(XL + ((size_t)g * 1024 + 16 * jb + jl) * 128 + 16 * zt + 4 * gq) = acc;
    }
}
__device__ __forceinline__ void phase_s5_scan(const Ctx& c, const float* const* in, unsigned char* ws) {
    const float* __restrict__ XL = (const float*)(ws + WS_XLOC); bf16* __restrict__ SX = (bf16*)(ws + WS_SX);
    for (int i = c.gtid; i < 2 * 32 * 64; i += c.ngt) {
        const int n = i & 63, g = (i >> 6) & 31, b = i >> 11;
        const S5P sp = s5_params(in[15], in[16], in[22], g, n);
        float ar, ai; s5_pow(sp, 16.0f, ar, ai);
        float xr = 0.f, xi = 0.f;
        const size_t o0 = ((size_t)g * 1024 + b * 512) * 128 + n;
        float cr[16], ci[16], nr_[16], ni_[16];
#pragma unroll
        for (int k = 0; k < 16; ++k) { cr[k] = XL[o0 + (size_t)k * 128]; ci[k] = XL[o0 + (size_t)k * 128 + 64]; }
#pragma unroll 1
        for (int j0 = 0; j0 < 512; j0 += 16) {
            const size_t o = o0 + (size_t)j0 * 128;
            if (j0 + 16 < 512) {
#pragma unroll
                for (int k = 0; k < 16; ++k) { nr_[k] = XL[o + (size_t)(16 + k) * 128]; ni_[k] = XL[o + (size_t)(16 + k) * 128 + 64]; }
            }
#pragma unroll
            for (int k = 0; k < 16; ++k) {
                SX[o + (size_t)k * 128] = f2bf(xr); SX[o + (size_t)k * 128 + 64] = f2bf(xi);
                const float tr = ar * xr - ai * xi + cr[k], ti = ar * xi + ai * xr + ci[k];
                xr = tr; xi = ti;
            }
#pragma unroll
            for (int k = 0; k < 16; ++k) { cr[k] = nr_[k]; ci[k] = ni_[k]; }
        }
    }
}
__device__ __forceinline__ void s5c_item(const bf16* P1, const bf16* AM, const bf16* SX, const float* dvec, bf16* YS, int item, int lane) {
    const int g = item >> 6, jb = item & 63, jl = lane & 15, gq = lane >> 4;
    bf16x8 bu[12]; s5_bfrags(P1, g, jb, lane, bu);
#pragma unroll
    for (int ks = 0; ks < 4; ++ks) bu[8 + ks] = ld8(SX + ((size_t)g * 1024 + 16 * jb + jl) * 128 + 32 * ks + 8 * gq);
    const bf16* Ag = AM + (size_t)g * 256 * 384;
    float dv[4];
#pragma unroll
    for (int e = 0; e < 4; ++e) dv[e] = dvec[16 * g + 4 * gq + e];
#pragma unroll 4
    for (int rt = 0; rt < 16; ++rt) {
        f32x4 acc = (f32x4){0.f, 0.f, 0.f, 0.f};
#pragma unroll
        for (int ks = 0; ks < 12; ++ks) acc = mfma16(ld8(Ag + (size_t)(16 * rt + jl) * 384 + 32 * ks + 8 * gq), bu[ks], acc);
        const size_t tok = (size_t)(16 * jb + jl) * 16 + rt;
        const u32x2 uv = *(const u32x2*)(P1 + tok * P1LD + 16 * g + 4 * gq);
        float o[4];
#pragma unroll
        for (int e = 0; e < 4; ++e) { const float y = acc[e] + dv[e] * bfw(uv[e >> 1], e & 1); o[e] = gelu_tanh(y); }
        u32x2 w; w.x = cvt_pk_bf16(o[0], o[1]); w.y = cvt_pk_bf16(o[2], o[3]);
        *(u32x2*)(YS + tok * 512 + 16 * g + 4 * gq) = w;
    }
}

__device__ __forceinline__ void gla_kv_item(const bf16* KDT, const bf16* VTG, bf16* KVS, int item, int lane) {
    const int cc = item & 127, h = (item >> 7) & 3, b = item >> 9, jl = lane & 15, gq = lane >> 4;
    const bf16* kd = KDT + ((size_t)((b * 4 + h) * 64 + jl)) * SEQ + 64 * cc + 8 * gq;
    const bf16* vt = VTG + ((size_t)((b * 4 + h) * 128 + jl)) * SEQ + 64 * cc + 8 * gq;
    bf16x8 af[4][2];
#pragma unroll
    for (int dt = 0; dt < 4; ++dt)
#pragma unroll
        for (int ks = 0; ks < 2; ++ks) af[dt][ks] = ld8(kd + (size_t)dt * 16 * SEQ + 32 * ks);
    bf16* out = KVS + ((size_t)(((b * 128 + cc) * 4 + h) * 128 + jl)) * 64 + 4 * gq;
#pragma unroll
    for (int et = 0; et < 8; ++et) {
        const bf16x8 b0 = ld8(vt + (size_t)et * 16 * SEQ), b1 = ld8(vt + (size_t)et * 16 * SEQ + 32);
#pragma unroll
        for (int dt = 0; dt < 4; ++dt) {
            f32x4 acc = mfma16(af[dt][0], b0, (f32x4){0.f, 0.f, 0.f, 0.f}); acc = mfma16(af[dt][1], b1, acc);
            u32x2 w; w.x = pg8::cvtpk(acc[0], acc[1]); w.y = pg8::cvtpk(acc[2], acc[3]);
            *(u32x2*)(out + (size_t)et * 16 * 64 + 16 * dt) = w;
        }
    }
}
__device__ __forceinline__ void phase_gla_scan(const Ctx& c, unsigned char* ws) {
    bf16* KVS = (bf16*)(ws + WS_KVS); const float* DEC = (const float*)(ws + WS_DECAY);
    for (int i = c.gtid; i < 2 * 4 * 128 * 16; i += c.ngt) {
        const int dq = i & 15, e = (i >> 4) & 127, h = (i >> 11) & 3, b = i >> 13;
        float s0 = 0.f, s1 = 0.f, s2 = 0.f, s3 = 0.f;
        bf16* p0 = KVS + ((size_t)((b * 128 * 4 + h) * 128 + e)) * 64 + 4 * dq;
        const float* d0 = DEC + (b * 128) * 256 + h * 64 + 4 * dq;
        u32x2 kv[8], nkv[8]; f32x4 dc[8], ndc[8];
#pragma unroll
        for (int k = 0; k < 8; ++k) { kv[k] = *(const u32x2*)(p0 + (size_t)k * (4 * 128 * 64)); dc[k] = *(const f32x4*)(d0 + k * 256); }
#pragma unroll 1
        for (int c0 = 0; c0 < 128; c0 += 8) {
            if (c0 + 8 < 128) {
#pragma unroll
                for (int k = 0; k < 8; ++k) { nkv[k] = *(const u32x2*)(p0 + (size_t)(c0 + 8 + k) * (4 * 128 * 64)); ndc[k] = *(const f32x4*)(d0 + (c0 + 8 + k) * 256); }
            }
#pragma unroll
            for (int k = 0; k < 8; ++k) {
                u32x2 w; w.x = cvt_pk_bf16(s0, s1); w.y = cvt_pk_bf16(s2, s3); *(u32x2*)(p0 + (size_t)(c0 + k) * (4 * 128 * 64)) = w;
                s0 = dc[k][0] * s0 + bfw(kv[k][0], 0); s1 = dc[k][1] * s1 + bfw(kv[k][0], 1); s2 = dc[k][2] * s2 + bfw(kv[k][1], 0); s3 = dc[k][3] * s3 + bfw(kv[k][1], 1);
            }
#pragma unroll
            for (int k = 0; k < 8; ++k) { kv[k] = nkv[k]; dc[k] = ndc[k]; }
        }
    }
}
__device__ __forceinline__ void gla_out_item(const bf16* P1, const bf16* VTG, const bf16* KVS, const float* gnorm, bf16* ycat, int item, int lane) {
    const int tt = item & 3, cc = (item >> 2) & 127, h = (item >> 9) & 3, b = item >> 11, jl = lane & 15, gq = lane >> 4;
    const size_t tokc = (size_t)b * SEQ + 64 * cc;
    const bf16* qrow = P1 + (tokc + 16 * tt + jl) * P1LD + 512 + h * 64 + 8 * gq;
    const bf16x8 qf0 = ld8(qrow), qf1 = ld8(qrow + 32);
    f32x4 o[8];
#pragma unroll
    for (int et = 0; et < 8; ++et) o[et] = (f32x4){0.f, 0.f, 0.f, 0.f};
    {
        const bf16* sp = KVS + ((size_t)(((b * 128 + cc) * 4 + h) * 128 + jl)) * 64 + 8 * gq;
#pragma unroll
        for (int et = 0; et < 8; ++et) { o[et] = mfma16(ld8(sp + (size_t)et * 16 * 64), qf0, o[et]); o[et] = mfma16(ld8(sp + (size_t)et * 16 * 64 + 32), qf1, o[et]); }
    }
    const int tl = 16 * tt + jl, rho_off = 8 * (jl >> 2) + (jl & 3);
    const bf16* vt = VTG + ((size_t)((b * 4 + h) * 128 + jl)) * SEQ + 64 * cc + 8 * gq;
    for (int sp_ = 0; sp_ <= (tt >> 1); ++sp_) {
        const bf16* kx = P1 + (tokc + 32 * sp_ + rho_off) * P1LD + 768 + h * 64 + 8 * gq;
        const bf16* ky = kx + (size_t)4 * P1LD;
        f32x4 sx = mfma16(ld8(kx), qf0, (f32x4){0.f, 0.f, 0.f, 0.f}); sx = mfma16(ld8(kx + 32), qf1, sx);
        f32x4 sy = mfma16(ld8(ky), qf0, (f32x4){0.f, 0.f, 0.f, 0.f}); sy = mfma16(ld8(ky + 32), qf1, sy);
        const int kb = 32 * sp_ + 8 * gq;
        float pe[8];
#pragma unroll
        for (int r = 0; r < 4; ++r) { pe[r] = (kb + r <= tl) ? sx[r] : 0.f; pe[4 + r] = (kb + 4 + r <= tl) ? sy[r] : 0.f; }
        const u32x4 pw = pack8(pe); const bf16x8 pf = __builtin_bit_cast(bf16x8, pw);
#pragma unroll
        for (int et = 0; et < 8; ++et) o[et] = mfma16(ld8(vt + (size_t)et * 16 * SEQ + 32 * sp_), pf, o[et]);
    }
    float q = 0.f;
#pragma unroll
    for (int et = 0; et < 8; ++et) q += (o[et][0] * o[et][0] + o[et][1] * o[et][1]) + (o[et][2] * o[et][2] + o[et][3] * o[et][3]);
    q += __shfl_xor(q, 16); q += __shfl_xor(q, 32);
    const float rs = rsqrtf(q * (1.0f / 128.0f) + 1e-6f);
    const bf16* grow = P1 + (tokc + tl) * P1LD + 1536 + h * 128 + 4 * gq;
    bf16* orow = ycat + (tokc + tl) * 1024 + 512 + h * 128 + 4 * gq;
#pragma unroll
    for (int et = 0; et < 8; ++et) {
        const u32x2 gv = *(const u32x2*)(grow + 16 * et);
        const f32x4 gn = *(const f32x4*)(gnorm + 16 * et + 4 * gq);
        float r[4];
#pragma unroll
        for (int e = 0; e < 4; ++e) { const float gg = bfw(gv[e >> 1], e & 1); r[e] = (o[et][e] * rs * gn[e]) * (gg * sigm(gg)); }
        u32x2 w; w.x = cvt_pk_bf16(r[0], r[1]); w.y = cvt_pk_bf16(r[2], r[3]);
        *(u32x2*)(orow + 16 * et) = w;
    }
}

struct Args { const float* in[34]; float* out; unsigned char* ws; int ph_lo, ph_hi; };
constexpr int NPHASE = 19;

template <class Epi>
__device__ __forceinline__ void run_gemm(LAS unsigned char* lds, const bf16* A, const bf16* Bt, int M, int N, int K, const Epi& E) {
    pg8::Gemm g{A, Bt, M, N, K}; pg8::StaticOrder S; S.init(M, N, (int)gridDim.x, (int)blockIdx.x);
    pg8::gemm_phase<Epi, pg8::StaticOrder, true, true>(lds, g, S, E);
}

__global__ void __launch_bounds__(512, 2) fwd_kernel(Args a) {
    extern __shared__ __attribute__((aligned(16))) unsigned char lds_raw[];
    cg::grid_group grid = cg::this_grid();
    Ctx c; c.tid = threadIdx.x; c.lane = c.tid & 63; c.wave = __builtin_amdgcn_readfirstlane(c.tid >> 6);
    c.gw = blockIdx.x * 8 + c.wave; c.ngw = gridDim.x * 8; c.gtid = blockIdx.x * 512 + c.tid; c.ngt = gridDim.x * 512;
    c.lds = (LAS unsigned char*)lds_raw;
    unsigned char* ws = a.ws; const float* const* in = a.in;
    const int lo = a.ph_lo, hi = a.ph_hi;
#define IN(k) (lo <= (k) && (k) < hi)
#define SYNC(k) do { if (IN(k) && IN((k) + 1)) { if ((k) == 0) grid.sync(); else xcd_barrier(bar); } } while (0)
    volatile LAS unsigned* misc = (volatile LAS unsigned*)(c.lds + 131072);
    if (c.tid < 8) misc[c.tid] = 0u;
    __syncthreads();
    XcdBarrier bar = xcd_barrier_post((unsigned*)(ws + WS_BARRIER), misc);
    float* ss = (float*)(ws + WS_SS);
    bf16* XB = (bf16*)(ws + WS_XB); bf16* BIG = (bf16*)(ws + WS_BIG); bf16* YCAT = (bf16*)(ws + WS_YCAT);
    LAS float* halo = (LAS float*)(c.lds + HALO_OFF);

    if (IN(0)) phase_prologue(c, in, ws);
    SYNC(0);
    if (IN(1)) { pg8::EpiProj E{BIG, P0LD, ss}; run_gemm(c.lds, XB, (const bf16*)(ws + WS_W_EIN), TT, 2560, 1024, E); }
    SYNC(1);
    if (IN(2)) phase_prep0(c, in, ws, a.out);
    SYNC(2);
    if (IN(3)) { pg8::EpiGates E{(const bf16*)(ws + WS_XC), (bf16*)(ws + WS_LOGA), (bf16*)(ws + WS_GI), in[6], in[8], in[9]};
        run_gemm(c.lds, (const bf16*)(ws + WS_XC), (const bf16*)(ws + WS_W_GATE), TT, 1024, 512, E); }
    SYNC(3);
    if (IN(4)) {
        phase_lru_a(c, ws);
        for (int it = c.gw; it < 2 * 8 * 16 * 32; it += c.ngw) attn_item(BIG, (const bf16*)a.out, YCAT, it, c.lane);
    }
    SYNC(4);
    if (IN(5)) phase_lru_b(c, ws);
    SYNC(5);
    if (IN(6)) { pg8::EpiRes E{in[0], a.out, XB, ss + TT}; run_gemm(c.lds, YCAT, (const bf16*)(ws + WS_W_EOUT), TT, 1024, 1024, E); }
    SYNC(6);
    if (IN(7)) { pg8::EpiFfn E{BIG, ss + TT, in[31], in[32], (float*)(ws + WS_EDGEA), (float*)(ws + WS_EDGEL), (float*)(ws + WS_TAILA), halo};
        run_gemm(c.lds, XB, (const bf16*)(ws + WS_W_FIN0), TT, 6144, 1024, E); }
    SYNC(7);
    if (IN(8)) phase_fixup(c, ws, in[31], in[32]);
    SYNC(8);
    if (IN(9)) { pg8::EpiRes E{a.out, a.out, XB, ss + 2 * TT}; run_gemm(c.lds, BIG, (const bf16*)(ws + WS_W_FOUT0), TT, 1024, 3072, E); }
    SYNC(9);
    if (IN(10)) { pg8::EpiProj E{BIG, P1LD, ss + 2 * TT}; run_gemm(c.lds, XB, (const bf16*)(ws + WS_W_OIN), TT, 2304, 1024, E); }
    SYNC(10);
    if (IN(11)) {
        phase_gla_prep(c, in, ws);
        vt_run(c, BIG, P1LD, 1024, 128, 4, (bf16*)(ws + WS_VTG), 0, 8 * 2 * 1024);
        for (int it = c.gw; it < 32 * 64; it += c.ngw) s5a_item(BIG, (const bf16*)(ws + WS_S5F), (float*)(ws + WS_XLOC), it, c.lane);
    }
    SYNC(11);
    if (IN(12)) {
        phase_s5_scan(c, in, ws);
        for (int it = c.ngw - 1 - c.gw; it < 2 * 4 * 128; it += c.ngw) gla_kv_item((const bf16*)(ws + WS_KDT), (const bf16*)(ws + WS_VTG), (bf16*)(ws + WS_KVS), it, c.lane);
    }
    SYNC(12);
    if (IN(13)) {
        phase_gla_scan(c, ws);
        for (int it = c.ngw - 1 - c.gw; it < 32 * 64; it += c.ngw) s5c_item(BIG, (const bf16*)(ws + WS_S5A), (const bf16*)(ws + WS_SX), in[21], (bf16*)(ws + WS_XLOC), it, c.lane);
    }
    SYNC(13);
    if (IN(14)) {
        { pg8::EpiGlu E{(const bf16*)(ws + WS_XLOC), YCAT, in[24]}; run_gemm(c.lds, (const bf16*)(ws + WS_XLOC), (const bf16*)(ws + WS_W_GLU), TT, 512, 512, E); }
        for (int it = c.ngw - 1 - c.gw; it < 2 * 4 * 128 * 4; it += c.ngw) gla_out_item(BIG, (const bf16*)(ws + WS_VTG), (const bf16*)(ws + WS_KVS), in[27], YCAT, it, c.lane);
    }
    SYNC(14);
    if (IN(15)) { pg8::EpiRes E{a.out, a.out, XB, ss + 3 * TT}; run_gemm(c.lds, YCAT, (const bf16*)(ws + WS_W_OOUT), TT, 1024, 1024, E); }
    SYNC(15);
    if (IN(16)) { pg8::EpiFfn E{BIG, ss + 3 * TT, in[31] + 3 * 3072, in[32] + 3072, (float*)(ws + WS_EDGEA), (float*)(ws + WS_EDGEL), (float*)(ws + WS_TAILA), halo};
        run_gemm(c.lds, XB, (const bf16*)(ws + WS_W_FIN1), TT, 6144, 1024, E); }
    SYNC(16);
    if (IN(17)) phase_fixup(c, ws, in[31] + 3 * 3072, in[32] + 3072);
    SYNC(17);
    if (IN(18)) { pg8::EpiRes E{a.out, a.out, nullptr, nullptr}; run_gemm(c.lds, BIG, (const bf16*)(ws + WS_W_FOUT1), TT, 1024, 3072, E); }
#ifdef DBG_PROBE
    { grid.sync();
      const bf16* pb = (const bf16*)(ws + (size_t)DBG_B0 * MiB); const size_t nb = (size_t)(DBG_B1 - DBG_B0) * MiB / 2;
      const float* pf = (const float*)(ws + (size_t)DBG_F0 * MiB); const size_t nf = (size_t)(DBG_F1 - DBG_F0) * MiB / 4;
      for (size_t i = c.gtid; i < (size_t)TT * DM; i += c.ngt) { float s = 0.f;
          for (size_t j = i; j < nb; j += (size_t)TT * DM) s += bf2f(pb[j]);
          for (size_t j = i; j < nf; j += (size_t)TT * DM) s += pf[j];
          a.out[i] += 1e-3f * s; } }
#endif
    if (hi < 7) { grid.sync(); for (int i = c.gtid; i < TT * DM / 4; i += c.ngt) ((f32x4*)a.out)[i] = ((const f32x4*)in[0])[i]; }
#undef IN
#undef SYNC
}

#ifndef DBG_HI
#define DBG_HI NPHASE
#endif
#ifndef MK_PER_PHASE
#define MK_PER_PHASE 0
#endif
extern "C" void kernel_launch(void* const* d_in, const int* in_sizes, int n_in, void* d_out, int out_size, void* d_ws, size_t ws_size, hipStream_t stream) {
    static int grid = 0;
    if (grid == 0) {
        if (n_in != 34 || out_size != TT * DM || ws_size < WS_END) { fprintf(stderr, "kernel_launch: unexpected shapes (n_in %d out %d ws %zu)\n", n_in, out_size, ws_size); grid = -1; return; }
        int dev = 0, cus = 0, per_cu = 0;
        hipGetDevice(&dev); hipDeviceGetAttribute(&cus, hipDeviceAttributeMultiprocessorCount, dev);
        if (hipFuncSetAttribute((const void*)fwd_kernel, hipFuncAttributeMaxDynamicSharedMemorySize, LDS_BYTES) != hipSuccess) { fprintf(stderr, "kernel_launch: hipFuncSetAttribute failed\n"); grid = -1; return; }
        if (hipOccupancyMaxActiveBlocksPerMultiprocessor(&per_cu, (const void*)fwd_kernel, 512, LDS_BYTES) != hipSuccess || per_cu < 1) { fprintf(stderr, "kernel_launch: occupancy query says %d\n", per_cu); per_cu = 1; }
        (void)hipGetLastError();
        grid = cus;
        if (grid > 256) grid = 256;
    }
    if (grid < 0) return;
    if (hipMemsetAsync((char*)d_ws + WS_BARRIER, 0, 16384, stream) != hipSuccess) { fprintf(stderr, "kernel_launch: memset failed\n"); return; }
    Args a{};
    for (int i = 0; i < 34; ++i) a.in[i] = (const float*)d_in[i];
    a.out = (float*)d_out; a.ws = (unsigned char*)d_ws;
#if MK_PER_PHASE
    for (int p = 0; p < NPHASE; ++p) { a.ph_lo = p; a.ph_hi = p + 1; hipLaunchKernelGGL(fwd_kernel, dim3(grid), dim3(512), LDS_BYTES, stream, a); }
#else
    a.ph_lo = 0; a.ph_hi = DBG_HI;
    void* args[] = {&a};
    hipError_t e = hipLaunchCooperativeKernel((const void*)fwd_kernel, dim3(grid), dim3(512), args, LDS_BYTES, stream);
    if (e != hipSuccess) fprintf(stderr, "cooperative launch failed: %s (grid %d)\n", hipGetErrorString(e), grid);
#endif
}
```

```cpp
#include <hip/hip_runtime.h>
#include <hip/hip_cooperative_groups.h>
#include <cstdio>
#include <cstdint>
namespace cg = cooperative_groups;
namespace pg8 {
#define PG8_LAS __attribute__((address_space(3)))
typedef unsigned short bf16_t;
typedef short bf16x8 __attribute__((ext_vector_type(8)));
typedef float f32x4 __attribute__((ext_vector_type(4)));
typedef unsigned u32x4 __attribute__((ext_vector_type(4)));
constexpr int BM = 256, BK = 64, HALF = 128, HTB = HALF * BK * 2  , STAGE_BYTES = 8 * HTB, NXCD = 8, WGM = 8;

__host__ __device__ __forceinline__ int lds_byte(int r, int c) { const int st = (r >> 4) * 2 + (c >> 5), rr = r & 15, cc = c & 31, ob = rr * 64 + cc * 2; return st * 1024 + (ob ^ (((ob >> 9) & 1) << 5)); }
__host__ __device__ __forceinline__ void stage_rc(int b, int& R, int& C) { const int st = b / 1024, sb = b % 1024, swz = sb ^ (((sb >> 9) & 1) << 5); R = (st >> 1) * 16 + swz / 64; C = (st & 1) * 32 + (swz % 64) / 2; }
__host__ __device__ __forceinline__ int perm32(int rho) { const int n = rho >> 4, i = rho & 15; return 8 * (i >> 2) + 4 * n + (i & 3); }

struct Unit { int pm, pn; };
struct Gemm { const bf16_t* A; const bf16_t* Bt; int M, N, K; };

struct StaticOrder {
    int nM, nN, nwg, G, c;
    __host__ __device__ void init(int M, int N, int G_, int c_) { nM = M / BM; nN = N / BM; nwg = nM * nN; G = G_; c = c_; }
    __host__ __device__ bool next(int i, Unit& u) const {
        const long L = (long)i * G + c; if (L >= nwg) return false;
        int wgid = (int)L; { const int q = nwg / NXCD, r = nwg % NXCD, xcd = wgid % NXCD, off = wgid / NXCD; wgid = (xcd < r ? xcd * (q + 1) : r * (q + 1) + (xcd - r) * q) + off; }
        const int nig = WGM * nN, gid = wgid / nig, fm = gid * WGM, gsz = (nM - fm) < WGM ? (nM - fm) : WGM;
        u.pm = fm + ((wgid % nig) % gsz); u.pn = (wgid % nig) / gsz; return true;
    }
    __device__ __forceinline__ void a_ready(const Unit&) const {}
    __device__ __forceinline__ void done(const Unit&) const {}
};

__device__ __forceinline__ unsigned cvt_pk_bf16(float lo, float hi) { unsigned r; asm volatile("v_cvt_pk_bf16_f32 %0, %1, %2" : "=v"(r) : "v"(lo), "v"(hi)); return r; }
typedef float f32x2 __attribute__((ext_vector_type(2)));
template <class Epi, class Sched, bool ALIGN_EPI = false, bool SP2 = false>
__device__ __forceinline__ void gemm_phase(PG8_LAS unsigned char* lds, const Gemm g, const Sched& S, const Epi& E) {
    const int tid = threadIdx.x, wid = __builtin_amdgcn_readfirstlane(tid >> 6), lane = tid & 63, wr = wid >> 2, wc = wid & 3, fr = lane & 15, fq = lane >> 4;
    const int K = g.K, nt = K / BK;
    unsigned voffA[2], voffB[2];
#pragma unroll
    for (int i = 0; i < 2; ++i) { int R, C; stage_rc(tid * 16 + i * 8192, R, C); const int Rb = Epi::PERM ? ((R & ~31) + perm32(R & 31)) : R;
        voffA[i] = (unsigned)(R * K + C) * 2u; voffB[i] = (unsigned)(Rb * K + C) * 2u; }
    const size_t kstep = (size_t)(BK * 2);
    const size_t hstep = (size_t)HALF * K * 2;
    const size_t tstep = 2 * hstep;
    const unsigned ldsw = (unsigned)wid * 1024u;
    const int aoff = lds_byte(wr * 64 + fr, fq * 8), boff = lds_byte(wc * 32 + fr, fq * 8);
#define PG8_SA(b, h) (((b) * 2 + (h)) * HTB)
#define PG8_SB(b, h) ((4 + (b) * 2 + (h)) * HTB)
#define PG8_STAGE(bufoff, gbase, voff) do { _Pragma("unroll") for (int _i = 0; _i < 2; ++_i) \
        __builtin_amdgcn_global_load_lds((const unsigned*)((const char*)(gbase) + (voff)[_i]), (PG8_LAS unsigned*)(lds + (bufoff) + ldsw + _i * 8192), 16, 0, 0); } while (0)
#define PG8_LDA(dst, b, h) do { _Pragma("unroll") for (int m = 0; m < 4; ++m) _Pragma("unroll") for (int k = 0; k < 2; ++k) dst[m][k] = *(const PG8_LAS bf16x8*)(lds + PG8_SA(b, h) + aoff + m * 2048 + k * 1024); } while (0)
#define PG8_LDB(dst, b, h) do { _Pragma("unroll") for (int n = 0; n < 2; ++n) _Pragma("unroll") for (int k = 0; k < 2; ++k) dst[n][k] = *(const PG8_LAS bf16x8*)(lds + PG8_SB(b, h) + boff + n * 2048 + k * 1024); } while (0)
#define PG8_MMA(ai, bj, At, Bt) do { __builtin_amdgcn_s_setprio(1); _Pragma("unroll") for (int m = 0; m < 4; ++m) _Pragma("unroll") for (int n = 0; n < 2; ++n) _Pragma("unroll") for (int k = 0; k < 2; ++k) \
        acc[ai][bj][m][n] = __builtin_amdgcn_mfma_f32_16x16x32_bf16(Bt[n][k], At[m][k], acc[ai][bj][m][n], 0, 0, 0); __builtin_amdgcn_s_setprio(0); } while (0)
#define PG8_WAIT_V(n) asm volatile("s_waitcnt vmcnt(" #n ")" ::: "memory")
#define PG8_WAIT_L(n) asm volatile("s_waitcnt lgkmcnt(" #n ")" ::: "memory")
#define PG8_BAR __builtin_amdgcn_s_barrier()
#define PG8_SCHED __builtin_amdgcn_sched_barrier(0)
    Unit cur, nxt; int ui = 0;
    if (!S.next(0, cur)) return;
    f32x4 acc[2][2][4][2];
#pragma unroll
    for (int a = 0; a < 2; ++a)
#pragma unroll
        for (int b = 0; b < 2; ++b)
#pragma unroll
            for (int m = 0; m < 4; ++m)
#pragma unroll
                for (int n = 0; n < 2; ++n) acc[a][b][m][n] = (f32x4){0.f, 0.f, 0.f, 0.f};
    bf16x8 At[4][2], B0[2][2], B1[2][2];
    const char* cA = (const char*)g.A + (size_t)cur.pm * tstep; const char* cB = (const char*)g.Bt + (size_t)cur.pn * tstep;
    S.a_ready(cur);
    if constexpr (SP2) {
        PG8_STAGE(PG8_SB(0, 0), cB, voffB); PG8_STAGE(PG8_SB(0, 1), cB + hstep, voffB); PG8_STAGE(PG8_SA(0, 0), cA, voffA); PG8_STAGE(PG8_SA(0, 1), cA + hstep, voffA);
        if (wr == 1) PG8_BAR;
        PG8_WAIT_V(2); PG8_BAR;
        PG8_STAGE(PG8_SB(1, 0), cB + kstep, voffB); PG8_STAGE(PG8_SA(1, 0), cA + kstep, voffA); PG8_STAGE(PG8_SB(1, 1), cB + hstep + kstep, voffB);
        PG8_WAIT_V(6); PG8_BAR;
    } else {
        PG8_STAGE(PG8_SB(0, 0), cB, voffB); PG8_STAGE(PG8_SA(0, 0), cA, voffA); PG8_STAGE(PG8_SB(0, 1), cB + hstep, voffB); PG8_STAGE(PG8_SA(0, 1), cA + hstep, voffA);
        if (wr == 1) PG8_BAR;
        PG8_WAIT_V(4); PG8_BAR;
        PG8_STAGE(PG8_SB(1, 0), cB + kstep, voffB); PG8_STAGE(PG8_SA(1, 0), cA + kstep, voffA); PG8_STAGE(PG8_SB(1, 1), cB + hstep + kstep, voffB);
        PG8_WAIT_V(6); PG8_BAR;
    }
    for (;;) {
        const bool has_next = S.next(ui + 1, nxt);
        const char* nA = has_next ? (const char*)g.A + (size_t)nxt.pm * tstep : cA; const char* nB = has_next ? (const char*)g.Bt + (size_t)nxt.pn * tstep : cB;
        for (int t = 0; t < nt; t += 2) {
            const bool last = (t == nt - 2);
            const char* a1 = cA + (size_t)(t + 1) * kstep;
            const char* a2 = last ? nA : cA + (size_t)(t + 2) * kstep; const char* b2 = last ? nB : cB + (size_t)(t + 2) * kstep;
            const char* a3 = a2 + kstep; const char* b3 = b2 + kstep;
            if (last && has_next) S.a_ready(nxt);
            if constexpr (SP2) {
            PG8_LDB(B0, 0, 0); PG8_LDB(B1, 0, 1); PG8_SCHED; PG8_LDA(At, 0, 0); PG8_STAGE(PG8_SA(1, 1), a1 + hstep, voffA);
            PG8_WAIT_V(8); PG8_WAIT_L(0); PG8_BAR; PG8_MMA(0, 0, At, B0); PG8_MMA(0, 1, At, B1); PG8_BAR; PG8_SCHED;
            PG8_LDA(At, 0, 1); PG8_STAGE(PG8_SB(0, 0), b2, voffB); PG8_STAGE(PG8_SB(0, 1), b2 + hstep, voffB); PG8_STAGE(PG8_SA(0, 0), a2, voffA);
            PG8_WAIT_V(8); PG8_WAIT_L(0); PG8_BAR; PG8_MMA(1, 0, At, B0); PG8_MMA(1, 1, At, B1); PG8_BAR; PG8_SCHED;
            PG8_LDB(B0, 1, 0); PG8_LDB(B1, 1, 1); PG8_SCHED; PG8_LDA(At, 1, 0); PG8_STAGE(PG8_SA(0, 1), a2 + hstep, voffA);
            PG8_WAIT_V(8); PG8_WAIT_L(0); PG8_BAR; PG8_MMA(0, 0, At, B0); PG8_MMA(0, 1, At, B1); PG8_BAR; PG8_SCHED;
            PG8_LDA(At, 1, 1); PG8_STAGE(PG8_SB(1, 0), b3, voffB); PG8_STAGE(PG8_SB(1, 1), b3 + hstep, voffB); PG8_STAGE(PG8_SA(1, 0), a3, voffA);
            PG8_WAIT_V(8); PG8_WAIT_L(0); PG8_BAR; PG8_MMA(1, 0, At, B0); PG8_MMA(1, 1, At, B1); PG8_BAR; PG8_SCHED;
            } else {
            PG8_LDB(B0, 0, 0); PG8_SCHED; PG8_LDA(At, 0, 0); PG8_STAGE(PG8_SA(1, 1), a1 + hstep, voffA);
            PG8_WAIT_L(8); PG8_BAR; PG8_WAIT_L(0); PG8_MMA(0, 0, At, B0); PG8_BAR; PG8_SCHED;
            PG8_LDB(B1, 0, 1); PG8_STAGE(PG8_SB(0, 0), b2, voffB);
            PG8_BAR; PG8_WAIT_L(0); PG8_MMA(0, 1, At, B1); PG8_BAR;
            PG8_LDA(At, 0, 1); PG8_STAGE(PG8_SA(0, 0), a2, voffA);
            PG8_BAR; PG8_WAIT_L(0); PG8_MMA(1, 0, At, B0); PG8_BAR; PG8_SCHED;
            PG8_STAGE(PG8_SB(0, 1), b2 + hstep, voffB);
            PG8_WAIT_V(6); PG8_BAR; PG8_MMA(1, 1, At, B1); PG8_BAR;
            PG8_LDB(B0, 1, 0); PG8_SCHED; PG8_LDA(At, 1, 0); PG8_STAGE(PG8_SA(0, 1), a2 + hstep, voffA);
            PG8_WAIT_L(8); PG8_BAR; PG8_WAIT_L(0); PG8_MMA(0, 0, At, B0); PG8_BAR; PG8_SCHED;
            PG8_LDB(B1, 1, 1); PG8_STAGE(PG8_SB(1, 0), b3, voffB);
            PG8_BAR; PG8_WAIT_L(0); PG8_MMA(0, 1, At, B1); PG8_BAR;
            PG8_LDA(At, 1, 1); PG8_STAGE(PG8_SA(1, 0), a3, voffA);
            PG8_BAR; PG8_WAIT_L(0); PG8_MMA(1, 0, At, B0); PG8_BAR; PG8_SCHED;
            PG8_STAGE(PG8_SB(1, 1), b3 + hstep, voffB);
            PG8_WAIT_V(6); PG8_BAR; PG8_MMA(1, 1, At, B1); PG8_BAR;
            }
        }
        if constexpr (ALIGN_EPI) { if (wr == 0) PG8_BAR; }
        if constexpr (!Epi::AFTER_DRAIN) { E(acc, cur, wr, wc, fr, fq); S.done(cur); }
        if (!has_next) break;
#pragma unroll
        for (int a = 0; a < 2; ++a)
#pragma unroll
            for (int b = 0; b < 2; ++b)
#pragma unroll
                for (int m = 0; m < 4; ++m)
#pragma unroll
                    for (int n = 0; n < 2; ++n) acc[a][b][m][n] = (f32x4){0.f, 0.f, 0.f, 0.f};
        cur = nxt; cA = nA; cB = nB; ++ui;
        if constexpr (ALIGN_EPI) { if (wr == 1) PG8_BAR; }
    }
    PG8_WAIT_V(0);
    if constexpr (!ALIGN_EPI) { if (wr == 0) PG8_BAR; }
    PG8_BAR;
    if constexpr (Epi::AFTER_DRAIN) { E.fused(acc, cur, wr, wc, fr, fq, lds, wid, lane); S.done(cur); }
#undef PG8_SA
#undef PG8_SB
#undef PG8_STAGE
#undef PG8_LDA
#undef PG8_LDB
#undef PG8_MMA
#undef PG8_WAIT_V
#undef PG8_WAIT_L
#undef PG8_BAR
#undef PG8_SCHED
}
}
namespace pg8 {
typedef unsigned u32x2 __attribute__((ext_vector_type(2)));
typedef float f32x2_t __attribute__((ext_vector_type(2))); typedef __bf16 bf16x2_t __attribute__((ext_vector_type(2)));
__device__ __forceinline__ unsigned cvtpk(float lo, float hi) { f32x2_t v = {lo, hi}; bf16x2_t b = __builtin_convertvector(v, bf16x2_t); return __builtin_bit_cast(unsigned, b); }
__device__ __forceinline__ float sigm(float x) { return __builtin_amdgcn_rcpf(1.0f + __expf(-x)); }
__device__ __forceinline__ float gelu_tanh(float x) { const float u = 1.5957691216057308f * (x + 0.044715f * x * x * x); return x * __builtin_amdgcn_rcpf(1.0f + __expf(-u)); }
__device__ __forceinline__ float bfw(unsigned w, int hi) { return __uint_as_float(hi ? (w & 0xffff0000u) : (w << 16)); }
__device__ __forceinline__ float logsig(float z) { return fminf(z, 0.f) - log1pf(__expf(-fabsf(z))); }
__device__ __forceinline__ float dpp_ror1(float v) { return __int_as_float(__builtin_amdgcn_update_dpp(__float_as_int(v), __float_as_int(v), 0x121, 0xf, 0xf, false)); }
__device__ __forceinline__ float dpp_ror2(float v) { return __int_as_float(__builtin_amdgcn_update_dpp(__float_as_int(v), __float_as_int(v), 0x122, 0xf, 0xf, false)); }

struct EpiProj {
    static constexpr bool PERM = true, AFTER_DRAIN = false;
    bf16_t* O; int ldc; const float* ss;
    __device__ __forceinline__ void operator()(const f32x4 (&acc)[2][2][4][2], const Unit& u, int wr, int wc, int fr, int fq) const {
        const int row0 = u.pm * BM + wr * 64 + fr, col0 = u.pn * BM + wc * 32 + 8 * fq;
#pragma unroll
        for (int ai = 0; ai < 2; ++ai)
#pragma unroll
            for (int m = 0; m < 4; ++m) {
                const int row = row0 + ai * HALF + m * 16;
                const float rs = rsqrtf(ss[row] * (1.0f / 1024.0f) + 1e-6f);
                bf16_t* rowp = O + (size_t)row * ldc + col0;
#pragma unroll
                for (int bj = 0; bj < 2; ++bj) {
                    const f32x4 v0 = acc[ai][bj][m][0] * rs, v1 = acc[ai][bj][m][1] * rs;
                    u32x4 w; w.x = cvt_pk_bf16(v0[0], v0[1]); w.y = cvt_pk_bf16(v0[2], v0[3]); w.z = cvt_pk_bf16(v1[0], v1[1]); w.w = cvt_pk_bf16(v1[2], v1[3]);
                    *(u32x4*)(rowp + bj * HALF) = w;
                }
            }
    }
};

struct EpiGates {
    static constexpr bool PERM = true, AFTER_DRAIN = false;
    const bf16_t* xc; bf16_t* loga; bf16_t* gi; const float* ga_b; const float* gx_b; const float* lam;
    __device__ __forceinline__ void operator()(const f32x4 (&acc)[2][2][4][2], const Unit& u, int wr, int wc, int fr, int fq) const {
        const int row0 = u.pm * BM + wr * 64 + fr, ch0 = u.pn * HALF + wc * 32 + 8 * fq;
        float gab[8], gxb[8], ls[8];
#pragma unroll
        for (int e = 0; e < 8; ++e) { gab[e] = ga_b[ch0 + e]; gxb[e] = gx_b[ch0 + e]; ls[e] = 8.0f * logsig(lam[ch0 + e]); }
#pragma unroll
        for (int ai = 0; ai < 2; ++ai)
#pragma unroll
            for (int m = 0; m < 4; ++m) {
                const int row = row0 + ai * HALF + m * 16;
                const u32x4 xv = *(const u32x4*)(xc + (size_t)row * 512 + ch0);
                float la[8], g[8];
#pragma unroll
                for (int n = 0; n < 2; ++n)
#pragma unroll
                    for (int e = 0; e < 4; ++e) {
                        const int idx = 4 * n + e;
                        const float r = acc[ai][0][m][n][e] + gab[idx], i = acc[ai][1][m][n][e] + gxb[idx];
                        la[idx] = sigm(r) * ls[idx];
                        g[idx] = sigm(i) * bfw(xv[idx >> 1], idx & 1);
                    }
                u32x4 w; w.x = cvt_pk_bf16(la[0], la[1]); w.y = cvt_pk_bf16(la[2], la[3]); w.z = cvt_pk_bf16(la[4], la[5]); w.w = cvt_pk_bf16(la[6], la[7]);
                *(u32x4*)(loga + (size_t)row * 512 + ch0) = w;
                u32x4 w2; w2.x = cvt_pk_bf16(g[0], g[1]); w2.y = cvt_pk_bf16(g[2], g[3]); w2.z = cvt_pk_bf16(g[4], g[5]); w2.w = cvt_pk_bf16(g[6], g[7]);
                *(u32x4*)(gi + (size_t)row * 512 + ch0) = w2;
            }
    }
};

struct EpiRes {
    static constexpr bool PERM = false, AFTER_DRAIN = false;
    const float* base; float* out; bf16_t* xb; float* ss;
    __device__ __forceinline__ void operator()(const f32x4 (&acc)[2][2][4][2], const Unit& u, int wr, int wc, int fr, int fq) const {
        const int row0 = u.pm * BM + wr * 64 + fr, col0 = u.pn * BM + wc * 32 + 4 * fq;
#pragma unroll
        for (int ai = 0; ai < 2; ++ai)
#pragma unroll
            for (int m = 0; m < 4; ++m) {
                const int row = row0 + ai * HALF + m * 16; float q = 0.f;
#pragma unroll
                for (int bj = 0; bj < 2; ++bj)
#pragma unroll
                    for (int n = 0; n < 2; ++n) {
                        const size_t off = (size_t)row * 1024 + col0 + bj * HALF + n * 16;
                        const f32x4 b = *(const f32x4*)(base + off);
                        const f32x4 o = b + acc[ai][bj][m][n];
                        *(f32x4*)(out + off) = o;
                        if (xb) { u32x2 w; w.x = cvt_pk_bf16(o[0], o[1]); w.y = cvt_pk_bf16(o[2], o[3]); *(u32x2*)(xb + off) = w; }
                        q += (o[0] * o[0] + o[1] * o[1]) + (o[2] * o[2] + o[3] * o[3]);
                    }
                if (ss) { q += __shfl_xor(q, 16); q += __shfl_xor(q, 32); if (fq == 0) atomicAdd(ss + row, q); }
            }
    }
};

struct EpiGlu {
    static constexpr bool PERM = true, AFTER_DRAIN = false;
    const bf16_t* ys; bf16_t* ycat; const float* bias;
    __device__ __forceinline__ void operator()(const f32x4 (&acc)[2][2][4][2], const Unit& u, int wr, int wc, int fr, int fq) const {
        const int row0 = u.pm * BM + wr * 64 + fr, col0 = u.pn * BM + wc * 32 + 8 * fq;
#pragma unroll
        for (int bj = 0; bj < 2; ++bj) {
            const int col = col0 + bj * HALF;
            float bs[8];
#pragma unroll
            for (int e = 0; e < 8; ++e) bs[e] = bias[col + e];
#pragma unroll
            for (int ai = 0; ai < 2; ++ai)
#pragma unroll
                for (int m = 0; m < 4; ++m) {
                    const int row = row0 + ai * HALF + m * 16;
                    const u32x4 yv = *(const u32x4*)(ys + (size_t)row * 512 + col);
                    float o[8];
#pragma unroll
                    for (int n = 0; n < 2; ++n)
#pragma unroll
                        for (int e = 0; e < 4; ++e) { const int idx = 4 * n + e; o[idx] = bfw(yv[idx >> 1], idx & 1) * sigm(acc[ai][bj][m][n][e] + bs[idx]); }
                    u32x4 w; w.x = cvt_pk_bf16(o[0], o[1]); w.y = cvt_pk_bf16(o[2], o[3]); w.z = cvt_pk_bf16(o[4], o[5]); w.w = cvt_pk_bf16(o[6], o[7]);
                    *(u32x4*)(ycat + (size_t)row * 1024 + col) = w;
                }
        }
    }
};

struct EpiFfn {
    static constexpr bool PERM = true, AFTER_DRAIN = false;
    bf16_t* U; const float* ss; const float* cw; const float* cb; float* edgeA; float* edgeL; float* tailA; PG8_LAS float* halo;
    __device__ __forceinline__ void operator()(const f32x4 (&acc)[2][2][4][2], const Unit& u, int wr, int wc, int fr, int fq) const {
        const int cl = wc * 32 + 8 * fq, ch0 = u.pn * HALF + cl;
        const int row0 = u.pm * BM + wr * 64 + fr;
        float w0[8], w1[8], w2[8], bb[8];
#pragma unroll
        for (int e = 0; e < 8; ++e) { w0[e] = cw[ch0 + e]; w1[e] = cw[3072 + ch0 + e]; w2[e] = cw[6144 + ch0 + e]; bb[e] = cb[ch0 + e]; }
        float rs[2][4];
#pragma unroll
        for (int ai = 0; ai < 2; ++ai)
#pragma unroll
            for (int m = 0; m < 4; ++m) rs[ai][m] = rsqrtf(ss[row0 + ai * HALF + m * 16] * (1.0f / 1024.0f) + 1e-6f);
        if (fr >= 14) {
#pragma unroll
            for (int ai = 0; ai < 2; ++ai) {
                PG8_LAS float* hp = halo + ((ai * 2 + wr) * 2 + (fr - 14)) * 128 + cl;
                *(PG8_LAS f32x4*)hp = acc[ai][0][3][0] * rs[ai][3];
                *(PG8_LAS f32x4*)(hp + 4) = acc[ai][0][3][1] * rs[ai][3];
            }
            if (wr == 1) {
                float* tp = tailA + (size_t)(u.pm * 2 + (fr - 14)) * 3072 + ch0;
                *(f32x4*)tp = acc[1][0][3][0] * rs[1][3]; *(f32x4*)(tp + 4) = acc[1][0][3][1] * rs[1][3];
            }
        }
        if (wr == 0 && fr < 2) {
            float* ea = edgeA + (size_t)(u.pm * 2 + fr) * 3072 + ch0; float* el = edgeL + (size_t)(u.pm * 2 + fr) * 3072 + ch0;
            *(f32x4*)ea = acc[0][0][0][0] * rs[0][0]; *(f32x4*)(ea + 4) = acc[0][0][0][1] * rs[0][0];
            *(f32x4*)el = acc[0][1][0][0] * rs[0][0]; *(f32x4*)(el + 4) = acc[0][1][0][1] * rs[0][0];
        }
        asm volatile("s_waitcnt lgkmcnt(0)" ::: "memory"); __builtin_amdgcn_s_barrier(); asm volatile("" ::: "memory");
#pragma unroll
        for (int ai = 0; ai < 2; ++ai) {
            f32x4 pv[2];
            if (ai == 0 && wr == 0) { pv[0] = (f32x4){0.f, 0.f, 0.f, 0.f}; pv[1] = pv[0]; }
            else {
                const int pai = (wr == 1) ? ai : 0, pwr = (wr == 1) ? 0 : 1;
                const PG8_LAS float* hp = halo + ((pai * 2 + pwr) * 2 + (fr & 1)) * 128 + cl;
                pv[0] = *(const PG8_LAS f32x4*)hp; pv[1] = *(const PG8_LAS f32x4*)(hp + 4);
            }
#pragma unroll
            for (int m = 0; m < 4; ++m) {
                const int row = row0 + ai * HALF + m * 16;
                f32x4 av[2]; av[0] = acc[ai][0][m][0] * rs[ai][m]; av[1] = acc[ai][0][m][1] * rs[ai][m];
                float o[8];
#pragma unroll
                for (int n = 0; n < 2; ++n)
#pragma unroll
                    for (int e = 0; e < 4; ++e) {
                        const int idx = 4 * n + e;
                        const float cur = av[n][e], prv = pv[n][e];
                        const float r1c = dpp_ror1(cur), r1p = dpp_ror1(prv), r2c = dpp_ror2(cur), r2p = dpp_ror2(prv);
                        const float t1 = (fr >= 1) ? r1c : r1p, t2 = (fr >= 2) ? r2c : r2p;
                        const float cv = w0[idx] * t2 + w1[idx] * t1 + w2[idx] * cur + bb[idx];
                        o[idx] = gelu_tanh(cv) * (acc[ai][1][m][n][e] * rs[ai][m]);
                    }
                u32x4 w; w.x = cvt_pk_bf16(o[0], o[1]); w.y = cvt_pk_bf16(o[2], o[3]); w.z = cvt_pk_bf16(o[4], o[5]); w.w = cvt_pk_bf16(o[6], o[7]);
                *(u32x4*)(U + (size_t)row * 3072 + ch0) = w;
                pv[0] = av[0]; pv[1] = av[1];
            }
        }
    }
};
}
#define LAS __attribute__((address_space(3)))
typedef unsigned short bf16;
typedef short bf16x8 __attribute__((ext_vector_type(8)));
typedef float f32x4 __attribute__((ext_vector_type(4)));
typedef unsigned u32x4 __attribute__((ext_vector_type(4)));
typedef unsigned u32x2 __attribute__((ext_vector_type(2)));
using pg8::cvt_pk_bf16; using pg8::sigm; using pg8::gelu_tanh; using pg8::bfw; using pg8::logsig;

constexpr int TT = 16384, SEQ = 8192, DM = 1024, DFF = 3072;
constexpr size_t MiB = 1u << 20;
constexpr size_t WS_SS = 0;
constexpr size_t WS_SUMA = 256 * 1024, WS_SUMB = 768 * 1024;
constexpr size_t WS_DECAY = 1280 * 1024;
constexpr size_t WS_BARRIER = 3 * 1024 * 1024;
constexpr size_t WS_ROPE = 1536 * 1024;
constexpr size_t WS_W_EIN = 4 * MiB, WS_W_EOUT = 9 * MiB, WS_W_GATE = 11 * MiB, WS_W_FIN0 = 12 * MiB, WS_W_FIN1 = 24 * MiB, WS_W_FOUT0 = 36 * MiB, WS_W_FOUT1 = 42 * MiB;
constexpr size_t WS_W_OIN = 48 * MiB, WS_W_GLU = 53 * MiB, WS_W_OOUT = 54 * MiB, WS_S5A = 56 * MiB, WS_S5F = 62 * MiB;
constexpr size_t WS_XB = 64 * MiB;
constexpr size_t WS_LOGA = 64 * MiB, WS_GI = 80 * MiB;
constexpr size_t WS_KDT = 64 * MiB, WS_VTG = 72 * MiB, WS_SX = 88 * MiB;
constexpr size_t WS_BIG = 96 * MiB;
constexpr size_t WS_XC = 224 * MiB, WS_KVS = 168 * MiB;
constexpr size_t WS_YCAT = 192 * MiB;
constexpr size_t WS_XLOC = 224 * MiB;
constexpr size_t WS_EDGEA = 240 * MiB, WS_EDGEL = 242 * MiB, WS_TAILA = 244 * MiB;
constexpr size_t WS_END = 256 * MiB;
constexpr int P0LD = 2568, P1LD = 2304;
constexpr int VTP = SEQ + 128;
constexpr int LDS_BYTES = 147456, HALO_OFF = 131072 + 1024;

__device__ __forceinline__ float wave_sum(float v) {
#pragma unroll
    for (int o = 1; o < 64; o <<= 1) v += __shfl_xor(v, o);
    return v;
}
__device__ __forceinline__ float bf2f(bf16 b) { return __uint_as_float((unsigned)b << 16); }
__device__ __forceinline__ bf16 f2bf(float f) { return (bf16)(cvt_pk_bf16(f, 0.f) & 0xffffu); }
__device__ __forceinline__ f32x4 mfma16(bf16x8 a, bf16x8 b, f32x4 c) { return __builtin_amdgcn_mfma_f32_16x16x32_bf16(a, b, c, 0, 0, 0); }
__device__ __forceinline__ bf16x8 ld8(const bf16* p) { return *(const bf16x8*)p; }
__device__ __forceinline__ void unpack8(u32x4 v, float* f) {
#pragma unroll
    for (int i = 0; i < 4; ++i) { f[2 * i] = __uint_as_float(v[i] << 16); f[2 * i + 1] = __uint_as_float(v[i] & 0xffff0000u); }
}
__device__ __forceinline__ u32x4 pack8v(const float* f) { u32x4 w; w.x = pg8::cvtpk(f[0], f[1]); w.y = pg8::cvtpk(f[2], f[3]); w.z = pg8::cvtpk(f[4], f[5]); w.w = pg8::cvtpk(f[6], f[7]); return w; }
__device__ __forceinline__ u32x4 pack8(const float* f) { u32x4 w; w.x = cvt_pk_bf16(f[0], f[1]); w.y = cvt_pk_bf16(f[2], f[3]); w.z = cvt_pk_bf16(f[4], f[5]); w.w = cvt_pk_bf16(f[6], f[7]); return w; }

struct Ctx { int tid, lane, wave, gw, ngw, gtid, ngt; LAS unsigned char* lds; };

struct TrDesc { const float* W; const float* gk; bf16* WT; int ldw, nsrc, ldt, k0, n0, dst_row0; };
__device__ __forceinline__ void tr_load(const TrDesc& t, int lane, float* v) {
    const int n = t.n0 + (lane & 31);
#pragma unroll
    for (int i = 0; i < 32; ++i) { const int kk = 2 * i + (lane >> 5); v[i] = (n < t.nsrc) ? t.W[(size_t)(t.k0 + kk) * t.ldw + n] : 0.f; }
}
__device__ __forceinline__ void tr_finish(const TrDesc& t, int lane, const float* v, LAS float* scr) {
#pragma unroll
    for (int i = 0; i < 32; ++i) { const int kk = 2 * i + (lane >> 5); float x = v[i]; if (t.gk) x *= t.gk[t.k0 + kk]; scr[kk * 33 + (lane & 31)] = x; }
    asm volatile("s_waitcnt lgkmcnt(0)" ::: "memory");
    const int c = lane & 7;
#pragma unroll
    for (int j = 0; j < 4; ++j) {
        const int n = (lane >> 3) + 8 * j; const LAS float* s = scr + (8 * c) * 33 + n;
        u32x4 o; o.x = cvt_pk_bf16(s[0], s[33]); o.y = cvt_pk_bf16(s[66], s[99]); o.z = cvt_pk_bf16(s[132], s[165]); o.w = cvt_pk_bf16(s[198], s[231]);
        *(u32x4*)(t.WT + (size_t)(t.dst_row0 + n) * t.ldt + t.k0 + 8 * c) = o;
    }
    asm volatile("s_waitcnt lgkmcnt(0)" ::: "memory");
}

struct S5P { float m, th, cr, ci, ar, ai; };
__device__ __forceinline__ S5P s5_params(const float* lam_re, const float* lam_im, const float* log_step, int g, int n) {
    const float step = expf(log_step[g]), lr = lam_re[g * 64 + n], li = lam_im[g * 64 + n];
    S5P p; p.m = lr * step; p.th = li * step;
    float sn, cs; sincosf(p.th, &sn, &cs);
    const float mag = expf(p.m), ar = mag * cs, ai = mag * sn, den = lr * lr + li * li;
    p.cr = ((ar - 1.0f) * lr + ai * li) / den; p.ci = (ai * lr - (ar - 1.0f) * li) / den; p.ar = ar; p.ai = ai;
    return p;
}
__device__ __forceinline__ void s5_pow(const S5P& p, float tau, float& pr, float& pi) {
    float sn, cs; sincosf(p.th * tau, &sn, &cs); const float mag = expf(p.m * tau); pr = mag * cs; pi = mag * sn;
}

__device__ __forceinline__ TrDesc tr_decode(const float* const* in, unsigned char* ws, int it) {
    constexpr int I_EIN = 16 * 80, I_EOUT = 16 * 32, I_FIN = 16 * 192, I_FOUT = 48 * 32, I_OIN = 16 * 72, I_GLU = 8 * 16;
    TrDesc t; int r = it;
    if (r < I_EIN) { const int kb = r / 80, nb = r % 80; t = TrDesc{in[2], in[1], (bf16*)(ws + WS_W_EIN), 2560, 2560, 1024, 64 * kb, 32 * nb, 32 * nb}; return t; } r -= I_EIN;
    if (r < I_EOUT) { const int kb = r / 32, nb = r % 32; t = TrDesc{in[12], nullptr, (bf16*)(ws + WS_W_EOUT), 1024, 1024, 1024, 64 * kb, 32 * nb, 32 * nb}; return t; } r -= I_EOUT;
    if (r < 2 * I_FIN) { const int l = r / I_FIN; r %= I_FIN; const int kb = r / 192, nb = r % 192, n0 = 32 * nb;
        const int dst = (n0 < 3072) ? (256 * (n0 / 128) + (n0 % 128)) : (256 * ((n0 - 3072) / 128) + 128 + ((n0 - 3072) % 128));
        t = TrDesc{in[30] + (size_t)l * 1024 * 6144, in[29] + l * 1024, (bf16*)(ws + (l ? WS_W_FIN1 : WS_W_FIN0)), 6144, 6144, 1024, 64 * kb, n0, dst}; return t; } r -= 2 * I_FIN;
    if (r < 2 * I_FOUT) { const int l = r / I_FOUT; r %= I_FOUT; const int kb = r / 32, nb = r % 32;
        t = TrDesc{in[33] + (size_t)l * 3072 * 1024, nullptr, (bf16*)(ws + (l ? WS_W_FOUT1 : WS_W_FOUT0)), 1024, 1024, 3072, 64 * kb, 32 * nb, 32 * nb}; return t; } r -= 2 * I_FOUT;
    if (r < I_OIN) { const int kb = r / 72, nb = r % 72; t = TrDesc{in[14], in[13], (bf16*)(ws + WS_W_OIN), 2064, 2064, 1024, 64 * kb, 32 * nb, 32 * nb}; return t; } r -= I_OIN;
    if (r < I_GLU) { const int kb = r / 16, nb = r % 16; t = TrDesc{in[23], nullptr, (bf16*)(ws + WS_W_GLU), 512, 512, 512, 64 * kb, 32 * nb, 32 * nb}; return t; } r -= I_GLU;
    { const int kb = r / 32, nb = r % 32; t = TrDesc{in[28], nullptr, (bf16*)(ws + WS_W_OOUT), 1024, 1024, 1024, 64 * kb, 32 * nb, 32 * nb}; return t; }
}
__device__ __forceinline__ void do_tr_items(const Ctx& c, const float* const* in, unsigned char* ws, int it_begin, int it_end, int widx, int nw) {
    LAS float* scr = (LAS float*)(c.lds + c.wave * 16384);
    int it = it_begin + widx;
    if (it >= it_end) return;
    TrDesc cur = tr_decode(in, ws, it); float v[32]; tr_load(cur, c.lane, v);
    for (;;) {
        const int nx = it + nw; const bool more = nx < it_end;
        TrDesc nxt = cur; float w[32];
        if (more) { nxt = tr_decode(in, ws, nx); tr_load(nxt, c.lane, w); }
        tr_finish(cur, c.lane, v, scr);
        if (!more) break;
        cur = nxt; it = nx;
#pragma unroll
        for (int i = 0; i < 32; ++i) v[i] = w[i];
    }
}
#ifndef DEFER_TR
#define DEFER_TR 0
#endif
#ifndef DEFER_P1
#define DEFER_P1 0
#endif
constexpr int TR_EIN0 = 0, TR_EOUT0 = 1280, TR_FIN00 = 1792, TR_FIN10 = 4864, TR_FOUT00 = 7936, TR_FOUT10 = 9472, TR_OIN0 = 11008, TR_GLU0 = 12160, TR_OOUT0 = 12288, TR_END = 12800;

__device__ __forceinline__ void phase_prologue(const Ctx& c, const float* const* in, unsigned char* ws) {
#if DEFER_TR
    do_tr_items(c, in, ws, TR_EIN0, TR_EOUT0, c.gw, c.ngw);
#elif DEFER_P1
    do_tr_items(c, in, ws, TR_EIN0, TR_EOUT0, c.gw, c.ngw); do_tr_items(c, in, ws, TR_FIN10, TR_END, c.gw, c.ngw);
#else
    do_tr_items(c, in, ws, TR_EIN0, TR_END, c.gw, c.ngw);
#endif
    {
        const float* x = in[0]; bf16* xb = (bf16*)(ws + WS_XB); float* ss = (float*)(ws + WS_SS);
        for (int m0 = c.gw; m0 < TT; m0 += 2 * c.ngw) {
            f32x4 v[2][4];
#pragma unroll
            for (int u = 0; u < 2; ++u) { const f32x4* xr = (const f32x4*)(x + (size_t)(m0 + u * c.ngw) * DM) + c.lane;
#pragma unroll
                for (int j = 0; j < 4; ++j) v[u][j] = xr[64 * j]; }
#pragma unroll
            for (int u = 0; u < 2; ++u) { const int m = m0 + u * c.ngw; float s = 0.f;
                u32x2* o8 = (u32x2*)(xb + (size_t)m * DM) + c.lane;
#pragma unroll
                for (int j = 0; j < 4; ++j) { const f32x4 q = v[u][j]; s += (q.x * q.x + q.y * q.y) + (q.z * q.z + q.w * q.w); u32x2 w; w.x = cvt_pk_bf16(q.x, q.y); w.y = cvt_pk_bf16(q.z, q.w); o8[64 * j] = w; }
                s = wave_sum(s);
                if (c.lane == 0) ss[m] = s; }
        }
        for (int i = c.gtid; i < 3 * TT; i += c.ngt) ss[TT + i] = 0.f;
    }
    {
        bf16* G = (bf16*)(ws + WS_W_GATE);
        for (int i = c.gtid; i < 1024 * 512; i += c.ngt) {
            const int R = i >> 9, k = i & 511, pn = R >> 8, half = (R >> 7) & 1, ch = 128 * pn + (R & 127), h = ch >> 6, j = ch & 63;
            float v = 0.f;
            if ((k >> 6) == h) v = (half ? in[7] : in[5])[(h * 64 + (k & 63)) * 64 + j];
            G[i] = f2bf(v);
        }
    }
    {
        float* RT = (float*)(ws + WS_ROPE);
        for (int i = c.gtid; i < SEQ * 8; i += c.ngt) {
            const int pos = i >> 3, e = i & 7;
            const float inv = powf(500000.0f, -(float)e * 0.125f);
            float sn, cs; sincosf((float)pos * inv, &sn, &cs);
            RT[pos * 16 + e] = cs; RT[pos * 16 + 8 + e] = sn;
        }
    }
}
__device__ __forceinline__ void phase_s5_mats(const Ctx& c, const float* const* in, unsigned char* ws) {
    {
        const float *lam_re = in[15], *lam_im = in[16], *b_re = in[17], *b_im = in[18], *c_re = in[19], *c_im = in[20], *lstep = in[22];
        bf16* AM = (bf16*)(ws + WS_S5A);
        bf16* FM = (bf16*)(ws + WS_S5F);
        for (int i = c.gtid; i < 32 * 256 * 4; i += c.ngt) {
            const int nq = i & 3, pp = (i >> 2) & 15, p = (i >> 6) & 15, g = i >> 10;
            float acc[16];
#pragma unroll
            for (int t = 0; t < 16; ++t) acc[t] = 0.f;
            for (int n = nq * 16; n < nq * 16 + 16; ++n) {
                const S5P sp = s5_params(lam_re, lam_im, lstep, g, n);
                const float br = b_re[(g * 64 + n) * 16 + pp], bi = b_im[(g * 64 + n) * 16 + pp];
                const float bbr = sp.cr * br - sp.ci * bi, bbi = sp.cr * bi + sp.ci * br;
                const float cr_ = c_re[(g * 16 + p) * 64 + n], ci_ = c_im[(g * 16 + p) * 64 + n];
                float zr = cr_ * bbr - ci_ * bbi, zi = cr_ * bbi + ci_ * bbr;
#pragma unroll
                for (int t = 0; t < 16; ++t) { acc[t] += zr; const float nr = zr * sp.ar - zi * sp.ai, ni = zr * sp.ai + zi * sp.ar; zr = nr; zi = ni; }
            }
            bf16* Ag = AM + (size_t)g * 256 * 384;
#pragma unroll
            for (int tau = 0; tau < 16; ++tau) {
                float v = acc[tau]; v += __shfl_xor(v, 1); v += __shfl_xor(v, 2);
                if ((tau & 3) == nq) {
                    const bf16 kv = f2bf(v);
                    for (int t = tau; t < 16; ++t) Ag[(t * 16 + p) * 384 + (t - tau) * 16 + pp] = kv;
                    if (tau >= 1) for (int t = 0; t + tau < 16; ++t) Ag[(t * 16 + p) * 384 + (t + tau) * 16 + pp] = 0;
                }
            }
        }
        for (int i = (c.gtid + c.ngt - c.ngt / 4) % c.ngt; i < 32 * 16 * 64; i += c.ngt) {
            const int g = i >> 10, p = (i >> 6) & 15, n = i & 63;
            const S5P sp = s5_params(lam_re, lam_im, lstep, g, n);
            const float cr_ = c_re[(g * 16 + p) * 64 + n], ci_ = c_im[(g * 16 + p) * 64 + n];
            float pr = sp.ar, pi = sp.ai;
            for (int t = 0; t < 16; ++t) {
                bf16* row = AM + ((size_t)g * 256 + t * 16 + p) * 384 + 256;
                row[n] = f2bf(cr_ * pr - ci_ * pi);
                row[64 + n] = f2bf(-(cr_ * pi + ci_ * pr));
                const float nr = pr * sp.ar - pi * sp.ai, ni = pr * sp.ai + pi * sp.ar; pr = nr; pi = ni;
            }
        }
        for (int i = (c.gtid + c.ngt - c.ngt / 2) % c.ngt; i < 32 * 64 * 16; i += c.ngt) {
            const int g = i >> 10, n = (i >> 4) & 63, pp = i & 15;
            const S5P sp = s5_params(lam_re, lam_im, lstep, g, n);
            const float br = b_re[(g * 64 + n) * 16 + pp], bi = b_im[(g * 64 + n) * 16 + pp];
            const float bbr = sp.cr * br - sp.ci * bi, bbi = sp.cr * bi + sp.ci * br;
            float pr = 1.f, pi = 0.f;
            for (int s = 15; s >= 0; --s) {
                FM[((size_t)g * 128 + n) * 256 + s * 16 + pp] = f2bf(pr * bbr - pi * bbi);
                FM[((size_t)g * 128 + 64 + n) * 256 + s * 16 + pp] = f2bf(pr * bbi + pi * bbr);
                const float nr = pr * sp.ar - pi * sp.ai, ni = pr * sp.ai + pi * sp.ar; pr = nr; pi = ni;
            }
        }
    }
}

__device__ __forceinline__ u32x4 vt_load(const bf16* src, int pitch, int coloff, int hd, int nh, int sh, int item, int lane) {
    const int cgp = item & 1023; int r = item >> 10; const int nblk = hd >> 6, dblk = r % nblk, bh = r / nblk, b = bh / nh, h = bh % nh;
    const int d = dblk * 64 + lane, Ld = SEQ >> sh;
    const bf16* s = src + (size_t)b * SEQ * pitch + coloff + h * hd + d;
    unsigned short v[8];
#pragma unroll
    for (int i = 0; i < 8; ++i) { const int col = cgp * 8 + i, rres = col / Ld, l = col - rres * Ld, t = (l << sh) + rres; v[i] = s[(size_t)t * pitch]; }
    u32x4 w; w.x = v[0] | ((unsigned)v[1] << 16); w.y = v[2] | ((unsigned)v[3] << 16); w.z = v[4] | ((unsigned)v[5] << 16); w.w = v[6] | ((unsigned)v[7] << 16);
    return w;
}
__device__ __forceinline__ void vt_store(u32x4 w, int hd, bf16* dst, int dpitch, int item, int lane) {
    const int cgp = item & 1023; int r = item >> 10; const int nblk = hd >> 6, dblk = r % nblk, bh = r / nblk;
    const int d = dblk * 64 + lane;
    *(u32x4*)(dst + ((size_t)bh * hd + d) * dpitch + cgp * 8) = w;
}
__device__ __forceinline__ void vt_store_blk(u32x4 w, bf16* dst, int item, int lane) {
    const int cgp = item & 1023, bh = item >> 10, dt = lane >> 4, dl = lane & 15, col0 = cgp * 8;
    *(u32x4*)(dst + ((size_t)((bh * 4 + dt) * 256 + (col0 >> 5))) * 512 + dl * 32 + (col0 & 31)) = w;
}
__device__ __forceinline__ void vt_run(const Ctx& c, const bf16* src, int pitch, int coloff, int hd, int nh, bf16* dst, int dpitch, int sh, int nitems) {
    for (int it0 = c.gw; it0 < nitems; it0 += 8 * c.ngw) {
        u32x4 w[8];
#pragma unroll
        for (int u = 0; u < 8; ++u) { const int it = it0 + u * c.ngw; if (it < nitems) w[u] = vt_load(src, pitch, coloff, hd, nh, sh, it, c.lane); }
#pragma unroll
        for (int u = 0; u < 8; ++u) { const int it = it0 + u * c.ngw; if (it < nitems) { if (dpitch == 0) vt_store_blk(w[u], dst, it, c.lane); else vt_store(w[u], hd, dst, dpitch, it, c.lane); } }
    }
}

__device__ __forceinline__ void vt32_load(const bf16* src, int sh, int item, int lane, u32x4* w) {
    const int kb = item & 255, bh = item >> 8, b = bh >> 3, h = bh & 7, Ld = SEQ >> sh;
    const bf16* s = src + (size_t)b * SEQ * P0LD + 2048 + h * 64 + lane;
    const int col0 = kb * 32, rres = col0 / Ld, l0 = col0 - rres * Ld;
    unsigned short v[32];
#pragma unroll
    for (int i = 0; i < 32; ++i) v[i] = s[(size_t)(((l0 + i) << sh) + rres) * P0LD];
#pragma unroll
    for (int q = 0; q < 4; ++q) { w[q].x = v[8 * q] | ((unsigned)v[8 * q + 1] << 16); w[q].y = v[8 * q + 2] | ((unsigned)v[8 * q + 3] << 16); w[q].z = v[8 * q + 4] | ((unsigned)v[8 * q + 5] << 16); w[q].w = v[8 * q + 6] | ((unsigned)v[8 * q + 7] << 16); }
}
__device__ __forceinline__ void vt32_store(const u32x4* w, bf16* dst, int p, int item, int lane) {
    const int kb = item & 255, bh = item >> 8;
    bf16* o = (p == 0) ? dst + ((size_t)bh * 64 + lane) * VTP + kb * 32 : dst + ((size_t)((bh * 4 + (lane >> 4)) * 256 + kb)) * 512 + (lane & 15) * 32;
#pragma unroll
    for (int q = 0; q < 4; ++q) *(u32x4*)(o + 8 * q) = w[q];
}
__device__ __forceinline__ void phase_prep0(const Ctx& c, const float* const* in, unsigned char* ws, float* dout) {
    bf16* P0 = (bf16*)(ws + WS_BIG); bf16* XC = (bf16*)(ws + WS_XC);
    const float* cw = in[3]; const float* cbias = in[4];
    for (int i0 = c.gtid; i0 < TT * 64; i0 += 2 * c.ngt) {
        u32x4 raw[2][4];
#pragma unroll
        for (int u = 0; u < 2; ++u) { const int i = i0 + u * c.ngt, t = i >> 6, c0 = (i & 63) * 8, tl = t & (SEQ - 1);
#pragma unroll
            for (int j = 0; j < 4; ++j) raw[u][j] = (tl - 3 + j >= 0) ? *(const u32x4*)(P0 + (size_t)(t - 3 + j) * P0LD + c0) : (u32x4){0u, 0u, 0u, 0u}; }
#pragma unroll
        for (int u = 0; u < 2; ++u) { const int i = i0 + u * c.ngt, t = i >> 6, c0 = (i & 63) * 8;
            float acc[8];
#pragma unroll
            for (int e = 0; e < 8; ++e) acc[e] = cbias[c0 + e];
#pragma unroll
            for (int j = 0; j < 4; ++j) { float v[8]; unpack8(raw[u][j], v);
#pragma unroll
                for (int e = 0; e < 8; ++e) acc[e] += cw[j * 512 + c0 + e] * v[e]; }
            *(u32x4*)(XC + (size_t)t * 512 + c0) = pack8(acc); }
    }
    for (int it0 = c.gw * 4; it0 < 2 * TT; it0 += c.ngw * 4) {
        const int sub = c.lane & 7;
        u32x4 raw[4];
#pragma unroll
        for (int u = 0; u < 4; ++u) { const int it = it0 + u, t = it >> 1, which = it & 1; raw[u] = *(const u32x4*)(P0 + (size_t)t * P0LD + 1024 + which * 512 + c.lane * 8); }
#pragma unroll
        for (int u = 0; u < 4; ++u) {
            const int it = it0 + u, t = it >> 1, which = it & 1;
            bf16* p = P0 + (size_t)t * P0LD + 1024 + which * 512 + c.lane * 8;
            float v[8]; unpack8(raw[u], v);
            float s = 0.f;
#pragma unroll
            for (int e = 0; e < 8; ++e) s += v[e] * v[e];
            s += __shfl_xor(s, 1); s += __shfl_xor(s, 2); s += __shfl_xor(s, 4);
            const float rs = rsqrtf(s * (1.0f / 64.0f) + 1e-6f);
            const float* gn = (which ? in[11] : in[10]) + sub * 8;
#pragma unroll
            for (int e = 0; e < 8; ++e) v[e] = v[e] * rs * gn[e];
            float oth[8];
#pragma unroll
            for (int e = 0; e < 8; ++e) oth[e] = __shfl_xor(v[e], 1);
            if (sub < 2) {
                const float* rt = (const float*)(ws + WS_ROPE) + (t & (SEQ - 1)) * 16;
                const f32x4 c0 = *(const f32x4*)rt, c1 = *(const f32x4*)(rt + 4), s0 = *(const f32x4*)(rt + 8), s1 = *(const f32x4*)(rt + 12);
#pragma unroll
                for (int e = 0; e < 8; ++e) {
                    const float cs = (e < 4) ? c0[e & 3] : c1[e & 3], sn = (e < 4) ? s0[e & 3] : s1[e & 3];
                    v[e] = (sub == 0) ? (v[e] * cs - oth[e] * sn) : (v[e] * cs + oth[e] * sn);
                }
            }
            *(u32x4*)p = pack8(v);
        }
    }
    bf16* VT3 = (bf16*)dout;
    for (int it0 = c.gw; it0 < 3 * 4096; it0 += 2 * c.ngw) {
        u32x4 w[2][4];
#pragma unroll
        for (int u = 0; u < 2; ++u) { const int it = it0 + u * c.ngw; if (it < 3 * 4096) vt32_load(P0, 2 * (it >> 12), it & 4095, c.lane, w[u]); }
#pragma unroll
        for (int u = 0; u < 2; ++u) { const int it = it0 + u * c.ngw; if (it < 3 * 4096) vt32_store(w[u], VT3 + (size_t)(it >> 12) * (16 * 64 * VTP), it >> 12, it & 4095, c.lane); }
    }
}

#define ATT_D 3
constexpr int ATT_KP = 144, ATT_VP = 784, ATT_KBYTES = 384 * ATT_KP, ATT_LDS = ATT_KBYTES + 64 * ATT_VP;
struct AttState { float m, l; f32x4 o[4]; };
__device__ __forceinline__ void attn_math(const bf16x8 kx0, const bf16x8 kx1, const bf16x8 ky0, const bf16x8 ky1, const bf16x8 (&vf)[4], const bf16x8 qf0, const bf16x8 qf1,
                                          int lq, int kb, AttState& st) {
    const float cs = 0.125f * 1.4426950408889634f;
    f32x4 sx = mfma16(kx0, qf0, (f32x4){0.f, 0.f, 0.f, 0.f}); sx = mfma16(kx1, qf1, sx);
    f32x4 sy = mfma16(ky0, qf0, (f32x4){0.f, 0.f, 0.f, 0.f}); sy = mfma16(ky1, qf1, sy);
    float mx = -1e30f;
#pragma unroll
    for (int r = 0; r < 4; ++r) {
        sx[r] = ((unsigned)(lq - (kb + r)) <= 128u) ? sx[r] : -1e30f; sy[r] = ((unsigned)(lq - (kb + 4 + r)) <= 128u) ? sy[r] : -1e30f;
        mx = fmaxf(mx, fmaxf(sx[r], sy[r]));
    }
    { auto rr = __builtin_amdgcn_permlane32_swap(__float_as_uint(mx), __float_as_uint(mx), false, false); mx = fmaxf(__uint_as_float(rr[0]), __uint_as_float(rr[1]));
      rr = __builtin_amdgcn_permlane16_swap(__float_as_uint(mx), __float_as_uint(mx), false, false); mx = fmaxf(__uint_as_float(rr[0]), __uint_as_float(rr[1]));
      rr = __builtin_amdgcn_permlane32_swap(__float_as_uint(mx), __float_as_uint(mx), false, false); mx = fmaxf(__uint_as_float(rr[0]), __uint_as_float(rr[1])); }
    const float mn = fmaxf(st.m, mx), alpha = __builtin_amdgcn_exp2f((st.m - mn) * cs); st.m = mn;
    const float mref = fmaxf(mn, -1e29f) * cs;
    float pe[8]; float ps = 0.f;
#pragma unroll
    for (int r = 0; r < 4; ++r) { pe[r] = __builtin_amdgcn_exp2f(sx[r] * cs - mref); pe[4 + r] = __builtin_amdgcn_exp2f(sy[r] * cs - mref); ps += pe[r] + pe[4 + r]; }
    st.l = st.l * alpha + ps;
    const u32x4 pw = pack8v(pe);
    const bf16x8 pf = __builtin_bit_cast(bf16x8, pw);
#pragma unroll
    for (int dt = 0; dt < 4; ++dt) { st.o[dt] = st.o[dt] * alpha; st.o[dt] = mfma16(vf[dt], pf, st.o[dt]); }
}
__device__ __forceinline__ void attn_stage_p1(const Ctx& c, const bf16* P0, const bf16* VT3, int b, int h, int lb) {
    const int tok0 = 256 * lb - 128;
    u32x4 kr[6], vr[6];
#pragma unroll
    for (int i = 0; i < 6; ++i) { const int p = c.tid + 512 * i, row = p >> 3, c16 = p & 7; int tk = tok0 + row; if (tk < 0) tk = 0;
        kr[i] = *(const u32x4*)(P0 + (size_t)(b * SEQ + tk) * P0LD + 1536 + h * 64 + c16 * 8); }
#pragma unroll
    for (int i = 0; i < 6; ++i) { const int p = c.tid + 512 * i, d = p / 48, c16 = p - d * 48; int tk = tok0 + c16 * 8; if (tk < 0) tk = 0;
        vr[i] = *(const u32x4*)(VT3 + ((size_t)((b * 8 + h) * 64 + d)) * VTP + tk); }
#pragma unroll
    for (int i = 0; i < 6; ++i) { const int p = c.tid + 512 * i, row = p >> 3, c16 = p & 7; *(LAS u32x4*)(c.lds + row * ATT_KP + c16 * 16) = kr[i]; }
#pragma unroll
    for (int i = 0; i < 6; ++i) { const int p = c.tid + 512 * i, d = p / 48, c16 = p - d * 48; *(LAS u32x4*)(c.lds + ATT_KBYTES + d * ATT_VP + c16 * 16) = vr[i]; }
}
template <bool P1_LDS>
__device__ __forceinline__ void attn_item(const Ctx& c, const bf16* P0, const bf16* VT3, bf16* ycat, int item, int lane) {
    const int lb = item & 31, r16 = (item >> 5) & 15, h = (item >> 9) & 7, b = item >> 12;
    const int qi = lane & 15, g = lane >> 4;
    const int tq = r16 + 16 * (16 * lb + qi);
    const bf16* qrow = P0 + (size_t)(b * SEQ + tq) * P0LD + 1024 + h * 64;
    const bf16x8 qf0 = ld8(qrow + 8 * g), qf1 = ld8(qrow + 32 + 8 * g);
    AttState st; st.m = -1e30f; st.l = 0.f;
#pragma unroll
    for (int dt = 0; dt < 4; ++dt) st.o[dt] = (f32x4){0.f, 0.f, 0.f, 0.f};
    const int rho_off = 8 * (qi >> 2) + (qi & 3);
    int sb0_[3], n_[3]; const bf16* kb_[3]; const bf16* vb_[3];
#pragma unroll
    for (int p = 0; p < 3; ++p) {
        const int sh = 2 * p, rres = r16 & ((1 << sh) - 1), Ld = SEQ >> sh;
        const int lq0 = (r16 + 256 * lb) >> sh, lq15 = (r16 + 256 * lb + 240) >> sh;
        int s0 = lq0 - 128; if (s0 < 0) s0 = 0; s0 &= ~31;
        sb0_[p] = s0; n_[p] = (((lq15 & ~31) - s0) >> 5) + 1;
        kb_[p] = P0 + (size_t)(b * SEQ + rres) * P0LD + 1536 + h * 64 + 8 * g;
        vb_[p] = (p == 0) ? VT3 + ((size_t)((b * 8 + h) * 64 + qi)) * VTP + 8 * g
                          : VT3 + (size_t)p * (16 * 64 * VTP) + ((size_t)((b * 8 + h) * 4) * 256 + ((rres * Ld) >> 5)) * 512 + qi * 32 + 8 * g;
    }
    if (P1_LDS) n_[0] = 0;
    const int n01 = n_[0] + n_[1], total = n01 + n_[2];
    bf16x8 rk[ATT_D][4], rv[ATT_D][4];
#define ATT_ISSUE(s_, buf) do { const int s__ = (s_); if (s__ < total) { \
        const int p_ = (s__ >= n_[0]) + (s__ >= n01); const int loc_ = s__ - (p_ == 0 ? 0 : (p_ == 1 ? n_[0] : n01)); \
        const int sb_ = (p_ == 0 ? sb0_[0] : (p_ == 1 ? sb0_[1] : sb0_[2])) + 32 * loc_; const int sh_ = 2 * p_; \
        const bf16* kbp = (p_ == 0 ? kb_[0] : (p_ == 1 ? kb_[1] : kb_[2])); const bf16* vbp = (p_ == 0 ? vb_[0] : (p_ == 1 ? vb_[1] : vb_[2])); \
        const bf16* kx = kbp + ((size_t)(sb_ + rho_off) << sh_) * P0LD; const bf16* ky = kx + ((size_t)4 << sh_) * P0LD; \
        rk[buf][0] = ld8(kx); rk[buf][1] = ld8(kx + 32); rk[buf][2] = ld8(ky); rk[buf][3] = ld8(ky + 32); \
        const size_t dstr_ = (p_ == 0) ? (size_t)16 * VTP : (size_t)256 * 512; const size_t soff_ = (p_ == 0) ? (size_t)sb_ : (size_t)(sb_ >> 5) * 512; \
        _Pragma("unroll") for (int dt = 0; dt < 4; ++dt) rv[buf][dt] = ld8(vbp + dt * dstr_ + soff_); } } while (0)
#pragma unroll
    for (int d = 0; d < ATT_D; ++d) ATT_ISSUE(d, d);
    if (P1_LDS) {
        const int w = c.wave, half = r16 >> 3, tok0 = 256 * lb - 128;
        const int tq1 = 256 * lb + 32 * w + 16 * (qi >> 3) + 8 * half + (qi & 7);
        const bf16* q1row = P0 + (size_t)(b * SEQ + tq1) * P0LD + 1024 + h * 64;
        const bf16x8 q1f0 = ld8(q1row + 8 * g), q1f1 = ld8(q1row + 32 + 8 * g);
        AttState s1; s1.m = -1e30f; s1.l = 0.f;
#pragma unroll
        for (int dt = 0; dt < 4; ++dt) s1.o[dt] = (f32x4){0.f, 0.f, 0.f, 0.f};
        const LAS unsigned char* kl = c.lds + rho_off * ATT_KP + 16 * g;
        const LAS unsigned char* vl = c.lds + ATT_KBYTES + qi * ATT_VP + 16 * g;
        LAS unsigned* ex = (LAS unsigned*)(c.lds + ATT_LDS);
        __syncthreads();
        for (int i = ((lb == 0 && w < 4) ? 4 : w); i <= w + 4; ++i) {
            const LAS unsigned char* kx = kl + 32 * i * ATT_KP;
            const bf16x8 kx0 = *(const LAS bf16x8*)kx, kx1 = *(const LAS bf16x8*)(kx + 64), ky0 = *(const LAS bf16x8*)(kx + 4 * ATT_KP), ky1 = *(const LAS bf16x8*)(kx + 4 * ATT_KP + 64);
            bf16x8 vf[4];
#pragma unroll
            for (int dt = 0; dt < 4; ++dt) vf[dt] = *(const LAS bf16x8*)(vl + dt * 16 * ATT_VP + 64 * i);
            attn_math(kx0, kx1, ky0, ky1, vf, q1f0, q1f1, tq1, tok0 + 32 * i + 8 * g, s1);
        }
        {
            LAS unsigned* e = ex + ((16 * w + qi) * 4 + g) * 10;
            e[0] = __float_as_uint(s1.m); e[1] = __float_as_uint(s1.l);
#pragma unroll
            for (int dt = 0; dt < 4; ++dt) { e[2 + 2 * dt] = pg8::cvtpk(s1.o[dt][0], s1.o[dt][1]); e[3 + 2 * dt] = pg8::cvtpk(s1.o[dt][2], s1.o[dt][3]); }
        }
        __syncthreads();
        {
            const LAS unsigned* e = ex + ((qi * 8 + (r16 & 7)) * 4 + g) * 10;
            st.m = __uint_as_float(e[0]); st.l = __uint_as_float(e[1]);
#pragma unroll
            for (int dt = 0; dt < 4; ++dt) { const unsigned a0 = e[2 + 2 * dt], a1 = e[3 + 2 * dt]; st.o[dt] = (f32x4){bfw(a0, 0), bfw(a0, 1), bfw(a1, 0), bfw(a1, 1)}; }
        }
    }
    for (int s0 = 0; s0 < total; s0 += ATT_D) {
#pragma unroll
        for (int j = 0; j < ATT_D; ++j) {
            const int s = s0 + j;
            if (s < total) {
                const int p = (s >= n_[0]) + (s >= n01), loc = s - (p == 0 ? 0 : (p == 1 ? n_[0] : n01));
                const int sb = (p == 0 ? sb0_[0] : (p == 1 ? sb0_[1] : sb0_[2])) + 32 * loc;
                attn_math(rk[j][0], rk[j][1], rk[j][2], rk[j][3], rv[j], qf0, qf1, tq >> (2 * p), sb + 8 * g, st);
                ATT_ISSUE(s + ATT_D, j);
            }
        }
    }
#undef ATT_ISSUE
    float l = st.l;
    l += __shfl_xor(l, 16); l += __shfl_xor(l, 32);
    const float inv = 1.0f / l;
    bf16* orow = ycat + (size_t)(b * SEQ + tq) * 1024 + 512 + h * 64 + 4 * g;
#pragma unroll
    for (int dt = 0; dt < 4; ++dt) { u32x2 w; w.x = cvt_pk_bf16(st.o[dt][0] * inv, st.o[dt][1] * inv); w.y = cvt_pk_bf16(st.o[dt][2] * inv, st.o[dt][3] * inv); *(u32x2*)(orow + 16 * dt) = w; }
}

__device__ __forceinline__ void lru_step(float la, float gi, float& h) { const float a = __expf(la), bq = __builtin_amdgcn_sqrtf(fmaxf(1.0f - a * a, 0.f)) * gi; h = a * h + bq; }
__device__ __forceinline__ void phase_lru_a(const Ctx& c, unsigned char* ws) {
    const bf16* __restrict__ LA = (const bf16*)(ws + WS_LOGA); const bf16* __restrict__ GI = (const bf16*)(ws + WS_GI);
    float* __restrict__ SA = (float*)(ws + WS_SUMA); float* __restrict__ SB = (float*)(ws + WS_SUMB);
    for (int ch = blockIdx.x; ch < 256; ch += gridDim.x) {
        const int t0 = ch * 64, cn = c.tid; float h = 0.f, P = 0.f;
#pragma unroll 1
        for (int tb = 0; tb < 64; tb += 32) {
            float la[32], gi[32];
#pragma unroll
            for (int t = 0; t < 32; ++t) { la[t] = bf2f(LA[(size_t)(t0 + tb + t) * 512 + cn]); gi[t] = bf2f(GI[(size_t)(t0 + tb + t) * 512 + cn]); }
#pragma unroll
            for (int t = 0; t < 32; ++t) { lru_step(la[t], gi[t], h); P += la[t]; }
        }
        SA[ch * 512 + cn] = __expf(P); SB[ch * 512 + cn] = h;
    }
}
__device__ __forceinline__ void phase_lru_b(const Ctx& c, unsigned char* ws) {
    const bf16* __restrict__ LA = (const bf16*)(ws + WS_LOGA); const bf16* __restrict__ GI = (const bf16*)(ws + WS_GI);
    const float* __restrict__ SA = (const float*)(ws + WS_SUMA); const float* __restrict__ SB = (const float*)(ws + WS_SUMB);
    const bf16* __restrict__ P0 = (const bf16*)(ws + WS_BIG); bf16* __restrict__ ycat = (bf16*)(ws + WS_YCAT);
    for (int ch = blockIdx.x; ch < 256; ch += gridDim.x) {
        const int t0 = ch * 64, cn = c.tid; float h = 0.f;
        bf16 la0[16], gi0[16], gl0[16];
#pragma unroll
        for (int t = 0; t < 16; ++t) { la0[t] = LA[(size_t)(t0 + t) * 512 + cn]; gi0[t] = GI[(size_t)(t0 + t) * 512 + cn]; gl0[t] = P0[(size_t)(t0 + t) * P0LD + 512 + cn]; }
        int j = ch & ~127;
        for (; j + 32 <= ch; j += 32) {
            float sa[32], sb[32];
#pragma unroll
            for (int k = 0; k < 32; ++k) { sa[k] = SA[(j + k) * 512 + cn]; sb[k] = SB[(j + k) * 512 + cn]; }
#pragma unroll
            for (int k = 0; k < 32; ++k) h = sa[k] * h + sb[k];
        }
        for (; j + 8 <= ch; j += 8) {
            float sa[8], sb[8];
#pragma unroll
            for (int k = 0; k < 8; ++k) { sa[k] = SA[(j + k) * 512 + cn]; sb[k] = SB[(j + k) * 512 + cn]; }
#pragma unroll
            for (int k = 0; k < 8; ++k) h = sa[k] * h + sb[k];
        }
        for (; j < ch; ++j) h = SA[j * 512 + cn] * h + SB[j * 512 + cn];
#pragma unroll
        for (int t = 0; t < 16; ++t) { lru_step(bf2f(la0[t]), bf2f(gi0[t]), h); ycat[(size_t)(t0 + t) * 1024 + cn] = f2bf(h * gelu_tanh(bf2f(gl0[t]))); }
#pragma unroll 1
        for (int tb = 16; tb < 64; tb += 16) {
            float la[16], gi[16], gl[16];
#pragma unroll
            for (int t = 0; t < 16; ++t) { la[t] = bf2f(LA[(size_t)(t0 + tb + t) * 512 + cn]); gi[t] = bf2f(GI[(size_t)(t0 + tb + t) * 512 + cn]); gl[t] = bf2f(P0[(size_t)(t0 + tb + t) * P0LD + 512 + cn]); }
#pragma unroll
            for (int t = 0; t < 16; ++t) { lru_step(la[t], gi[t], h); ycat[(size_t)(t0 + tb + t) * 1024 + cn] = f2bf(h * gelu_tanh(gl[t])); }
        }
    }
}

__device__ __forceinline__ void fixup_panel(const Ctx& c, unsigned char* ws, const float* cw, const float* cb, int pm) {
    if ((pm & 31) != 0) {
        const float* EA = (const float*)(ws + WS_EDGEA); const float* EL = (const float*)(ws + WS_EDGEL); const float* TA = (const float*)(ws + WS_TAILA);
        bf16* U = (bf16*)(ws + WS_BIG);
        for (int col = c.tid; col < 3072; col += 512) {
            const float tm2 = TA[(size_t)((pm - 1) * 2 + 0) * 3072 + col], tm1 = TA[(size_t)((pm - 1) * 2 + 1) * 3072 + col];
            const float a0 = EA[(size_t)(pm * 2) * 3072 + col], a1 = EA[(size_t)(pm * 2 + 1) * 3072 + col];
            const float l0 = EL[(size_t)(pm * 2) * 3072 + col], l1 = EL[(size_t)(pm * 2 + 1) * 3072 + col];
            const float w0 = cw[col], w1 = cw[3072 + col], w2 = cw[6144 + col], bb = cb[col];
            U[(size_t)(pm * 256) * 3072 + col] = f2bf(gelu_tanh(w0 * tm2 + w1 * tm1 + w2 * a0 + bb) * l0);
            U[(size_t)(pm * 256 + 1) * 3072 + col] = f2bf(gelu_tanh(w0 * tm1 + w1 * a0 + w2 * a1 + bb) * l1);
        }
    }
    asm volatile("s_waitcnt vmcnt(0)" ::: "memory");
    __syncthreads();
}
__device__ __forceinline__ void phase_fixup(const Ctx& c, unsigned char* ws, const float* cw, const float* cb) {
    const float* EA = (const float*)(ws + WS_EDGEA); const float* EL = (const float*)(ws + WS_EDGEL); const float* TA = (const float*)(ws + WS_TAILA);
    bf16* U = (bf16*)(ws + WS_BIG);
    for (int i = c.gtid; i < 64 * 3072; i += c.ngt) {
        const int pm = i / 3072, col = i % 3072;
        if ((pm & 31) == 0) continue;
        const float tm2 = TA[(size_t)((pm - 1) * 2 + 0) * 3072 + col], tm1 = TA[(size_t)((pm - 1) * 2 + 1) * 3072 + col];
        const float a0 = EA[(size_t)(pm * 2) * 3072 + col], a1 = EA[(size_t)(pm * 2 + 1) * 3072 + col];
        const float l0 = EL[(size_t)(pm * 2) * 3072 + col], l1 = EL[(size_t)(pm * 2 + 1) * 3072 + col];
        const float w0 = cw[col], w1 = cw[3072 + col], w2 = cw[6144 + col], bb = cb[col];
        U[(size_t)(pm * 256) * 3072 + col] = f2bf(gelu_tanh(w0 * tm2 + w1 * tm1 + w2 * a0 + bb) * l0);
        U[(size_t)(pm * 256 + 1) * 3072 + col] = f2bf(gelu_tanh(w0 * tm1 + w1 * a0 + w2 * a1 + bb) * l1);
    }
}
#define XB_TMO      128
#define XB_XCNT(j)  (256  + 64 * (j))
#define XB_XSUB(j)  (1280 + 64 * (j))
#define XB_XGEN(j)  (2304 + 64 * (j))
#define XB_TOP      3328
#define XB_TOPGEN   3392
#define XCD_BAR_WORDS 3456
#define XB_SPIN_CAP (1u << 18)

__device__ __forceinline__ unsigned xb_ld(unsigned* p)              { return __hip_atomic_load(p, __ATOMIC_RELAXED, __HIP_MEMORY_SCOPE_AGENT); }
__device__ __forceinline__ unsigned xb_add(unsigned* p, unsigned v) { return __hip_atomic_fetch_add(p, v, __ATOMIC_RELAXED, __HIP_MEMORY_SCOPE_AGENT); }
__device__ __forceinline__ unsigned xb_xcc_id() { return (unsigned)__builtin_amdgcn_s_getreg((3 << 11) | 20) & 0xFu; }
#define XB_SPIN(cond, bar) do { unsigned _sp = 0; while (cond) { __builtin_amdgcn_s_sleep(1); \
    if ((++_sp & 255u) == 0u) { if (xb_ld(&(bar)[XB_TMO])) break; if (_sp > XB_SPIN_CAP) { atomicAdd(&(bar)[XB_TMO], 1u); break; } } } } while (0)

struct XcdBarrier {
    unsigned* bar; unsigned x;
    volatile LAS unsigned* st;
};

__device__ __forceinline__ XcdBarrier xcd_barrier_post(unsigned* bar, volatile LAS unsigned* st) {
    XcdBarrier b; b.bar = bar; b.x = xb_xcc_id(); b.st = st;
    if (threadIdx.x == 0) (void)xb_add(&bar[XB_XCNT(b.x)], 1u);
    return b;
}
__device__ __forceinline__ void xcd_barrier_complete(unsigned* bar, unsigned x, unsigned& nloc, unsigned& nx) {
    const unsigned G = gridDim.x * gridDim.y * gridDim.z;
    unsigned sum, cnt, mine, sp = 0u;
    for (;;) {
        sum = 0u; cnt = 0u; mine = 0u;
#pragma unroll
        for (unsigned j = 0; j < 16; ++j) { const unsigned c = xb_ld(&bar[XB_XCNT(j)]); sum += c; cnt += (c > 0u) ? 1u : 0u; mine = (j == x) ? c : mine; }
        if (sum == G) break;
        __builtin_amdgcn_s_sleep(1);
        if ((++sp & 255u) == 0u) { if (xb_ld(&bar[XB_TMO])) break; if (sp > XB_SPIN_CAP) { atomicAdd(&bar[XB_TMO], 1u); break; } }
    }
    nloc = mine > 0u ? mine : 1u; nx = cnt > 0u ? cnt : 1u;
}

__device__ __forceinline__ void xcd_barrier(const XcdBarrier& b) {
    asm volatile("s_waitcnt vmcnt(0)" ::: "memory");
    __syncthreads();
    if (threadIdx.x == 0) {
        unsigned* bar = b.bar;
        __builtin_amdgcn_s_waitcnt(0);
        unsigned nloc = b.st[0], nx = b.st[1];
        if (nloc == 0u) { xcd_barrier_complete(bar, b.x, nloc, nx); b.st[0] = nloc; b.st[1] = nx; }
        const unsigned old = xb_add(&bar[XB_XSUB(b.x)], 1u);
        const unsigned gen = old / nloc;
        if (old + 1u == (gen + 1u) * nloc) {
            __builtin_amdgcn_fence(__ATOMIC_RELEASE, "agent");
            asm volatile("s_waitcnt vmcnt(0)" ::: "memory");
            const unsigned og = xb_add(&bar[XB_TOP], 1u);
            const unsigned tg = og / nx;
            if (og + 1u == (tg + 1u) * nx) xb_add(&bar[XB_TOPGEN], 1u);
            else XB_SPIN(xb_ld(&bar[XB_TOPGEN]) == tg, bar);
            __builtin_amdgcn_fence(__ATOMIC_ACQUIRE, "agent");
            xb_add(&bar[XB_XGEN(b.x)], 1u);
            asm volatile("s_waitcnt vmcnt(0)" ::: "memory");
        } else {
            XB_SPIN(xb_ld(&bar[XB_XGEN(b.x)]) == gen, bar);
            __builtin_amdgcn_fence(__ATOMIC_ACQUIRE, "agent");
            asm volatile("s_waitcnt vmcnt(0)" ::: "memory");
        }
    }
    __syncthreads();
}
__device__ __forceinline__ void gk_item(const bf16* XB, const bf16* Wt, const float* ss, bf16* P1, int item, int lane) {
    const int jl = lane & 15, gq = lane >> 4, tok = item * 16 + jl;
    const bf16* ap = Wt + (size_t)(2048 + jl) * 1024 + 8 * gq; const bf16* bp = XB + (size_t)tok * 1024 + 8 * gq;
    f32x4 acc0 = (f32x4){0.f, 0.f, 0.f, 0.f}, acc1 = acc0;
#pragma unroll 8
    for (int ks = 0; ks < 32; ks += 2) { acc0 = mfma16(ld8(ap + 32 * ks), ld8(bp + 32 * ks), acc0); acc1 = mfma16(ld8(ap + 32 * ks + 32), ld8(bp + 32 * ks + 32), acc1); }
    const float rs = rsqrtf(ss[tok] * (1.0f / 1024.0f) + 1e-6f);
    u32x2 w; w.x = cvt_pk_bf16((acc0[0] + acc1[0]) * rs, (acc0[1] + acc1[1]) * rs); w.y = cvt_pk_bf16((acc0[2] + acc1[2]) * rs, (acc0[3] + acc1[3]) * rs);
    *(u32x2*)(P1 + (size_t)tok * P1LD + 2048 + 4 * gq) = w;
}

__device__ __forceinline__ void phase_gla_prep(const Ctx& c, const float* const* in, unsigned char* ws) {
    bf16* P1 = (bf16*)(ws + WS_BIG); bf16* KDT = (bf16*)(ws + WS_KDT); float* DEC = (float*)(ws + WS_DECAY);
    const float* gkw = in[25]; const float* gkb = in[26];
    for (int i = blockIdx.x * 256 + c.tid; c.tid < 256 && i < 256 * 256; i += gridDim.x * 256) {
        const int chunk = i >> 8, chn = i & 255, t0 = chunk * 64, b = chunk >> 7, h = chn >> 6, d = chn & 63;
        float w[16];
#pragma unroll
        for (int k = 0; k < 16; ++k) w[k] = gkw[k * 256 + chn];
        const float bias = gkb[chn];
        float kin[64]; float bc = 0.f;
#pragma unroll
        for (int tb = 0; tb < 64; tb += 8) {
            u32x4 l0[8], l1[8]; bf16 qv[8], kv[8];
#pragma unroll
            for (int t = 0; t < 8; ++t) { const bf16* row = P1 + (size_t)(t0 + tb + t) * P1LD; l0[t] = *(const u32x4*)(row + 2048); l1[t] = *(const u32x4*)(row + 2056); qv[t] = row[512 + chn]; kv[t] = row[768 + chn]; }
#pragma unroll
            for (int t = 0; t < 8; ++t) {
                bf16* row = P1 + (size_t)(t0 + tb + t) * P1LD;
                float lr[16]; unpack8(l0[t], lr); unpack8(l1[t], lr + 8);
                float z = bias;
#pragma unroll
                for (int k = 0; k < 16; ++k) z += lr[k] * w[k];
                bc += logsig(z) * (1.0f / 16.0f);
                row[512 + chn] = f2bf(bf2f(qv[t]) * 0.125f * __expf(bc));
                kin[tb + t] = bf2f(kv[t]) * __expf(-bc);
                row[768 + chn] = f2bf(kin[tb + t]);
            }
        }
        const float eb = __expf(bc);
        DEC[chunk * 256 + chn] = eb;
        bf16* kd = KDT + ((size_t)((b * 4 + h) * 64 + d)) * SEQ + (t0 & (SEQ - 1));
#pragma unroll
        for (int t8 = 0; t8 < 8; ++t8) {
            float f[8];
#pragma unroll
            for (int e = 0; e < 8; ++e) f[e] = kin[t8 * 8 + e] * eb;
            *(u32x4*)(kd + t8 * 8) = pack8(f);
        }
    }
}

__device__ __forceinline__ void s5_bfrags(const bf16* P1, int g, int jb, int lane, bf16x8* bu) {
    const int jl = lane & 15, gq = lane >> 4;
#pragma unroll
    for (int ks = 0; ks < 8; ++ks) {
        const int s = 2 * ks + (gq >> 1), p0 = 8 * (gq & 1);
        bu[ks] = ld8(P1 + (size_t)((16 * jb + jl) * 16 + s) * P1LD + 16 * g + p0);
    }
}
__device__ __forceinline__ void s5a_item(const bf16* P1, const bf16* FM, float* XL, int item, int lane) {
    const int g = item >> 6, jb = item & 63, jl = lane & 15, gq = lane >> 4;
    bf16x8 bu[8]; s5_bfrags(P1, g, jb, lane, bu);
    const bf16* Fg = FM + (size_t)g * 128 * 256;
#pragma unroll
    for (int zt = 0; zt < 8; ++zt) {
        f32x4 acc = (f32x4){0.f, 0.f, 0.f, 0.f};
#pragma unroll
        for (int ks = 0; ks < 8; ++ks) acc = mfma16(ld8(Fg + (size_t)(16 * zt + jl) * 256 + 32 * ks + 8 * gq), bu[ks], acc);
        *(f32x4*)(XL + ((size_t)g * 1024 + 16 * jb + jl) * 128 + 16 * zt + 4 * gq) = acc;
    }
}
__device__ __forceinline__ void phase_s5_scan(const Ctx& c, const float* const* in, unsigned char* ws) {
    const float* __restrict__ XL = (const float*)(ws + WS_XLOC); bf16* __restrict__ SX = (bf16*)(ws + WS_SX);
    LAS float* ex = (LAS float*)c.lds;
    for (int bg = blockIdx.x; bg < 64; bg += gridDim.x) {
        const int b = bg >> 5, g = bg & 31, seg = c.wave, n = c.lane;
        const S5P sp = s5_params(in[15], in[16], in[22], g, n);
        float ar, ai; s5_pow(sp, 16.0f, ar, ai);
        float Ar, Ai; s5_pow(sp, 1024.0f, Ar, Ai);
        const size_t o0 = ((size_t)g * 1024 + b * 512 + seg * 64) * 128 + n;
        float xr = 0.f, xi = 0.f;
#pragma unroll 1
        for (int h2 = 0; h2 < 2; ++h2) {
            float cr[32], ci[32];
#pragma unroll
            for (int k = 0; k < 32; ++k) { cr[k] = XL[o0 + (size_t)(h2 * 32 + k) * 128]; ci[k] = XL[o0 + (size_t)(h2 * 32 + k) * 128 + 64]; }
#pragma unroll
            for (int k = 0; k < 32; ++k) { const float tr = ar * xr - ai * xi + cr[k], ti = ar * xi + ai * xr + ci[k]; xr = tr; xi = ti; }
        }
        ex[(seg * 64 + n) * 2] = xr; ex[(seg * 64 + n) * 2 + 1] = xi;
        __syncthreads();
        xr = 0.f; xi = 0.f;
        for (int j = 0; j < seg; ++j) { const float er = ex[(j * 64 + n) * 2], ei = ex[(j * 64 + n) * 2 + 1]; const float tr = Ar * xr - Ai * xi + er, ti = Ar * xi + Ai * xr + ei; xr = tr; xi = ti; }
#pragma unroll 1
        for (int h2 = 0; h2 < 2; ++h2) {
            float cr[32], ci[32];
#pragma unroll
            for (int k = 0; k < 32; ++k) { cr[k] = XL[o0 + (size_t)(h2 * 32 + k) * 128]; ci[k] = XL[o0 + (size_t)(h2 * 32 + k) * 128 + 64]; }
#pragma unroll
            for (int k = 0; k < 32; ++k) {
                SX[o0 + (size_t)(h2 * 32 + k) * 128] = f2bf(xr); SX[o0 + (size_t)(h2 * 32 + k) * 128 + 64] = f2bf(xi);
                const float tr = ar * xr - ai * xi + cr[k], ti = ar * xi + ai * xr + ci[k]; xr = tr; xi = ti;
            }
        }
        __syncthreads();
    }
}
__device__ __forceinline__ void s5c_item(const bf16* P1, const bf16* AM, const bf16* SX, const float* dvec, bf16* YS, int item, int lane) {
    const int g = item >> 6, jb = item & 63, jl = lane & 15, gq = lane >> 4;
    bf16x8 bu[12]; s5_bfrags(P1, g, jb, lane, bu);
#pragma unroll
    for (int ks = 0; ks < 4; ++ks) bu[8 + ks] = ld8(SX + ((size_t)g * 1024 + 16 * jb + jl) * 128 + 32 * ks + 8 * gq);
    const bf16* Ag = AM + (size_t)g * 256 * 384;
    float dv[4];
#pragma unroll
    for (int e = 0; e < 4; ++e) dv[e] = dvec[16 * g + 4 * gq + e];
#pragma unroll 4
    for (int rt = 0; rt < 16; ++rt) {
        f32x4 acc = (f32x4){0.f, 0.f, 0.f, 0.f};
#pragma unroll
        for (int ks = 0; ks < 12; ++ks) acc = mfma16(ld8(Ag + (size_t)(16 * rt + jl) * 384 + 32 * ks + 8 * gq), bu[ks], acc);
        const size_t tok = (size_t)(16 * jb + jl) * 16 + rt;
        const u32x2 uv = *(const u32x2*)(P1 + tok * P1LD + 16 * g + 4 * gq);
        float o[4];
#pragma unroll
        for (int e = 0; e < 4; ++e) { const float y = acc[e] + dv[e] * bfw(uv[e >> 1], e & 1); o[e] = gelu_tanh(y); }
        u32x2 w; w.x = cvt_pk_bf16(o[0], o[1]); w.y = cvt_pk_bf16(o[2], o[3]);
        *(u32x2*)(YS + tok * 512 + 16 * g + 4 * gq) = w;
    }
}

__device__ __forceinline__ void s5c_block(const Ctx& c, const bf16* P1, const bf16* AM, const bf16* SX, const float* dvec, bf16* YS, int g, int jb) {
    const int lane = c.lane, jl = lane & 15, gq = lane >> 4;
    bf16x8 bu[12]; s5_bfrags(P1, g, jb, lane, bu);
#pragma unroll
    for (int ks = 0; ks < 4; ++ks) bu[8 + ks] = ld8(SX + ((size_t)g * 1024 + 16 * jb + jl) * 128 + 32 * ks + 8 * gq);
    float dv[4];
#pragma unroll
    for (int e = 0; e < 4; ++e) dv[e] = dvec[16 * g + 4 * gq + e];
    const bf16* Ag = AM + (size_t)g * 256 * 384;
    for (int half = 0; half < 2; ++half) {
        __syncthreads();
        for (int p = c.tid; p < 128 * 48; p += 512) { const int row = p / 48, c16 = p - row * 48;
            *(LAS u32x4*)(c.lds + row * 784 + c16 * 16) = *(const u32x4*)(Ag + (size_t)(half * 128 + row) * 384 + c16 * 8); }
        __syncthreads();
#pragma unroll 2
        for (int r8 = 0; r8 < 8; ++r8) {
            const int rt = half * 8 + r8;
            f32x4 acc = (f32x4){0.f, 0.f, 0.f, 0.f};
#pragma unroll
            for (int ks = 0; ks < 12; ++ks) acc = mfma16(*(const LAS bf16x8*)(c.lds + (16 * r8 + jl) * 784 + 64 * ks + 16 * gq), bu[ks], acc);
            const size_t tok = (size_t)(16 * jb + jl) * 16 + rt;
            const u32x2 uv = *(const u32x2*)(P1 + tok * P1LD + 16 * g + 4 * gq);
            float o[4];
#pragma unroll
            for (int e = 0; e < 4; ++e) { const float y = acc[e] + dv[e] * bfw(uv[e >> 1], e & 1); o[e] = gelu_tanh(y); }
            u32x2 w; w.x = cvt_pk_bf16(o[0], o[1]); w.y = cvt_pk_bf16(o[2], o[3]);
            *(u32x2*)(YS + tok * 512 + 16 * g + 4 * gq) = w;
        }
    }
    __syncthreads();
}

__device__ __forceinline__ void gla_kv_item(const bf16* KDT, const bf16* VTG, bf16* KVS, int item, int lane) {
    const int cc = item & 127, h = (item >> 7) & 3, b = item >> 9, jl = lane & 15, gq = lane >> 4;
    const bf16* kd = KDT + ((size_t)((b * 4 + h) * 64 + jl)) * SEQ + 64 * cc + 8 * gq;
    const bf16* vt = VTG + ((size_t)((b * 4 + h) * 128 + jl)) * SEQ + 64 * cc + 8 * gq;
    bf16x8 af[4][2];
#pragma unroll
    for (int dt = 0; dt < 4; ++dt)
#pragma unroll
        for (int ks = 0; ks < 2; ++ks) af[dt][ks] = ld8(kd + (size_t)dt * 16 * SEQ + 32 * ks);
    bf16* out = KVS + ((size_t)(((b * 128 + cc) * 4 + h) * 128 + jl)) * 64 + 4 * gq;
#pragma unroll
    for (int et = 0; et < 8; ++et) {
        const bf16x8 b0 = ld8(vt + (size_t)et * 16 * SEQ), b1 = ld8(vt + (size_t)et * 16 * SEQ + 32);
#pragma unroll
        for (int dt = 0; dt < 4; ++dt) {
            f32x4 acc = mfma16(af[dt][0], b0, (f32x4){0.f, 0.f, 0.f, 0.f}); acc = mfma16(af[dt][1], b1, acc);
            u32x2 w; w.x = pg8::cvtpk(acc[0], acc[1]); w.y = pg8::cvtpk(acc[2], acc[3]);
            *(u32x2*)(out + (size_t)et * 16 * 64 + 16 * dt) = w;
        }
    }
}
__device__ __forceinline__ void phase_gla_scan(const Ctx& c, unsigned char* ws) {
    bf16* KVS = (bf16*)(ws + WS_KVS); const float* DEC = (const float*)(ws + WS_DECAY);
    for (int i = c.gtid; i < 2 * 4 * 128 * 64; i += c.ngt) {
        const int d = i & 63, e = (i >> 6) & 127, h = (i >> 13) & 3, b = i >> 15;
        float s = 0.f;
        bf16* p0 = KVS + ((size_t)((b * 128 * 4 + h) * 128 + e)) * 64 + d;
        const float* d0 = DEC + (b * 128) * 256 + h * 64 + d;
#pragma unroll 1
        for (int c0 = 0; c0 < 128; c0 += 32) {
            bf16 kv[32]; float dc[32];
#pragma unroll
            for (int k = 0; k < 32; ++k) { kv[k] = p0[(size_t)(c0 + k) * (4 * 128 * 64)]; dc[k] = d0[(c0 + k) * 256]; }
#pragma unroll
            for (int k = 0; k < 32; ++k) { p0[(size_t)(c0 + k) * (4 * 128 * 64)] = f2bf(s); s = dc[k] * s + bf2f(kv[k]); }
        }
    }
}
__device__ __forceinline__ void gla_out_item(const bf16* P1, const bf16* VTG, const bf16* KVS, const float* gnorm, bf16* ycat, int item, int lane) {
    const int tt = item & 3, cc = (item >> 2) & 127, h = (item >> 9) & 3, b = item >> 11, jl = lane & 15, gq = lane >> 4;
    const size_t tokc = (size_t)b * SEQ + 64 * cc;
    const bf16* qrow = P1 + (tokc + 16 * tt + jl) * P1LD + 512 + h * 64 + 8 * gq;
    const bf16x8 qf0 = ld8(qrow), qf1 = ld8(qrow + 32);
    f32x4 o[8];
#pragma unroll
    for (int et = 0; et < 8; ++et) o[et] = (f32x4){0.f, 0.f, 0.f, 0.f};
    {
        const bf16* sp = KVS + ((size_t)(((b * 128 + cc) * 4 + h) * 128 + jl)) * 64 + 8 * gq;
#pragma unroll
        for (int et = 0; et < 8; ++et) { o[et] = mfma16(ld8(sp + (size_t)et * 16 * 64), qf0, o[et]); o[et] = mfma16(ld8(sp + (size_t)et * 16 * 64 + 32), qf1, o[et]); }
    }
    const int tl = 16 * tt + jl, rho_off = 8 * (jl >> 2) + (jl & 3);
    const bf16* vt = VTG + ((size_t)((b * 4 + h) * 128 + jl)) * SEQ + 64 * cc + 8 * gq;
    for (int sp_ = 0; sp_ <= (tt >> 1); ++sp_) {
        const bf16* kx = P1 + (tokc + 32 * sp_ + rho_off) * P1LD + 768 + h * 64 + 8 * gq;
        const bf16* ky = kx + (size_t)4 * P1LD;
        f32x4 sx = mfma16(ld8(kx), qf0, (f32x4){0.f, 0.f, 0.f, 0.f}); sx = mfma16(ld8(kx + 32), qf1, sx);
        f32x4 sy = mfma16(ld8(ky), qf0, (f32x4){0.f, 0.f, 0.f, 0.f}); sy = mfma16(ld8(ky + 32), qf1, sy);
        const int kb = 32 * sp_ + 8 * gq;
        float pe[8];
#pragma unroll
        for (int r = 0; r < 4; ++r) { pe[r] = (kb + r <= tl) ? sx[r] : 0.f; pe[4 + r] = (kb + 4 + r <= tl) ? sy[r] : 0.f; }
        const u32x4 pw = pack8(pe); const bf16x8 pf = __builtin_bit_cast(bf16x8, pw);
#pragma unroll
        for (int et = 0; et < 8; ++et) o[et] = mfma16(ld8(vt + (size_t)et * 16 * SEQ + 32 * sp_), pf, o[et]);
    }
    float q = 0.f;
#pragma unroll
    for (int et = 0; et < 8; ++et) q += (o[et][0] * o[et][0] + o[et][1] * o[et][1]) + (o[et][2] * o[et][2] + o[et][3] * o[et][3]);
    q += __shfl_xor(q, 16); q += __shfl_xor(q, 32);
    const float rs = rsqrtf(q * (1.0f / 128.0f) + 1e-6f);
    const bf16* grow = P1 + (tokc + tl) * P1LD + 1536 + h * 128 + 4 * gq;
    bf16* orow = ycat + (tokc + tl) * 1024 + 512 + h * 128 + 4 * gq;
#pragma unroll
    for (int et = 0; et < 8; ++et) {
        const u32x2 gv = *(const u32x2*)(grow + 16 * et);
        const f32x4 gn = *(const f32x4*)(gnorm + 16 * et + 4 * gq);
        float r[4];
#pragma unroll
        for (int e = 0; e < 4; ++e) { const float gg = bfw(gv[e >> 1], e & 1); r[e] = (o[et][e] * rs * gn[e]) * (gg * sigm(gg)); }
        u32x2 w; w.x = cvt_pk_bf16(r[0], r[1]); w.y = cvt_pk_bf16(r[2], r[3]);
        *(u32x2*)(orow + 16 * et) = w;
    }
}

struct Args { const float* in[34]; float* out; unsigned char* ws; int ph_lo, ph_hi; };
constexpr int NPHASE = 19;

template <class Epi>
__device__ __forceinline__ void run_gemm(LAS unsigned char* lds, const bf16* A, const bf16* Bt, int M, int N, int K, const Epi& E) {
    pg8::Gemm g{A, Bt, M, N, K}; pg8::StaticOrder S; S.init(M, N, (int)gridDim.x, (int)blockIdx.x);
    pg8::gemm_phase<Epi, pg8::StaticOrder, true, true>(lds, g, S, E);
}

__global__ void __launch_bounds__(512, 2) fwd_kernel(Args a) {
    extern __shared__ __attribute__((aligned(16))) unsigned char lds_raw[];
    cg::grid_group grid = cg::this_grid();
    Ctx c; c.tid = threadIdx.x; c.lane = c.tid & 63; c.wave = __builtin_amdgcn_readfirstlane(c.tid >> 6);
    c.gw = blockIdx.x * 8 + c.wave; c.ngw = gridDim.x * 8; c.gtid = blockIdx.x * 512 + c.tid; c.ngt = gridDim.x * 512;
    c.lds = (LAS unsigned char*)lds_raw;
    unsigned char* ws = a.ws; const float* const* in = a.in;
    const int lo = a.ph_lo, hi = a.ph_hi;
#define IN(k) (lo <= (k) && (k) < hi)
#ifndef REP_MASK
#define REP_MASK 0
#endif
#define REPS(k) for (int r_ = 0; r_ < 1 + ((REP_MASK >> (k)) & 1); ++r_)
#define REPBAR() do { if (r_) xcd_barrier(bar); } while (0)
#define SYNC(k) do { if (IN(k) && IN((k) + 1)) { if ((k) == 0) grid.sync(); else xcd_barrier(bar); } } while (0)
    volatile LAS unsigned* misc = (volatile LAS unsigned*)(c.lds + 131072);
    if (c.tid < 8) misc[c.tid] = 0u;
    __syncthreads();
    XcdBarrier bar = xcd_barrier_post((unsigned*)(ws + WS_BARRIER), misc);
    float* ss = (float*)(ws + WS_SS);
    bf16* XB = (bf16*)(ws + WS_XB); bf16* BIG = (bf16*)(ws + WS_BIG); bf16* YCAT = (bf16*)(ws + WS_YCAT);
    LAS float* halo = (LAS float*)(c.lds + HALO_OFF);

#ifdef TIMING_PROBE
    volatile LAS unsigned long long* tsl = (volatile LAS unsigned long long*)(c.lds + 131072 + 64);
#define STAMP(k) do { if (blockIdx.x == 0 && c.tid == 0) tsl[k] = __builtin_amdgcn_s_memrealtime(); } while (0)
#else
#define STAMP(k) do {} while (0)
#endif
    STAMP(0);
    if (IN(0)) REPS(0) { REPBAR(); phase_prologue(c, in, ws); if (!DEFER_TR) phase_s5_mats(c, in, ws); }
    SYNC(0); STAMP(1);
    if (IN(1)) REPS(1) { REPBAR(); { pg8::EpiProj E{BIG, P0LD, ss}; run_gemm(c.lds, XB, (const bf16*)(ws + WS_W_EIN), TT, 2560, 1024, E); }
        if ((DEFER_TR || DEFER_P1) && r_ == 0) { if (gridDim.x == 256) { if (blockIdx.x >= 128) do_tr_items(c, in, ws, TR_EOUT0, TR_FIN10, (blockIdx.x - 128) * 8 + c.wave, 1024); } else do_tr_items(c, in, ws, TR_EOUT0, TR_FIN10, c.gw, c.ngw); } }
    SYNC(1); STAMP(2);
    if (IN(2)) REPS(2) { REPBAR(); phase_prep0(c, in, ws, a.out); }
    SYNC(2); STAMP(3);
    if (IN(3)) REPS(3) { REPBAR(); { pg8::EpiGates E{(const bf16*)(ws + WS_XC), (bf16*)(ws + WS_LOGA), (bf16*)(ws + WS_GI), in[6], in[8], in[9]};
        run_gemm(c.lds, (const bf16*)(ws + WS_XC), (const bf16*)(ws + WS_W_GATE), TT, 1024, 512, E); } }
    SYNC(3); STAMP(4);
    if (IN(4)) REPS(4) { REPBAR();
        phase_lru_a(c, ws);
        if (gridDim.x == 256) {
            const int x = blockIdx.x & 7, j = blockIdx.x >> 3;
            for (int k = 0; k < 4; ++k) { const int bh = 2 * x + (k >> 1), r16 = 8 * (k & 1) + c.wave;
                if ((k & 1) == 0) { __syncthreads(); attn_stage_p1(c, BIG, (const bf16*)a.out, bh >> 3, bh & 7, j); __syncthreads(); }
                attn_item<true>(c, BIG, (const bf16*)a.out, YCAT, (bh << 9) | (r16 << 5) | j, c.lane); }
            __syncthreads();
        } else
        for (int it = c.gw; it < 2 * 8 * 16 * 32; it += c.ngw) attn_item<false>(c, BIG, (const bf16*)a.out, YCAT, it, c.lane);
    }
    SYNC(4); STAMP(5);
    if (IN(5)) REPS(5) { REPBAR(); phase_lru_b(c, ws); if (DEFER_TR && r_ == 0) { do_tr_items(c, in, ws, TR_FOUT00, TR_FOUT10, c.gw, c.ngw); do_tr_items(c, in, ws, TR_OIN0, TR_GLU0, c.gw, c.ngw); } }
    SYNC(5); STAMP(6);
#ifdef EXTRA_BARS
    for (int k_ = 0; k_ < EXTRA_BARS; ++k_) xcd_barrier(bar);
#endif
    if (IN(6)) REPS(6) { REPBAR(); { pg8::EpiRes E{in[0], a.out, XB, ss + TT}; run_gemm(c.lds, YCAT, (const bf16*)(ws + WS_W_EOUT), TT, 1024, 1024, E); } }
    SYNC(6); STAMP(7);
    if (IN(7)) REPS(7) { REPBAR(); { pg8::EpiFfn E{BIG, ss + TT, in[31], in[32], (float*)(ws + WS_EDGEA), (float*)(ws + WS_EDGEL), (float*)(ws + WS_TAILA), halo};
        run_gemm(c.lds, XB, (const bf16*)(ws + WS_W_FIN0), TT, 6144, 1024, E); } }
    SYNC(7); STAMP(8);
    const bool fuse_fix = (gridDim.x == 256) && !DEFER_TR;
    if (!fuse_fix) { if (IN(8)) REPS(8) { REPBAR(); phase_fixup(c, ws, in[31], in[32]); if (DEFER_TR && r_ == 0) phase_s5_mats(c, in, ws); }
    SYNC(8); } STAMP(9);
    if (IN(9)) REPS(9) { REPBAR(); if (fuse_fix) fixup_panel(c, ws, in[31], in[32], 8 * (blockIdx.x & 7) + ((blockIdx.x >> 3) & 7));
        { pg8::EpiRes E{a.out, a.out, XB, ss + 2 * TT}; run_gemm(c.lds, BIG, (const bf16*)(ws + WS_W_FOUT0), TT, 1024, 3072, E); } }
    SYNC(9); STAMP(10);
    if (IN(10)) REPS(10) { REPBAR(); { pg8::EpiProj E{BIG, P1LD, ss + 2 * TT}; run_gemm(c.lds, XB, (const bf16*)(ws + WS_W_OIN), TT, 2048, 1024, E); }
        for (int it = c.gw; it < TT / 16; it += c.ngw) gk_item(XB, (const bf16*)(ws + WS_W_OIN), ss + 2 * TT, BIG, it, c.lane);
        if (DEFER_TR && r_ == 0) { int widx = c.gw, nw = c.ngw; if (gridDim.x == 256) { widx = (blockIdx.x >= 64) ? (blockIdx.x - 64) * 8 + c.wave : -1; nw = 192 * 8; }
            if (widx >= 0) { do_tr_items(c, in, ws, TR_FIN10, TR_FOUT00, widx, nw); do_tr_items(c, in, ws, TR_FOUT10, TR_OIN0, widx, nw); do_tr_items(c, in, ws, TR_GLU0, TR_END, widx, nw); } } }
    SYNC(10); STAMP(11);
    if (IN(11)) REPS(11) { REPBAR();
        phase_gla_prep(c, in, ws);
        if (c.wave >= 4) {
            Ctx c2 = c; c2.gw = blockIdx.x * 4 + (c.wave - 4); c2.ngw = gridDim.x * 4;
            vt_run(c2, BIG, P1LD, 1024, 128, 4, (bf16*)(ws + WS_VTG), SEQ, 0, 8 * 2 * 1024);
            for (int it = c2.gw; it < 32 * 64; it += c2.ngw) s5a_item(BIG, (const bf16*)(ws + WS_S5F), (float*)(ws + WS_XLOC), it, c.lane);
        }
    }
    SYNC(11); STAMP(12);
    if (IN(12)) REPS(12) { REPBAR();
        phase_s5_scan(c, in, ws);
        for (int it = c.ngw - 1 - c.gw; it < 2 * 4 * 128; it += c.ngw) gla_kv_item((const bf16*)(ws + WS_KDT), (const bf16*)(ws + WS_VTG), (bf16*)(ws + WS_KVS), it, c.lane);
    }
    SYNC(12); STAMP(13);
    if (IN(13)) REPS(13) { REPBAR();
        phase_gla_scan(c, ws);
        if (gridDim.x == 256) s5c_block(c, BIG, (const bf16*)(ws + WS_S5A), (const bf16*)(ws + WS_SX), in[21], (bf16*)(ws + WS_XLOC), 31 - (blockIdx.x >> 3), (blockIdx.x & 7) * 8 + c.wave);
        else
        for (int it = c.ngw - 1 - c.gw; it < 32 * 64; it += c.ngw) s5c_item(BIG, (const bf16*)(ws + WS_S5A), (const bf16*)(ws + WS_SX), in[21], (bf16*)(ws + WS_XLOC), it, c.lane);
    }
    SYNC(13); STAMP(14);
    if (IN(14)) REPS(14) { REPBAR();
        { pg8::EpiGlu E{(const bf16*)(ws + WS_XLOC), YCAT, in[24]}; run_gemm(c.lds, (const bf16*)(ws + WS_XLOC), (const bf16*)(ws + WS_W_GLU), TT, 512, 512, E); }
        if (gridDim.x == 256) {
            if (blockIdx.x < 128) gla_out_item(BIG, (const bf16*)(ws + WS_VTG), (const bf16*)(ws + WS_KVS), in[27], YCAT, c.gw, c.lane);
            else for (int k = 0; k < 3; ++k) gla_out_item(BIG, (const bf16*)(ws + WS_VTG), (const bf16*)(ws + WS_KVS), in[27], YCAT, 1024 + ((blockIdx.x - 128) * 8 + c.wave) * 3 + k, c.lane);
        } else
        for (int it = c.ngw - 1 - c.gw; it < 2 * 4 * 128 * 4; it += c.ngw) gla_out_item(BIG, (const bf16*)(ws + WS_VTG), (const bf16*)(ws + WS_KVS), in[27], YCAT, it, c.lane);
    }
    SYNC(14); STAMP(15);
    if (IN(15)) REPS(15) { REPBAR(); { pg8::EpiRes E{a.out, a.out, XB, ss + 3 * TT}; run_gemm(c.lds, YCAT, (const bf16*)(ws + WS_W_OOUT), TT, 1024, 1024, E); } }
    SYNC(15); STAMP(16);
    if (IN(16)) REPS(16) { REPBAR(); { pg8::EpiFfn E{BIG, ss + 3 * TT, in[31] + 3 * 3072, in[32] + 3072, (float*)(ws + WS_EDGEA), (float*)(ws + WS_EDGEL), (float*)(ws + WS_TAILA), halo};
        run_gemm(c.lds, XB, (const bf16*)(ws + WS_W_FIN1), TT, 6144, 1024, E); } }
    SYNC(16); STAMP(17);
    if (!fuse_fix) { if (IN(17)) REPS(17) { REPBAR(); phase_fixup(c, ws, in[31] + 3 * 3072, in[32] + 3072); }
    SYNC(17); } STAMP(18);
    if (IN(18)) REPS(18) { REPBAR(); if (fuse_fix) fixup_panel(c, ws, in[31] + 3 * 3072, in[32] + 3072, 8 * (blockIdx.x & 7) + ((blockIdx.x >> 3) & 7));
        { pg8::EpiRes E{a.out, a.out, nullptr, nullptr}; run_gemm(c.lds, BIG, (const bf16*)(ws + WS_W_FOUT1), TT, 1024, 3072, E); } }
#ifdef TIMING_PROBE
    xcd_barrier(bar); STAMP(19);
    if (blockIdx.x == 0 && c.tid == 0) {
        const float d1 = (float)(tsl[TP_A_HI] - tsl[TP_A_LO]) * 0.01f, d2 = (float)(tsl[TP_B_HI] - tsl[TP_B_LO]) * 0.01f;
#ifdef TP_CALIB
        a.out[0] += 1000.0f;
#else
        a.out[0] += d1;
        for (int j = 1; j <= 10000; ++j) a.out[j] += 0.1f * d2;
#endif
    }
#endif
#ifdef DBG_PROBE
    { grid.sync();
      const bf16* pb = (const bf16*)(ws + (size_t)DBG_B0 * MiB); const size_t nb = (size_t)(DBG_B1 - DBG_B0) * MiB / 2;
      const float* pf = (const float*)(ws + (size_t)DBG_F0 * MiB); const size_t nf = (size_t)(DBG_F1 - DBG_F0) * MiB / 4;
      for (size_t i = c.gtid; i < (size_t)TT * DM; i += c.ngt) { float s = 0.f;
          for (size_t j = i; j < nb; j += (size_t)TT * DM) s += bf2f(pb[j]);
          for (size_t j = i; j < nf; j += (size_t)TT * DM) s += pf[j];
          a.out[i] += 1e-3f * s; } }
#endif
    if (hi < 7) { grid.sync(); for (int i = c.gtid; i < TT * DM / 4; i += c.ngt) ((f32x4*)a.out)[i] = ((const f32x4*)in[0])[i]; }
#undef IN
#undef SYNC
}

#ifndef DBG_HI
#define DBG_HI NPHASE
#endif
#ifndef MK_PER_PHASE
#define MK_PER_PHASE 0
#endif
extern "C" void kernel_launch(void* const* d_in, const int* in_sizes, int n_in, void* d_out, int out_size, void* d_ws, size_t ws_size, hipStream_t stream) {
    static int grid = 0;
    if (grid == 0) {
        if (n_in != 34 || out_size != TT * DM || ws_size < WS_END) { fprintf(stderr, "kernel_launch: unexpected shapes (n_in %d out %d ws %zu)\n", n_in, out_size, ws_size); grid = -1; return; }
        int dev = 0, cus = 0, per_cu = 0;
        hipGetDevice(&dev); hipDeviceGetAttribute(&cus, hipDeviceAttributeMultiprocessorCount, dev);
        if (hipFuncSetAttribute((const void*)fwd_kernel, hipFuncAttributeMaxDynamicSharedMemorySize, LDS_BYTES) != hipSuccess) { fprintf(stderr, "kernel_launch: hipFuncSetAttribute failed\n"); grid = -1; return; }
        if (hipOccupancyMaxActiveBlocksPerMultiprocessor(&per_cu, (const void*)fwd_kernel, 512, LDS_BYTES) != hipSuccess || per_cu < 1) { fprintf(stderr, "kernel_launch: occupancy query says %d\n", per_cu); per_cu = 1; }
        (void)hipGetLastError();
        grid = cus;
        if (grid > 256) grid = 256;
    }
    if (grid < 0) return;
    if (hipMemsetAsync((char*)d_ws + WS_BARRIER, 0, 16384, stream) != hipSuccess) { fprintf(stderr, "kernel_launch: memset failed\n"); return; }
    Args a{};
    for (int i = 0; i < 34; ++i) a.in[i] = (const float*)d_in[i];
    a.out = (float*)d_out; a.ws = (unsigned char*)d_ws;
#if MK_PER_PHASE
    for (int p = 0; p < NPHASE; ++p) { a.ph_lo = p; a.ph_hi = p + 1; hipLaunchKernelGGL(fwd_kernel, dim3(grid), dim3(512), LDS_BYTES, stream, a); }
#else
    a.ph_lo = 0; a.ph_hi = DBG_HI;
    void* args[] = {&a};
    hipError_t e = hipLaunchCooperativeKernel((const void*)fwd_kernel, dim3(grid), dim3(512), args, LDS_BYTES, stream);
    if (e != hipSuccess) fprintf(stderr, "cooperative launch failed: %s (grid %d)\n", hipGetErrorString(e), grid);
#ifdef PROBE_LO
    (void)hipMemsetAsync((char*)d_ws + WS_BARRIER, 0, 16384, stream);
    Args a2 = a; a2.ph_lo = PROBE_LO; a2.ph_hi = PROBE_HI;
    void* args2[] = {&a2};
    (void)hipLaunchCooperativeKernel((const void*)fwd_kernel, dim3(grid), dim3(512), args2, LDS_BYTES, stream);
#endif
#endif
}
```

```cpp
#include <hip/hip_runtime.h>
#include <hip/hip_cooperative_groups.h>
#include <cstdio>
#include <cstdint>
namespace cg = cooperative_groups;
namespace pg8 {
#define PG8_LAS __attribute__((address_space(3)))
typedef unsigned short bf16_t;
typedef short bf16x8 __attribute__((ext_vector_type(8)));
typedef float f32x4 __attribute__((ext_vector_type(4)));
typedef unsigned u32x4 __attribute__((ext_vector_type(4)));
constexpr int BM = 256, BK = 64, HALF = 128, HTB = HALF * BK * 2  , STAGE_BYTES = 8 * HTB, NXCD = 8, WGM = 8;

__host__ __device__ __forceinline__ int lds_byte(int r, int c) { const int st = (r >> 4) * 2 + (c >> 5), rr = r & 15, cc = c & 31, ob = rr * 64 + cc * 2; return st * 1024 + (ob ^ (((ob >> 9) & 1) << 5)); }
__host__ __device__ __forceinline__ void stage_rc(int b, int& R, int& C) { const int st = b / 1024, sb = b % 1024, swz = sb ^ (((sb >> 9) & 1) << 5); R = (st >> 1) * 16 + swz / 64; C = (st & 1) * 32 + (swz % 64) / 2; }
__host__ __device__ __forceinline__ int perm32(int rho) { const int n = rho >> 4, i = rho & 15; return 8 * (i >> 2) + 4 * n + (i & 3); }

struct Unit { int pm, pn; };
struct Gemm { const bf16_t* A; const bf16_t* Bt; int M, N, K; };

struct StaticOrder {
    int nM, nN, nwg, G, c;
    __host__ __device__ void init(int M, int N, int G_, int c_) { nM = M / BM; nN = N / BM; nwg = nM * nN; G = G_; c = c_; }
    __host__ __device__ bool next(int i, Unit& u) const {
        const long L = (long)i * G + c; if (L >= nwg) return false;
        int wgid = (int)L; { const int q = nwg / NXCD, r = nwg % NXCD, xcd = wgid % NXCD, off = wgid / NXCD; wgid = (xcd < r ? xcd * (q + 1) : r * (q + 1) + (xcd - r) * q) + off; }
        const int nig = WGM * nN, gid = wgid / nig, fm = gid * WGM, gsz = (nM - fm) < WGM ? (nM - fm) : WGM;
        u.pm = fm + ((wgid % nig) % gsz); u.pn = (wgid % nig) / gsz; return true;
    }
    __device__ __forceinline__ void a_ready(const Unit&) const {}
    __device__ __forceinline__ void done(const Unit&) const {}
};

__device__ __forceinline__ unsigned cvt_pk_bf16(float lo, float hi) { unsigned r; asm volatile("v_cvt_pk_bf16_f32 %0, %1, %2" : "=v"(r) : "v"(lo), "v"(hi)); return r; }
typedef float f32x2 __attribute__((ext_vector_type(2)));
template <class Epi, class Sched, bool ALIGN_EPI = false, bool SP2 = false>
__device__ __forceinline__ void gemm_phase(PG8_LAS unsigned char* lds, const Gemm g, const Sched& S, const Epi& E) {
    const int tid = threadIdx.x, wid = __builtin_amdgcn_readfirstlane(tid >> 6), lane = tid & 63, wr = wid >> 2, wc = wid & 3, fr = lane & 15, fq = lane >> 4;
    const int K = g.K, nt = K / BK;
    unsigned voffA[2], voffB[2];
#pragma unroll
    for (int i = 0; i < 2; ++i) { int R, C; stage_rc(tid * 16 + i * 8192, R, C); const int Rb = Epi::PERM ? ((R & ~31) + perm32(R & 31)) : R;
        voffA[i] = (unsigned)(R * K + C) * 2u; voffB[i] = (unsigned)(Rb * K + C) * 2u; }
    const size_t kstep = (size_t)(BK * 2);
    const size_t hstep = (size_t)HALF * K * 2;
    const size_t tstep = 2 * hstep;
    const unsigned ldsw = (unsigned)wid * 1024u;
    const int aoff = lds_byte(wr * 64 + fr, fq * 8), boff = lds_byte(wc * 32 + fr, fq * 8);
#define PG8_SA(b, h) (((b) * 2 + (h)) * HTB)
#define PG8_SB(b, h) ((4 + (b) * 2 + (h)) * HTB)
#define PG8_STAGE(bufoff, gbase, voff) do { _Pragma("unroll") for (int _i = 0; _i < 2; ++_i) \
        __builtin_amdgcn_global_load_lds((const unsigned*)((const char*)(gbase) + (voff)[_i]), (PG8_LAS unsigned*)(lds + (bufoff) + ldsw + _i * 8192), 16, 0, 0); } while (0)
#define PG8_LDA(dst, b, h) do { _Pragma("unroll") for (int m = 0; m < 4; ++m) _Pragma("unroll") for (int k = 0; k < 2; ++k) dst[m][k] = *(const PG8_LAS bf16x8*)(lds + PG8_SA(b, h) + aoff + m * 2048 + k * 1024); } while (0)
#define PG8_LDB(dst, b, h) do { _Pragma("unroll") for (int n = 0; n < 2; ++n) _Pragma("unroll") for (int k = 0; k < 2; ++k) dst[n][k] = *(const PG8_LAS bf16x8*)(lds + PG8_SB(b, h) + boff + n * 2048 + k * 1024); } while (0)
#define PG8_MMA(ai, bj, At, Bt) do { __builtin_amdgcn_s_setprio(1); _Pragma("unroll") for (int m = 0; m < 4; ++m) _Pragma("unroll") for (int n = 0; n < 2; ++n) _Pragma("unroll") for (int k = 0; k < 2; ++k) \
        acc[ai][bj][m][n] = __builtin_amdgcn_mfma_f32_16x16x32_bf16(Bt[n][k], At[m][k], acc[ai][bj][m][n], 0, 0, 0); __builtin_amdgcn_s_setprio(0); } while (0)
#define PG8_WAIT_V(n) asm volatile("s_waitcnt vmcnt(" #n ")" ::: "memory")
#define PG8_WAIT_L(n) asm volatile("s_waitcnt lgkmcnt(" #n ")" ::: "memory")
#define PG8_BAR __builtin_amdgcn_s_barrier()
#define PG8_SCHED __builtin_amdgcn_sched_barrier(0)
    Unit cur, nxt; int ui = 0;
    if (!S.next(0, cur)) return;
    f32x4 acc[2][2][4][2];
#pragma unroll
    for (int a = 0; a < 2; ++a)
#pragma unroll
        for (int b = 0; b < 2; ++b)
#pragma unroll
            for (int m = 0; m < 4; ++m)
#pragma unroll
                for (int n = 0; n < 2; ++n) acc[a][b][m][n] = (f32x4){0.f, 0.f, 0.f, 0.f};
    bf16x8 At[4][2], B0[2][2], B1[2][2];
    const char* cA = (const char*)g.A + (size_t)cur.pm * tstep; const char* cB = (const char*)g.Bt + (size_t)cur.pn * tstep;
    S.a_ready(cur);
    if constexpr (SP2) {
        PG8_STAGE(PG8_SB(0, 0), cB, voffB); PG8_STAGE(PG8_SB(0, 1), cB + hstep, voffB); PG8_STAGE(PG8_SA(0, 0), cA, voffA); PG8_STAGE(PG8_SA(0, 1), cA + hstep, voffA);
        if (wr == 1) PG8_BAR;
        PG8_WAIT_V(2); PG8_BAR;
        PG8_STAGE(PG8_SB(1, 0), cB + kstep, voffB); PG8_STAGE(PG8_SA(1, 0), cA + kstep, voffA); PG8_STAGE(PG8_SB(1, 1), cB + hstep + kstep, voffB);
        PG8_WAIT_V(6); PG8_BAR;
    } else {
        PG8_STAGE(PG8_SB(0, 0), cB, voffB); PG8_STAGE(PG8_SA(0, 0), cA, voffA); PG8_STAGE(PG8_SB(0, 1), cB + hstep, voffB); PG8_STAGE(PG8_SA(0, 1), cA + hstep, voffA);
        if (wr == 1) PG8_BAR;
        PG8_WAIT_V(4); PG8_BAR;
        PG8_STAGE(PG8_SB(1, 0), cB + kstep, voffB); PG8_STAGE(PG8_SA(1, 0), cA + kstep, voffA); PG8_STAGE(PG8_SB(1, 1), cB + hstep + kstep, voffB);
        PG8_WAIT_V(6); PG8_BAR;
    }
    for (;;) {
        const bool has_next = S.next(ui + 1, nxt);
        const char* nA = has_next ? (const char*)g.A + (size_t)nxt.pm * tstep : cA; const char* nB = has_next ? (const char*)g.Bt + (size_t)nxt.pn * tstep : cB;
        for (int t = 0; t < nt; t += 2) {
            const bool last = (t == nt - 2);
            const char* a1 = cA + (size_t)(t + 1) * kstep;
            const char* a2 = last ? nA : cA + (size_t)(t + 2) * kstep; const char* b2 = last ? nB : cB + (size_t)(t + 2) * kstep;
            const char* a3 = a2 + kstep; const char* b3 = b2 + kstep;
            if (last && has_next) S.a_ready(nxt);
            if constexpr (SP2) {
            PG8_LDB(B0, 0, 0); PG8_LDB(B1, 0, 1); PG8_SCHED; PG8_LDA(At, 0, 0); PG8_STAGE(PG8_SA(1, 1), a1 + hstep, voffA);
            PG8_WAIT_V(8); PG8_WAIT_L(0); PG8_BAR; PG8_MMA(0, 0, At, B0); PG8_MMA(0, 1, At, B1); PG8_BAR; PG8_SCHED;
            PG8_LDA(At, 0, 1); PG8_STAGE(PG8_SB(0, 0), b2, voffB); PG8_STAGE(PG8_SB(0, 1), b2 + hstep, voffB); PG8_STAGE(PG8_SA(0, 0), a2, voffA);
            PG8_WAIT_V(8); PG8_WAIT_L(0); PG8_BAR; PG8_MMA(1, 0, At, B0); PG8_MMA(1, 1, At, B1); PG8_BAR; PG8_SCHED;
            PG8_LDB(B0, 1, 0); PG8_LDB(B1, 1, 1); PG8_SCHED; PG8_LDA(At, 1, 0); PG8_STAGE(PG8_SA(0, 1), a2 + hstep, voffA);
            PG8_WAIT_V(8); PG8_WAIT_L(0); PG8_BAR; PG8_MMA(0, 0, At, B0); PG8_MMA(0, 1, At, B1); PG8_BAR; PG8_SCHED;
            PG8_LDA(At, 1, 1); PG8_STAGE(PG8_SB(1, 0), b3, voffB); PG8_STAGE(PG8_SB(1, 1), b3 + hstep, voffB); PG8_STAGE(PG8_SA(1, 0), a3, voffA);
            PG8_WAIT_V(8); PG8_WAIT_L(0); PG8_BAR; PG8_MMA(1, 0, At, B0); PG8_MMA(1, 1, At, B1); PG8_BAR; PG8_SCHED;
            } else {
            PG8_LDB(B0, 0, 0); PG8_SCHED; PG8_LDA(At, 0, 0); PG8_STAGE(PG8_SA(1, 1), a1 + hstep, voffA);
            PG8_WAIT_L(8); PG8_BAR; PG8_WAIT_L(0); PG8_MMA(0, 0, At, B0); PG8_BAR; PG8_SCHED;
            PG8_LDB(B1, 0, 1); PG8_STAGE(PG8_SB(0, 0), b2, voffB);
            PG8_BAR; PG8_WAIT_L(0); PG8_MMA(0, 1, At, B1); PG8_BAR;
            PG8_LDA(At, 0, 1); PG8_STAGE(PG8_SA(0, 0), a2, voffA);
            PG8_BAR; PG8_WAIT_L(0); PG8_MMA(1, 0, At, B0); PG8_BAR; PG8_SCHED;
            PG8_STAGE(PG8_SB(0, 1), b2 + hstep, voffB);
            PG8_WAIT_V(6); PG8_BAR; PG8_MMA(1, 1, At, B1); PG8_BAR;
            PG8_LDB(B0, 1, 0); PG8_SCHED; PG8_LDA(At, 1, 0); PG8_STAGE(PG8_SA(0, 1), a2 + hstep, voffA);
            PG8_WAIT_L(8); PG8_BAR; PG8_WAIT_L(0); PG8_MMA(0, 0, At, B0); PG8_BAR; PG8_SCHED;
            PG8_LDB(B1, 1, 1); PG8_STAGE(PG8_SB(1, 0), b3, voffB);
            PG8_BAR; PG8_WAIT_L(0); PG8_MMA(0, 1, At, B1); PG8_BAR;
            PG8_LDA(At, 1, 1); PG8_STAGE(PG8_SA(1, 0), a3, voffA);
            PG8_BAR; PG8_WAIT_L(0); PG8_MMA(1, 0, At, B0); PG8_BAR; PG8_SCHED;
            PG8_STAGE(PG8_SB(1, 1), b3 + hstep, voffB);
            PG8_WAIT_V(6); PG8_BAR; PG8_MMA(1, 1, At, B1); PG8_BAR;
            }
        }
        if constexpr (ALIGN_EPI) { if (wr == 0) PG8_BAR; }
        if constexpr (!Epi::AFTER_DRAIN) { E(acc, cur, wr, wc, fr, fq); S.done(cur); }
        if (!has_next) break;
#pragma unroll
        for (int a = 0; a < 2; ++a)
#pragma unroll
            for (int b = 0; b < 2; ++b)
#pragma unroll
                for (int m = 0; m < 4; ++m)
#pragma unroll
                    for (int n = 0; n < 2; ++n) acc[a][b][m][n] = (f32x4){0.f, 0.f, 0.f, 0.f};
        cur = nxt; cA = nA; cB = nB; ++ui;
        if constexpr (ALIGN_EPI) { if (wr == 1) PG8_BAR; }
    }
    PG8_WAIT_V(0);
    if constexpr (!ALIGN_EPI) { if (wr == 0) PG8_BAR; }
    PG8_BAR;
    if constexpr (Epi::AFTER_DRAIN) { E.fused(acc, cur, wr, wc, fr, fq, lds, wid, lane); S.done(cur); }
#undef PG8_SA
#undef PG8_SB
#undef PG8_STAGE
#undef PG8_LDA
#undef PG8_LDB
#undef PG8_MMA
#undef PG8_WAIT_V
#undef PG8_WAIT_L
#undef PG8_BAR
#undef PG8_SCHED
}
}
namespace pg8 {
typedef unsigned u32x2 __attribute__((ext_vector_type(2)));
typedef float f32x2_t __attribute__((ext_vector_type(2))); typedef __bf16 bf16x2_t __attribute__((ext_vector_type(2)));
__device__ __forceinline__ unsigned cvtpk(float lo, float hi) { f32x2_t v = {lo, hi}; bf16x2_t b = __builtin_convertvector(v, bf16x2_t); return __builtin_bit_cast(unsigned, b); }
__device__ __forceinline__ float sigm(float x) { return __builtin_amdgcn_rcpf(1.0f + __expf(-x)); }
__device__ __forceinline__ float gelu_tanh(float x) { const float u = 1.5957691216057308f * (x + 0.044715f * x * x * x); return x * __builtin_amdgcn_rcpf(1.0f + __expf(-u)); }
__device__ __forceinline__ float bfw(unsigned w, int hi) { return __uint_as_float(hi ? (w & 0xffff0000u) : (w << 16)); }
__device__ __forceinline__ float logsig(float z) { return fminf(z, 0.f) - log1pf(__expf(-fabsf(z))); }
__device__ __forceinline__ float dpp_ror1(float v) { return __int_as_float(__builtin_amdgcn_update_dpp(__float_as_int(v), __float_as_int(v), 0x121, 0xf, 0xf, false)); }
__device__ __forceinline__ float dpp_ror2(float v) { return __int_as_float(__builtin_amdgcn_update_dpp(__float_as_int(v), __float_as_int(v), 0x122, 0xf, 0xf, false)); }

struct EpiProj {
    static constexpr bool PERM = true, AFTER_DRAIN = false;
    bf16_t* O; int ldc; const float* ss;
    __device__ __forceinline__ void operator()(const f32x4 (&acc)[2][2][4][2], const Unit& u, int wr, int wc, int fr, int fq) const {
        const int row0 = u.pm * BM + wr * 64 + fr, col0 = u.pn * BM + wc * 32 + 8 * fq;
#pragma unroll
        for (int ai = 0; ai < 2; ++ai)
#pragma unroll
            for (int m = 0; m < 4; ++m) {
                const int row = row0 + ai * HALF + m * 16;
                const float rs = rsqrtf(ss[row] * (1.0f / 1024.0f) + 1e-6f);
                bf16_t* rowp = O + (size_t)row * ldc + col0;
#pragma unroll
                for (int bj = 0; bj < 2; ++bj) {
                    const f32x4 v0 = acc[ai][bj][m][0] * rs, v1 = acc[ai][bj][m][1] * rs;
                    u32x4 w; w.x = cvt_pk_bf16(v0[0], v0[1]); w.y = cvt_pk_bf16(v0[2], v0[3]); w.z = cvt_pk_bf16(v1[0], v1[1]); w.w = cvt_pk_bf16(v1[2], v1[3]);
                    *(u32x4*)(rowp + bj * HALF) = w;
                }
            }
    }
};

struct EpiGates {
    static constexpr bool PERM = true, AFTER_DRAIN = false;
    const bf16_t* xc; bf16_t* loga; bf16_t* gi; const float* ga_b; const float* gx_b; const float* lam;
    __device__ __forceinline__ void operator()(const f32x4 (&acc)[2][2][4][2], const Unit& u, int wr, int wc, int fr, int fq) const {
        const int row0 = u.pm * BM + wr * 64 + fr, ch0 = u.pn * HALF + wc * 32 + 8 * fq;
        float gab[8], gxb[8], ls[8];
#pragma unroll
        for (int e = 0; e < 8; ++e) { gab[e] = ga_b[ch0 + e]; gxb[e] = gx_b[ch0 + e]; ls[e] = 8.0f * logsig(lam[ch0 + e]); }
#pragma unroll
        for (int ai = 0; ai < 2; ++ai)
#pragma unroll
            for (int m = 0; m < 4; ++m) {
                const int row = row0 + ai * HALF + m * 16;
                const u32x4 xv = *(const u32x4*)(xc + (size_t)row * 512 + ch0);
                float la[8], g[8];
#pragma unroll
                for (int n = 0; n < 2; ++n)
#pragma unroll
                    for (int e = 0; e < 4; ++e) {
                        const int idx = 4 * n + e;
                        const float r = acc[ai][0][m][n][e] + gab[idx], i = acc[ai][1][m][n][e] + gxb[idx];
                        la[idx] = sigm(r) * ls[idx];
                        g[idx] = sigm(i) * bfw(xv[idx >> 1], idx & 1);
                    }
                u32x4 w; w.x = cvt_pk_bf16(la[0], la[1]); w.y = cvt_pk_bf16(la[2], la[3]); w.z = cvt_pk_bf16(la[4], la[5]); w.w = cvt_pk_bf16(la[6], la[7]);
                *(u32x4*)(loga + (size_t)row * 512 + ch0) = w;
                u32x4 w2; w2.x = cvt_pk_bf16(g[0], g[1]); w2.y = cvt_pk_bf16(g[2], g[3]); w2.z = cvt_pk_bf16(g[4], g[5]); w2.w = cvt_pk_bf16(g[6], g[7]);
                *(u32x4*)(gi + (size_t)row * 512 + ch0) = w2;
            }
    }
};

struct EpiRes {
    static constexpr bool PERM = false, AFTER_DRAIN = false;
    const float* base; float* out; bf16_t* xb; float* ss;
    __device__ __forceinline__ void operator()(const f32x4 (&acc)[2][2][4][2], const Unit& u, int wr, int wc, int fr, int fq) const {
        const int row0 = u.pm * BM + wr * 64 + fr, col0 = u.pn * BM + wc * 32 + 4 * fq;
#pragma unroll
        for (int ai = 0; ai < 2; ++ai)
#pragma unroll
            for (int m = 0; m < 4; ++m) {
                const int row = row0 + ai * HALF + m * 16; float q = 0.f;
#pragma unroll
                for (int bj = 0; bj < 2; ++bj)
#pragma unroll
                    for (int n = 0; n < 2; ++n) {
                        const size_t off = (size_t)row * 1024 + col0 + bj * HALF + n * 16;
                        const f32x4 b = *(const f32x4*)(base + off);
                        const f32x4 o = b + acc[ai][bj][m][n];
                        *(f32x4*)(out + off) = o;
                        if (xb) { u32x2 w; w.x = cvt_pk_bf16(o[0], o[1]); w.y = cvt_pk_bf16(o[2], o[3]); *(u32x2*)(xb + off) = w; }
                        q += (o[0] * o[0] + o[1] * o[1]) + (o[2] * o[2] + o[3] * o[3]);
                    }
                if (ss) { q += __shfl_xor(q, 16); q += __shfl_xor(q, 32); if (fq == 0) atomicAdd(ss + row, q); }
            }
    }
};

struct EpiGlu {
    static constexpr bool PERM = true, AFTER_DRAIN = false;
    const bf16_t* ys; bf16_t* ycat; const float* bias;
    __device__ __forceinline__ void operator()(const f32x4 (&acc)[2][2][4][2], const Unit& u, int wr, int wc, int fr, int fq) const {
        const int row0 = u.pm * BM + wr * 64 + fr, col0 = u.pn * BM + wc * 32 + 8 * fq;
#pragma unroll
        for (int bj = 0; bj < 2; ++bj) {
            const int col = col0 + bj * HALF;
            float bs[8];
#pragma unroll
            for (int e = 0; e < 8; ++e) bs[e] = bias[col + e];
#pragma unroll
            for (int ai = 0; ai < 2; ++ai)
#pragma unroll
                for (int m = 0; m < 4; ++m) {
                    const int row = row0 + ai * HALF + m * 16;
                    const u32x4 yv = *(const u32x4*)(ys + (size_t)row * 512 + col);
                    float o[8];
#pragma unroll
                    for (int n = 0; n < 2; ++n)
#pragma unroll
                        for (int e = 0; e < 4; ++e) { const int idx = 4 * n + e; o[idx] = bfw(yv[idx >> 1], idx & 1) * sigm(acc[ai][bj][m][n][e] + bs[idx]); }
                    u32x4 w; w.x = cvt_pk_bf16(o[0], o[1]); w.y = cvt_pk_bf16(o[2], o[3]); w.z = cvt_pk_bf16(o[4], o[5]); w.w = cvt_pk_bf16(o[6], o[7]);
                    *(u32x4*)(ycat + (size_t)row * 1024 + col) = w;
                }
        }
    }
};

struct EpiFfn {
    static constexpr bool PERM = true, AFTER_DRAIN = false;
    bf16_t* U; const float* ss; const float* cw; const float* cb; float* edgeA; float* edgeL; float* tailA; PG8_LAS float* halo;
    __device__ __forceinline__ void operator()(const f32x4 (&acc)[2][2][4][2], const Unit& u, int wr, int wc, int fr, int fq) const {
        const int cl = wc * 32 + 8 * fq, ch0 = u.pn * HALF + cl;
        const int row0 = u.pm * BM + wr * 64 + fr;
        float w0[8], w1[8], w2[8], bb[8];
#pragma unroll
        for (int e = 0; e < 8; ++e) { w0[e] = cw[ch0 + e]; w1[e] = cw[3072 + ch0 + e]; w2[e] = cw[6144 + ch0 + e]; bb[e] = cb[ch0 + e]; }
        float rs[2][4];
#pragma unroll
        for (int ai = 0; ai < 2; ++ai)
#pragma unroll
            for (int m = 0; m < 4; ++m) rs[ai][m] = rsqrtf(ss[row0 + ai * HALF + m * 16] * (1.0f / 1024.0f) + 1e-6f);
        if (fr >= 14) {
#pragma unroll
            for (int ai = 0; ai < 2; ++ai) {
                PG8_LAS float* hp = halo + ((ai * 2 + wr) * 2 + (fr - 14)) * 128 + cl;
                *(PG8_LAS f32x4*)hp = acc[ai][0][3][0] * rs[ai][3];
                *(PG8_LAS f32x4*)(hp + 4) = acc[ai][0][3][1] * rs[ai][3];
            }
            if (wr == 1) {
                float* tp = tailA + (size_t)(u.pm * 2 + (fr - 14)) * 3072 + ch0;
                *(f32x4*)tp = acc[1][0][3][0] * rs[1][3]; *(f32x4*)(tp + 4) = acc[1][0][3][1] * rs[1][3];
            }
        }
        if (wr == 0 && fr < 2) {
            float* ea = edgeA + (size_t)(u.pm * 2 + fr) * 3072 + ch0; float* el = edgeL + (size_t)(u.pm * 2 + fr) * 3072 + ch0;
            *(f32x4*)ea = acc[0][0][0][0] * rs[0][0]; *(f32x4*)(ea + 4) = acc[0][0][0][1] * rs[0][0];
            *(f32x4*)el = acc[0][1][0][0] * rs[0][0]; *(f32x4*)(el + 4) = acc[0][1][0][1] * rs[0][0];
        }
        asm volatile("s_waitcnt lgkmcnt(0)" ::: "memory"); __builtin_amdgcn_s_barrier(); asm volatile("" ::: "memory");
#pragma unroll
        for (int ai = 0; ai < 2; ++ai) {
            f32x4 pv[2];
            if (ai == 0 && wr == 0) { pv[0] = (f32x4){0.f, 0.f, 0.f, 0.f}; pv[1] = pv[0]; }
            else {
                const int pai = (wr == 1) ? ai : 0, pwr = (wr == 1) ? 0 : 1;
                const PG8_LAS float* hp = halo + ((pai * 2 + pwr) * 2 + (fr & 1)) * 128 + cl;
                pv[0] = *(const PG8_LAS f32x4*)hp; pv[1] = *(const PG8_LAS f32x4*)(hp + 4);
            }
#pragma unroll
            for (int m = 0; m < 4; ++m) {
                const int row = row0 + ai * HALF + m * 16;
                f32x4 av[2]; av[0] = acc[ai][0][m][0] * rs[ai][m]; av[1] = acc[ai][0][m][1] * rs[ai][m];
                float o[8];
#pragma unroll
                for (int n = 0; n < 2; ++n)
#pragma unroll
                    for (int e = 0; e < 4; ++e) {
                        const int idx = 4 * n + e;
                        const float cur = av[n][e], prv = pv[n][e];
                        const float r1c = dpp_ror1(cur), r1p = dpp_ror1(prv), r2c = dpp_ror2(cur), r2p = dpp_ror2(prv);
                        const float t1 = (fr >= 1) ? r1c : r1p, t2 = (fr >= 2) ? r2c : r2p;
                        const float cv = w0[idx] * t2 + w1[idx] * t1 + w2[idx] * cur + bb[idx];
                        o[idx] = gelu_tanh(cv) * (acc[ai][1][m][n][e] * rs[ai][m]);
                    }
                u32x4 w; w.x = cvt_pk_bf16(o[0], o[1]); w.y = cvt_pk_bf16(o[2], o[3]); w.z = cvt_pk_bf16(o[4], o[5]); w.w = cvt_pk_bf16(o[6], o[7]);
                *(u32x4*)(U + (size_t)row * 3072 + ch0) = w;
                pv[0] = av[0]; pv[1] = av[1];
            }
        }
    }
};
}
#define LAS __attribute__((address_space(3)))
typedef unsigned short bf16;
typedef short bf16x8 __attribute__((ext_vector_type(8)));
typedef float f32x4 __attribute__((ext_vector_type(4)));
typedef unsigned u32x4 __attribute__((ext_vector_type(4)));
typedef unsigned u32x2 __attribute__((ext_vector_type(2)));
using pg8::cvt_pk_bf16; using pg8::sigm; using pg8::gelu_tanh; using pg8::bfw; using pg8::logsig;

constexpr int TT = 16384, SEQ = 8192, DM = 1024, DFF = 3072;
constexpr size_t MiB = 1u << 20;
constexpr size_t WS_SS = 0;
constexpr size_t WS_SUMA = 256 * 1024, WS_SUMB = 768 * 1024;
constexpr size_t WS_DECAY = 1280 * 1024;
constexpr size_t WS_BARRIER = 3 * 1024 * 1024;
constexpr size_t WS_ROPE = 1536 * 1024;
constexpr size_t WS_W_EIN = 4 * MiB, WS_W_EOUT = 9 * MiB, WS_W_GATE = 11 * MiB, WS_W_FIN0 = 12 * MiB, WS_W_FIN1 = 24 * MiB, WS_W_FOUT0 = 36 * MiB, WS_W_FOUT1 = 42 * MiB;
constexpr size_t WS_W_OIN = 48 * MiB, WS_W_GLU = 53 * MiB, WS_W_OOUT = 54 * MiB, WS_S5A = 56 * MiB, WS_S5F = 62 * MiB;
constexpr size_t WS_XB = 64 * MiB;
constexpr size_t WS_LOGA = 64 * MiB, WS_GI = 80 * MiB;
constexpr size_t WS_KDT = 64 * MiB, WS_VTG = 72 * MiB, WS_SX = 88 * MiB;
constexpr size_t WS_BIG = 96 * MiB;
constexpr size_t WS_XC = 224 * MiB, WS_KVS = 168 * MiB;
constexpr size_t WS_YCAT = 192 * MiB;
constexpr size_t WS_XLOC = 224 * MiB;
constexpr size_t WS_EDGEA = 240 * MiB, WS_EDGEL = 242 * MiB, WS_TAILA = 244 * MiB;
constexpr size_t WS_END = 256 * MiB;
constexpr int P0LD = 2568, P1LD = 2304;
constexpr int VTP = SEQ + 128;
constexpr int LDS_BYTES = 147456, HALO_OFF = 131072 + 1024;

__device__ __forceinline__ float wave_sum(float v) {
#pragma unroll
    for (int o = 1; o < 64; o <<= 1) v += __shfl_xor(v, o);
    return v;
}
__device__ __forceinline__ float bf2f(bf16 b) { return __uint_as_float((unsigned)b << 16); }
__device__ __forceinline__ bf16 f2bf(float f) { return (bf16)(cvt_pk_bf16(f, 0.f) & 0xffffu); }
__device__ __forceinline__ f32x4 mfma16(bf16x8 a, bf16x8 b, f32x4 c) { return __builtin_amdgcn_mfma_f32_16x16x32_bf16(a, b, c, 0, 0, 0); }
__device__ __forceinline__ bf16x8 ld8(const bf16* p) { return *(const bf16x8*)p; }
__device__ __forceinline__ void unpack8(u32x4 v, float* f) {
#pragma unroll
    for (int i = 0; i < 4; ++i) { f[2 * i] = __uint_as_float(v[i] << 16); f[2 * i + 1] = __uint_as_float(v[i] & 0xffff0000u); }
}
__device__ __forceinline__ u32x4 pack8v(const float* f) { u32x4 w; w.x = pg8::cvtpk(f[0], f[1]); w.y = pg8::cvtpk(f[2], f[3]); w.z = pg8::cvtpk(f[4], f[5]); w.w = pg8::cvtpk(f[6], f[7]); return w; }
__device__ __forceinline__ u32x4 pack8(const float* f) { u32x4 w; w.x = cvt_pk_bf16(f[0], f[1]); w.y = cvt_pk_bf16(f[2], f[3]); w.z = cvt_pk_bf16(f[4], f[5]); w.w = cvt_pk_bf16(f[6], f[7]); return w; }

struct Ctx { int tid, lane, wave, gw, ngw, gtid, ngt; LAS unsigned char* lds; };

struct TrDesc { const float* W; const float* gk; bf16* WT; int ldw, nsrc, ldt, k0, n0, dst_row0; };
__device__ __forceinline__ void tr_load(const TrDesc& t, int lane, float* v) {
    const int n = t.n0 + (lane & 31);
#pragma unroll
    for (int i = 0; i < 32; ++i) { const int kk = 2 * i + (lane >> 5); v[i] = (n < t.nsrc) ? t.W[(size_t)(t.k0 + kk) * t.ldw + n] : 0.f; }
}
__device__ __forceinline__ void tr_finish(const TrDesc& t, int lane, const float* v, LAS float* scr) {
#pragma unroll
    for (int i = 0; i < 32; ++i) { const int kk = 2 * i + (lane >> 5); float x = v[i]; if (t.gk) x *= t.gk[t.k0 + kk]; scr[kk * 33 + (lane & 31)] = x; }
    asm volatile("s_waitcnt lgkmcnt(0)" ::: "memory");
    const int c = lane & 7;
#pragma unroll
    for (int j = 0; j < 4; ++j) {
        const int n = (lane >> 3) + 8 * j; const LAS float* s = scr + (8 * c) * 33 + n;
        u32x4 o; o.x = cvt_pk_bf16(s[0], s[33]); o.y = cvt_pk_bf16(s[66], s[99]); o.z = cvt_pk_bf16(s[132], s[165]); o.w = cvt_pk_bf16(s[198], s[231]);
        *(u32x4*)(t.WT + (size_t)(t.dst_row0 + n) * t.ldt + t.k0 + 8 * c) = o;
    }
    asm volatile("s_waitcnt lgkmcnt(0)" ::: "memory");
}

struct S5P { float m, th, cr, ci, ar, ai; };
__device__ __forceinline__ S5P s5_params(const float* lam_re, const float* lam_im, const float* log_step, int g, int n) {
    const float step = expf(log_step[g]), lr = lam_re[g * 64 + n], li = lam_im[g * 64 + n];
    S5P p; p.m = lr * step; p.th = li * step;
    float sn, cs; sincosf(p.th, &sn, &cs);
    const float mag = expf(p.m), ar = mag * cs, ai = mag * sn, den = lr * lr + li * li;
    p.cr = ((ar - 1.0f) * lr + ai * li) / den; p.ci = (ai * lr - (ar - 1.0f) * li) / den; p.ar = ar; p.ai = ai;
    return p;
}
__device__ __forceinline__ void s5_pow(const S5P& p, float tau, float& pr, float& pi) {
    float sn, cs; sincosf(p.th * tau, &sn, &cs); const float mag = expf(p.m * tau); pr = mag * cs; pi = mag * sn;
}

__device__ __forceinline__ TrDesc tr_decode(const float* const* in, unsigned char* ws, int it) {
    constexpr int I_EIN = 16 * 80, I_EOUT = 16 * 32, I_FIN = 16 * 192, I_FOUT = 48 * 32, I_OIN = 16 * 72, I_GLU = 8 * 16;
    TrDesc t; int r = it;
    if (r < I_EIN) { const int kb = r / 80, nb = r % 80; t = TrDesc{in[2], in[1], (bf16*)(ws + WS_W_EIN), 2560, 2560, 1024, 64 * kb, 32 * nb, 32 * nb}; return t; } r -= I_EIN;
    if (r < I_EOUT) { const int kb = r / 32, nb = r % 32; t = TrDesc{in[12], nullptr, (bf16*)(ws + WS_W_EOUT), 1024, 1024, 1024, 64 * kb, 32 * nb, 32 * nb}; return t; } r -= I_EOUT;
    if (r < 2 * I_FIN) { const int l = r / I_FIN; r %= I_FIN; const int kb = r / 192, nb = r % 192, n0 = 32 * nb;
        const int dst = (n0 < 3072) ? (256 * (n0 / 128) + (n0 % 128)) : (256 * ((n0 - 3072) / 128) + 128 + ((n0 - 3072) % 128));
        t = TrDesc{in[30] + (size_t)l * 1024 * 6144, in[29] + l * 1024, (bf16*)(ws + (l ? WS_W_FIN1 : WS_W_FIN0)), 6144, 6144, 1024, 64 * kb, n0, dst}; return t; } r -= 2 * I_FIN;
    if (r < 2 * I_FOUT) { const int l = r / I_FOUT; r %= I_FOUT; const int kb = r / 32, nb = r % 32;
        t = TrDesc{in[33] + (size_t)l * 3072 * 1024, nullptr, (bf16*)(ws + (l ? WS_W_FOUT1 : WS_W_FOUT0)), 1024, 1024, 3072, 64 * kb, 32 * nb, 32 * nb}; return t; } r -= 2 * I_FOUT;
    if (r < I_OIN) { const int kb = r / 72, nb = r % 72; t = TrDesc{in[14], in[13], (bf16*)(ws + WS_W_OIN), 2064, 2064, 1024, 64 * kb, 32 * nb, 32 * nb}; return t; } r -= I_OIN;
    if (r < I_GLU) { const int kb = r / 16, nb = r % 16; t = TrDesc{in[23], nullptr, (bf16*)(ws + WS_W_GLU), 512, 512, 512, 64 * kb, 32 * nb, 32 * nb}; return t; } r -= I_GLU;
    { const int kb = r / 32, nb = r % 32; t = TrDesc{in[28], nullptr, (bf16*)(ws + WS_W_OOUT), 1024, 1024, 1024, 64 * kb, 32 * nb, 32 * nb}; return t; }
}
__device__ __forceinline__ void do_tr_items(const Ctx& c, const float* const* in, unsigned char* ws, int it_begin, int it_end, int widx, int nw) {
    LAS float* scr = (LAS float*)(c.lds + c.wave * 16384);
    int it = it_begin + widx;
    if (it >= it_end) return;
    TrDesc cur = tr_decode(in, ws, it); float v[32]; tr_load(cur, c.lane, v);
    for (;;) {
        const int nx = it + nw; const bool more = nx < it_end;
        TrDesc nxt = cur; float w[32];
        if (more) { nxt = tr_decode(in, ws, nx); tr_load(nxt, c.lane, w); }
        tr_finish(cur, c.lane, v, scr);
        if (!more) break;
        cur = nxt; it = nx;
#pragma unroll
        for (int i = 0; i < 32; ++i) v[i] = w[i];
    }
}
#ifndef DEFER_TR
#define DEFER_TR 0
#endif
#ifndef DEFER_P1
#define DEFER_P1 0
#endif
constexpr int TR_EIN0 = 0, TR_EOUT0 = 1280, TR_FIN00 = 1792, TR_FIN10 = 4864, TR_FOUT00 = 7936, TR_FOUT10 = 9472, TR_OIN0 = 11008, TR_GLU0 = 12160, TR_OOUT0 = 12288, TR_END = 12800;

__device__ __forceinline__ void phase_prologue(const Ctx& c, const float* const* in, unsigned char* ws) {
#if DEFER_TR
    do_tr_items(c, in, ws, TR_EIN0, TR_EOUT0, c.gw, c.ngw);
#elif DEFER_P1
    do_tr_items(c, in, ws, TR_EIN0, TR_EOUT0, c.gw, c.ngw); do_tr_items(c, in, ws, TR_FIN10, TR_END, c.gw, c.ngw);
#else
    do_tr_items(c, in, ws, TR_EIN0, TR_END, c.gw, c.ngw);
#endif
    {
        const float* x = in[0]; bf16* xb = (bf16*)(ws + WS_XB); float* ss = (float*)(ws + WS_SS);
        for (int m0 = c.gw; m0 < TT; m0 += 2 * c.ngw) {
            f32x4 v[2][4];
#pragma unroll
            for (int u = 0; u < 2; ++u) { const f32x4* xr = (const f32x4*)(x + (size_t)(m0 + u * c.ngw) * DM) + c.lane;
#pragma unroll
                for (int j = 0; j < 4; ++j) v[u][j] = xr[64 * j]; }
#pragma unroll
            for (int u = 0; u < 2; ++u) { const int m = m0 + u * c.ngw; float s = 0.f;
                u32x2* o8 = (u32x2*)(xb + (size_t)m * DM) + c.lane;
#pragma unroll
                for (int j = 0; j < 4; ++j) { const f32x4 q = v[u][j]; s += (q.x * q.x + q.y * q.y) + (q.z * q.z + q.w * q.w); u32x2 w; w.x = cvt_pk_bf16(q.x, q.y); w.y = cvt_pk_bf16(q.z, q.w); o8[64 * j] = w; }
                s = wave_sum(s);
                if (c.lane == 0) ss[m] = s; }
        }
        for (int i = c.gtid; i < 3 * TT; i += c.ngt) ss[TT + i] = 0.f;
    }
    {
        bf16* G = (bf16*)(ws + WS_W_GATE);
        for (int i = c.gtid; i < 1024 * 512; i += c.ngt) {
            const int R = i >> 9, k = i & 511, pn = R >> 8, half = (R >> 7) & 1, ch = 128 * pn + (R & 127), h = ch >> 6, j = ch & 63;
            float v = 0.f;
            if ((k >> 6) == h) v = (half ? in[7] : in[5])[(h * 64 + (k & 63)) * 64 + j];
            G[i] = f2bf(v);
        }
    }
    {
        float* RT = (float*)(ws + WS_ROPE);
        for (int i = c.gtid; i < SEQ * 8; i += c.ngt) {
            const int pos = i >> 3, e = i & 7;
            const float inv = powf(500000.0f, -(float)e * 0.125f);
            float sn, cs; sincosf((float)pos * inv, &sn, &cs);
            RT[pos * 16 + e] = cs; RT[pos * 16 + 8 + e] = sn;
        }
    }
}
__device__ __forceinline__ void phase_s5_mats(const Ctx& c, const float* const* in, unsigned char* ws) {
    {
        const float *lam_re = in[15], *lam_im = in[16], *b_re = in[17], *b_im = in[18], *c_re = in[19], *c_im = in[20], *lstep = in[22];
        bf16* AM = (bf16*)(ws + WS_S5A);
        bf16* FM = (bf16*)(ws + WS_S5F);
        for (int i = c.gtid; i < 32 * 256 * 4; i += c.ngt) {
            const int nq = i & 3, pp = (i >> 2) & 15, p = (i >> 6) & 15, g = i >> 10;
            float acc[16];
#pragma unroll
            for (int t = 0; t < 16; ++t) acc[t] = 0.f;
            for (int n = nq * 16; n < nq * 16 + 16; ++n) {
                const S5P sp = s5_params(lam_re, lam_im, lstep, g, n);
                const float br = b_re[(g * 64 + n) * 16 + pp], bi = b_im[(g * 64 + n) * 16 + pp];
                const float bbr = sp.cr * br - sp.ci * bi, bbi = sp.cr * bi + sp.ci * br;
                const float cr_ = c_re[(g * 16 + p) * 64 + n], ci_ = c_im[(g * 16 + p) * 64 + n];
                float zr = cr_ * bbr - ci_ * bbi, zi = cr_ * bbi + ci_ * bbr;
#pragma unroll
                for (int t = 0; t < 16; ++t) { acc[t] += zr; const float nr = zr * sp.ar - zi * sp.ai, ni = zr * sp.ai + zi * sp.ar; zr = nr; zi = ni; }
            }
            bf16* Ag = AM + (size_t)g * 256 * 384;
#pragma unroll
            for (int tau = 0; tau < 16; ++tau) {
                float v = acc[tau]; v += __shfl_xor(v, 1); v += __shfl_xor(v, 2);
                if ((tau & 3) == nq) {
                    const bf16 kv = f2bf(v);
                    for (int t = tau; t < 16; ++t) Ag[(t * 16 + p) * 384 + (t - tau) * 16 + pp] = kv;
                    if (tau >= 1) for (int t = 0; t + tau < 16; ++t) Ag[(t * 16 + p) * 384 + (t + tau) * 16 + pp] = 0;
                }
            }
        }
        for (int i = (c.gtid + c.ngt - c.ngt / 4) % c.ngt; i < 32 * 16 * 64; i += c.ngt) {
            const int g = i >> 10, p = (i >> 6) & 15, n = i & 63;
            const S5P sp = s5_params(lam_re, lam_im, lstep, g, n);
            const float cr_ = c_re[(g * 16 + p) * 64 + n], ci_ = c_im[(g * 16 + p) * 64 + n];
            float pr = sp.ar, pi = sp.ai;
            for (int t = 0; t < 16; ++t) {
                bf16* row = AM + ((size_t)g * 256 + t * 16 + p) * 384 + 256;
                row[n] = f2bf(cr_ * pr - ci_ * pi);
                row[64 + n] = f2bf(-(cr_ * pi + ci_ * pr));
                const float nr = pr * sp.ar - pi * sp.ai, ni = pr * sp.ai + pi * sp.ar; pr = nr; pi = ni;
            }
        }
        for (int i = (c.gtid + c.ngt - c.ngt / 2) % c.ngt; i < 32 * 64 * 16; i += c.ngt) {
            const int g = i >> 10, n = (i >> 4) & 63, pp = i & 15;
            const S5P sp = s5_params(lam_re, lam_im, lstep, g, n);
            const float br = b_re[(g * 64 + n) * 16 + pp], bi = b_im[(g * 64 + n) * 16 + pp];
            const float bbr = sp.cr * br - sp.ci * bi, bbi = sp.cr * bi + sp.ci * br;
            float pr = 1.f, pi = 0.f;
            for (int s = 15; s >= 0; --s) {
                FM[((size_t)g * 128 + n) * 256 + s * 16 + pp] = f2bf(pr * bbr - pi * bbi);
                FM[((size_t)g * 128 + 64 + n) * 256 + s * 16 + pp] = f2bf(pr * bbi + pi * bbr);
                const float nr = pr * sp.ar - pi * sp.ai, ni = pr * sp.ai + pi * sp.ar; pr = nr; pi = ni;
            }
        }
    }
}

__device__ __forceinline__ u32x4 vt_load(const bf16* src, int pitch, int coloff, int hd, int nh, int sh, int item, int lane) {
    const int cgp = item & 1023; int r = item >> 10; const int nblk = hd >> 6, dblk = r % nblk, bh = r / nblk, b = bh / nh, h = bh % nh;
    const int d = dblk * 64 + lane, Ld = SEQ >> sh;
    const bf16* s = src + (size_t)b * SEQ * pitch + coloff + h * hd + d;
    unsigned short v[8];
#pragma unroll
    for (int i = 0; i < 8; ++i) { const int col = cgp * 8 + i, rres = col / Ld, l = col - rres * Ld, t = (l << sh) + rres; v[i] = s[(size_t)t * pitch]; }
    u32x4 w; w.x = v[0] | ((unsigned)v[1] << 16); w.y = v[2] | ((unsigned)v[3] << 16); w.z = v[4] | ((unsigned)v[5] << 16); w.w = v[6] | ((unsigned)v[7] << 16);
    return w;
}
__device__ __forceinline__ void vt_store(u32x4 w, int hd, bf16* dst, int dpitch, int item, int lane) {
    const int cgp = item & 1023; int r = item >> 10; const int nblk = hd >> 6, dblk = r % nblk, bh = r / nblk;
    const int d = dblk * 64 + lane;
    *(u32x4*)(dst + ((size_t)bh * hd + d) * dpitch + cgp * 8) = w;
}
__device__ __forceinline__ void vt_store_blk(u32x4 w, bf16* dst, int item, int lane) {
    const int cgp = item & 1023, bh = item >> 10, dt = lane >> 4, dl = lane & 15, col0 = cgp * 8;
    *(u32x4*)(dst + ((size_t)((bh * 4 + dt) * 256 + (col0 >> 5))) * 512 + dl * 32 + (col0 & 31)) = w;
}
__device__ __forceinline__ void vt_run(const Ctx& c, const bf16* src, int pitch, int coloff, int hd, int nh, bf16* dst, int dpitch, int sh, int nitems) {
    for (int it0 = c.gw; it0 < nitems; it0 += 8 * c.ngw) {
        u32x4 w[8];
#pragma unroll
        for (int u = 0; u < 8; ++u) { const int it = it0 + u * c.ngw; if (it < nitems) w[u] = vt_load(src, pitch, coloff, hd, nh, sh, it, c.lane); }
#pragma unroll
        for (int u = 0; u < 8; ++u) { const int it = it0 + u * c.ngw; if (it < nitems) { if (dpitch == 0) vt_store_blk(w[u], dst, it, c.lane); else vt_store(w[u], hd, dst, dpitch, it, c.lane); } }
    }
}

__device__ __forceinline__ void vt32_load(const bf16* src, int sh, int item, int lane, u32x4* w) {
    const int kb = item & 255, bh = item >> 8, b = bh >> 3, h = bh & 7, Ld = SEQ >> sh;
    const bf16* s = src + (size_t)b * SEQ * P0LD + 2048 + h * 64 + lane;
    const int col0 = kb * 32, rres = col0 / Ld, l0 = col0 - rres * Ld;
    unsigned short v[32];
#pragma unroll
    for (int i = 0; i < 32; ++i) v[i] = s[(size_t)(((l0 + i) << sh) + rres) * P0LD];
#pragma unroll
    for (int q = 0; q < 4; ++q) { w[q].x = v[8 * q] | ((unsigned)v[8 * q + 1] << 16); w[q].y = v[8 * q + 2] | ((unsigned)v[8 * q + 3] << 16); w[q].z = v[8 * q + 4] | ((unsigned)v[8 * q + 5] << 16); w[q].w = v[8 * q + 6] | ((unsigned)v[8 * q + 7] << 16); }
}
__device__ __forceinline__ void vt32_store(const u32x4* w, bf16* dst, int p, int item, int lane) {
    const int kb = item & 255, bh = item >> 8;
    bf16* o = (p == 0) ? dst + ((size_t)bh * 64 + lane) * VTP + kb * 32 : dst + ((size_t)((bh * 4 + (lane >> 4)) * 256 + kb)) * 512 + (lane & 15) * 32;
#pragma unroll
    for (int q = 0; q < 4; ++q) *(u32x4*)(o + 8 * q) = w[q];
}
__device__ __forceinline__ void phase_prep0(const Ctx& c, const float* const* in, unsigned char* ws, float* dout) {
    bf16* P0 = (bf16*)(ws + WS_BIG); bf16* XC = (bf16*)(ws + WS_XC);
    const float* cw = in[3]; const float* cbias = in[4];
    for (int i0 = c.gtid; i0 < TT * 64; i0 += 2 * c.ngt) {
        u32x4 raw[2][4];
#pragma unroll
        for (int u = 0; u < 2; ++u) { const int i = i0 + u * c.ngt, t = i >> 6, c0 = (i & 63) * 8, tl = t & (SEQ - 1);
#pragma unroll
            for (int j = 0; j < 4; ++j) raw[u][j] = (tl - 3 + j >= 0) ? *(const u32x4*)(P0 + (size_t)(t - 3 + j) * P0LD + c0) : (u32x4){0u, 0u, 0u, 0u}; }
#pragma unroll
        for (int u = 0; u < 2; ++u) { const int i = i0 + u * c.ngt, t = i >> 6, c0 = (i & 63) * 8;
            float acc[8];
#pragma unroll
            for (int e = 0; e < 8; ++e) acc[e] = cbias[c0 + e];
#pragma unroll
            for (int j = 0; j < 4; ++j) { float v[8]; unpack8(raw[u][j], v);
#pragma unroll
                for (int e = 0; e < 8; ++e) acc[e] += cw[j * 512 + c0 + e] * v[e]; }
            *(u32x4*)(XC + (size_t)t * 512 + c0) = pack8(acc); }
    }
    for (int it0 = c.gw * 4; it0 < 2 * TT; it0 += c.ngw * 4) {
        const int sub = c.lane & 7;
        u32x4 raw[4];
#pragma unroll
        for (int u = 0; u < 4; ++u) { const int it = it0 + u, t = it >> 1, which = it & 1; raw[u] = *(const u32x4*)(P0 + (size_t)t * P0LD + 1024 + which * 512 + c.lane * 8); }
#pragma unroll
        for (int u = 0; u < 4; ++u) {
            const int it = it0 + u, t = it >> 1, which = it & 1;
            bf16* p = P0 + (size_t)t * P0LD + 1024 + which * 512 + c.lane * 8;
            float v[8]; unpack8(raw[u], v);
            float s = 0.f;
#pragma unroll
            for (int e = 0; e < 8; ++e) s += v[e] * v[e];
            s += __shfl_xor(s, 1); s += __shfl_xor(s, 2); s += __shfl_xor(s, 4);
            const float rs = rsqrtf(s * (1.0f / 64.0f) + 1e-6f);
            const float* gn = (which ? in[11] : in[10]) + sub * 8;
#pragma unroll
            for (int e = 0; e < 8; ++e) v[e] = v[e] * rs * gn[e];
            float oth[8];
#pragma unroll
            for (int e = 0; e < 8; ++e) oth[e] = __shfl_xor(v[e], 1);
            if (sub < 2) {
                const float* rt = (const float*)(ws + WS_ROPE) + (t & (SEQ - 1)) * 16;
                const f32x4 c0 = *(const f32x4*)rt, c1 = *(const f32x4*)(rt + 4), s0 = *(const f32x4*)(rt + 8), s1 = *(const f32x4*)(rt + 12);
#pragma unroll
                for (int e = 0; e < 8; ++e) {
                    const float cs = (e < 4) ? c0[e & 3] : c1[e & 3], sn = (e < 4) ? s0[e & 3] : s1[e & 3];
                    v[e] = (sub == 0) ? (v[e] * cs - oth[e] * sn) : (v[e] * cs + oth[e] * sn);
                }
            }
            *(u32x4*)p = pack8(v);
        }
    }
    bf16* VT3 = (bf16*)dout;
    for (int it0 = c.gw; it0 < 3 * 4096; it0 += 2 * c.ngw) {
        u32x4 w[2][4];
#pragma unroll
        for (int u = 0; u < 2; ++u) { const int it = it0 + u * c.ngw; if (it < 3 * 4096) vt32_load(P0, 2 * (it >> 12), it & 4095, c.lane, w[u]); }
#pragma unroll
        for (int u = 0; u < 2; ++u) { const int it = it0 + u * c.ngw; if (it < 3 * 4096) vt32_store(w[u], VT3 + (size_t)(it >> 12) * (16 * 64 * VTP), it >> 12, it & 4095, c.lane); }
    }
}

#define ATT_D 2
constexpr int ATT_KP = 144, ATT_VP = 784, ATT_KBYTES = 384 * ATT_KP, ATT_LDS = ATT_KBYTES + 64 * ATT_VP;
struct AttState { float m, l; f32x4 o[4]; };
__device__ __forceinline__ void attn_math(const bf16x8 kx0, const bf16x8 kx1, const bf16x8 ky0, const bf16x8 ky1, const bf16x8 (&vf)[4], const bf16x8 qf0, const bf16x8 qf1,
                                          int lq, int kb, AttState& st) {
    const float cs = 0.125f * 1.4426950408889634f;
    f32x4 sx = mfma16(kx0, qf0, (f32x4){0.f, 0.f, 0.f, 0.f}); sx = mfma16(kx1, qf1, sx);
    f32x4 sy = mfma16(ky0, qf0, (f32x4){0.f, 0.f, 0.f, 0.f}); sy = mfma16(ky1, qf1, sy);
    float mx = -1e30f;
#pragma unroll
    for (int r = 0; r < 4; ++r) {
        sx[r] = ((unsigned)(lq - (kb + r)) <= 128u) ? sx[r] : -1e30f; sy[r] = ((unsigned)(lq - (kb + 4 + r)) <= 128u) ? sy[r] : -1e30f;
        mx = fmaxf(mx, fmaxf(sx[r], sy[r]));
    }
    { auto rr = __builtin_amdgcn_permlane32_swap(__float_as_uint(mx), __float_as_uint(mx), false, false); mx = fmaxf(__uint_as_float(rr[0]), __uint_as_float(rr[1]));
      rr = __builtin_amdgcn_permlane16_swap(__float_as_uint(mx), __float_as_uint(mx), false, false); mx = fmaxf(__uint_as_float(rr[0]), __uint_as_float(rr[1]));
      rr = __builtin_amdgcn_permlane32_swap(__float_as_uint(mx), __float_as_uint(mx), false, false); mx = fmaxf(__uint_as_float(rr[0]), __uint_as_float(rr[1])); }
    const float mn = fmaxf(st.m, mx), alpha = __builtin_amdgcn_exp2f((st.m - mn) * cs); st.m = mn;
    const float mref = fmaxf(mn, -1e29f) * cs;
    float pe[8]; float ps = 0.f;
#pragma unroll
    for (int r = 0; r < 4; ++r) { pe[r] = __builtin_amdgcn_exp2f(sx[r] * cs - mref); pe[4 + r] = __builtin_amdgcn_exp2f(sy[r] * cs - mref); ps += pe[r] + pe[4 + r]; }
    st.l = st.l * alpha + ps;
    const u32x4 pw = pack8v(pe);
    const bf16x8 pf = __builtin_bit_cast(bf16x8, pw);
#pragma unroll
    for (int dt = 0; dt < 4; ++dt) { st.o[dt] = st.o[dt] * alpha; st.o[dt] = mfma16(vf[dt], pf, st.o[dt]); }
}
__device__ __forceinline__ void attn_stage_p1(const Ctx& c, const bf16* P0, const bf16* VT3, int b, int h, int lb) {
    const int tok0 = 256 * lb - 128;
    u32x4 kr[6], vr[6];
#pragma unroll
    for (int i = 0; i < 6; ++i) { const int p = c.tid + 512 * i, row = p >> 3, c16 = p & 7; int tk = tok0 + row; if (tk < 0) tk = 0;
        kr[i] = *(const u32x4*)(P0 + (size_t)(b * SEQ + tk) * P0LD + 1536 + h * 64 + c16 * 8); }
#pragma unroll
    for (int i = 0; i < 6; ++i) { const int p = c.tid + 512 * i, d = p / 48, c16 = p - d * 48; int tk = tok0 + c16 * 8; if (tk < 0) tk = 0;
        vr[i] = *(const u32x4*)(VT3 + ((size_t)((b * 8 + h) * 64 + d)) * VTP + tk); }
#pragma unroll
    for (int i = 0; i < 6; ++i) { const int p = c.tid + 512 * i, row = p >> 3, c16 = p & 7; *(LAS u32x4*)(c.lds + row * ATT_KP + c16 * 16) = kr[i]; }
#pragma unroll
    for (int i = 0; i < 6; ++i) { const int p = c.tid + 512 * i, d = p / 48, c16 = p - d * 48; *(LAS u32x4*)(c.lds + ATT_KBYTES + d * ATT_VP + c16 * 16) = vr[i]; }
}
template <bool P1_LDS>
__device__ __forceinline__ void attn_item(const Ctx& c, const bf16* P0, const bf16* VT3, bf16* ycat, int item, int lane) {
    const int lb = item & 31, r16 = (item >> 5) & 15, h = (item >> 9) & 7, b = item >> 12;
    const int qi = lane & 15, g = lane >> 4;
    const int tq = r16 + 16 * (16 * lb + qi);
    const bf16* qrow = P0 + (size_t)(b * SEQ + tq) * P0LD + 1024 + h * 64;
    const bf16x8 qf0 = ld8(qrow + 8 * g), qf1 = ld8(qrow + 32 + 8 * g);
    AttState st; st.m = -1e30f; st.l = 0.f;
#pragma unroll
    for (int dt = 0; dt < 4; ++dt) st.o[dt] = (f32x4){0.f, 0.f, 0.f, 0.f};
    const int rho_off = 8 * (qi >> 2) + (qi & 3);
    int sb0_[3], n_[3]; const bf16* kb_[3]; const bf16* vb_[3];
#pragma unroll
    for (int p = 0; p < 3; ++p) {
        const int sh = 2 * p, rres = r16 & ((1 << sh) - 1), Ld = SEQ >> sh;
        const int lq0 = (r16 + 256 * lb) >> sh, lq15 = (r16 + 256 * lb + 240) >> sh;
        int s0 = lq0 - 128; if (s0 < 0) s0 = 0; s0 &= ~31;
        sb0_[p] = s0; n_[p] = (((lq15 & ~31) - s0) >> 5) + 1;
        kb_[p] = P0 + (size_t)(b * SEQ + rres) * P0LD + 1536 + h * 64 + 8 * g;
        vb_[p] = (p == 0) ? VT3 + ((size_t)((b * 8 + h) * 64 + qi)) * VTP + 8 * g
                          : VT3 + (size_t)p * (16 * 64 * VTP) + ((size_t)((b * 8 + h) * 4) * 256 + ((rres * Ld) >> 5)) * 512 + qi * 32 + 8 * g;
    }
    if (P1_LDS) n_[0] = 0;
    const int n01 = n_[0] + n_[1], total = n01 + n_[2];
    bf16x8 rk[ATT_D][4], rv[ATT_D][4];
#define ATT_ISSUE(s_, buf) do { const int s__ = (s_); if (s__ < total) { \
        const int p_ = (s__ >= n_[0]) + (s__ >= n01); const int loc_ = s__ - (p_ == 0 ? 0 : (p_ == 1 ? n_[0] : n01)); \
        const int sb_ = (p_ == 0 ? sb0_[0] : (p_ == 1 ? sb0_[1] : sb0_[2])) + 32 * loc_; const int sh_ = 2 * p_; \
        const bf16* kbp = (p_ == 0 ? kb_[0] : (p_ == 1 ? kb_[1] : kb_[2])); const bf16* vbp = (p_ == 0 ? vb_[0] : (p_ == 1 ? vb_[1] : vb_[2])); \
        const bf16* kx = kbp + ((size_t)(sb_ + rho_off) << sh_) * P0LD; const bf16* ky = kx + ((size_t)4 << sh_) * P0LD; \
        rk[buf][0] = ld8(kx); rk[buf][1] = ld8(kx + 32); rk[buf][2] = ld8(ky); rk[buf][3] = ld8(ky + 32); \
        const size_t dstr_ = (p_ == 0) ? (size_t)16 * VTP : (size_t)256 * 512; const size_t soff_ = (p_ == 0) ? (size_t)sb_ : (size_t)(sb_ >> 5) * 512; \
        _Pragma("unroll") for (int dt = 0; dt < 4; ++dt) rv[buf][dt] = ld8(vbp + dt * dstr_ + soff_); } } while (0)
#pragma unroll
    for (int d = 0; d < ATT_D; ++d) ATT_ISSUE(d, d);
    if (P1_LDS) {
        const int w = c.wave, half = r16 >> 3, tok0 = 256 * lb - 128;
        const int tq1 = 256 * lb + 32 * w + 16 * (qi >> 3) + 8 * half + (qi & 7);
        const bf16* q1row = P0 + (size_t)(b * SEQ + tq1) * P0LD + 1024 + h * 64;
        const bf16x8 q1f0 = ld8(q1row + 8 * g), q1f1 = ld8(q1row + 32 + 8 * g);
        AttState s1; s1.m = -1e30f; s1.l = 0.f;
#pragma unroll
        for (int dt = 0; dt < 4; ++dt) s1.o[dt] = (f32x4){0.f, 0.f, 0.f, 0.f};
        const LAS unsigned char* kl = c.lds + rho_off * ATT_KP + 16 * g;
        const LAS unsigned char* vl = c.lds + ATT_KBYTES + qi * ATT_VP + 16 * g;
        LAS unsigned* ex = (LAS unsigned*)(c.lds + ATT_LDS);
        __syncthreads();
        for (int i = ((lb == 0 && w < 4) ? 4 : w); i <= w + 4; ++i) {
            const LAS unsigned char* kx = kl + 32 * i * ATT_KP;
            const bf16x8 kx0 = *(const LAS bf16x8*)kx, kx1 = *(const LAS bf16x8*)(kx + 64), ky0 = *(const LAS bf16x8*)(kx + 4 * ATT_KP), ky1 = *(const LAS bf16x8*)(kx + 4 * ATT_KP + 64);
            bf16x8 vf[4];
#pragma unroll
            for (int dt = 0; dt < 4; ++dt) vf[dt] = *(const LAS bf16x8*)(vl + dt * 16 * ATT_VP + 64 * i);
            attn_math(kx0, kx1, ky0, ky1, vf, q1f0, q1f1, tq1, tok0 + 32 * i + 8 * g, s1);
        }
        {
            LAS unsigned* e = ex + ((16 * w + qi) * 4 + g) * 10;
            e[0] = __float_as_uint(s1.m); e[1] = __float_as_uint(s1.l);
#pragma unroll
            for (int dt = 0; dt < 4; ++dt) { e[2 + 2 * dt] = pg8::cvtpk(s1.o[dt][0], s1.o[dt][1]); e[3 + 2 * dt] = pg8::cvtpk(s1.o[dt][2], s1.o[dt][3]); }
        }
        __syncthreads();
        {
            const LAS unsigned* e = ex + ((qi * 8 + (r16 & 7)) * 4 + g) * 10;
            st.m = __uint_as_float(e[0]); st.l = __uint_as_float(e[1]);
#pragma unroll
            for (int dt = 0; dt < 4; ++dt) { const unsigned a0 = e[2 + 2 * dt], a1 = e[3 + 2 * dt]; st.o[dt] = (f32x4){bfw(a0, 0), bfw(a0, 1), bfw(a1, 0), bfw(a1, 1)}; }
        }
    }
    for (int s0 = 0; s0 < total; s0 += ATT_D) {
#pragma unroll
        for (int j = 0; j < ATT_D; ++j) {
            const int s = s0 + j;
            if (s < total) {
                const int p = (s >= n_[0]) + (s >= n01), loc = s - (p == 0 ? 0 : (p == 1 ? n_[0] : n01));
                const int sb = (p == 0 ? sb0_[0] : (p == 1 ? sb0_[1] : sb0_[2])) + 32 * loc;
                attn_math(rk[j][0], rk[j][1], rk[j][2], rk[j][3], rv[j], qf0, qf1, tq >> (2 * p), sb + 8 * g, st);
                ATT_ISSUE(s + ATT_D, j);
            }
        }
    }
#undef ATT_ISSUE
    float l = st.l;
    l += __shfl_xor(l, 16); l += __shfl_xor(l, 32);
    const float inv = 1.0f / l;
    bf16* orow = ycat + (size_t)(b * SEQ + tq) * 1024 + 512 + h * 64 + 4 * g;
#pragma unroll
    for (int dt = 0; dt < 4; ++dt) { u32x2 w; w.x = cvt_pk_bf16(st.o[dt][0] * inv, st.o[dt][1] * inv); w.y = cvt_pk_bf16(st.o[dt][2] * inv, st.o[dt][3] * inv); *(u32x2*)(orow + 16 * dt) = w; }
}

__device__ __forceinline__ void lru_step(float la, float gi, float& h) { const float a = __expf(la), bq = __builtin_amdgcn_sqrtf(fmaxf(1.0f - a * a, 0.f)) * gi; h = a * h + bq; }
__device__ __forceinline__ void phase_lru_a(const Ctx& c, unsigned char* ws) {
    const bf16* __restrict__ LA = (const bf16*)(ws + WS_LOGA); const bf16* __restrict__ GI = (const bf16*)(ws + WS_GI);
    float* __restrict__ SA = (float*)(ws + WS_SUMA); float* __restrict__ SB = (float*)(ws + WS_SUMB);
    for (int ch = blockIdx.x; ch < 256; ch += gridDim.x) {
        const int t0 = ch * 64, cn = c.tid; float h = 0.f, P = 0.f;
#pragma unroll 1
        for (int tb = 0; tb < 64; tb += 32) {
            float la[32], gi[32];
#pragma unroll
            for (int t = 0; t < 32; ++t) { la[t] = bf2f(LA[(size_t)(t0 + tb + t) * 512 + cn]); gi[t] = bf2f(GI[(size_t)(t0 + tb + t) * 512 + cn]); }
#pragma unroll
            for (int t = 0; t < 32; ++t) { lru_step(la[t], gi[t], h); P += la[t]; }
        }
        SA[ch * 512 + cn] = __expf(P); SB[ch * 512 + cn] = h;
    }
}
__device__ __forceinline__ void phase_lru_b(const Ctx& c, unsigned char* ws) {
    const bf16* __restrict__ LA = (const bf16*)(ws + WS_LOGA); const bf16* __restrict__ GI = (const bf16*)(ws + WS_GI);
    const float* __restrict__ SA = (const float*)(ws + WS_SUMA); const float* __restrict__ SB = (const float*)(ws + WS_SUMB);
    const bf16* __restrict__ P0 = (const bf16*)(ws + WS_BIG); bf16* __restrict__ ycat = (bf16*)(ws + WS_YCAT);
    for (int ch = blockIdx.x; ch < 256; ch += gridDim.x) {
        const int t0 = ch * 64, cn = c.tid; float h = 0.f;
        bf16 la0[16], gi0[16], gl0[16];
#pragma unroll
        for (int t = 0; t < 16; ++t) { la0[t] = LA[(size_t)(t0 + t) * 512 + cn]; gi0[t] = GI[(size_t)(t0 + t) * 512 + cn]; gl0[t] = P0[(size_t)(t0 + t) * P0LD + 512 + cn]; }
        int j = ch & ~127;
        for (; j + 32 <= ch; j += 32) {
            float sa[32], sb[32];
#pragma unroll
            for (int k = 0; k < 32; ++k) { sa[k] = SA[(j + k) * 512 + cn]; sb[k] = SB[(j + k) * 512 + cn]; }
#pragma unroll
            for (int k = 0; k < 32; ++k) h = sa[k] * h + sb[k];
        }
        for (; j + 8 <= ch; j += 8) {
            float sa[8], sb[8];
#pragma unroll
            for (int k = 0; k < 8; ++k) { sa[k] = SA[(j + k) * 512 + cn]; sb[k] = SB[(j + k) * 512 + cn]; }
#pragma unroll
            for (int k = 0; k < 8; ++k) h = sa[k] * h + sb[k];
        }
        for (; j < ch; ++j) h = SA[j * 512 + cn] * h + SB[j * 512 + cn];
#pragma unroll
        for (int t = 0; t < 16; ++t) { lru_step(bf2f(la0[t]), bf2f(gi0[t]), h); ycat[(size_t)(t0 + t) * 1024 + cn] = f2bf(h * gelu_tanh(bf2f(gl0[t]))); }
#pragma unroll 1
        for (int tb = 16; tb < 64; tb += 16) {
            float la[16], gi[16], gl[16];
#pragma unroll
            for (int t = 0; t < 16; ++t) { la[t] = bf2f(LA[(size_t)(t0 + tb + t) * 512 + cn]); gi[t] = bf2f(GI[(size_t)(t0 + tb + t) * 512 + cn]); gl[t] = bf2f(P0[(size_t)(t0 + tb + t) * P0LD + 512 + cn]); }
#pragma unroll
            for (int t = 0; t < 16; ++t) { lru_step(la[t], gi[t], h); ycat[(size_t)(t0 + tb + t) * 1024 + cn] = f2bf(h * gelu_tanh(gl[t])); }
        }
    }
}

__device__ __forceinline__ void fixup_panel(const Ctx& c, unsigned char* ws, const float* cw, const float* cb, int pm) {
    if ((pm & 31) != 0) {
        const float* EA = (const float*)(ws + WS_EDGEA); const float* EL = (const float*)(ws + WS_EDGEL); const float* TA = (const float*)(ws + WS_TAILA);
        bf16* U = (bf16*)(ws + WS_BIG);
        for (int col = c.tid; col < 3072; col += 512) {
            const float tm2 = TA[(size_t)((pm - 1) * 2 + 0) * 3072 + col], tm1 = TA[(size_t)((pm - 1) * 2 + 1) * 3072 + col];
            const float a0 = EA[(size_t)(pm * 2) * 3072 + col], a1 = EA[(size_t)(pm * 2 + 1) * 3072 + col];
            const float l0 = EL[(size_t)(pm * 2) * 3072 + col], l1 = EL[(size_t)(pm * 2 + 1) * 3072 + col];
            const float w0 = cw[col], w1 = cw[3072 + col], w2 = cw[6144 + col], bb = cb[col];
            U[(size_t)(pm * 256) * 3072 + col] = f2bf(gelu_tanh(w0 * tm2 + w1 * tm1 + w2 * a0 + bb) * l0);
            U[(size_t)(pm * 256 + 1) * 3072 + col] = f2bf(gelu_tanh(w0 * tm1 + w1 * a0 + w2 * a1 + bb) * l1);
        }
    }
    asm volatile("s_waitcnt vmcnt(0)" ::: "memory");
    __syncthreads();
}
__device__ __forceinline__ void phase_fixup(const Ctx& c, unsigned char* ws, const float* cw, const float* cb) {
    const float* EA = (const float*)(ws + WS_EDGEA); const float* EL = (const float*)(ws + WS_EDGEL); const float* TA = (const float*)(ws + WS_TAILA);
    bf16* U = (bf16*)(ws + WS_BIG);
    for (int i = c.gtid; i < 64 * 3072; i += c.ngt) {
        const int pm = i / 3072, col = i % 3072;
        if ((pm & 31) == 0) continue;
        const float tm2 = TA[(size_t)((pm - 1) * 2 + 0) * 3072 + col], tm1 = TA[(size_t)((pm - 1) * 2 + 1) * 3072 + col];
        const float a0 = EA[(size_t)(pm * 2) * 3072 + col], a1 = EA[(size_t)(pm * 2 + 1) * 3072 + col];
        const float l0 = EL[(size_t)(pm * 2) * 3072 + col], l1 = EL[(size_t)(pm * 2 + 1) * 3072 + col];
        const float w0 = cw[col], w1 = cw[3072 + col], w2 = cw[6144 + col], bb = cb[col];
        U[(size_t)(pm * 256) * 3072 + col] = f2bf(gelu_tanh(w0 * tm2 + w1 * tm1 + w2 * a0 + bb) * l0);
        U[(size_t)(pm * 256 + 1) * 3072 + col] = f2bf(gelu_tanh(w0 * tm1 + w1 * a0 + w2 * a1 + bb) * l1);
    }
}
#define XB_TMO      128
#define XB_XCNT(j)  (256  + 64 * (j))
#define XB_XSUB(j)  (1280 + 64 * (j))
#define XB_XGEN(j)  (2304 + 64 * (j))
#define XB_TOP      3328
#define XB_TOPGEN   3392
#define XCD_BAR_WORDS 3456
#define XB_SPIN_CAP (1u << 18)

__device__ __forceinline__ unsigned xb_ld(unsigned* p)              { return __hip_atomic_load(p, __ATOMIC_RELAXED, __HIP_MEMORY_SCOPE_AGENT); }
__device__ __forceinline__ unsigned xb_add(unsigned* p, unsigned v) { return __hip_atomic_fetch_add(p, v, __ATOMIC_RELAXED, __HIP_MEMORY_SCOPE_AGENT); }
__device__ __forceinline__ unsigned xb_xcc_id() { return (unsigned)__builtin_amdgcn_s_getreg((3 << 11) | 20) & 0xFu; }
#define XB_SPIN(cond, bar) do { unsigned _sp = 0; while (cond) { __builtin_amdgcn_s_sleep(1); \
    if ((++_sp & 255u) == 0u) { if (xb_ld(&(bar)[XB_TMO])) break; if (_sp > XB_SPIN_CAP) { atomicAdd(&(bar)[XB_TMO], 1u); break; } } } } while (0)

struct XcdBarrier {
    unsigned* bar; unsigned x;
    volatile LAS unsigned* st;
};

__device__ __forceinline__ XcdBarrier xcd_barrier_post(unsigned* bar, volatile LAS unsigned* st) {
    XcdBarrier b; b.bar = bar; b.x = xb_xcc_id(); b.st = st;
    if (threadIdx.x == 0) (void)xb_add(&bar[XB_XCNT(b.x)], 1u);
    return b;
}
__device__ __forceinline__ void xcd_barrier_complete(unsigned* bar, unsigned x, unsigned& nloc, unsigned& nx) {
    const unsigned G = gridDim.x * gridDim.y * gridDim.z;
    unsigned sum, cnt, mine, sp = 0u;
    for (;;) {
        sum = 0u; cnt = 0u; mine = 0u;
#pragma unroll
        for (unsigned j = 0; j < 16; ++j) { const unsigned c = xb_ld(&bar[XB_XCNT(j)]); sum += c; cnt += (c > 0u) ? 1u : 0u; mine = (j == x) ? c : mine; }
        if (sum == G) break;
        __builtin_amdgcn_s_sleep(1);
        if ((++sp & 255u) == 0u) { if (xb_ld(&bar[XB_TMO])) break; if (sp > XB_SPIN_CAP) { atomicAdd(&bar[XB_TMO], 1u); break; } }
    }
    nloc = mine > 0u ? mine : 1u; nx = cnt > 0u ? cnt : 1u;
}

__device__ __forceinline__ void xcd_barrier(const XcdBarrier& b) {
    asm volatile("s_waitcnt vmcnt(0)" ::: "memory");
    __syncthreads();
    if (threadIdx.x == 0) {
        unsigned* bar = b.bar;
        __builtin_amdgcn_s_waitcnt(0);
        unsigned nloc = b.st[0], nx = b.st[1];
        if (nloc == 0u) { xcd_barrier_complete(bar, b.x, nloc, nx); b.st[0] = nloc; b.st[1] = nx; }
        const unsigned old = xb_add(&bar[XB_XSUB(b.x)], 1u);
        const unsigned gen = old / nloc;
        if (old + 1u == (gen + 1u) * nloc) {
            __builtin_amdgcn_fence(__ATOMIC_RELEASE, "agent");
            asm volatile("s_waitcnt vmcnt(0)" ::: "memory");
            const unsigned og = xb_add(&bar[XB_TOP], 1u);
            const unsigned tg = og / nx;
            if (og + 1u == (tg + 1u) * nx) xb_add(&bar[XB_TOPGEN], 1u);
            else XB_SPIN(xb_ld(&bar[XB_TOPGEN]) == tg, bar);
            __builtin_amdgcn_fence(__ATOMIC_ACQUIRE, "agent");
            xb_add(&bar[XB_XGEN(b.x)], 1u);
            asm volatile("s_waitcnt vmcnt(0)" ::: "memory");
        } else {
            XB_SPIN(xb_ld(&bar[XB_XGEN(b.x)]) == gen, bar);
            __builtin_amdgcn_fence(__ATOMIC_ACQUIRE, "agent");
            asm volatile("s_waitcnt vmcnt(0)" ::: "memory");
        }
    }
    __syncthreads();
}
__device__ __forceinline__ void gk_item(const bf16* XB, const bf16* Wt, const float* ss, bf16* P1, int item, int lane) {
    const int jl = lane & 15, gq = lane >> 4, tok = item * 16 + jl;
    const bf16* ap = Wt + (size_t)(2048 + jl) * 1024 + 8 * gq; const bf16* bp = XB + (size_t)tok * 1024 + 8 * gq;
    f32x4 acc0 = (f32x4){0.f, 0.f, 0.f, 0.f}, acc1 = acc0;
#pragma unroll 8
    for (int ks = 0; ks < 32; ks += 2) { acc0 = mfma16(ld8(ap + 32 * ks), ld8(bp + 32 * ks), acc0); acc1 = mfma16(ld8(ap + 32 * ks + 32), ld8(bp + 32 * ks + 32), acc1); }
    const float rs = rsqrtf(ss[tok] * (1.0f / 1024.0f) + 1e-6f);
    u32x2 w; w.x = cvt_pk_bf16((acc0[0] + acc1[0]) * rs, (acc0[1] + acc1[1]) * rs); w.y = cvt_pk_bf16((acc0[2] + acc1[2]) * rs, (acc0[3] + acc1[3]) * rs);
    *(u32x2*)(P1 + (size_t)tok * P1LD + 2048 + 4 * gq) = w;
}

__device__ __forceinline__ void phase_gla_prep(const Ctx& c, const float* const* in, unsigned char* ws) {
    bf16* P1 = (bf16*)(ws + WS_BIG); bf16* KDT = (bf16*)(ws + WS_KDT); float* DEC = (float*)(ws + WS_DECAY);
    const float* gkw = in[25]; const float* gkb = in[26];
    for (int i = blockIdx.x * 256 + c.tid; c.tid < 256 && i < 256 * 256; i += gridDim.x * 256) {
        const int chunk = i >> 8, chn = i & 255, t0 = chunk * 64, b = chunk >> 7, h = chn >> 6, d = chn & 63;
        float w[16];
#pragma unroll
        for (int k = 0; k < 16; ++k) w[k] = gkw[k * 256 + chn];
        const float bias = gkb[chn];
        float kin[64]; float bc = 0.f;
#pragma unroll
        for (int tb = 0; tb < 64; tb += 8) {
            u32x4 l0[8], l1[8]; bf16 qv[8], kv[8];
#pragma unroll
            for (int t = 0; t < 8; ++t) { const bf16* row = P1 + (size_t)(t0 + tb + t) * P1LD; l0[t] = *(const u32x4*)(row + 2048); l1[t] = *(const u32x4*)(row + 2056); qv[t] = row[512 + chn]; kv[t] = row[768 + chn]; }
#pragma unroll
            for (int t = 0; t < 8; ++t) {
                bf16* row = P1 + (size_t)(t0 + tb + t) * P1LD;
                float lr[16]; unpack8(l0[t], lr); unpack8(l1[t], lr + 8);
                float z = bias;
#pragma unroll
                for (int k = 0; k < 16; ++k) z += lr[k] * w[k];
                bc += logsig(z) * (1.0f / 16.0f);
                row[512 + chn] = f2bf(bf2f(qv[t]) * 0.125f * __expf(bc));
                kin[tb + t] = bf2f(kv[t]) * __expf(-bc);
                row[768 + chn] = f2bf(kin[tb + t]);
            }
        }
        const float eb = __expf(bc);
        DEC[chunk * 256 + chn] = eb;
        bf16* kd = KDT + ((size_t)((b * 4 + h) * 64 + d)) * SEQ + (t0 & (SEQ - 1));
#pragma unroll
        for (int t8 = 0; t8 < 8; ++t8) {
            float f[8];
#pragma unroll
            for (int e = 0; e < 8; ++e) f[e] = kin[t8 * 8 + e] * eb;
            *(u32x4*)(kd + t8 * 8) = pack8(f);
        }
    }
}

__device__ __forceinline__ void s5_bfrags(const bf16* P1, int g, int jb, int lane, bf16x8* bu) {
    const int jl = lane & 15, gq = lane >> 4;
#pragma unroll
    for (int ks = 0; ks < 8; ++ks) {
        const int s = 2 * ks + (gq >> 1), p0 = 8 * (gq & 1);
        bu[ks] = ld8(P1 + (size_t)((16 * jb + jl) * 16 + s) * P1LD + 16 * g + p0);
    }
}
__device__ __forceinline__ void s5a_item(const bf16* P1, const bf16* FM, float* XL, int item, int lane) {
    const int g = item >> 6, jb = item & 63, jl = lane & 15, gq = lane >> 4;
    bf16x8 bu[8]; s5_bfrags(P1, g, jb, lane, bu);
    const bf16* Fg = FM + (size_t)g * 128 * 256;
#pragma unroll
    for (int zt = 0; zt < 8; ++zt) {
        f32x4 acc = (f32x4){0.f, 0.f, 0.f, 0.f};
#pragma unroll
        for (int ks = 0; ks < 8; ++ks) acc = mfma16(ld8(Fg + (size_t)(16 * zt + jl) * 256 + 32 * ks + 8 * gq), bu[ks], acc);
        *(f32x4*)(XL + ((size_t)g * 1024 + 16 * jb + jl) * 128 + 16 * zt + 4 * gq) = acc;
    }
}
__device__ __forceinline__ void phase_s5_scan(const Ctx& c, const float* const* in, unsigned char* ws) {
    const float* __restrict__ XL = (const float*)(ws + WS_XLOC); bf16* __restrict__ SX = (bf16*)(ws + WS_SX);
    LAS float* ex = (LAS float*)c.lds;
    for (int bg = blockIdx.x; bg < 64; bg += gridDim.x) {
        const int b = bg >> 5, g = bg & 31, seg = c.wave, n = c.lane;
        const S5P sp = s5_params(in[15], in[16], in[22], g, n);
        float ar, ai; s5_pow(sp, 16.0f, ar, ai);
        float Ar, Ai; s5_pow(sp, 1024.0f, Ar, Ai);
        const size_t o0 = ((size_t)g * 1024 + b * 512 + seg * 64) * 128 + n;
        float xr = 0.f, xi = 0.f;
#pragma unroll 1
        for (int h2 = 0; h2 < 2; ++h2) {
            float cr[32], ci[32];
#pragma unroll
            for (int k = 0; k < 32; ++k) { cr[k] = XL[o0 + (size_t)(h2 * 32 + k) * 128]; ci[k] = XL[o0 + (size_t)(h2 * 32 + k) * 128 + 64]; }
#pragma unroll
            for (int k = 0; k < 32; ++k) { const float tr = ar * xr - ai * xi + cr[k], ti = ar * xi + ai * xr + ci[k]; xr = tr; xi = ti; }
        }
        ex[(seg * 64 + n) * 2] = xr; ex[(seg * 64 + n) * 2 + 1] = xi;
        __syncthreads();
        xr = 0.f; xi = 0.f;
        for (int j = 0; j < seg; ++j) { const float er = ex[(j * 64 + n) * 2], ei = ex[(j * 64 + n) * 2 + 1]; const float tr = Ar * xr - Ai * xi + er, ti = Ar * xi + Ai * xr + ei; xr = tr; xi = ti; }
#pragma unroll 1
        for (int h2 = 0; h2 < 2; ++h2) {
            float cr[32], ci[32];
#pragma unroll
            for (int k = 0; k < 32; ++k) { cr[k] = XL[o0 + (size_t)(h2 * 32 + k) * 128]; ci[k] = XL[o0 + (size_t)(h2 * 32 + k) * 128 + 64]; }
#pragma unroll
            for (int k = 0; k < 32; ++k) {
                SX[o0 + (size_t)(h2 * 32 + k) * 128] = f2bf(xr); SX[o0 + (size_t)(h2 * 32 + k) * 128 + 64] = f2bf(xi);
                const float tr = ar * xr - ai * xi + cr[k], ti = ar * xi + ai * xr + ci[k]; xr = tr; xi = ti;
            }
        }
        __syncthreads();
    }
}
__device__ __forceinline__ void s5c_item(const bf16* P1, const bf16* AM, const bf16* SX, const float* dvec, bf16* YS, int item, int lane) {
    const int g = item >> 6, jb = item & 63, jl = lane & 15, gq = lane >> 4;
    bf16x8 bu[12]; s5_bfrags(P1, g, jb, lane, bu);
#pragma unroll
    for (int ks = 0; ks < 4; ++ks) bu[8 + ks] = ld8(SX + ((size_t)g * 1024 + 16 * jb + jl) * 128 + 32 * ks + 8 * gq);
    const bf16* Ag = AM + (size_t)g * 256 * 384;
    float dv[4];
#pragma unroll
    for (int e = 0; e < 4; ++e) dv[e] = dvec[16 * g + 4 * gq + e];
#pragma unroll 4
    for (int rt = 0; rt < 16; ++rt) {
        f32x4 acc = (f32x4){0.f, 0.f, 0.f, 0.f};
#pragma unroll
        for (int ks = 0; ks < 12; ++ks) acc = mfma16(ld8(Ag + (size_t)(16 * rt + jl) * 384 + 32 * ks + 8 * gq), bu[ks], acc);
        const size_t tok = (size_t)(16 * jb + jl) * 16 + rt;
        const u32x2 uv = *(const u32x2*)(P1 + tok * P1LD + 16 * g + 4 * gq);
        float o[4];
#pragma unroll
        for (int e = 0; e < 4; ++e) { const float y = acc[e] + dv[e] * bfw(uv[e >> 1], e & 1); o[e] = gelu_tanh(y); }
        u32x2 w; w.x = cvt_pk_bf16(o[0], o[1]); w.y = cvt_pk_bf16(o[2], o[3]);
        *(u32x2*)(YS + tok * 512 + 16 * g + 4 * gq) = w;
    }
}

__device__ __forceinline__ void s5c_block(const Ctx& c, const bf16* P1, const bf16* AM, const bf16* SX, const float* dvec, bf16* YS, int g, int jb) {
    const int lane = c.lane, jl = lane & 15, gq = lane >> 4;
    bf16x8 bu[12]; s5_bfrags(P1, g, jb, lane, bu);
#pragma unroll
    for (int ks = 0; ks < 4; ++ks) bu[8 + ks] = ld8(SX + ((size_t)g * 1024 + 16 * jb + jl) * 128 + 32 * ks + 8 * gq);
    float dv[4];
#pragma unroll
    for (int e = 0; e < 4; ++e) dv[e] = dvec[16 * g + 4 * gq + e];
    const bf16* Ag = AM + (size_t)g * 256 * 384;
    for (int half = 0; half < 2; ++half) {
        __syncthreads();
        for (int p = c.tid; p < 128 * 48; p += 512) { const int row = p / 48, c16 = p - row * 48;
            *(LAS u32x4*)(c.lds + row * 784 + c16 * 16) = *(const u32x4*)(Ag + (size_t)(half * 128 + row) * 384 + c16 * 8); }
        __syncthreads();
#pragma unroll 2
        for (int r8 = 0; r8 < 8; ++r8) {
            const int rt = half * 8 + r8;
            f32x4 acc = (f32x4){0.f, 0.f, 0.f, 0.f};
#pragma unroll
            for (int ks = 0; ks < 12; ++ks) acc = mfma16(*(const LAS bf16x8*)(c.lds + (16 * r8 + jl) * 784 + 64 * ks + 16 * gq), bu[ks], acc);
            const size_t tok = (size_t)(16 * jb + jl) * 16 + rt;
            const u32x2 uv = *(const u32x2*)(P1 + tok * P1LD + 16 * g + 4 * gq);
            float o[4];
#pragma unroll
            for (int e = 0; e < 4; ++e) { const float y = acc[e] + dv[e] * bfw(uv[e >> 1], e & 1); o[e] = gelu_tanh(y); }
            u32x2 w; w.x = cvt_pk_bf16(o[0], o[1]); w.y = cvt_pk_bf16(o[2], o[3]);
            *(u32x2*)(YS + tok * 512 + 16 * g + 4 * gq) = w;
        }
    }
    __syncthreads();
}

__device__ __forceinline__ void gla_kv_item(const bf16* KDT, const bf16* VTG, bf16* KVS, int item, int lane) {
    const int cc = item & 127, h = (item >> 7) & 3, b = item >> 9, jl = lane & 15, gq = lane >> 4;
    const bf16* kd = KDT + ((size_t)((b * 4 + h) * 64 + jl)) * SEQ + 64 * cc + 8 * gq;
    const bf16* vt = VTG + ((size_t)((b * 4 + h) * 128 + jl)) * SEQ + 64 * cc + 8 * gq;
    bf16x8 af[4][2];
#pragma unroll
    for (int dt = 0; dt < 4; ++dt)
#pragma unroll
        for (int ks = 0; ks < 2; ++ks) af[dt][ks] = ld8(kd + (size_t)dt * 16 * SEQ + 32 * ks);
    bf16* out = KVS + ((size_t)(((b * 128 + cc) * 4 + h) * 128 + jl)) * 64 + 4 * gq;
#pragma unroll
    for (int et = 0; et < 8; ++et) {
        const bf16x8 b0 = ld8(vt + (size_t)et * 16 * SEQ), b1 = ld8(vt + (size_t)et * 16 * SEQ + 32);
#pragma unroll
        for (int dt = 0; dt < 4; ++dt) {
            f32x4 acc = mfma16(af[dt][0], b0, (f32x4){0.f, 0.f, 0.f, 0.f}); acc = mfma16(af[dt][1], b1, acc);
            u32x2 w; w.x = pg8::cvtpk(acc[0], acc[1]); w.y = pg8::cvtpk(acc[2], acc[3]);
            *(u32x2*)(out + (size_t)et * 16 * 64 + 16 * dt) = w;
        }
    }
}
__device__ __forceinline__ void phase_gla_scan(const Ctx& c, unsigned char* ws) {
    bf16* KVS = (bf16*)(ws + WS_KVS); const float* DEC = (const float*)(ws + WS_DECAY);
    for (int i = c.gtid; i < 2 * 4 * 128 * 64; i += c.ngt) {
        const int d = i & 63, e = (i >> 6) & 127, h = (i >> 13) & 3, b = i >> 15;
        float s = 0.f;
        bf16* p0 = KVS + ((size_t)((b * 128 * 4 + h) * 128 + e)) * 64 + d;
        const float* d0 = DEC + (b * 128) * 256 + h * 64 + d;
#pragma unroll 1
        for (int c0 = 0; c0 < 128; c0 += 32) {
            bf16 kv[32]; float dc[32];
#pragma unroll
            for (int k = 0; k < 32; ++k) { kv[k] = p0[(size_t)(c0 + k) * (4 * 128 * 64)]; dc[k] = d0[(c0 + k) * 256]; }
#pragma unroll
            for (int k = 0; k < 32; ++k) { p0[(size_t)(c0 + k) * (4 * 128 * 64)] = f2bf(s); s = dc[k] * s + bf2f(kv[k]); }
        }
    }
}
__device__ __forceinline__ void gla_out_item(const bf16* P1, const bf16* VTG, const bf16* KVS, const float* gnorm, bf16* ycat, int item, int lane) {
    const int tt = item & 3, cc = (item >> 2) & 127, h = (item >> 9) & 3, b = item >> 11, jl = lane & 15, gq = lane >> 4;
    const size_t tokc = (size_t)b * SEQ + 64 * cc;
    const bf16* qrow = P1 + (tokc + 16 * tt + jl) * P1LD + 512 + h * 64 + 8 * gq;
    const bf16x8 qf0 = ld8(qrow), qf1 = ld8(qrow + 32);
    f32x4 o[8];
#pragma unroll
    for (int et = 0; et < 8; ++et) o[et] = (f32x4){0.f, 0.f, 0.f, 0.f};
    {
        const bf16* sp = KVS + ((size_t)(((b * 128 + cc) * 4 + h) * 128 + jl)) * 64 + 8 * gq;
#pragma unroll
        for (int et = 0; et < 8; ++et) { o[et] = mfma16(ld8(sp + (size_t)et * 16 * 64), qf0, o[et]); o[et] = mfma16(ld8(sp + (size_t)et * 16 * 64 + 32), qf1, o[et]); }
    }
    const int tl = 16 * tt + jl, rho_off = 8 * (jl >> 2) + (jl & 3);
    const bf16* vt = VTG + ((size_t)((b * 4 + h) * 128 + jl)) * SEQ + 64 * cc + 8 * gq;
    for (int sp_ = 0; sp_ <= (tt >> 1); ++sp_) {
        const bf16* kx = P1 + (tokc + 32 * sp_ + rho_off) * P1LD + 768 + h * 64 + 8 * gq;
        const bf16* ky = kx + (size_t)4 * P1LD;
        f32x4 sx = mfma16(ld8(kx), qf0, (f32x4){0.f, 0.f, 0.f, 0.f}); sx = mfma16(ld8(kx + 32), qf1, sx);
        f32x4 sy = mfma16(ld8(ky), qf0, (f32x4){0.f, 0.f, 0.f, 0.f}); sy = mfma16(ld8(ky + 32), qf1, sy);
        const int kb = 32 * sp_ + 8 * gq;
        float pe[8];
#pragma unroll
        for (int r = 0; r < 4; ++r) { pe[r] = (kb + r <= tl) ? sx[r] : 0.f; pe[4 + r] = (kb + 4 + r <= tl) ? sy[r] : 0.f; }
        const u32x4 pw = pack8(pe); const bf16x8 pf = __builtin_bit_cast(bf16x8, pw);
#pragma unroll
        for (int et = 0; et < 8; ++et) o[et] = mfma16(ld8(vt + (size_t)et * 16 * SEQ + 32 * sp_), pf, o[et]);
    }
    float q = 0.f;
#pragma unroll
    for (int et = 0; et < 8; ++et) q += (o[et][0] * o[et][0] + o[et][1] * o[et][1]) + (o[et][2] * o[et][2] + o[et][3] * o[et][3]);
    q += __shfl_xor(q, 16); q += __shfl_xor(q, 32);
    const float rs = rsqrtf(q * (1.0f / 128.0f) + 1e-6f);
    const bf16* grow = P1 + (tokc + tl) * P1LD + 1536 + h * 128 + 4 * gq;
    bf16* orow = ycat + (tokc + tl) * 1024 + 512 + h * 128 + 4 * gq;
#pragma unroll
    for (int et = 0; et < 8; ++et) {
        const u32x2 gv = *(const u32x2*)(grow + 16 * et);
        const f32x4 gn = *(const f32x4*)(gnorm + 16 * et + 4 * gq);
        float r[4];
#pragma unroll
        for (int e = 0; e < 4; ++e) { const float gg = bfw(gv[e >> 1], e & 1); r[e] = (o[et][e] * rs * gn[e]) * (gg * sigm(gg)); }
        u32x2 w; w.x = cvt_pk_bf16(r[0], r[1]); w.y = cvt_pk_bf16(r[2], r[3]);
        *(u32x2*)(orow + 16 * et) = w;
    }
}

struct Args { const float* in[34]; float* out; unsigned char* ws; int ph_lo, ph_hi; };
constexpr int NPHASE = 19;

template <class Epi>
__device__ __forceinline__ void run_gemm(LAS unsigned char* lds, const bf16* A, const bf16* Bt, int M, int N, int K, const Epi& E) {
    pg8::Gemm g{A, Bt, M, N, K}; pg8::StaticOrder S; S.init(M, N, (int)gridDim.x, (int)blockIdx.x);
    pg8::gemm_phase<Epi, pg8::StaticOrder, true, true>(lds, g, S, E);
}

__global__ void __launch_bounds__(512, 2) fwd_kernel(Args a) {
    extern __shared__ __attribute__((aligned(16))) unsigned char lds_raw[];
    cg::grid_group grid = cg::this_grid();
    Ctx c; c.tid = threadIdx.x; c.lane = c.tid & 63; c.wave = __builtin_amdgcn_readfirstlane(c.tid >> 6);
    c.gw = blockIdx.x * 8 + c.wave; c.ngw = gridDim.x * 8; c.gtid = blockIdx.x * 512 + c.tid; c.ngt = gridDim.x * 512;
    c.lds = (LAS unsigned char*)lds_raw;
    unsigned char* ws = a.ws; const float* const* in = a.in;
    const int lo = a.ph_lo, hi = a.ph_hi;
#define IN(k) (lo <= (k) && (k) < hi)
#ifndef REP_MASK
#define REP_MASK 0
#endif
#define REPS(k) for (int r_ = 0; r_ < 1 + ((REP_MASK >> (k)) & 1); ++r_)
#define REPBAR() do { if (r_) xcd_barrier(bar); } while (0)
#define SYNC(k) do { if (IN(k) && IN((k) + 1)) { if ((k) == 0) grid.sync(); else xcd_barrier(bar); } } while (0)
    volatile LAS unsigned* misc = (volatile LAS unsigned*)(c.lds + 131072);
    if (c.tid < 8) misc[c.tid] = 0u;
    __syncthreads();
    XcdBarrier bar = xcd_barrier_post((unsigned*)(ws + WS_BARRIER), misc);
    float* ss = (float*)(ws + WS_SS);
    bf16* XB = (bf16*)(ws + WS_XB); bf16* BIG = (bf16*)(ws + WS_BIG); bf16* YCAT = (bf16*)(ws + WS_YCAT);
    LAS float* halo = (LAS float*)(c.lds + HALO_OFF);

#ifdef TIMING_PROBE
    volatile LAS unsigned long long* tsl = (volatile LAS unsigned long long*)(c.lds + 131072 + 64);
#define STAMP(k) do { if (blockIdx.x == 0 && c.tid == 0) tsl[k] = __builtin_amdgcn_s_memrealtime(); } while (0)
#else
#define STAMP(k) do {} while (0)
#endif
    STAMP(0);
    if (IN(0)) REPS(0) { REPBAR(); phase_prologue(c, in, ws); if (!DEFER_TR) phase_s5_mats(c, in, ws); }
    SYNC(0); STAMP(1);
    if (IN(1)) REPS(1) { REPBAR(); { pg8::EpiProj E{BIG, P0LD, ss}; run_gemm(c.lds, XB, (const bf16*)(ws + WS_W_EIN), TT, 2560, 1024, E); }
        if ((DEFER_TR || DEFER_P1) && r_ == 0) { if (gridDim.x == 256) { if (blockIdx.x >= 128) do_tr_items(c, in, ws, TR_EOUT0, TR_FIN10, (blockIdx.x - 128) * 8 + c.wave, 1024); } else do_tr_items(c, in, ws, TR_EOUT0, TR_FIN10, c.gw, c.ngw); } }
    SYNC(1); STAMP(2);
    if (IN(2)) REPS(2) { REPBAR(); phase_prep0(c, in, ws, a.out); }
    SYNC(2); STAMP(3);
    if (IN(3)) REPS(3) { REPBAR(); { pg8::EpiGates E{(const bf16*)(ws + WS_XC), (bf16*)(ws + WS_LOGA), (bf16*)(ws + WS_GI), in[6], in[8], in[9]};
        run_gemm(c.lds, (const bf16*)(ws + WS_XC), (const bf16*)(ws + WS_W_GATE), TT, 1024, 512, E); } }
    SYNC(3); STAMP(4);
    if (IN(4)) REPS(4) { REPBAR();
        phase_lru_a(c, ws);
        if (gridDim.x == 256) {
            const int x = blockIdx.x & 7, j = blockIdx.x >> 3;
            for (int k = 0; k < 4; ++k) { const int bh = 2 * x + (k >> 1), r16 = 8 * (k & 1) + c.wave;
                if ((k & 1) == 0) { __syncthreads(); attn_stage_p1(c, BIG, (const bf16*)a.out, bh >> 3, bh & 7, j); __syncthreads(); }
                attn_item<true>(c, BIG, (const bf16*)a.out, YCAT, (bh << 9) | (r16 << 5) | j, c.lane); }
            __syncthreads();
        } else
        for (int it = c.gw; it < 2 * 8 * 16 * 32; it += c.ngw) attn_item<false>(c, BIG, (const bf16*)a.out, YCAT, it, c.lane);
    }
    SYNC(4); STAMP(5);
    if (IN(5)) REPS(5) { REPBAR(); phase_lru_b(c, ws); if (DEFER_TR && r_ == 0) { do_tr_items(c, in, ws, TR_FOUT00, TR_FOUT10, c.gw, c.ngw); do_tr_items(c, in, ws, TR_OIN0, TR_GLU0, c.gw, c.ngw); } }
    SYNC(5); STAMP(6);
#ifdef EXTRA_BARS
    for (int k_ = 0; k_ < EXTRA_BARS; ++k_) xcd_barrier(bar);
#endif
    if (IN(6)) REPS(6) { REPBAR(); { pg8::EpiRes E{in[0], a.out, XB, ss + TT}; run_gemm(c.lds, YCAT, (const bf16*)(ws + WS_W_EOUT), TT, 1024, 1024, E); } }
    SYNC(6); STAMP(7);
    if (IN(7)) REPS(7) { REPBAR(); { pg8::EpiFfn E{BIG, ss + TT, in[31], in[32], (float*)(ws + WS_EDGEA), (float*)(ws + WS_EDGEL), (float*)(ws + WS_TAILA), halo};
        run_gemm(c.lds, XB, (const bf16*)(ws + WS_W_FIN0), TT, 6144, 1024, E); } }
    SYNC(7); STAMP(8);
    const bool fuse_fix = (gridDim.x == 256) && !DEFER_TR;
    if (!fuse_fix) { if (IN(8)) REPS(8) { REPBAR(); phase_fixup(c, ws, in[31], in[32]); if (DEFER_TR && r_ == 0) phase_s5_mats(c, in, ws); }
    SYNC(8); } STAMP(9);
    if (IN(9)) REPS(9) { REPBAR(); if (fuse_fix) fixup_panel(c, ws, in[31], in[32], 8 * (blockIdx.x & 7) + ((blockIdx.x >> 3) & 7));
        { pg8::EpiRes E{a.out, a.out, XB, ss + 2 * TT}; run_gemm(c.lds, BIG, (const bf16*)(ws + WS_W_FOUT0), TT, 1024, 3072, E); } }
    SYNC(9); STAMP(10);
    if (IN(10)) REPS(10) { REPBAR(); { pg8::EpiProj E{BIG, P1LD, ss + 2 * TT}; run_gemm(c.lds, XB, (const bf16*)(ws + WS_W_OIN), TT, 2048, 1024, E); }
        for (int it = c.gw; it < TT / 16; it += c.ngw) gk_item(XB, (const bf16*)(ws + WS_W_OIN), ss + 2 * TT, BIG, it, c.lane);
        if (DEFER_TR && r_ == 0) { int widx = c.gw, nw = c.ngw; if (gridDim.x == 256) { widx = (blockIdx.x >= 64) ? (blockIdx.x - 64) * 8 + c.wave : -1; nw = 192 * 8; }
            if (widx >= 0) { do_tr_items(c, in, ws, TR_FIN10, TR_FOUT00, widx, nw); do_tr_items(c, in, ws, TR_FOUT10, TR_OIN0, widx, nw); do_tr_items(c, in, ws, TR_GLU0, TR_END, widx, nw); } } }
    SYNC(10); STAMP(11);
    if (IN(11)) REPS(11) { REPBAR();
        phase_gla_prep(c, in, ws);
        if (c.wave >= 4) {
            Ctx c2 = c; c2.gw = blockIdx.x * 4 + (c.wave - 4); c2.ngw = gridDim.x * 4;
            vt_run(c2, BIG, P1LD, 1024, 128, 4, (bf16*)(ws + WS_VTG), SEQ, 0, 8 * 2 * 1024);
            for (int it = c2.gw; it < 32 * 64; it += c2.ngw) s5a_item(BIG, (const bf16*)(ws + WS_S5F), (float*)(ws + WS_XLOC), it, c.lane);
        }
    }
    SYNC(11); STAMP(12);
    if (IN(12)) REPS(12) { REPBAR();
        phase_s5_scan(c, in, ws);
        for (int it = c.ngw - 1 - c.gw; it < 2 * 4 * 128; it += c.ngw) gla_kv_item((const bf16*)(ws + WS_KDT), (const bf16*)(ws + WS_VTG), (bf16*)(ws + WS_KVS), it, c.lane);
    }
    SYNC(12); STAMP(13);
    if (IN(13)) REPS(13) { REPBAR();
        phase_gla_scan(c, ws);
        if (gridDim.x == 256) s5c_block(c, BIG, (const bf16*)(ws + WS_S5A), (const bf16*)(ws + WS_SX), in[21], (bf16*)(ws + WS_XLOC), 31 - (blockIdx.x >> 3), (blockIdx.x & 7) * 8 + c.wave);
        else
        for (int it = c.ngw - 1 - c.gw; it < 32 * 64; it += c.ngw) s5c_item(BIG, (const bf16*)(ws + WS_S5A), (const bf16*)(ws + WS_SX), in[21], (bf16*)(ws + WS_XLOC), it, c.lane);
    }
    SYNC(13); STAMP(14);
    if (IN(14)) REPS(14) { REPBAR();
        { pg8::EpiGlu E{(const bf16*)(ws + WS_XLOC), YCAT, in[24]}; run_gemm(c.lds, (const bf16*)(ws + WS_XLOC), (const bf16*)(ws + WS_W_GLU), TT, 512, 512, E); }
        if (gridDim.x == 256) {
            if (blockIdx.x < 128) gla_out_item(BIG, (const bf16*)(ws + WS_VTG), (const bf16*)(ws + WS_KVS), in[27], YCAT, c.gw, c.lane);
            else for (int k = 0; k < 3; ++k) gla_out_item(BIG, (const bf16*)(ws + WS_VTG), (const bf16*)(ws + WS_KVS), in[27], YCAT, 1024 + ((blockIdx.x - 128) * 8 + c.wave) * 3 + k, c.lane);
        } else
        for (int it = c.ngw - 1 - c.gw; it < 2 * 4 * 128 * 4; it += c.ngw) gla_out_item(BIG, (const bf16*)(ws + WS_VTG), (const bf16*)(ws + WS_KVS), in[27], YCAT, it, c.lane);
    }
    SYNC(14); STAMP(15);
    if (IN(15)) REPS(15) { REPBAR(); { pg8::EpiRes E{a.out, a.out, XB, ss + 3 * TT}; run_gemm(c.lds, YCAT, (const bf16*)(ws + WS_W_OOUT), TT, 1024, 1024, E); } }
    SYNC(15); STAMP(16);
    if (IN(16)) REPS(16) { REPBAR(); { pg8::EpiFfn E{BIG, ss + 3 * TT, in[31] + 3 * 3072, in[32] + 3072, (float*)(ws + WS_EDGEA), (float*)(ws + WS_EDGEL), (float*)(ws + WS_TAILA), halo};
        run_gemm(c.lds, XB, (const bf16*)(ws + WS_W_FIN1), TT, 6144, 1024, E); } }
    SYNC(16); STAMP(17);
    if (!fuse_fix) { if (IN(17)) REPS(17) { REPBAR(); phase_fixup(c, ws, in[31] + 3 * 3072, in[32] + 3072); }
    SYNC(17); } STAMP(18);
    if (IN(18)) REPS(18) { REPBAR(); if (fuse_fix) fixup_panel(c, ws, in[31] + 3 * 3072, in[32] + 3072, 8 * (blockIdx.x & 7) + ((blockIdx.x >> 3) & 7));
        { pg8::EpiRes E{a.out, a.out, nullptr, nullptr}; run_gemm(c.lds, BIG, (const bf16*)(ws + WS_W_FOUT1), TT, 1024, 3072, E); } }
#ifdef TIMING_PROBE
    xcd_barrier(bar); STAMP(19);
    if (blockIdx.x == 0 && c.tid == 0) {
        const float d1 = (float)(tsl[TP_A_HI] - tsl[TP_A_LO]) * 0.01f, d2 = (float)(tsl[TP_B_HI] - tsl[TP_B_LO]) * 0.01f;
#ifdef TP_CALIB
        a.out[0] += 1000.0f;
#else
        a.out[0] += d1;
        for (int j = 1; j <= 10000; ++j) a.out[j] += 0.1f * d2;
#endif
    }
#endif
#ifdef DBG_PROBE
    { grid.sync();
      const bf16* pb = (const bf16*)(ws + (size_t)DBG_B0 * MiB); const size_t nb = (size_t)(DBG_B1 - DBG_B0) * MiB / 2;
      const float* pf = (const float*)(ws + (size_t)DBG_F0 * MiB); const size_t nf = (size_t)(DBG_F1 - DBG_F0) * MiB / 4;
      for (size_t i = c.gtid; i < (size_t)TT * DM; i += c.ngt) { float s = 0.f;
          for (size_t j = i; j < nb; j += (size_t)TT * DM) s += bf2f(pb[j]);
          for (size_t j = i; j < nf; j += (size_t)TT * DM) s += pf[j];
          a.out[i] += 1e-3f * s; } }
#endif
    if (hi < 7) { grid.sync(); for (int i = c.gtid; i < TT * DM / 4; i += c.ngt) ((f32x4*)a.out)[i] = ((const f32x4*)in[0])[i]; }
#undef IN
#undef SYNC
}

#ifndef DBG_HI
#define DBG_HI NPHASE
#endif
#ifndef MK_PER_PHASE
#define MK_PER_PHASE 0
#endif
extern "C" void kernel_launch(void* const* d_in, const int* in_sizes, int n_in, void* d_out, int out_size, void* d_ws, size_t ws_size, hipStream_t stream) {
    static int grid = 0;
    if (grid == 0) {
        if (n_in != 34 || out_size != TT * DM || ws_size < WS_END) { fprintf(stderr, "kernel_launch: unexpected shapes (n_in %d out %d ws %zu)\n", n_in, out_size, ws_size); grid = -1; return; }
        int dev = 0, cus = 0, per_cu = 0;
        hipGetDevice(&dev); hipDeviceGetAttribute(&cus, hipDeviceAttributeMultiprocessorCount, dev);
        if (hipFuncSetAttribute((const void*)fwd_kernel, hipFuncAttributeMaxDynamicSharedMemorySize, LDS_BYTES) != hipSuccess) { fprintf(stderr, "kernel_launch: hipFuncSetAttribute failed\n"); grid = -1; return; }
        if (hipOccupancyMaxActiveBlocksPerMultiprocessor(&per_cu, (const void*)fwd_kernel, 512, LDS_BYTES) != hipSuccess || per_cu < 1) { fprintf(stderr, "kernel_launch: occupancy query says %d\n", per_cu); per_cu = 1; }
        (void)hipGetLastError();
        grid = cus;
        if (grid > 256) grid = 256;
    }
    if (grid < 0) return;
    if (hipMemsetAsync((char*)d_ws + WS_BARRIER, 0, 16384, stream) != hipSuccess) { fprintf(stderr, "kernel_launch: memset failed\n"); return; }
    Args a{};
    for (int i = 0; i < 34; ++i) a.in[i] = (const float*)d_in[i];
    a.out = (float*)d_out; a.ws = (unsigned char*)d_ws;
#if MK_PER_PHASE
    for (int p = 0; p < NPHASE; ++p) { a.ph_lo = p; a.ph_hi = p + 1; hipLaunchKernelGGL(fwd_kernel, dim3(grid), dim3(512), LDS_BYTES, stream, a); }
#else
    a.ph_lo = 0; a.ph_hi = DBG_HI;
    void* args[] = {&a};
    hipError_t e = hipLaunchCooperativeKernel((const void*)fwd_kernel, dim3(grid), dim3(512), args, LDS_BYTES, stream);
    if (e != hipSuccess) fprintf(stderr, "cooperative launch failed: %s (grid %d)\n", hipGetErrorString(e), grid);
#ifdef PROBE_LO
    (void)hipMemsetAsync((char*)d_ws + WS_BARRIER, 0, 16384, stream);
    Args a2 = a; a2.ph_lo = PROBE_LO; a2.ph_hi = PROBE_HI;
    void* args2[] = {&a2};
    (void)hipLaunchCooperativeKernel((const void*)fwd_kernel, dim3(grid), dim3(512), args2, LDS_BYTES, stream);
#endif
#endif
}
```

```cpp
#include <hip/hip_runtime.h>
#include <hip/hip_cooperative_groups.h>
#include <cstdio>
#include <cstdint>
namespace cg = cooperative_groups;
namespace pg8 {
#define PG8_LAS __attribute__((address_space(3)))
typedef unsigned short bf16_t;
typedef short bf16x8 __attribute__((ext_vector_type(8)));
typedef float f32x4 __attribute__((ext_vector_type(4)));
typedef unsigned u32x4 __attribute__((ext_vector_type(4)));
constexpr int BM = 256, BK = 64, HALF = 128, HTB = HALF * BK * 2  , STAGE_BYTES = 8 * HTB, NXCD = 8, WGM = 8;

__host__ __device__ __forceinline__ int lds_byte(int r, int c) { const int st = (r >> 4) * 2 + (c >> 5), rr = r & 15, cc = c & 31, ob = rr * 64 + cc * 2; return st * 1024 + (ob ^ (((ob >> 9) & 1) << 5)); }
__host__ __device__ __forceinline__ void stage_rc(int b, int& R, int& C) { const int st = b / 1024, sb = b % 1024, swz = sb ^ (((sb >> 9) & 1) << 5); R = (st >> 1) * 16 + swz / 64; C = (st & 1) * 32 + (swz % 64) / 2; }
__host__ __device__ __forceinline__ int perm32(int rho) { const int n = rho >> 4, i = rho & 15; return 8 * (i >> 2) + 4 * n + (i & 3); }

struct Unit { int pm, pn; };
struct Gemm { const bf16_t* A; const bf16_t* Bt; int M, N, K; };

struct StaticOrder {
    int nM, nN, nwg, G, c;
    __host__ __device__ void init(int M, int N, int G_, int c_) { nM = M / BM; nN = N / BM; nwg = nM * nN; G = G_; c = c_; }
    __host__ __device__ bool next(int i, Unit& u) const {
        const long L = (long)i * G + c; if (L >= nwg) return false;
        int wgid = (int)L; { const int q = nwg / NXCD, r = nwg % NXCD, xcd = wgid % NXCD, off = wgid / NXCD; wgid = (xcd < r ? xcd * (q + 1) : r * (q + 1) + (xcd - r) * q) + off; }
        const int nig = WGM * nN, gid = wgid / nig, fm = gid * WGM, gsz = (nM - fm) < WGM ? (nM - fm) : WGM;
        u.pm = fm + ((wgid % nig) % gsz); u.pn = (wgid % nig) / gsz; return true;
    }
    __device__ __forceinline__ void a_ready(const Unit&) const {}
    __device__ __forceinline__ void done(const Unit&) const {}
};

__device__ __forceinline__ unsigned cvt_pk_bf16(float lo, float hi) { unsigned r; asm volatile("v_cvt_pk_bf16_f32 %0, %1, %2" : "=v"(r) : "v"(lo), "v"(hi)); return r; }
typedef float f32x2 __attribute__((ext_vector_type(2)));
template <class Epi, class Sched, bool ALIGN_EPI = false, bool SP2 = false>
__device__ __forceinline__ void gemm_phase(PG8_LAS unsigned char* lds, const Gemm g, const Sched& S, const Epi& E) {
    const int tid = threadIdx.x, wid = __builtin_amdgcn_readfirstlane(tid >> 6), lane = tid & 63, wr = wid >> 2, wc = wid & 3, fr = lane & 15, fq = lane >> 4;
    const int K = g.K, nt = K / BK;
    unsigned voffA[2], voffB[2];
#pragma unroll
    for (int i = 0; i < 2; ++i) { int R, C; stage_rc(tid * 16 + i * 8192, R, C); const int Rb = Epi::PERM ? ((R & ~31) + perm32(R & 31)) : R;
        voffA[i] = (unsigned)(R * K + C) * 2u; voffB[i] = (unsigned)(Rb * K + C) * 2u; }
    const size_t kstep = (size_t)(BK * 2);
    const size_t hstep = (size_t)HALF * K * 2;
    const size_t tstep = 2 * hstep;
    const unsigned ldsw = (unsigned)wid * 1024u;
    const int aoff = lds_byte(wr * 64 + fr, fq * 8), boff = lds_byte(wc * 32 + fr, fq * 8);
#define PG8_SA(b, h) (((b) * 2 + (h)) * HTB)
#define PG8_SB(b, h) ((4 + (b) * 2 + (h)) * HTB)
#define PG8_STAGE(bufoff, gbase, voff) do { _Pragma("unroll") for (int _i = 0; _i < 2; ++_i) \
        __builtin_amdgcn_global_load_lds((const unsigned*)((const char*)(gbase) + (voff)[_i]), (PG8_LAS unsigned*)(lds + (bufoff) + ldsw + _i * 8192), 16, 0, 0); } while (0)
#define PG8_LDA(dst, b, h) do { _Pragma("unroll") for (int m = 0; m < 4; ++m) _Pragma("unroll") for (int k = 0; k < 2; ++k) dst[m][k] = *(const PG8_LAS bf16x8*)(lds + PG8_SA(b, h) + aoff + m * 2048 + k * 1024); } while (0)
#define PG8_LDB(dst, b, h) do { _Pragma("unroll") for (int n = 0; n < 2; ++n) _Pragma("unroll") for (int k = 0; k < 2; ++k) dst[n][k] = *(const PG8_LAS bf16x8*)(lds + PG8_SB(b, h) + boff + n * 2048 + k * 1024); } while (0)
#define PG8_MMA(ai, bj, At, Bt) do { __builtin_amdgcn_s_setprio(1); _Pragma("unroll") for (int m = 0; m < 4; ++m) _Pragma("unroll") for (int n = 0; n < 2; ++n) _Pragma("unroll") for (int k = 0; k < 2; ++k) \
        acc[ai][bj][m][n] = __builtin_amdgcn_mfma_f32_16x16x32_bf16(Bt[n][k], At[m][k], acc[ai][bj][m][n], 0, 0, 0); __builtin_amdgcn_s_setprio(0); } while (0)
#define PG8_WAIT_V(n) asm volatile("s_waitcnt vmcnt(" #n ")" ::: "memory")
#define PG8_WAIT_L(n) asm volatile("s_waitcnt lgkmcnt(" #n ")" ::: "memory")
#define PG8_BAR __builtin_amdgcn_s_barrier()
#define PG8_SCHED __builtin_amdgcn_sched_barrier(0)
    Unit cur, nxt; int ui = 0;
    if (!S.next(0, cur)) return;
    f32x4 acc[2][2][4][2];
#pragma unroll
    for (int a = 0; a < 2; ++a)
#pragma unroll
        for (int b = 0; b < 2; ++b)
#pragma unroll
            for (int m = 0; m < 4; ++m)
#pragma unroll
                for (int n = 0; n < 2; ++n) acc[a][b][m][n] = (f32x4){0.f, 0.f, 0.f, 0.f};
    bf16x8 At[4][2], B0[2][2], B1[2][2];
    const char* cA = (const char*)g.A + (size_t)cur.pm * tstep; const char* cB = (const char*)g.Bt + (size_t)cur.pn * tstep;
    S.a_ready(cur);
    if constexpr (SP2) {
        PG8_STAGE(PG8_SB(0, 0), cB, voffB); PG8_STAGE(PG8_SB(0, 1), cB + hstep, voffB); PG8_STAGE(PG8_SA(0, 0), cA, voffA); PG8_STAGE(PG8_SA(0, 1), cA + hstep, voffA);
        if (wr == 1) PG8_BAR;
        PG8_WAIT_V(2); PG8_BAR;
        PG8_STAGE(PG8_SB(1, 0), cB + kstep, voffB); PG8_STAGE(PG8_SA(1, 0), cA + kstep, voffA); PG8_STAGE(PG8_SB(1, 1), cB + hstep + kstep, voffB);
        PG8_WAIT_V(6); PG8_BAR;
    } else {
        PG8_STAGE(PG8_SB(0, 0), cB, voffB); PG8_STAGE(PG8_SA(0, 0), cA, voffA); PG8_STAGE(PG8_SB(0, 1), cB + hstep, voffB); PG8_STAGE(PG8_SA(0, 1), cA + hstep, voffA);
        if (wr == 1) PG8_BAR;
        PG8_WAIT_V(4); PG8_BAR;
        PG8_STAGE(PG8_SB(1, 0), cB + kstep, voffB); PG8_STAGE(PG8_SA(1, 0), cA + kstep, voffA); PG8_STAGE(PG8_SB(1, 1), cB + hstep + kstep, voffB);
        PG8_WAIT_V(6); PG8_BAR;
    }
    for (;;) {
        const bool has_next = S.next(ui + 1, nxt);
        const char* nA = has_next ? (const char*)g.A + (size_t)nxt.pm * tstep : cA; const char* nB = has_next ? (const char*)g.Bt + (size_t)nxt.pn * tstep : cB;
        for (int t = 0; t < nt; t += 2) {
            const bool last = (t == nt - 2);
            const char* a1 = cA + (size_t)(t + 1) * kstep;
            const char* a2 = last ? nA : cA + (size_t)(t + 2) * kstep; const char* b2 = last ? nB : cB + (size_t)(t + 2) * kstep;
            const char* a3 = a2 + kstep; const char* b3 = b2 + kstep;
            if (last && has_next) S.a_ready(nxt);
            if constexpr (SP2) {
            PG8_LDB(B0, 0, 0); PG8_LDB(B1, 0, 1); PG8_SCHED; PG8_LDA(At, 0, 0); PG8_STAGE(PG8_SA(1, 1), a1 + hstep, voffA);
            PG8_WAIT_V(8); PG8_WAIT_L(0); PG8_BAR; PG8_MMA(0, 0, At, B0); PG8_MMA(0, 1, At, B1); PG8_BAR; PG8_SCHED;
            PG8_LDA(At, 0, 1); PG8_STAGE(PG8_SB(0, 0), b2, voffB); PG8_STAGE(PG8_SB(0, 1), b2 + hstep, voffB); PG8_STAGE(PG8_SA(0, 0), a2, voffA);
            PG8_WAIT_V(8); PG8_WAIT_L(0); PG8_BAR; PG8_MMA(1, 0, At, B0); PG8_MMA(1, 1, At, B1); PG8_BAR; PG8_SCHED;
            PG8_LDB(B0, 1, 0); PG8_LDB(B1, 1, 1); PG8_SCHED; PG8_LDA(At, 1, 0); PG8_STAGE(PG8_SA(0, 1), a2 + hstep, voffA);
            PG8_WAIT_V(8); PG8_WAIT_L(0); PG8_BAR; PG8_MMA(0, 0, At, B0); PG8_MMA(0, 1, At, B1); PG8_BAR; PG8_SCHED;
            PG8_LDA(At, 1, 1); PG8_STAGE(PG8_SB(1, 0), b3, voffB); PG8_STAGE(PG8_SB(1, 1), b3 + hstep, voffB); PG8_STAGE(PG8_SA(1, 0), a3, voffA);
            PG8_WAIT_V(8); PG8_WAIT_L(0); PG8_BAR; PG8_MMA(1, 0, At, B0); PG8_MMA(1, 1, At, B1); PG8_BAR; PG8_SCHED;
            } else {
            PG8_LDB(B0, 0, 0); PG8_SCHED; PG8_LDA(At, 0, 0); PG8_STAGE(PG8_SA(1, 1), a1 + hstep, voffA);
            PG8_WAIT_L(8); PG8_BAR; PG8_WAIT_L(0); PG8_MMA(0, 0, At, B0); PG8_BAR; PG8_SCHED;
            PG8_LDB(B1, 0, 1); PG8_STAGE(PG8_SB(0, 0), b2, voffB);
            PG8_BAR; PG8_WAIT_L(0); PG8_MMA(0, 1, At, B1); PG8_BAR;
            PG8_LDA(At, 0, 1); PG8_STAGE(PG8_SA(0, 0), a2, voffA);
            PG8_BAR; PG8_WAIT_L(0); PG8_MMA(1, 0, At, B0); PG8_BAR; PG8_SCHED;
            PG8_STAGE(PG8_SB(0, 1), b2 + hstep, voffB);
            PG8_WAIT_V(6); PG8_BAR; PG8_MMA(1, 1, At, B1); PG8_BAR;
            PG8_LDB(B0, 1, 0); PG8_SCHED; PG8_LDA(At, 1, 0); PG8_STAGE(PG8_SA(0, 1), a2 + hstep, voffA);
            PG8_WAIT_L(8); PG8_BAR; PG8_WAIT_L(0); PG8_MMA(0, 0, At, B0); PG8_BAR; PG8_SCHED;
            PG8_LDB(B1, 1, 1); PG8_STAGE(PG8_SB(1, 0), b3, voffB);
            PG8_BAR; PG8_WAIT_L(0); PG8_MMA(0, 1, At, B1); PG8_BAR;
            PG8_LDA(At, 1, 1); PG8_STAGE(PG8_SA(1, 0), a3, voffA);
            PG8_BAR; PG8_WAIT_L(0); PG8_MMA(1, 0, At, B0); PG8_BAR; PG8_SCHED;
            PG8_STAGE(PG8_SB(1, 1), b3 + hstep, voffB);
            PG8_WAIT_V(6); PG8_BAR; PG8_MMA(1, 1, At, B1); PG8_BAR;
            }
        }
        if constexpr (ALIGN_EPI) { if (wr == 0) PG8_BAR; }
        if constexpr (!Epi::AFTER_DRAIN) { E(acc, cur, wr, wc, fr, fq); S.done(cur); }
        if (!has_next) break;
#pragma unroll
        for (int a = 0; a < 2; ++a)
#pragma unroll
            for (int b = 0; b < 2; ++b)
#pragma unroll
                for (int m = 0; m < 4; ++m)
#pragma unroll
                    for (int n = 0; n < 2; ++n) acc[a][b][m][n] = (f32x4){0.f, 0.f, 0.f, 0.f};
        cur = nxt; cA = nA; cB = nB; ++ui;
        if constexpr (ALIGN_EPI) { if (wr == 1) PG8_BAR; }
    }
    PG8_WAIT_V(0);
    if constexpr (!ALIGN_EPI) { if (wr == 0) PG8_BAR; }
    PG8_BAR;
    if constexpr (Epi::AFTER_DRAIN) { E.fused(acc, cur, wr, wc, fr, fq, lds, wid, lane); S.done(cur); }
#undef PG8_SA
#undef PG8_SB
#undef PG8_STAGE
#undef PG8_LDA
#undef PG8_LDB
#undef PG8_MMA
#undef PG8_WAIT_V
#undef PG8_WAIT_L
#undef PG8_BAR
#undef PG8_SCHED
}
}
namespace pg8 {
typedef unsigned u32x2 __attribute__((ext_vector_type(2)));
typedef float f32x2_t __attribute__((ext_vector_type(2))); typedef __bf16 bf16x2_t __attribute__((ext_vector_type(2)));
__device__ __forceinline__ unsigned cvtpk(float lo, float hi) { f32x2_t v = {lo, hi}; bf16x2_t b = __builtin_convertvector(v, bf16x2_t); return __builtin_bit_cast(unsigned, b); }
__device__ __forceinline__ float sigm(float x) { return __builtin_amdgcn_rcpf(1.0f + __expf(-x)); }
__device__ __forceinline__ float gelu_tanh(float x) { const float u = 1.5957691216057308f * (x + 0.044715f * x * x * x); return x * __builtin_amdgcn_rcpf(1.0f + __expf(-u)); }
__device__ __forceinline__ float bfw(unsigned w, int hi) { return __uint_as_float(hi ? (w & 0xffff0000u) : (w << 16)); }
__device__ __forceinline__ float logsig(float z) { return fminf(z, 0.f) - log1pf(__expf(-fabsf(z))); }
__device__ __forceinline__ float dpp_ror1(float v) { return __int_as_float(__builtin_amdgcn_update_dpp(__float_as_int(v), __float_as_int(v), 0x121, 0xf, 0xf, false)); }
__device__ __forceinline__ float dpp_ror2(float v) { return __int_as_float(__builtin_amdgcn_update_dpp(__float_as_int(v), __float_as_int(v), 0x122, 0xf, 0xf, false)); }

struct EpiProj {
    static constexpr bool PERM = true, AFTER_DRAIN = false;
    bf16_t* O; int ldc; const float* ss;
    __device__ __forceinline__ void operator()(const f32x4 (&acc)[2][2][4][2], const Unit& u, int wr, int wc, int fr, int fq) const {
        const int row0 = u.pm * BM + wr * 64 + fr, col0 = u.pn * BM + wc * 32 + 8 * fq;
#pragma unroll
        for (int ai = 0; ai < 2; ++ai)
#pragma unroll
            for (int m = 0; m < 4; ++m) {
                const int row = row0 + ai * HALF + m * 16;
                const float rs = rsqrtf(ss[row] * (1.0f / 1024.0f) + 1e-6f);
                bf16_t* rowp = O + (size_t)row * ldc + col0;
#pragma unroll
                for (int bj = 0; bj < 2; ++bj) {
                    const f32x4 v0 = acc[ai][bj][m][0] * rs, v1 = acc[ai][bj][m][1] * rs;
                    u32x4 w; w.x = cvt_pk_bf16(v0[0], v0[1]); w.y = cvt_pk_bf16(v0[2], v0[3]); w.z = cvt_pk_bf16(v1[0], v1[1]); w.w = cvt_pk_bf16(v1[2], v1[3]);
                    *(u32x4*)(rowp + bj * HALF) = w;
                }
            }
    }
};

struct EpiGates {
    static constexpr bool PERM = true, AFTER_DRAIN = false;
    const bf16_t* xc; bf16_t* loga; bf16_t* gi; const float* ga_b; const float* gx_b; const float* lam;
    __device__ __forceinline__ void operator()(const f32x4 (&acc)[2][2][4][2], const Unit& u, int wr, int wc, int fr, int fq) const {
        const int row0 = u.pm * BM + wr * 64 + fr, ch0 = u.pn * HALF + wc * 32 + 8 * fq;
        float gab[8], gxb[8], ls[8];
#pragma unroll
        for (int e = 0; e < 8; ++e) { gab[e] = ga_b[ch0 + e]; gxb[e] = gx_b[ch0 + e]; ls[e] = 8.0f * logsig(lam[ch0 + e]); }
#pragma unroll
        for (int ai = 0; ai < 2; ++ai)
#pragma unroll
            for (int m = 0; m < 4; ++m) {
                const int row = row0 + ai * HALF + m * 16;
                const u32x4 xv = *(const u32x4*)(xc + (size_t)row * 512 + ch0);
                float la[8], g[8];
#pragma unroll
                for (int n = 0; n < 2; ++n)
#pragma unroll
                    for (int e = 0; e < 4; ++e) {
                        const int idx = 4 * n + e;
                        const float r = acc[ai][0][m][n][e] + gab[idx], i = acc[ai][1][m][n][e] + gxb[idx];
                        la[idx] = sigm(r) * ls[idx];
                        g[idx] = sigm(i) * bfw(xv[idx >> 1], idx & 1);
                    }
                u32x4 w; w.x = cvt_pk_bf16(la[0], la[1]); w.y = cvt_pk_bf16(la[2], la[3]); w.z = cvt_pk_bf16(la[4], la[5]); w.w = cvt_pk_bf16(la[6], la[7]);
                *(u32x4*)(loga + (size_t)row * 512 + ch0) = w;
                u32x4 w2; w2.x = cvt_pk_bf16(g[0], g[1]); w2.y = cvt_pk_bf16(g[2], g[3]); w2.z = cvt_pk_bf16(g[4], g[5]); w2.w = cvt_pk_bf16(g[6], g[7]);
                *(u32x4*)(gi + (size_t)row * 512 + ch0) = w2;
            }
    }
};

struct EpiRes {
    static constexpr bool PERM = false, AFTER_DRAIN = false;
    const float* base; float* out; bf16_t* xb; float* ss;
    __device__ __forceinline__ void operator()(const f32x4 (&acc)[2][2][4][2], const Unit& u, int wr, int wc, int fr, int fq) const {
        const int row0 = u.pm * BM + wr * 64 + fr, col0 = u.pn * BM + wc * 32 + 4 * fq;
#pragma unroll
        for (int ai = 0; ai < 2; ++ai)
#pragma unroll
            for (int m = 0; m < 4; ++m) {
                const int row = row0 + ai * HALF + m * 16; float q = 0.f;
#pragma unroll
                for (int bj = 0; bj < 2; ++bj)
#pragma unroll
                    for (int n = 0; n < 2; ++n) {
                        const size_t off = (size_t)row * 1024 + col0 + bj * HALF + n * 16;
                        const f32x4 b = *(const f32x4*)(base + off);
                        const f32x4 o = b + acc[ai][bj][m][n];
                        *(f32x4*)(out + off) = o;
                        if (xb) { u32x2 w; w.x = cvt_pk_bf16(o[0], o[1]); w.y = cvt_pk_bf16(o[2], o[3]); *(u32x2*)(xb + off) = w; }
                        q += (o[0] * o[0] + o[1] * o[1]) + (o[2] * o[2] + o[3] * o[3]);
                    }
                if (ss) { q += __shfl_xor(q, 16); q += __shfl_xor(q, 32); if (fq == 0) atomicAdd(ss + row, q); }
            }
    }
};

struct EpiGlu {
    static constexpr bool PERM = true, AFTER_DRAIN = false;
    const bf16_t* ys; bf16_t* ycat; const float* bias;
    __device__ __forceinline__ void operator()(const f32x4 (&acc)[2][2][4][2], const Unit& u, int wr, int wc, int fr, int fq) const {
        const int row0 = u.pm * BM + wr * 64 + fr, col0 = u.pn * BM + wc * 32 + 8 * fq;
#pragma unroll
        for (int bj = 0; bj < 2; ++bj) {
            const int col = col0 + bj * HALF;
            float bs[8];
#pragma unroll
            for (int e = 0; e < 8; ++e) bs[e] = bias[col + e];
#pragma unroll
            for (int ai = 0; ai < 2; ++ai)
#pragma unroll
                for (int m = 0; m < 4; ++m) {
                    const int row = row0 + ai * HALF + m * 16;
                    const u32x4 yv = *(const u32x4*)(ys + (size_t)row * 512 + col);
                    float o[8];
#pragma unroll
                    for (int n = 0; n < 2; ++n)
#pragma unroll
                        for (int e = 0; e < 4; ++e) { const int idx = 4 * n + e; o[idx] = bfw(yv[idx >> 1], idx & 1) * sigm(acc[ai][bj][m][n][e] + bs[idx]); }
                    u32x4 w; w.x = cvt_pk_bf16(o[0], o[1]); w.y = cvt_pk_bf16(o[2], o[3]); w.z = cvt_pk_bf16(o[4], o[5]); w.w = cvt_pk_bf16(o[6], o[7]);
                    *(u32x4*)(ycat + (size_t)row * 1024 + col) = w;
                }
        }
    }
};

struct EpiFfn {
    static constexpr bool PERM = true, AFTER_DRAIN = false;
    bf16_t* U; const float* ss; const float* cw; const float* cb; float* edgeA; float* edgeL; float* tailA; PG8_LAS float* halo;
    __device__ __forceinline__ void operator()(const f32x4 (&acc)[2][2][4][2], const Unit& u, int wr, int wc, int fr, int fq) const {
        const int cl = wc * 32 + 8 * fq, ch0 = u.pn * HALF + cl;
        const int row0 = u.pm * BM + wr * 64 + fr;
        float w0[8], w1[8], w2[8], bb[8];
#pragma unroll
        for (int e = 0; e < 8; ++e) { w0[e] = cw[ch0 + e]; w1[e] = cw[3072 + ch0 + e]; w2[e] = cw[6144 + ch0 + e]; bb[e] = cb[ch0 + e]; }
        float rs[2][4];
#pragma unroll
        for (int ai = 0; ai < 2; ++ai)
#pragma unroll
            for (int m = 0; m < 4; ++m) rs[ai][m] = rsqrtf(ss[row0 + ai * HALF + m * 16] * (1.0f / 1024.0f) + 1e-6f);
        if (fr >= 14) {
#pragma unroll
            for (int ai = 0; ai < 2; ++ai) {
                PG8_LAS float* hp = halo + ((ai * 2 + wr) * 2 + (fr - 14)) * 128 + cl;
                *(PG8_LAS f32x4*)hp = acc[ai][0][3][0] * rs[ai][3];
                *(PG8_LAS f32x4*)(hp + 4) = acc[ai][0][3][1] * rs[ai][3];
            }
            if (wr == 1) {
                float* tp = tailA + (size_t)(u.pm * 2 + (fr - 14)) * 3072 + ch0;
                *(f32x4*)tp = acc[1][0][3][0] * rs[1][3]; *(f32x4*)(tp + 4) = acc[1][0][3][1] * rs[1][3];
            }
        }
        if (wr == 0 && fr < 2) {
            float* ea = edgeA + (size_t)(u.pm * 2 + fr) * 3072 + ch0; float* el = edgeL + (size_t)(u.pm * 2 + fr) * 3072 + ch0;
            *(f32x4*)ea = acc[0][0][0][0] * rs[0][0]; *(f32x4*)(ea + 4) = acc[0][0][0][1] * rs[0][0];
            *(f32x4*)el = acc[0][1][0][0] * rs[0][0]; *(f32x4*)(el + 4) = acc[0][1][0][1] * rs[0][0];
        }
        asm volatile("s_waitcnt lgkmcnt(0)" ::: "memory"); __builtin_amdgcn_s_barrier(); asm volatile("" ::: "memory");
#pragma unroll
        for (int ai = 0; ai < 2; ++ai) {
            f32x4 pv[2];
            if (ai == 0 && wr == 0) { pv[0] = (f32x4){0.f, 0.f, 0.f, 0.f}; pv[1] = pv[0]; }
            else {
                const int pai = (wr == 1) ? ai : 0, pwr = (wr == 1) ? 0 : 1;
                const PG8_LAS float* hp = halo + ((pai * 2 + pwr) * 2 + (fr & 1)) * 128 + cl;
                pv[0] = *(const PG8_LAS f32x4*)hp; pv[1] = *(const PG8_LAS f32x4*)(hp + 4);
            }
#pragma unroll
            for (int m = 0; m < 4; ++m) {
                const int row = row0 + ai * HALF + m * 16;
                f32x4 av[2]; av[0] = acc[ai][0][m][0] * rs[ai][m]; av[1] = acc[ai][0][m][1] * rs[ai][m];
                float o[8];
#pragma unroll
                for (int n = 0; n < 2; ++n)
#pragma unroll
                    for (int e = 0; e < 4; ++e) {
                        const int idx = 4 * n + e;
                        const float cur = av[n][e], prv = pv[n][e];
                        const float r1c = dpp_ror1(cur), r1p = dpp_ror1(prv), r2c = dpp_ror2(cur), r2p = dpp_ror2(prv);
                        const float t1 = (fr >= 1) ? r1c : r1p, t2 = (fr >= 2) ? r2c : r2p;
                        const float cv = w0[idx] * t2 + w1[idx] * t1 + w2[idx] * cur + bb[idx];
                        o[idx] = gelu_tanh(cv) * (acc[ai][1][m][n][e] * rs[ai][m]);
                    }
                u32x4 w; w.x = cvt_pk_bf16(o[0], o[1]); w.y = cvt_pk_bf16(o[2], o[3]); w.z = cvt_pk_bf16(o[4], o[5]); w.w = cvt_pk_bf16(o[6], o[7]);
                *(u32x4*)(U + (size_t)row * 3072 + ch0) = w;
                pv[0] = av[0]; pv[1] = av[1];
            }
        }
    }
};
}
#define LAS __attribute__((address_space(3)))
typedef unsigned short bf16;
typedef short bf16x8 __attribute__((ext_vector_type(8)));
typedef float f32x4 __attribute__((ext_vector_type(4)));
typedef unsigned u32x4 __attribute__((ext_vector_type(4)));
typedef unsigned u32x2 __attribute__((ext_vector_type(2)));
using pg8::cvt_pk_bf16; using pg8::sigm; using pg8::gelu_tanh; using pg8::bfw; using pg8::logsig;

constexpr int TT = 16384, SEQ = 8192, DM = 1024, DFF = 3072;
constexpr size_t MiB = 1u << 20;
constexpr size_t WS_SS = 0;
constexpr size_t WS_SUMA = 256 * 1024, WS_SUMB = 768 * 1024;
constexpr size_t WS_DECAY = 1280 * 1024;
constexpr size_t WS_BARRIER = 3 * 1024 * 1024;
constexpr size_t WS_ROPE = 1536 * 1024;
constexpr size_t WS_W_EIN = 4 * MiB, WS_W_EOUT = 9 * MiB, WS_W_GATE = 11 * MiB, WS_W_FIN0 = 12 * MiB, WS_W_FIN1 = 24 * MiB, WS_W_FOUT0 = 36 * MiB, WS_W_FOUT1 = 42 * MiB;
constexpr size_t WS_W_OIN = 48 * MiB, WS_W_GLU = 53 * MiB, WS_W_OOUT = 54 * MiB, WS_S5A = 56 * MiB, WS_S5F = 62 * MiB;
constexpr size_t WS_XB = 64 * MiB;
constexpr size_t WS_LOGA = 64 * MiB, WS_GI = 80 * MiB;
constexpr size_t WS_KDT = 64 * MiB, WS_VTG = 72 * MiB, WS_SX = 88 * MiB;
constexpr size_t WS_BIG = 96 * MiB;
constexpr size_t WS_XC = 224 * MiB, WS_KVS = 168 * MiB;
constexpr size_t WS_YCAT = 192 * MiB;
constexpr size_t WS_XLOC = 224 * MiB;
constexpr size_t WS_EDGEA = 240 * MiB, WS_EDGEL = 242 * MiB, WS_TAILA = 244 * MiB;
constexpr size_t WS_END = 256 * MiB;
constexpr int P0LD = 2568, P1LD = 2304;
constexpr int VTP = SEQ + 128;
constexpr int LDS_BYTES = 147456, HALO_OFF = 131072 + 1024;

__device__ __forceinline__ float wave_sum(float v) {
#pragma unroll
    for (int o = 1; o < 64; o <<= 1) v += __shfl_xor(v, o);
    return v;
}
__device__ __forceinline__ float bf2f(bf16 b) { return __uint_as_float((unsigned)b << 16); }
__device__ __forceinline__ bf16 f2bf(float f) { return (bf16)(cvt_pk_bf16(f, 0.f) & 0xffffu); }
__device__ __forceinline__ f32x4 mfma16(bf16x8 a, bf16x8 b, f32x4 c) { return __builtin_amdgcn_mfma_f32_16x16x32_bf16(a, b, c, 0, 0, 0); }
__device__ __forceinline__ bf16x8 ld8(const bf16* p) { return *(const bf16x8*)p; }
__device__ __forceinline__ void unpack8(u32x4 v, float* f) {
#pragma unroll
    for (int i = 0; i < 4; ++i) { f[2 * i] = __uint_as_float(v[i] << 16); f[2 * i + 1] = __uint_as_float(v[i] & 0xffff0000u); }
}
__device__ __forceinline__ u32x4 pack8v(const float* f) { u32x4 w; w.x = pg8::cvtpk(f[0], f[1]); w.y = pg8::cvtpk(f[2], f[3]); w.z = pg8::cvtpk(f[4], f[5]); w.w = pg8::cvtpk(f[6], f[7]); return w; }
__device__ __forceinline__ u32x4 pack8(const float* f) { u32x4 w; w.x = cvt_pk_bf16(f[0], f[1]); w.y = cvt_pk_bf16(f[2], f[3]); w.z = cvt_pk_bf16(f[4], f[5]); w.w = cvt_pk_bf16(f[6], f[7]); return w; }

struct Ctx { int tid, lane, wave, gw, ngw, gtid, ngt; LAS unsigned char* lds; };

struct TrDesc { const float* W; const float* gk; bf16* WT; int ldw, nsrc, ldt, k0, n0, dst_row0; };
__device__ __forceinline__ void tr_load(const TrDesc& t, int lane, float* v) {
    const int n = t.n0 + (lane & 31);
#pragma unroll
    for (int i = 0; i < 32; ++i) { const int kk = 2 * i + (lane >> 5); v[i] = (n < t.nsrc) ? t.W[(size_t)(t.k0 + kk) * t.ldw + n] : 0.f; }
}
__device__ __forceinline__ void tr_finish(const TrDesc& t, int lane, const float* v, LAS float* scr) {
#pragma unroll
    for (int i = 0; i < 32; ++i) { const int kk = 2 * i + (lane >> 5); float x = v[i]; if (t.gk) x *= t.gk[t.k0 + kk]; scr[kk * 33 + (lane & 31)] = x; }
    asm volatile("s_waitcnt lgkmcnt(0)" ::: "memory");
    const int c = lane & 7;
#pragma unroll
    for (int j = 0; j < 4; ++j) {
        const int n = (lane >> 3) + 8 * j; const LAS float* s = scr + (8 * c) * 33 + n;
        u32x4 o; o.x = cvt_pk_bf16(s[0], s[33]); o.y = cvt_pk_bf16(s[66], s[99]); o.z = cvt_pk_bf16(s[132], s[165]); o.w = cvt_pk_bf16(s[198], s[231]);
        *(u32x4*)(t.WT + (size_t)(t.dst_row0 + n) * t.ldt + t.k0 + 8 * c) = o;
    }
    asm volatile("s_waitcnt lgkmcnt(0)" ::: "memory");
}

struct S5P { float m, th, cr, ci, ar, ai; };
__device__ __forceinline__ S5P s5_params(const float* lam_re, const float* lam_im, const float* log_step, int g, int n) {
    const float step = expf(log_step[g]), lr = lam_re[g * 64 + n], li = lam_im[g * 64 + n];
    S5P p; p.m = lr * step; p.th = li * step;
    float sn, cs; sincosf(p.th, &sn, &cs);
    const float mag = expf(p.m), ar = mag * cs, ai = mag * sn, den = lr * lr + li * li;
    p.cr = ((ar - 1.0f) * lr + ai * li) / den; p.ci = (ai * lr - (ar - 1.0f) * li) / den; p.ar = ar; p.ai = ai;
    return p;
}
__device__ __forceinline__ void s5_pow(const S5P& p, float tau, float& pr, float& pi) {
    float sn, cs; sincosf(p.th * tau, &sn, &cs); const float mag = expf(p.m * tau); pr = mag * cs; pi = mag * sn;
}

__device__ __forceinline__ TrDesc tr_decode(const float* const* in, unsigned char* ws, int it) {
    constexpr int I_EIN = 16 * 80, I_EOUT = 16 * 32, I_FIN = 16 * 192, I_FOUT = 48 * 32, I_OIN = 16 * 72, I_GLU = 8 * 16;
    TrDesc t; int r = it;
    if (r < I_EIN) { const int kb = r / 80, nb = r % 80; t = TrDesc{in[2], in[1], (bf16*)(ws + WS_W_EIN), 2560, 2560, 1024, 64 * kb, 32 * nb, 32 * nb}; return t; } r -= I_EIN;
    if (r < I_EOUT) { const int kb = r / 32, nb = r % 32; t = TrDesc{in[12], nullptr, (bf16*)(ws + WS_W_EOUT), 1024, 1024, 1024, 64 * kb, 32 * nb, 32 * nb}; return t; } r -= I_EOUT;
    if (r < 2 * I_FIN) { const int l = r / I_FIN; r %= I_FIN; const int kb = r / 192, nb = r % 192, n0 = 32 * nb;
        const int dst = (n0 < 3072) ? (256 * (n0 / 128) + (n0 % 128)) : (256 * ((n0 - 3072) / 128) + 128 + ((n0 - 3072) % 128));
        t = TrDesc{in[30] + (size_t)l * 1024 * 6144, in[29] + l * 1024, (bf16*)(ws + (l ? WS_W_FIN1 : WS_W_FIN0)), 6144, 6144, 1024, 64 * kb, n0, dst}; return t; } r -= 2 * I_FIN;
    if (r < 2 * I_FOUT) { const int l = r / I_FOUT; r %= I_FOUT; const int kb = r / 32, nb = r % 32;
        t = TrDesc{in[33] + (size_t)l * 3072 * 1024, nullptr, (bf16*)(ws + (l ? WS_W_FOUT1 : WS_W_FOUT0)), 1024, 1024, 3072, 64 * kb, 32 * nb, 32 * nb}; return t; } r -= 2 * I_FOUT;
    if (r < I_OIN) { const int kb = r / 72, nb = r % 72; t = TrDesc{in[14], in[13], (bf16*)(ws + WS_W_OIN), 2064, 2064, 1024, 64 * kb, 32 * nb, 32 * nb}; return t; } r -= I_OIN;
    if (r < I_GLU) { const int kb = r / 16, nb = r % 16; t = TrDesc{in[23], nullptr, (bf16*)(ws + WS_W_GLU), 512, 512, 512, 64 * kb, 32 * nb, 32 * nb}; return t; } r -= I_GLU;
    { const int kb = r / 32, nb = r % 32; t = TrDesc{in[28], nullptr, (bf16*)(ws + WS_W_OOUT), 1024, 1024, 1024, 64 * kb, 32 * nb, 32 * nb}; return t; }
}
__device__ __forceinline__ void do_tr_items(const Ctx& c, const float* const* in, unsigned char* ws, int it_begin, int it_end, int widx, int nw) {
    LAS float* scr = (LAS float*)(c.lds + c.wave * 16384);
    int it = it_begin + widx;
    if (it >= it_end) return;
    TrDesc cur = tr_decode(in, ws, it); float v[32]; tr_load(cur, c.lane, v);
    for (;;) {
        const int nx = it + nw; const bool more = nx < it_end;
        TrDesc nxt = cur; float w[32];
        if (more) { nxt = tr_decode(in, ws, nx); tr_load(nxt, c.lane, w); }
        tr_finish(cur, c.lane, v, scr);
        if (!more) break;
        cur = nxt; it = nx;
#pragma unroll
        for (int i = 0; i < 32; ++i) v[i] = w[i];
    }
}
#ifndef DEFER_TR
#define DEFER_TR 0
#endif
#ifndef DEFER_P1
#define DEFER_P1 0
#endif
constexpr int TR_EIN0 = 0, TR_EOUT0 = 1280, TR_FIN00 = 1792, TR_FIN10 = 4864, TR_FOUT00 = 7936, TR_FOUT10 = 9472, TR_OIN0 = 11008, TR_GLU0 = 12160, TR_OOUT0 = 12288, TR_END = 12800;

__device__ __forceinline__ void phase_prologue(const Ctx& c, const float* const* in, unsigned char* ws) {
#if DEFER_TR
    do_tr_items(c, in, ws, TR_EIN0, TR_EOUT0, c.gw, c.ngw);
#elif DEFER_P1
    do_tr_items(c, in, ws, TR_EIN0, TR_EOUT0, c.gw, c.ngw); do_tr_items(c, in, ws, TR_FIN10, TR_END, c.gw, c.ngw);
#else
    do_tr_items(c, in, ws, TR_EIN0, TR_END, c.gw, c.ngw);
#endif
    {
        const float* x = in[0]; bf16* xb = (bf16*)(ws + WS_XB); float* ss = (float*)(ws + WS_SS);
        for (int m0 = c.gw; m0 < TT; m0 += 2 * c.ngw) {
            f32x4 v[2][4];
#pragma unroll
            for (int u = 0; u < 2; ++u) { const f32x4* xr = (const f32x4*)(x + (size_t)(m0 + u * c.ngw) * DM) + c.lane;
#pragma unroll
                for (int j = 0; j < 4; ++j) v[u][j] = xr[64 * j]; }
#pragma unroll
            for (int u = 0; u < 2; ++u) { const int m = m0 + u * c.ngw; float s = 0.f;
                u32x2* o8 = (u32x2*)(xb + (size_t)m * DM) + c.lane;
#pragma unroll
                for (int j = 0; j < 4; ++j) { const f32x4 q = v[u][j]; s += (q.x * q.x + q.y * q.y) + (q.z * q.z + q.w * q.w); u32x2 w; w.x = cvt_pk_bf16(q.x, q.y); w.y = cvt_pk_bf16(q.z, q.w); o8[64 * j] = w; }
                s = wave_sum(s);
                if (c.lane == 0) ss[m] = s; }
        }
        for (int i = c.gtid; i < 3 * TT; i += c.ngt) ss[TT + i] = 0.f;
    }
    {
        bf16* G = (bf16*)(ws + WS_W_GATE);
        for (int i = c.gtid; i < 1024 * 512; i += c.ngt) {
            const int R = i >> 9, k = i & 511, pn = R >> 8, half = (R >> 7) & 1, ch = 128 * pn + (R & 127), h = ch >> 6, j = ch & 63;
            float v = 0.f;
            if ((k >> 6) == h) v = (half ? in[7] : in[5])[(h * 64 + (k & 63)) * 64 + j];
            G[i] = f2bf(v);
        }
    }
    {
        float* RT = (float*)(ws + WS_ROPE);
        for (int i = c.gtid; i < SEQ * 8; i += c.ngt) {
            const int pos = i >> 3, e = i & 7;
            const float inv = powf(500000.0f, -(float)e * 0.125f);
            float sn, cs; sincosf((float)pos * inv, &sn, &cs);
            RT[pos * 16 + e] = cs; RT[pos * 16 + 8 + e] = sn;
        }
    }
}
__device__ __forceinline__ void phase_s5_mats(const Ctx& c, const float* const* in, unsigned char* ws) {
    {
        const float *lam_re = in[15], *lam_im = in[16], *b_re = in[17], *b_im = in[18], *c_re = in[19], *c_im = in[20], *lstep = in[22];
        bf16* AM = (bf16*)(ws + WS_S5A);
        bf16* FM = (bf16*)(ws + WS_S5F);
        for (int i = c.gtid; i < 32 * 256 * 4; i += c.ngt) {
            const int nq = i & 3, pp = (i >> 2) & 15, p = (i >> 6) & 15, g = i >> 10;
            float acc[16];
#pragma unroll
            for (int t = 0; t < 16; ++t) acc[t] = 0.f;
            for (int n = nq * 16; n < nq * 16 + 16; ++n) {
                const S5P sp = s5_params(lam_re, lam_im, lstep, g, n);
                const float br = b_re[(g * 64 + n) * 16 + pp], bi = b_im[(g * 64 + n) * 16 + pp];
                const float bbr = sp.cr * br - sp.ci * bi, bbi = sp.cr * bi + sp.ci * br;
                const float cr_ = c_re[(g * 16 + p) * 64 + n], ci_ = c_im[(g * 16 + p) * 64 + n];
                float zr = cr_ * bbr - ci_ * bbi, zi = cr_ * bbi + ci_ * bbr;
#pragma unroll
                for (int t = 0; t < 16; ++t) { acc[t] += zr; const float nr = zr * sp.ar - zi * sp.ai, ni = zr * sp.ai + zi * sp.ar; zr = nr; zi = ni; }
            }
            bf16* Ag = AM + (size_t)g * 256 * 384;
#pragma unroll
            for (int tau = 0; tau < 16; ++tau) {
                float v = acc[tau]; v += __shfl_xor(v, 1); v += __shfl_xor(v, 2);
                if ((tau & 3) == nq) {
                    const bf16 kv = f2bf(v);
                    for (int t = tau; t < 16; ++t) Ag[(t * 16 + p) * 384 + (t - tau) * 16 + pp] = kv;
                    if (tau >= 1) for (int t = 0; t + tau < 16; ++t) Ag[(t * 16 + p) * 384 + (t + tau) * 16 + pp] = 0;
                }
            }
        }
        for (int i = (c.gtid + c.ngt - c.ngt / 4) % c.ngt; i < 32 * 16 * 64; i += c.ngt) {
            const int g = i >> 10, p = (i >> 6) & 15, n = i & 63;
            const S5P sp = s5_params(lam_re, lam_im, lstep, g, n);
            const float cr_ = c_re[(g * 16 + p) * 64 + n], ci_ = c_im[(g * 16 + p) * 64 + n];
            float pr = sp.ar, pi = sp.ai;
            for (int t = 0; t < 16; ++t) {
                bf16* row = AM + ((size_t)g * 256 + t * 16 + p) * 384 + 256;
                row[n] = f2bf(cr_ * pr - ci_ * pi);
                row[64 + n] = f2bf(-(cr_ * pi + ci_ * pr));
                const float nr = pr * sp.ar - pi * sp.ai, ni = pr * sp.ai + pi * sp.ar; pr = nr; pi = ni;
            }
        }
        for (int i = (c.gtid + c.ngt - c.ngt / 2) % c.ngt; i < 32 * 64 * 16; i += c.ngt) {
            const int g = i >> 10, n = (i >> 4) & 63, pp = i & 15;
            const S5P sp = s5_params(lam_re, lam_im, lstep, g, n);
            const float br = b_re[(g * 64 + n) * 16 + pp], bi = b_im[(g * 64 + n) * 16 + pp];
            const float bbr = sp.cr * br - sp.ci * bi, bbi = sp.cr * bi + sp.ci * br;
            float pr = 1.f, pi = 0.f;
            for (int s = 15; s >= 0; --s) {
                FM[((size_t)g * 128 + n) * 256 + s * 16 + pp] = f2bf(pr * bbr - pi * bbi);
                FM[((size_t)g * 128 + 64 + n) * 256 + s * 16 + pp] = f2bf(pr * bbi + pi * bbr);
                const float nr = pr * sp.ar - pi * sp.ai, ni = pr * sp.ai + pi * sp.ar; pr = nr; pi = ni;
            }
        }
    }
}

__device__ __forceinline__ u32x4 vt_load(const bf16* src, int pitch, int coloff, int hd, int nh, int sh, int item, int lane) {
    const int cgp = item & 1023; int r = item >> 10; const int nblk = hd >> 6, dblk = r % nblk, bh = r / nblk, b = bh / nh, h = bh % nh;
    const int d = dblk * 64 + lane, Ld = SEQ >> sh;
    const bf16* s = src + (size_t)b * SEQ * pitch + coloff + h * hd + d;
    unsigned short v[8];
#pragma unroll
    for (int i = 0; i < 8; ++i) { const int col = cgp * 8 + i, rres = col / Ld, l = col - rres * Ld, t = (l << sh) + rres; v[i] = s[(size_t)t * pitch]; }
    u32x4 w; w.x = v[0] | ((unsigned)v[1] << 16); w.y = v[2] | ((unsigned)v[3] << 16); w.z = v[4] | ((unsigned)v[5] << 16); w.w = v[6] | ((unsigned)v[7] << 16);
    return w;
}
__device__ __forceinline__ void vt_store(u32x4 w, int hd, bf16* dst, int dpitch, int item, int lane) {
    const int cgp = item & 1023; int r = item >> 10; const int nblk = hd >> 6, dblk = r % nblk, bh = r / nblk;
    const int d = dblk * 64 + lane;
    *(u32x4*)(dst + ((size_t)bh * hd + d) * dpitch + cgp * 8) = w;
}
__device__ __forceinline__ void vt_store_blk(u32x4 w, bf16* dst, int item, int lane) {
    const int cgp = item & 1023, bh = item >> 10, dt = lane >> 4, dl = lane & 15, col0 = cgp * 8;
    *(u32x4*)(dst + ((size_t)((bh * 4 + dt) * 256 + (col0 >> 5))) * 512 + dl * 32 + (col0 & 31)) = w;
}
__device__ __forceinline__ void vt_run(const Ctx& c, const bf16* src, int pitch, int coloff, int hd, int nh, bf16* dst, int dpitch, int sh, int nitems) {
    for (int it0 = c.gw; it0 < nitems; it0 += 8 * c.ngw) {
        u32x4 w[8];
#pragma unroll
        for (int u = 0; u < 8; ++u) { const int it = it0 + u * c.ngw; if (it < nitems) w[u] = vt_load(src, pitch, coloff, hd, nh, sh, it, c.lane); }
#pragma unroll
        for (int u = 0; u < 8; ++u) { const int it = it0 + u * c.ngw; if (it < nitems) { if (dpitch == 0) vt_store_blk(w[u], dst, it, c.lane); else vt_store(w[u], hd, dst, dpitch, it, c.lane); } }
    }
}

__device__ __forceinline__ void vt32_load(const bf16* src, int sh, int item, int lane, u32x4* w) {
    const int kb = item & 255, bh = item >> 8, b = bh >> 3, h = bh & 7, Ld = SEQ >> sh;
    const bf16* s = src + (size_t)b * SEQ * P0LD + 2048 + h * 64 + lane;
    const int col0 = kb * 32, rres = col0 / Ld, l0 = col0 - rres * Ld;
    unsigned short v[32];
#pragma unroll
    for (int i = 0; i < 32; ++i) v[i] = s[(size_t)(((l0 + i) << sh) + rres) * P0LD];
#pragma unroll
    for (int q = 0; q < 4; ++q) { w[q].x = v[8 * q] | ((unsigned)v[8 * q + 1] << 16); w[q].y = v[8 * q + 2] | ((unsigned)v[8 * q + 3] << 16); w[q].z = v[8 * q + 4] | ((unsigned)v[8 * q + 5] << 16); w[q].w = v[8 * q + 6] | ((unsigned)v[8 * q + 7] << 16); }
}
__device__ __forceinline__ void vt32_store(const u32x4* w, bf16* dst, int p, int item, int lane) {
    const int kb = item & 255, bh = item >> 8;
    bf16* o = (p == 0) ? dst + ((size_t)bh * 64 + lane) * VTP + kb * 32 : dst + ((size_t)((bh * 4 + (lane >> 4)) * 256 + kb)) * 512 + (lane & 15) * 32;
#pragma unroll
    for (int q = 0; q < 4; ++q) *(u32x4*)(o + 8 * q) = w[q];
}
__device__ __forceinline__ void phase_prep0(const Ctx& c, const float* const* in, unsigned char* ws, float* dout) {
    bf16* P0 = (bf16*)(ws + WS_BIG); bf16* XC = (bf16*)(ws + WS_XC);
    const float* cw = in[3]; const float* cbias = in[4];
    for (int i0 = c.gtid; i0 < TT * 64; i0 += 2 * c.ngt) {
        u32x4 raw[2][4];
#pragma unroll
        for (int u = 0; u < 2; ++u) { const int i = i0 + u * c.ngt, t = i >> 6, c0 = (i & 63) * 8, tl = t & (SEQ - 1);
#pragma unroll
            for (int j = 0; j < 4; ++j) raw[u][j] = (tl - 3 + j >= 0) ? *(const u32x4*)(P0 + (size_t)(t - 3 + j) * P0LD + c0) : (u32x4){0u, 0u, 0u, 0u}; }
#pragma unroll
        for (int u = 0; u < 2; ++u) { const int i = i0 + u * c.ngt, t = i >> 6, c0 = (i & 63) * 8;
            float acc[8];
#pragma unroll
            for (int e = 0; e < 8; ++e) acc[e] = cbias[c0 + e];
#pragma unroll
            for (int j = 0; j < 4; ++j) { float v[8]; unpack8(raw[u][j], v);
#pragma unroll
                for (int e = 0; e < 8; ++e) acc[e] += cw[j * 512 + c0 + e] * v[e]; }
            *(u32x4*)(XC + (size_t)t * 512 + c0) = pack8(acc); }
    }
    for (int it0 = c.gw * 4; it0 < 2 * TT; it0 += c.ngw * 4) {
        const int sub = c.lane & 7;
        u32x4 raw[4];
#pragma unroll
        for (int u = 0; u < 4; ++u) { const int it = it0 + u, t = it >> 1, which = it & 1; raw[u] = *(const u32x4*)(P0 + (size_t)t * P0LD + 1024 + which * 512 + c.lane * 8); }
#pragma unroll
        for (int u = 0; u < 4; ++u) {
            const int it = it0 + u, t = it >> 1, which = it & 1;
            bf16* p = P0 + (size_t)t * P0LD + 1024 + which * 512 + c.lane * 8;
            float v[8]; unpack8(raw[u], v);
            float s = 0.f;
#pragma unroll
            for (int e = 0; e < 8; ++e) s += v[e] * v[e];
            s += __shfl_xor(s, 1); s += __shfl_xor(s, 2); s += __shfl_xor(s, 4);
            const float rs = rsqrtf(s * (1.0f / 64.0f) + 1e-6f);
            const float* gn = (which ? in[11] : in[10]) + sub * 8;
#pragma unroll
            for (int e = 0; e < 8; ++e) v[e] = v[e] * rs * gn[e];
            float oth[8];
#pragma unroll
            for (int e = 0; e < 8; ++e) oth[e] = __shfl_xor(v[e], 1);
            if (sub < 2) {
                const float* rt = (const float*)(ws + WS_ROPE) + (t & (SEQ - 1)) * 16;
                const f32x4 c0 = *(const f32x4*)rt, c1 = *(const f32x4*)(rt + 4), s0 = *(const f32x4*)(rt + 8), s1 = *(const f32x4*)(rt + 12);
#pragma unroll
                for (int e = 0; e < 8; ++e) {
                    const float cs = (e < 4) ? c0[e & 3] : c1[e & 3], sn = (e < 4) ? s0[e & 3] : s1[e & 3];
                    v[e] = (sub == 0) ? (v[e] * cs - oth[e] * sn) : (v[e] * cs + oth[e] * sn);
                }
            }
            *(u32x4*)p = pack8(v);
        }
    }
    bf16* VT3 = (bf16*)dout;
    for (int it0 = c.gw; it0 < 3 * 4096; it0 += 2 * c.ngw) {
        u32x4 w[2][4];
#pragma unroll
        for (int u = 0; u < 2; ++u) { const int it = it0 + u * c.ngw; if (it < 3 * 4096) vt32_load(P0, 2 * (it >> 12), it & 4095, c.lane, w[u]); }
#pragma unroll
        for (int u = 0; u < 2; ++u) { const int it = it0 + u * c.ngw; if (it < 3 * 4096) vt32_store(w[u], VT3 + (size_t)(it >> 12) * (16 * 64 * VTP), it >> 12, it & 4095, c.lane); }
    }
}

#define ATT_D 2
constexpr int ATT_KP = 144, ATT_VP = 784, ATT_KBYTES = 384 * ATT_KP, ATT_LDS = ATT_KBYTES + 64 * ATT_VP;
struct AttState { float m, l; f32x4 o[4]; };
__device__ __forceinline__ void attn_math(const bf16x8 kx0, const bf16x8 kx1, const bf16x8 ky0, const bf16x8 ky1, const bf16x8 (&vf)[4], const bf16x8 qf0, const bf16x8 qf1,
                                          int lq, int kb, AttState& st) {
    const float cs = 0.125f * 1.4426950408889634f;
    f32x4 sx = mfma16(kx0, qf0, (f32x4){0.f, 0.f, 0.f, 0.f}); sx = mfma16(kx1, qf1, sx);
    f32x4 sy = mfma16(ky0, qf0, (f32x4){0.f, 0.f, 0.f, 0.f}); sy = mfma16(ky1, qf1, sy);
    float mx = -1e30f;
#pragma unroll
    for (int r = 0; r < 4; ++r) {
        sx[r] = ((unsigned)(lq - (kb + r)) <= 128u) ? sx[r] : -1e30f; sy[r] = ((unsigned)(lq - (kb + 4 + r)) <= 128u) ? sy[r] : -1e30f;
        mx = fmaxf(mx, fmaxf(sx[r], sy[r]));
    }
    { auto rr = __builtin_amdgcn_permlane32_swap(__float_as_uint(mx), __float_as_uint(mx), false, false); mx = fmaxf(__uint_as_float(rr[0]), __uint_as_float(rr[1]));
      rr = __builtin_amdgcn_permlane16_swap(__float_as_uint(mx), __float_as_uint(mx), false, false); mx = fmaxf(__uint_as_float(rr[0]), __uint_as_float(rr[1]));
      rr = __builtin_amdgcn_permlane32_swap(__float_as_uint(mx), __float_as_uint(mx), false, false); mx = fmaxf(__uint_as_float(rr[0]), __uint_as_float(rr[1])); }
    const float mn = fmaxf(st.m, mx), alpha = __builtin_amdgcn_exp2f((st.m - mn) * cs); st.m = mn;
    const float mref = fmaxf(mn, -1e29f) * cs;
    float pe[8]; float ps = 0.f;
#pragma unroll
    for (int r = 0; r < 4; ++r) { pe[r] = __builtin_amdgcn_exp2f(sx[r] * cs - mref); pe[4 + r] = __builtin_amdgcn_exp2f(sy[r] * cs - mref); ps += pe[r] + pe[4 + r]; }
    st.l = st.l * alpha + ps;
    const u32x4 pw = pack8v(pe);
    const bf16x8 pf = __builtin_bit_cast(bf16x8, pw);
#pragma unroll
    for (int dt = 0; dt < 4; ++dt) { st.o[dt] = st.o[dt] * alpha; st.o[dt] = mfma16(vf[dt], pf, st.o[dt]); }
}
__device__ __forceinline__ void attn_stage_p1(const Ctx& c, const bf16* P0, const bf16* VT3, int b, int h, int lb) {
    const int tok0 = 256 * lb - 128;
    u32x4 kr[6], vr[6];
#pragma unroll
    for (int i = 0; i < 6; ++i) { const int p = c.tid + 512 * i, row = p >> 3, c16 = p & 7; int tk = tok0 + row; if (tk < 0) tk = 0;
        kr[i] = *(const u32x4*)(P0 + (size_t)(b * SEQ + tk) * P0LD + 1536 + h * 64 + c16 * 8); }
#pragma unroll
    for (int i = 0; i < 6; ++i) { const int p = c.tid + 512 * i, d = p / 48, c16 = p - d * 48; int tk = tok0 + c16 * 8; if (tk < 0) tk = 0;
        vr[i] = *(const u32x4*)(VT3 + ((size_t)((b * 8 + h) * 64 + d)) * VTP + tk); }
#pragma unroll
    for (int i = 0; i < 6; ++i) { const int p = c.tid + 512 * i, row = p >> 3, c16 = p & 7; *(LAS u32x4*)(c.lds + row * ATT_KP + c16 * 16) = kr[i]; }
#pragma unroll
    for (int i = 0; i < 6; ++i) { const int p = c.tid + 512 * i, d = p / 48, c16 = p - d * 48; *(LAS u32x4*)(c.lds + ATT_KBYTES + d * ATT_VP + c16 * 16) = vr[i]; }
}
template <bool P1_LDS>
__device__ __forceinline__ void attn_item(const Ctx& c, const bf16* P0, const bf16* VT3, bf16* ycat, int item, int lane) {
    const int lb = item & 31, r16 = (item >> 5) & 15, h = (item >> 9) & 7, b = item >> 12;
    const int qi = lane & 15, g = lane >> 4;
    const int tq = r16 + 16 * (16 * lb + qi);
    const bf16* qrow = P0 + (size_t)(b * SEQ + tq) * P0LD + 1024 + h * 64;
    const bf16x8 qf0 = ld8(qrow + 8 * g), qf1 = ld8(qrow + 32 + 8 * g);
    AttState st; st.m = -1e30f; st.l = 0.f;
#pragma unroll
    for (int dt = 0; dt < 4; ++dt) st.o[dt] = (f32x4){0.f, 0.f, 0.f, 0.f};
    const int rho_off = 8 * (qi >> 2) + (qi & 3);
    int sb0_[3], n_[3]; const bf16* kb_[3]; const bf16* vb_[3];
#pragma unroll
    for (int p = 0; p < 3; ++p) {
        const int sh = 2 * p, rres = r16 & ((1 << sh) - 1), Ld = SEQ >> sh;
        const int lq0 = (r16 + 256 * lb) >> sh, lq15 = (r16 + 256 * lb + 240) >> sh;
        int s0 = lq0 - 128; if (s0 < 0) s0 = 0; s0 &= ~31;
        sb0_[p] = s0; n_[p] = (((lq15 & ~31) - s0) >> 5) + 1;
        kb_[p] = P0 + (size_t)(b * SEQ + rres) * P0LD + 1536 + h * 64 + 8 * g;
        vb_[p] = (p == 0) ? VT3 + ((size_t)((b * 8 + h) * 64 + qi)) * VTP + 8 * g
                          : VT3 + (size_t)p * (16 * 64 * VTP) + ((size_t)((b * 8 + h) * 4) * 256 + ((rres * Ld) >> 5)) * 512 + qi * 32 + 8 * g;
    }
    if (P1_LDS) n_[0] = 0;
    const int n01 = n_[0] + n_[1], total = n01 + n_[2];
    bf16x8 rk[ATT_D][4], rv[ATT_D][4];
#define ATT_ISSUE(s_, buf) do { const int s__ = (s_); if (s__ < total) { \
        const int p_ = (s__ >= n_[0]) + (s__ >= n01); const int loc_ = s__ - (p_ == 0 ? 0 : (p_ == 1 ? n_[0] : n01)); \
        const int sb_ = (p_ == 0 ? sb0_[0] : (p_ == 1 ? sb0_[1] : sb0_[2])) + 32 * loc_; const int sh_ = 2 * p_; \
        const bf16* kbp = (p_ == 0 ? kb_[0] : (p_ == 1 ? kb_[1] : kb_[2])); const bf16* vbp = (p_ == 0 ? vb_[0] : (p_ == 1 ? vb_[1] : vb_[2])); \
        const bf16* kx = kbp + ((size_t)(sb_ + rho_off) << sh_) * P0LD; const bf16* ky = kx + ((size_t)4 << sh_) * P0LD; \
        rk[buf][0] = ld8(kx); rk[buf][1] = ld8(kx + 32); rk[buf][2] = ld8(ky); rk[buf][3] = ld8(ky + 32); \
        const size_t dstr_ = (p_ == 0) ? (size_t)16 * VTP : (size_t)256 * 512; const size_t soff_ = (p_ == 0) ? (size_t)sb_ : (size_t)(sb_ >> 5) * 512; \
        _Pragma("unroll") for (int dt = 0; dt < 4; ++dt) rv[buf][dt] = ld8(vbp + dt * dstr_ + soff_); } } while (0)
#pragma unroll
    for (int d = 0; d < ATT_D; ++d) ATT_ISSUE(d, d);
    if (P1_LDS) {
        const int w = c.wave, half = r16 >> 3, tok0 = 256 * lb - 128;
        const int tq1 = 256 * lb + 32 * w + 16 * (qi >> 3) + 8 * half + (qi & 7);
        const bf16* q1row = P0 + (size_t)(b * SEQ + tq1) * P0LD + 1024 + h * 64;
        const bf16x8 q1f0 = ld8(q1row + 8 * g), q1f1 = ld8(q1row + 32 + 8 * g);
        AttState s1; s1.m = -1e30f; s1.l = 0.f;
#pragma unroll
        for (int dt = 0; dt < 4; ++dt) s1.o[dt] = (f32x4){0.f, 0.f, 0.f, 0.f};
        const LAS unsigned char* kl = c.lds + rho_off * ATT_KP + 16 * g;
        const LAS unsigned char* vl = c.lds + ATT_KBYTES + qi * ATT_VP + 16 * g;
        LAS unsigned* ex = (LAS unsigned*)(c.lds + ATT_LDS);
        __syncthreads();
        for (int i = ((lb == 0 && w < 4) ? 4 : w); i <= w + 4; ++i) {
            const LAS unsigned char* kx = kl + 32 * i * ATT_KP;
            const bf16x8 kx0 = *(const LAS bf16x8*)kx, kx1 = *(const LAS bf16x8*)(kx + 64), ky0 = *(const LAS bf16x8*)(kx + 4 * ATT_KP), ky1 = *(const LAS bf16x8*)(kx + 4 * ATT_KP + 64);
            bf16x8 vf[4];
#pragma unroll
            for (int dt = 0; dt < 4; ++dt) vf[dt] = *(const LAS bf16x8*)(vl + dt * 16 * ATT_VP + 64 * i);
            attn_math(kx0, kx1, ky0, ky1, vf, q1f0, q1f1, tq1, tok0 + 32 * i + 8 * g, s1);
        }
        {
            LAS unsigned* e = ex + ((16 * w + qi) * 4 + g) * 10;
            e[0] = __float_as_uint(s1.m); e[1] = __float_as_uint(s1.l);
#pragma unroll
            for (int dt = 0; dt < 4; ++dt) { e[2 + 2 * dt] = pg8::cvtpk(s1.o[dt][0], s1.o[dt][1]); e[3 + 2 * dt] = pg8::cvtpk(s1.o[dt][2], s1.o[dt][3]); }
        }
        __syncthreads();
        {
            const LAS unsigned* e = ex + ((qi * 8 + (r16 & 7)) * 4 + g) * 10;
            st.m = __uint_as_float(e[0]); st.l = __uint_as_float(e[1]);
#pragma unroll
            for (int dt = 0; dt < 4; ++dt) { const unsigned a0 = e[2 + 2 * dt], a1 = e[3 + 2 * dt]; st.o[dt] = (f32x4){bfw(a0, 0), bfw(a0, 1), bfw(a1, 0), bfw(a1, 1)}; }
        }
    }
    for (int s0 = 0; s0 < total; s0 += ATT_D) {
#pragma unroll
        for (int j = 0; j < ATT_D; ++j) {
            const int s = s0 + j;
            if (s < total) {
                const int p = (s >= n_[0]) + (s >= n01), loc = s - (p == 0 ? 0 : (p == 1 ? n_[0] : n01));
                const int sb = (p == 0 ? sb0_[0] : (p == 1 ? sb0_[1] : sb0_[2])) + 32 * loc;
                attn_math(rk[j][0], rk[j][1], rk[j][2], rk[j][3], rv[j], qf0, qf1, tq >> (2 * p), sb + 8 * g, st);
                ATT_ISSUE(s + ATT_D, j);
            }
        }
    }
#undef ATT_ISSUE
    float l = st.l;
    l += __shfl_xor(l, 16); l += __shfl_xor(l, 32);
    const float inv = 1.0f / l;
    bf16* orow = ycat + (size_t)(b * SEQ + tq) * 1024 + 512 + h * 64 + 4 * g;
#pragma unroll
    for (int dt = 0; dt < 4; ++dt) { u32x2 w; w.x = cvt_pk_bf16(st.o[dt][0] * inv, st.o[dt][1] * inv); w.y = cvt_pk_bf16(st.o[dt][2] * inv, st.o[dt][3] * inv); *(u32x2*)(orow + 16 * dt) = w; }
}

__device__ __forceinline__ void lru_step(float la, float gi, float& h) { const float a = __expf(la), bq = __builtin_amdgcn_sqrtf(fmaxf(1.0f - a * a, 0.f)) * gi; h = a * h + bq; }
__device__ __forceinline__ void phase_lru_a(const Ctx& c, unsigned char* ws) {
    const bf16* __restrict__ LA = (const bf16*)(ws + WS_LOGA); const bf16* __restrict__ GI = (const bf16*)(ws + WS_GI);
    float* __restrict__ SA = (float*)(ws + WS_SUMA); float* __restrict__ SB = (float*)(ws + WS_SUMB);
    for (int ch = blockIdx.x; ch < 256; ch += gridDim.x) {
        const int t0 = ch * 64, cn = c.tid; float h = 0.f, P = 0.f;
#pragma unroll 1
        for (int tb = 0; tb < 64; tb += 32) {
            float la[32], gi[32];
#pragma unroll
            for (int t = 0; t < 32; ++t) { la[t] = bf2f(LA[(size_t)(t0 + tb + t) * 512 + cn]); gi[t] = bf2f(GI[(size_t)(t0 + tb + t) * 512 + cn]); }
#pragma unroll
            for (int t = 0; t < 32; ++t) { lru_step(la[t], gi[t], h); P += la[t]; }
        }
        SA[ch * 512 + cn] = __expf(P); SB[ch * 512 + cn] = h;
    }
}
__device__ __forceinline__ void phase_lru_b(const Ctx& c, unsigned char* ws) {
    const bf16* __restrict__ LA = (const bf16*)(ws + WS_LOGA); const bf16* __restrict__ GI = (const bf16*)(ws + WS_GI);
    const float* __restrict__ SA = (const float*)(ws + WS_SUMA); const float* __restrict__ SB = (const float*)(ws + WS_SUMB);
    const bf16* __restrict__ P0 = (const bf16*)(ws + WS_BIG); bf16* __restrict__ ycat = (bf16*)(ws + WS_YCAT);
    for (int ch = blockIdx.x; ch < 256; ch += gridDim.x) {
        const int t0 = ch * 64, cn = c.tid; float h = 0.f;
        bf16 la0[32], gi0[32], gl0[32];
#pragma unroll
        for (int t = 0; t < 32; ++t) { la0[t] = LA[(size_t)(t0 + t) * 512 + cn]; gi0[t] = GI[(size_t)(t0 + t) * 512 + cn]; gl0[t] = P0[(size_t)(t0 + t) * P0LD + 512 + cn]; }
        int j = ch & ~127;
        for (; j + 32 <= ch; j += 32) {
            float sa[32], sb[32];
#pragma unroll
            for (int k = 0; k < 32; ++k) { sa[k] = SA[(j + k) * 512 + cn]; sb[k] = SB[(j + k) * 512 + cn]; }
#pragma unroll
            for (int k = 0; k < 32; ++k) h = sa[k] * h + sb[k];
        }
        for (; j + 8 <= ch; j += 8) {
            float sa[8], sb[8];
#pragma unroll
            for (int k = 0; k < 8; ++k) { sa[k] = SA[(j + k) * 512 + cn]; sb[k] = SB[(j + k) * 512 + cn]; }
#pragma unroll
            for (int k = 0; k < 8; ++k) h = sa[k] * h + sb[k];
        }
        for (; j < ch; ++j) h = SA[j * 512 + cn] * h + SB[j * 512 + cn];
#pragma unroll
        for (int t = 0; t < 32; ++t) { lru_step(bf2f(la0[t]), bf2f(gi0[t]), h); ycat[(size_t)(t0 + t) * 1024 + cn] = f2bf(h * gelu_tanh(bf2f(gl0[t]))); }
#pragma unroll 1
        for (int tb = 32; tb < 64; tb += 32) {
            bf16 la[32], gi[32], gl[32];
#pragma unroll
            for (int t = 0; t < 32; ++t) { la[t] = LA[(size_t)(t0 + tb + t) * 512 + cn]; gi[t] = GI[(size_t)(t0 + tb + t) * 512 + cn]; gl[t] = P0[(size_t)(t0 + tb + t) * P0LD + 512 + cn]; }
#pragma unroll
            for (int t = 0; t < 32; ++t) { lru_step(bf2f(la[t]), bf2f(gi[t]), h); ycat[(size_t)(t0 + tb + t) * 1024 + cn] = f2bf(h * gelu_tanh(bf2f(gl[t]))); }
        }
    }
}

__device__ __forceinline__ void fixup_panel(const Ctx& c, unsigned char* ws, const float* cw, const float* cb, int pm) {
    if ((pm & 31) != 0) {
        const float* EA = (const float*)(ws + WS_EDGEA); const float* EL = (const float*)(ws + WS_EDGEL); const float* TA = (const float*)(ws + WS_TAILA);
        bf16* U = (bf16*)(ws + WS_BIG);
        for (int col = c.tid; col < 3072; col += 512) {
            const float tm2 = TA[(size_t)((pm - 1) * 2 + 0) * 3072 + col], tm1 = TA[(size_t)((pm - 1) * 2 + 1) * 3072 + col];
            const float a0 = EA[(size_t)(pm * 2) * 3072 + col], a1 = EA[(size_t)(pm * 2 + 1) * 3072 + col];
            const float l0 = EL[(size_t)(pm * 2) * 3072 + col], l1 = EL[(size_t)(pm * 2 + 1) * 3072 + col];
            const float w0 = cw[col], w1 = cw[3072 + col], w2 = cw[6144 + col], bb = cb[col];
            U[(size_t)(pm * 256) * 3072 + col] = f2bf(gelu_tanh(w0 * tm2 + w1 * tm1 + w2 * a0 + bb) * l0);
            U[(size_t)(pm * 256 + 1) * 3072 + col] = f2bf(gelu_tanh(w0 * tm1 + w1 * a0 + w2 * a1 + bb) * l1);
        }
    }
    asm volatile("s_waitcnt vmcnt(0)" ::: "memory");
    __syncthreads();
}
__device__ __forceinline__ void phase_fixup(const Ctx& c, unsigned char* ws, const float* cw, const float* cb) {
    const float* EA = (const float*)(ws + WS_EDGEA); const float* EL = (const float*)(ws + WS_EDGEL); const float* TA = (const float*)(ws + WS_TAILA);
    bf16* U = (bf16*)(ws + WS_BIG);
    for (int i = c.gtid; i < 64 * 3072; i += c.ngt) {
        const int pm = i / 3072, col = i % 3072;
        if ((pm & 31) == 0) continue;
        const float tm2 = TA[(size_t)((pm - 1) * 2 + 0) * 3072 + col], tm1 = TA[(size_t)((pm - 1) * 2 + 1) * 3072 + col];
        const float a0 = EA[(size_t)(pm * 2) * 3072 + col], a1 = EA[(size_t)(pm * 2 + 1) * 3072 + col];
        const float l0 = EL[(size_t)(pm * 2) * 3072 + col], l1 = EL[(size_t)(pm * 2 + 1) * 3072 + col];
        const float w0 = cw[col], w1 = cw[3072 + col], w2 = cw[6144 + col], bb = cb[col];
        U[(size_t)(pm * 256) * 3072 + col] = f2bf(gelu_tanh(w0 * tm2 + w1 * tm1 + w2 * a0 + bb) * l0);
        U[(size_t)(pm * 256 + 1) * 3072 + col] = f2bf(gelu_tanh(w0 * tm1 + w1 * a0 + w2 * a1 + bb) * l1);
    }
}
#define XB_TMO      128
#define XB_XCNT(j)  (256  + 64 * (j))
#define XB_XSUB(j)  (1280 + 64 * (j))
#define XB_XGEN(j)  (2304 + 64 * (j))
#define XB_TOP      3328
#define XB_TOPGEN   3392
#define XCD_BAR_WORDS 3456
#define XB_SPIN_CAP (1u << 18)

__device__ __forceinline__ unsigned xb_ld(unsigned* p)              { return __hip_atomic_load(p, __ATOMIC_RELAXED, __HIP_MEMORY_SCOPE_AGENT); }
__device__ __forceinline__ unsigned xb_add(unsigned* p, unsigned v) { return __hip_atomic_fetch_add(p, v, __ATOMIC_RELAXED, __HIP_MEMORY_SCOPE_AGENT); }
__device__ __forceinline__ unsigned xb_xcc_id() { return (unsigned)__builtin_amdgcn_s_getreg((3 << 11) | 20) & 0xFu; }
#define XB_SPIN(cond, bar) do { unsigned _sp = 0; while (cond) { __builtin_amdgcn_s_sleep(1); \
    if ((++_sp & 255u) == 0u) { if (xb_ld(&(bar)[XB_TMO])) break; if (_sp > XB_SPIN_CAP) { atomicAdd(&(bar)[XB_TMO], 1u); break; } } } } while (0)

struct XcdBarrier {
    unsigned* bar; unsigned x;
    volatile LAS unsigned* st;
};

__device__ __forceinline__ XcdBarrier xcd_barrier_post(unsigned* bar, volatile LAS unsigned* st) {
    XcdBarrier b; b.bar = bar; b.x = xb_xcc_id(); b.st = st;
    if (threadIdx.x == 0) (void)xb_add(&bar[XB_XCNT(b.x)], 1u);
    return b;
}
__device__ __forceinline__ void xcd_barrier_complete(unsigned* bar, unsigned x, unsigned& nloc, unsigned& nx) {
    const unsigned G = gridDim.x * gridDim.y * gridDim.z;
    unsigned sum, cnt, mine, sp = 0u;
    for (;;) {
        sum = 0u; cnt = 0u; mine = 0u;
#pragma unroll
        for (unsigned j = 0; j < 16; ++j) { const unsigned c = xb_ld(&bar[XB_XCNT(j)]); sum += c; cnt += (c > 0u) ? 1u : 0u; mine = (j == x) ? c : mine; }
        if (sum == G) break;
        __builtin_amdgcn_s_sleep(1);
        if ((++sp & 255u) == 0u) { if (xb_ld(&bar[XB_TMO])) break; if (sp > XB_SPIN_CAP) { atomicAdd(&bar[XB_TMO], 1u); break; } }
    }
    nloc = mine > 0u ? mine : 1u; nx = cnt > 0u ? cnt : 1u;
}

__device__ __forceinline__ void xcd_barrier(const XcdBarrier& b) {
    asm volatile("s_waitcnt vmcnt(0)" ::: "memory");
    __syncthreads();
    if (threadIdx.x == 0) {
        unsigned* bar = b.bar;
        __builtin_amdgcn_s_waitcnt(0);
        unsigned nloc = b.st[0], nx = b.st[1];
        if (nloc == 0u) { xcd_barrier_complete(bar, b.x, nloc, nx); b.st[0] = nloc; b.st[1] = nx; }
        const unsigned old = xb_add(&bar[XB_XSUB(b.x)], 1u);
        const unsigned gen = old / nloc;
        if (old + 1u == (gen + 1u) * nloc) {
            __builtin_amdgcn_fence(__ATOMIC_RELEASE, "agent");
            asm volatile("s_waitcnt vmcnt(0)" ::: "memory");
            const unsigned og = xb_add(&bar[XB_TOP], 1u);
            const unsigned tg = og / nx;
            if (og + 1u == (tg + 1u) * nx) xb_add(&bar[XB_TOPGEN], 1u);
            else XB_SPIN(xb_ld(&bar[XB_TOPGEN]) == tg, bar);
            __builtin_amdgcn_fence(__ATOMIC_ACQUIRE, "agent");
            xb_add(&bar[XB_XGEN(b.x)], 1u);
            asm volatile("s_waitcnt vmcnt(0)" ::: "memory");
        } else {
            XB_SPIN(xb_ld(&bar[XB_XGEN(b.x)]) == gen, bar);
            __builtin_amdgcn_fence(__ATOMIC_ACQUIRE, "agent");
            asm volatile("s_waitcnt vmcnt(0)" ::: "memory");
        }
    }
    __syncthreads();
}
__device__ __forceinline__ void gk_item(const bf16* XB, const bf16* Wt, const float* ss, bf16* P1, int item, int lane) {
    const int jl = lane & 15, gq = lane >> 4, tok = item * 16 + jl;
    const bf16* ap = Wt + (size_t)(2048 + jl) * 1024 + 8 * gq; const bf16* bp = XB + (size_t)tok * 1024 + 8 * gq;
    f32x4 acc0 = (f32x4){0.f, 0.f, 0.f, 0.f}, acc1 = acc0;
#pragma unroll 8
    for (int ks = 0; ks < 32; ks += 2) { acc0 = mfma16(ld8(ap + 32 * ks), ld8(bp + 32 * ks), acc0); acc1 = mfma16(ld8(ap + 32 * ks + 32), ld8(bp + 32 * ks + 32), acc1); }
    const float rs = rsqrtf(ss[tok] * (1.0f / 1024.0f) + 1e-6f);
    u32x2 w; w.x = cvt_pk_bf16((acc0[0] + acc1[0]) * rs, (acc0[1] + acc1[1]) * rs); w.y = cvt_pk_bf16((acc0[2] + acc1[2]) * rs, (acc0[3] + acc1[3]) * rs);
    *(u32x2*)(P1 + (size_t)tok * P1LD + 2048 + 4 * gq) = w;
}

__device__ __forceinline__ void phase_gla_prep(const Ctx& c, const float* const* in, unsigned char* ws) {
    bf16* P1 = (bf16*)(ws + WS_BIG); bf16* KDT = (bf16*)(ws + WS_KDT); float* DEC = (float*)(ws + WS_DECAY);
    const float* gkw = in[25]; const float* gkb = in[26];
    for (int i = blockIdx.x * 256 + c.tid; c.tid < 256 && i < 256 * 256; i += gridDim.x * 256) {
        const int chunk = i >> 8, chn = i & 255, t0 = chunk * 64, b = chunk >> 7, h = chn >> 6, d = chn & 63;
        float w[16];
#pragma unroll
        for (int k = 0; k < 16; ++k) w[k] = gkw[k * 256 + chn];
        const float bias = gkb[chn];
        float kin[64]; float bc = 0.f;
#pragma unroll
        for (int tb = 0; tb < 64; tb += 8) {
            u32x4 l0[8], l1[8]; bf16 qv[8], kv[8];
#pragma unroll
            for (int t = 0; t < 8; ++t) { const bf16* row = P1 + (size_t)(t0 + tb + t) * P1LD; l0[t] = *(const u32x4*)(row + 2048); l1[t] = *(const u32x4*)(row + 2056); qv[t] = row[512 + chn]; kv[t] = row[768 + chn]; }
#pragma unroll
            for (int t = 0; t < 8; ++t) {
                bf16* row = P1 + (size_t)(t0 + tb + t) * P1LD;
                float lr[16]; unpack8(l0[t], lr); unpack8(l1[t], lr + 8);
                float z = bias;
#pragma unroll
                for (int k = 0; k < 16; ++k) z += lr[k] * w[k];
                bc += logsig(z) * (1.0f / 16.0f);
                row[512 + chn] = f2bf(bf2f(qv[t]) * 0.125f * __expf(bc));
                kin[tb + t] = bf2f(kv[t]) * __expf(-bc);
                row[768 + chn] = f2bf(kin[tb + t]);
            }
        }
        const float eb = __expf(bc);
        DEC[chunk * 256 + chn] = eb;
        bf16* kd = KDT + ((size_t)((b * 4 + h) * 64 + d)) * SEQ + (t0 & (SEQ - 1));
#pragma unroll
        for (int t8 = 0; t8 < 8; ++t8) {
            float f[8];
#pragma unroll
            for (int e = 0; e < 8; ++e) f[e] = kin[t8 * 8 + e] * eb;
            *(u32x4*)(kd + t8 * 8) = pack8(f);
        }
    }
}

__device__ __forceinline__ void s5_bfrags(const bf16* P1, int g, int jb, int lane, bf16x8* bu) {
    const int jl = lane & 15, gq = lane >> 4;
#pragma unroll
    for (int ks = 0; ks < 8; ++ks) {
        const int s = 2 * ks + (gq >> 1), p0 = 8 * (gq & 1);
        bu[ks] = ld8(P1 + (size_t)((16 * jb + jl) * 16 + s) * P1LD + 16 * g + p0);
    }
}
__device__ __forceinline__ void s5a_item(const bf16* P1, const bf16* FM, float* XL, int item, int lane) {
    const int g = item >> 6, jb = item & 63, jl = lane & 15, gq = lane >> 4;
    bf16x8 bu[8]; s5_bfrags(P1, g, jb, lane, bu);
    const bf16* Fg = FM + (size_t)g * 128 * 256;
#pragma unroll
    for (int zt = 0; zt < 8; ++zt) {
        f32x4 acc = (f32x4){0.f, 0.f, 0.f, 0.f};
#pragma unroll
        for (int ks = 0; ks < 8; ++ks) acc = mfma16(ld8(Fg + (size_t)(16 * zt + jl) * 256 + 32 * ks + 8 * gq), bu[ks], acc);
        *(f32x4*)(XL + ((size_t)g * 1024 + 16 * jb + jl) * 128 + 16 * zt + 4 * gq) = acc;
    }
}
__device__ __forceinline__ void phase_s5_scan(const Ctx& c, const float* const* in, unsigned char* ws) {
    const float* __restrict__ XL = (const float*)(ws + WS_XLOC); bf16* __restrict__ SX = (bf16*)(ws + WS_SX);
    LAS float* ex = (LAS float*)c.lds;
    for (int bg = blockIdx.x; bg < 64; bg += gridDim.x) {
        const int b = bg >> 5, g = bg & 31, seg = c.wave, n = c.lane;
        const S5P sp = s5_params(in[15], in[16], in[22], g, n);
        float ar, ai; s5_pow(sp, 16.0f, ar, ai);
        float Ar, Ai; s5_pow(sp, 1024.0f, Ar, Ai);
        const size_t o0 = ((size_t)g * 1024 + b * 512 + seg * 64) * 128 + n;
        float xr = 0.f, xi = 0.f;
#pragma unroll 1
        for (int h2 = 0; h2 < 2; ++h2) {
            float cr[32], ci[32];
#pragma unroll
            for (int k = 0; k < 32; ++k) { cr[k] = XL[o0 + (size_t)(h2 * 32 + k) * 128]; ci[k] = XL[o0 + (size_t)(h2 * 32 + k) * 128 + 64]; }
#pragma unroll
            for (int k = 0; k < 32; ++k) { const float tr = ar * xr - ai * xi + cr[k], ti = ar * xi + ai * xr + ci[k]; xr = tr; xi = ti; }
        }
        ex[(seg * 64 + n) * 2] = xr; ex[(seg * 64 + n) * 2 + 1] = xi;
        __syncthreads();
        xr = 0.f; xi = 0.f;
        for (int j = 0; j < seg; ++j) { const float er = ex[(j * 64 + n) * 2], ei = ex[(j * 64 + n) * 2 + 1]; const float tr = Ar * xr - Ai * xi + er, ti = Ar * xi + Ai * xr + ei; xr = tr; xi = ti; }
#pragma unroll 1
        for (int h2 = 0; h2 < 2; ++h2) {
            float cr[32], ci[32];
#pragma unroll
            for (int k = 0; k < 32; ++k) { cr[k] = XL[o0 + (size_t)(h2 * 32 + k) * 128]; ci[k] = XL[o0 + (size_t)(h2 * 32 + k) * 128 + 64]; }
#pragma unroll
            for (int k = 0; k < 32; ++k) {
                SX[o0 + (size_t)(h2 * 32 + k) * 128] = f2bf(xr); SX[o0 + (size_t)(h2 * 32 + k) * 128 + 64] = f2bf(xi);
                const float tr = ar * xr - ai * xi + cr[k], ti = ar * xi + ai * xr + ci[k]; xr = tr; xi = ti;
            }
        }
        __syncthreads();
    }
}
__device__ __forceinline__ void s5c_item(const bf16* P1, const bf16* AM, const bf16* SX, const float* dvec, bf16* YS, int item, int lane) {
    const int g = item >> 6, jb = item & 63, jl = lane & 15, gq = lane >> 4;
    bf16x8 bu[12]; s5_bfrags(P1, g, jb, lane, bu);
#pragma unroll
    for (int ks = 0; ks < 4; ++ks) bu[8 + ks] = ld8(SX + ((size_t)g * 1024 + 16 * jb + jl) * 128 + 32 * ks + 8 * gq);
    const bf16* Ag = AM + (size_t)g * 256 * 384;
    float dv[4];
#pragma unroll
    for (int e = 0; e < 4; ++e) dv[e] = dvec[16 * g + 4 * gq + e];
#pragma unroll 4
    for (int rt = 0; rt < 16; ++rt) {
        f32x4 acc = (f32x4){0.f, 0.f, 0.f, 0.f};
#pragma unroll
        for (int ks = 0; ks < 12; ++ks) acc = mfma16(ld8(Ag + (size_t)(16 * rt + jl) * 384 + 32 * ks + 8 * gq), bu[ks], acc);
        const size_t tok = (size_t)(16 * jb + jl) * 16 + rt;
        const u32x2 uv = *(const u32x2*)(P1 + tok * P1LD + 16 * g + 4 * gq);
        float o[4];
#pragma unroll
        for (int e = 0; e < 4; ++e) { const float y = acc[e] + dv[e] * bfw(uv[e >> 1], e & 1); o[e] = gelu_tanh(y); }
        u32x2 w; w.x = cvt_pk_bf16(o[0], o[1]); w.y = cvt_pk_bf16(o[2], o[3]);
        *(u32x2*)(YS + tok * 512 + 16 * g + 4 * gq) = w;
    }
}

__device__ __forceinline__ void s5c_block(const Ctx& c, const bf16* P1, const bf16* AM, const bf16* SX, const float* dvec, bf16* YS, int g, int jb) {
    const int lane = c.lane, jl = lane & 15, gq = lane >> 4;
    bf16x8 bu[12]; s5_bfrags(P1, g, jb, lane, bu);
#pragma unroll
    for (int ks = 0; ks < 4; ++ks) bu[8 + ks] = ld8(SX + ((size_t)g * 1024 + 16 * jb + jl) * 128 + 32 * ks + 8 * gq);
    float dv[4];
#pragma unroll
    for (int e = 0; e < 4; ++e) dv[e] = dvec[16 * g + 4 * gq + e];
    const bf16* Ag = AM + (size_t)g * 256 * 384;
    for (int half = 0; half < 2; ++half) {
        __syncthreads();
        for (int p = c.tid; p < 128 * 48; p += 512) { const int row = p / 48, c16 = p - row * 48;
            *(LAS u32x4*)(c.lds + row * 784 + c16 * 16) = *(const u32x4*)(Ag + (size_t)(half * 128 + row) * 384 + c16 * 8); }
        __syncthreads();
#pragma unroll 2
        for (int r8 = 0; r8 < 8; ++r8) {
            const int rt = half * 8 + r8;
            f32x4 acc = (f32x4){0.f, 0.f, 0.f, 0.f};
#pragma unroll
            for (int ks = 0; ks < 12; ++ks) acc = mfma16(*(const LAS bf16x8*)(c.lds + (16 * r8 + jl) * 784 + 64 * ks + 16 * gq), bu[ks], acc);
            const size_t tok = (size_t)(16 * jb + jl) * 16 + rt;
            const u32x2 uv = *(const u32x2*)(P1 + tok * P1LD + 16 * g + 4 * gq);
            float o[4];
#pragma unroll
            for (int e = 0; e < 4; ++e) { const float y = acc[e] + dv[e] * bfw(uv[e >> 1], e & 1); o[e] = gelu_tanh(y); }
            u32x2 w; w.x = cvt_pk_bf16(o[0], o[1]); w.y = cvt_pk_bf16(o[2], o[3]);
            *(u32x2*)(YS + tok * 512 + 16 * g + 4 * gq) = w;
        }
    }
    __syncthreads();
}

__device__ __forceinline__ void gla_kv_item(const bf16* KDT, const bf16* VTG, bf16* KVS, int item, int lane) {
    const int cc = item & 127, h = (item >> 7) & 3, b = item >> 9, jl = lane & 15, gq = lane >> 4;
    const bf16* kd = KDT + ((size_t)((b * 4 + h) * 64 + jl)) * SEQ + 64 * cc + 8 * gq;
    const bf16* vt = VTG + ((size_t)((b * 4 + h) * 128 + jl)) * SEQ + 64 * cc + 8 * gq;
    bf16x8 af[4][2];
#pragma unroll
    for (int dt = 0; dt < 4; ++dt)
#pragma unroll
        for (int ks = 0; ks < 2; ++ks) af[dt][ks] = ld8(kd + (size_t)dt * 16 * SEQ + 32 * ks);
    bf16* out = KVS + ((size_t)(((b * 128 + cc) * 4 + h) * 128 + jl)) * 64 + 4 * gq;
#pragma unroll
    for (int et = 0; et < 8; ++et) {
        const bf16x8 b0 = ld8(vt + (size_t)et * 16 * SEQ), b1 = ld8(vt + (size_t)et * 16 * SEQ + 32);
#pragma unroll
        for (int dt = 0; dt < 4; ++dt) {
            f32x4 acc = mfma16(af[dt][0], b0, (f32x4){0.f, 0.f, 0.f, 0.f}); acc = mfma16(af[dt][1], b1, acc);
            u32x2 w; w.x = pg8::cvtpk(acc[0], acc[1]); w.y = pg8::cvtpk(acc[2], acc[3]);
            *(u32x2*)(out + (size_t)et * 16 * 64 + 16 * dt) = w;
        }
    }
}
__device__ __forceinline__ void phase_gla_scan(const Ctx& c, unsigned char* ws) {
    bf16* KVS = (bf16*)(ws + WS_KVS); const float* DEC = (const float*)(ws + WS_DECAY);
    for (int i = c.gtid; i < 2 * 4 * 128 * 64; i += c.ngt) {
        const int d = i & 63, e = (i >> 6) & 127, h = (i >> 13) & 3, b = i >> 15;
        float s = 0.f;
        bf16* p0 = KVS + ((size_t)((b * 128 * 4 + h) * 128 + e)) * 64 + d;
        const float* d0 = DEC + (b * 128) * 256 + h * 64 + d;
#pragma unroll 1
        for (int c0 = 0; c0 < 128; c0 += 43) {
            bf16 kv[43]; float dc[43];
#pragma unroll
            for (int k = 0; k < 43; ++k) if (c0 + k < 128) { kv[k] = p0[(size_t)(c0 + k) * (4 * 128 * 64)]; dc[k] = d0[(c0 + k) * 256]; }
#pragma unroll
            for (int k = 0; k < 43; ++k) if (c0 + k < 128) { p0[(size_t)(c0 + k) * (4 * 128 * 64)] = f2bf(s); s = dc[k] * s + bf2f(kv[k]); }
        }
    }
}
__device__ __forceinline__ void gla_out_item(const bf16* P1, const bf16* VTG, const bf16* KVS, const float* gnorm, bf16* ycat, int item, int lane) {
    const int tt = item & 3, cc = (item >> 2) & 127, h = (item >> 9) & 3, b = item >> 11, jl = lane & 15, gq = lane >> 4;
    const size_t tokc = (size_t)b * SEQ + 64 * cc;
    const bf16* qrow = P1 + (tokc + 16 * tt + jl) * P1LD + 512 + h * 64 + 8 * gq;
    const bf16x8 qf0 = ld8(qrow), qf1 = ld8(qrow + 32);
    f32x4 o[8];
#pragma unroll
    for (int et = 0; et < 8; ++et) o[et] = (f32x4){0.f, 0.f, 0.f, 0.f};
    {
        const bf16* sp = KVS + ((size_t)(((b * 128 + cc) * 4 + h) * 128 + jl)) * 64 + 8 * gq;
#pragma unroll
        for (int et = 0; et < 8; ++et) { o[et] = mfma16(ld8(sp + (size_t)et * 16 * 64), qf0, o[et]); o[et] = mfma16(ld8(sp + (size_t)et * 16 * 64 + 32), qf1, o[et]); }
    }
    const int tl = 16 * tt + jl, rho_off = 8 * (jl >> 2) + (jl & 3);
    const bf16* vt = VTG + ((size_t)((b * 4 + h) * 128 + jl)) * SEQ + 64 * cc + 8 * gq;
    for (int sp_ = 0; sp_ <= (tt >> 1); ++sp_) {
        const bf16* kx = P1 + (tokc + 32 * sp_ + rho_off) * P1LD + 768 + h * 64 + 8 * gq;
        const bf16* ky = kx + (size_t)4 * P1LD;
        f32x4 sx = mfma16(ld8(kx), qf0, (f32x4){0.f, 0.f, 0.f, 0.f}); sx = mfma16(ld8(kx + 32), qf1, sx);
        f32x4 sy = mfma16(ld8(ky), qf0, (f32x4){0.f, 0.f, 0.f, 0.f}); sy = mfma16(ld8(ky + 32), qf1, sy);
        const int kb = 32 * sp_ + 8 * gq;
        float pe[8];
#pragma unroll
        for (int r = 0; r < 4; ++r) { pe[r] = (kb + r <= tl) ? sx[r] : 0.f; pe[4 + r] = (kb + 4 + r <= tl) ? sy[r] : 0.f; }
        const u32x4 pw = pack8(pe); const bf16x8 pf = __builtin_bit_cast(bf16x8, pw);
#pragma unroll
        for (int et = 0; et < 8; ++et) o[et] = mfma16(ld8(vt + (size_t)et * 16 * SEQ + 32 * sp_), pf, o[et]);
    }
    float q = 0.f;
#pragma unroll
    for (int et = 0; et < 8; ++et) q += (o[et][0] * o[et][0] + o[et][1] * o[et][1]) + (o[et][2] * o[et][2] + o[et][3] * o[et][3]);
    q += __shfl_xor(q, 16); q += __shfl_xor(q, 32);
    const float rs = rsqrtf(q * (1.0f / 128.0f) + 1e-6f);
    const bf16* grow = P1 + (tokc + tl) * P1LD + 1536 + h * 128 + 4 * gq;
    bf16* orow = ycat + (tokc + tl) * 1024 + 512 + h * 128 + 4 * gq;
#pragma unroll
    for (int et = 0; et < 8; ++et) {
        const u32x2 gv = *(const u32x2*)(grow + 16 * et);
        const f32x4 gn = *(const f32x4*)(gnorm + 16 * et + 4 * gq);
        float r[4];
#pragma unroll
        for (int e = 0; e < 4; ++e) { const float gg = bfw(gv[e >> 1], e & 1); r[e] = (o[et][e] * rs * gn[e]) * (gg * sigm(gg)); }
        u32x2 w; w.x = cvt_pk_bf16(r[0], r[1]); w.y = cvt_pk_bf16(r[2], r[3]);
        *(u32x2*)(orow + 16 * et) = w;
    }
}

struct Args { const float* in[34]; float* out; unsigned char* ws; int ph_lo, ph_hi; };
constexpr int NPHASE = 19;

template <class Epi>
__device__ __forceinline__ void run_gemm(LAS unsigned char* lds, const bf16* A, const bf16* Bt, int M, int N, int K, const Epi& E) {
    pg8::Gemm g{A, Bt, M, N, K}; pg8::StaticOrder S; S.init(M, N, (int)gridDim.x, (int)blockIdx.x);
    pg8::gemm_phase<Epi, pg8::StaticOrder, true, true>(lds, g, S, E);
}

__global__ void __launch_bounds__(512, 2) fwd_kernel(Args a) {
    extern __shared__ __attribute__((aligned(16))) unsigned char lds_raw[];
    cg::grid_group grid = cg::this_grid();
    Ctx c; c.tid = threadIdx.x; c.lane = c.tid & 63; c.wave = __builtin_amdgcn_readfirstlane(c.tid >> 6);
    c.gw = blockIdx.x * 8 + c.wave; c.ngw = gridDim.x * 8; c.gtid = blockIdx.x * 512 + c.tid; c.ngt = gridDim.x * 512;
    c.lds = (LAS unsigned char*)lds_raw;
    unsigned char* ws = a.ws; const float* const* in = a.in;
    const int lo = a.ph_lo, hi = a.ph_hi;
#define IN(k) (lo <= (k) && (k) < hi)
#ifndef REP_MASK
#define REP_MASK 0
#endif
#define REPS(k) for (int r_ = 0; r_ < 1 + ((REP_MASK >> (k)) & 1); ++r_)
#define REPBAR() do { if (r_) xcd_barrier(bar); } while (0)
#define SYNC(k) do { if (IN(k) && IN((k) + 1)) { if ((k) == 0) grid.sync(); else xcd_barrier(bar); } } while (0)
    volatile LAS unsigned* misc = (volatile LAS unsigned*)(c.lds + 131072);
    if (c.tid < 8) misc[c.tid] = 0u;
    __syncthreads();
    XcdBarrier bar = xcd_barrier_post((unsigned*)(ws + WS_BARRIER), misc);
    float* ss = (float*)(ws + WS_SS);
    bf16* XB = (bf16*)(ws + WS_XB); bf16* BIG = (bf16*)(ws + WS_BIG); bf16* YCAT = (bf16*)(ws + WS_YCAT);
    LAS float* halo = (LAS float*)(c.lds + HALO_OFF);

#ifdef TIMING_PROBE
    volatile LAS unsigned long long* tsl = (volatile LAS unsigned long long*)(c.lds + 131072 + 64);
#define STAMP(k) do { if (blockIdx.x == 0 && c.tid == 0) tsl[k] = __builtin_amdgcn_s_memrealtime(); } while (0)
#else
#define STAMP(k) do {} while (0)
#endif
    STAMP(0);
    if (IN(0)) REPS(0) { REPBAR(); phase_prologue(c, in, ws); if (!DEFER_TR) phase_s5_mats(c, in, ws); }
    SYNC(0); STAMP(1);
    if (IN(1)) REPS(1) { REPBAR(); { pg8::EpiProj E{BIG, P0LD, ss}; run_gemm(c.lds, XB, (const bf16*)(ws + WS_W_EIN), TT, 2560, 1024, E); }
        if ((DEFER_TR || DEFER_P1) && r_ == 0) { if (gridDim.x == 256) { if (blockIdx.x >= 128) do_tr_items(c, in, ws, TR_EOUT0, TR_FIN10, (blockIdx.x - 128) * 8 + c.wave, 1024); } else do_tr_items(c, in, ws, TR_EOUT0, TR_FIN10, c.gw, c.ngw); } }
    SYNC(1); STAMP(2);
    if (IN(2)) REPS(2) { REPBAR(); phase_prep0(c, in, ws, a.out); }
    SYNC(2); STAMP(3);
    if (IN(3)) REPS(3) { REPBAR(); { pg8::EpiGates E{(const bf16*)(ws + WS_XC), (bf16*)(ws + WS_LOGA), (bf16*)(ws + WS_GI), in[6], in[8], in[9]};
        run_gemm(c.lds, (const bf16*)(ws + WS_XC), (const bf16*)(ws + WS_W_GATE), TT, 1024, 512, E); } }
    SYNC(3); STAMP(4);
    if (IN(4)) REPS(4) { REPBAR();
        phase_lru_a(c, ws);
        if (gridDim.x == 256) {
            const int x = blockIdx.x & 7, j = blockIdx.x >> 3;
            for (int k = 0; k < 4; ++k) { const int bh = 2 * x + (k >> 1), r16 = 8 * (k & 1) + c.wave;
                if ((k & 1) == 0) { __syncthreads(); attn_stage_p1(c, BIG, (const bf16*)a.out, bh >> 3, bh & 7, j); __syncthreads(); }
                attn_item<true>(c, BIG, (const bf16*)a.out, YCAT, (bh << 9) | (r16 << 5) | j, c.lane); }
            __syncthreads();
        } else
        for (int it = c.gw; it < 2 * 8 * 16 * 32; it += c.ngw) attn_item<false>(c, BIG, (const bf16*)a.out, YCAT, it, c.lane);
    }
    SYNC(4); STAMP(5);
    if (IN(5)) REPS(5) { REPBAR(); phase_lru_b(c, ws); if (DEFER_TR && r_ == 0) { do_tr_items(c, in, ws, TR_FOUT00, TR_FOUT10, c.gw, c.ngw); do_tr_items(c, in, ws, TR_OIN0, TR_GLU0, c.gw, c.ngw); } }
    SYNC(5); STAMP(6);
#ifdef EXTRA_BARS
    for (int k_ = 0; k_ < EXTRA_BARS; ++k_) xcd_barrier(bar);
#endif
    if (IN(6)) REPS(6) { REPBAR(); { pg8::EpiRes E{in[0], a.out, XB, ss + TT}; run_gemm(c.lds, YCAT, (const bf16*)(ws + WS_W_EOUT), TT, 1024, 1024, E); } }
    SYNC(6); STAMP(7);
    if (IN(7)) REPS(7) { REPBAR(); { pg8::EpiFfn E{BIG, ss + TT, in[31], in[32], (float*)(ws + WS_EDGEA), (float*)(ws + WS_EDGEL), (float*)(ws + WS_TAILA), halo};
        run_gemm(c.lds, XB, (const bf16*)(ws + WS_W_FIN0), TT, 6144, 1024, E); } }
    SYNC(7); STAMP(8);
    const bool fuse_fix = (gridDim.x == 256) && !DEFER_TR;
    if (!fuse_fix) { if (IN(8)) REPS(8) { REPBAR(); phase_fixup(c, ws, in[31], in[32]); if (DEFER_TR && r_ == 0) phase_s5_mats(c, in, ws); }
    SYNC(8); } STAMP(9);
    if (IN(9)) REPS(9) { REPBAR(); if (fuse_fix) fixup_panel(c, ws, in[31], in[32], 8 * (blockIdx.x & 7) + ((blockIdx.x >> 3) & 7));
        { pg8::EpiRes E{a.out, a.out, XB, ss + 2 * TT}; run_gemm(c.lds, BIG, (const bf16*)(ws + WS_W_FOUT0), TT, 1024, 3072, E); } }
    SYNC(9); STAMP(10);
    if (IN(10)) REPS(10) { REPBAR(); { pg8::EpiProj E{BIG, P1LD, ss + 2 * TT}; run_gemm(c.lds, XB, (const bf16*)(ws + WS_W_OIN), TT, 2048, 1024, E); }
        for (int it = c.gw; it < TT / 16; it += c.ngw) gk_item(XB, (const bf16*)(ws + WS_W_OIN), ss + 2 * TT, BIG, it, c.lane);
        if (DEFER_TR && r_ == 0) { int widx = c.gw, nw = c.ngw; if (gridDim.x == 256) { widx = (blockIdx.x >= 64) ? (blockIdx.x - 64) * 8 + c.wave : -1; nw = 192 * 8; }
            if (widx >= 0) { do_tr_items(c, in, ws, TR_FIN10, TR_FOUT00, widx, nw); do_tr_items(c, in, ws, TR_FOUT10, TR_OIN0, widx, nw); do_tr_items(c, in, ws, TR_GLU0, TR_END, widx, nw); } } }
    SYNC(10); STAMP(11);
    if (IN(11)) REPS(11) { REPBAR();
        phase_gla_prep(c, in, ws);
        if (c.wave >= 4) {
            Ctx c2 = c; c2.gw = blockIdx.x * 4 + (c.wave - 4); c2.ngw = gridDim.x * 4;
            vt_run(c2, BIG, P1LD, 1024, 128, 4, (bf16*)(ws + WS_VTG), SEQ, 0, 8 * 2 * 1024);
            for (int it = c2.gw; it < 32 * 64; it += c2.ngw) s5a_item(BIG, (const bf16*)(ws + WS_S5F), (float*)(ws + WS_XLOC), it, c.lane);
        }
    }
    SYNC(11); STAMP(12);
    if (IN(12)) REPS(12) { REPBAR();
        phase_s5_scan(c, in, ws);
        for (int it = c.ngw - 1 - c.gw; it < 2 * 4 * 128; it += c.ngw) gla_kv_item((const bf16*)(ws + WS_KDT), (const bf16*)(ws + WS_VTG), (bf16*)(ws + WS_KVS), it, c.lane);
    }
    SYNC(12); STAMP(13);
    if (IN(13)) REPS(13) { REPBAR();
        phase_gla_scan(c, ws);
        if (gridDim.x == 256) s5c_block(c, BIG, (const bf16*)(ws + WS_S5A), (const bf16*)(ws + WS_SX), in[21], (bf16*)(ws + WS_XLOC), 31 - (blockIdx.x >> 3), (blockIdx.x & 7) * 8 + c.wave);
        else
        for (int it = c.ngw - 1 - c.gw; it < 32 * 64; it += c.ngw) s5c_item(BIG, (const bf16*)(ws + WS_S5A), (const bf16*)(ws + WS_SX), in[21], (bf16*)(ws + WS_XLOC), it, c.lane);
    }
    SYNC(13); STAMP(14);
    if (IN(14)) REPS(14) { REPBAR();
        { pg8::EpiGlu E{(const bf16*)(ws + WS_XLOC), YCAT, in[24]}; run_gemm(c.lds, (const bf16*)(ws + WS_XLOC), (const bf16*)(ws + WS_W_GLU), TT, 512, 512, E); }
        if (gridDim.x == 256) {
            if (blockIdx.x < 128) gla_out_item(BIG, (const bf16*)(ws + WS_VTG), (const bf16*)(ws + WS_KVS), in[27], YCAT, c.gw, c.lane);
            else for (int k = 0; k < 3; ++k) gla_out_item(BIG, (const bf16*)(ws + WS_VTG), (const bf16*)(ws + WS_KVS), in[27], YCAT, 1024 + ((blockIdx.x - 128) * 8 + c.wave) * 3 + k, c.lane);
        } else
        for (int it = c.ngw - 1 - c.gw; it < 2 * 4 * 128 * 4; it += c.ngw) gla_out_item(BIG, (const bf16*)(ws + WS_VTG), (const bf16*)(ws + WS_KVS), in[27], YCAT, it, c.lane);
    }
    SYNC(14); STAMP(15);
    if (IN(15)) REPS(15) { REPBAR(); { pg8::EpiRes E{a.out, a.out, XB, ss + 3 * TT}; run_gemm(c.lds, YCAT, (const bf16*)(ws + WS_W_OOUT), TT, 1024, 1024, E); } }
    SYNC(15); STAMP(16);
    if (IN(16)) REPS(16) { REPBAR(); { pg8::EpiFfn E{BIG, ss + 3 * TT, in[31] + 3 * 3072, in[32] + 3072, (float*)(ws + WS_EDGEA), (float*)(ws + WS_EDGEL), (float*)(ws + WS_TAILA), halo};
        run_gemm(c.lds, XB, (const bf16*)(ws + WS_W_FIN1), TT, 6144, 1024, E); } }
    SYNC(16); STAMP(17);
    if (!fuse_fix) { if (IN(17)) REPS(17) { REPBAR(); phase_fixup(c, ws, in[31] + 3 * 3072, in[32] + 3072); }
    SYNC(17); } STAMP(18);
    if (IN(18)) REPS(18) { REPBAR(); if (fuse_fix) fixup_panel(c, ws, in[31] + 3 * 3072, in[32] + 3072, 8 * (blockIdx.x & 7) + ((blockIdx.x >> 3) & 7));
        { pg8::EpiRes E{a.out, a.out, nullptr, nullptr}; run_gemm(c.lds, BIG, (const bf16*)(ws + WS_W_FOUT1), TT, 1024, 3072, E); } }
#ifdef TIMING_PROBE
    xcd_barrier(bar); STAMP(19);
    if (blockIdx.x == 0 && c.tid == 0) {
        const float d1 = (float)(tsl[TP_A_HI] - tsl[TP_A_LO]) * 0.01f, d2 = (float)(tsl[TP_B_HI] - tsl[TP_B_LO]) * 0.01f;
#ifdef TP_CALIB
        a.out[0] += 1000.0f;
#else
        a.out[0] += d1;
        for (int j = 1; j <= 10000; ++j) a.out[j] += 0.1f * d2;
#endif
    }
#endif
#ifdef DBG_PROBE
    { grid.sync();
      const bf16* pb = (const bf16*)(ws + (size_t)DBG_B0 * MiB); const size_t nb = (size_t)(DBG_B1 - DBG_B0) * MiB / 2;
      const float* pf = (const float*)(ws + (size_t)DBG_F0 * MiB); const size_t nf = (size_t)(DBG_F1 - DBG_F0) * MiB / 4;
      for (size_t i = c.gtid; i < (size_t)TT * DM; i += c.ngt) { float s = 0.f;
          for (size_t j = i; j < nb; j += (size_t)TT * DM) s += bf2f(pb[j]);
          for (size_t j = i; j < nf; j += (size_t)TT * DM) s += pf[j];
          a.out[i] += 1e-3f * s; } }
#endif
    if (hi < 7) { grid.sync(); for (int i = c.gtid; i < TT * DM / 4; i += c.ngt) ((f32x4*)a.out)[i] = ((const f32x4*)in[0])[i]; }
#undef IN
#undef SYNC
}

#ifndef DBG_HI
#define DBG_HI NPHASE
#endif
#ifndef MK_PER_PHASE
#define MK_PER_PHASE 0
#endif
extern "C" void kernel_launch(void* const* d_in, const int* in_sizes, int n_in, void* d_out, int out_size, void* d_ws, size_t ws_size, hipStream_t stream) {
    static int grid = 0;
    if (grid == 0) {
        if (n_in != 34 || out_size != TT * DM || ws_size < WS_END) { fprintf(stderr, "kernel_launch: unexpected shapes (n_in %d out %d ws %zu)\n", n_in, out_size, ws_size); grid = -1; return; }
        int dev = 0, cus = 0, per_cu = 0;
        hipGetDevice(&dev); hipDeviceGetAttribute(&cus, hipDeviceAttributeMultiprocessorCount, dev);
        if (hipFuncSetAttribute((const void*)fwd_kernel, hipFuncAttributeMaxDynamicSharedMemorySize, LDS_BYTES) != hipSuccess) { fprintf(stderr, "kernel_launch: hipFuncSetAttribute failed\n"); grid = -1; return; }
        if (hipOccupancyMaxActiveBlocksPerMultiprocessor(&per_cu, (const void*)fwd_kernel, 512, LDS_BYTES) != hipSuccess || per_cu < 1) { fprintf(stderr, "kernel_launch: occupancy query says %d\n", per_cu); per_cu = 1; }
        (void)hipGetLastError();
        grid = cus;
        if (grid > 256) grid = 256;
    }
    if (grid < 0) return;
    if (hipMemsetAsync((char*)d_ws + WS_BARRIER, 0, 16384, stream) != hipSuccess) { fprintf(stderr, "kernel_launch: memset failed\n"); return; }
    Args a{};
    for (int i = 0; i < 34; ++i) a.in[i] = (const float*)d_in[i];
    a.out = (float*)d_out; a.ws = (unsigned char*)d_ws;
#if MK_PER_PHASE
    for (int p = 0; p < NPHASE; ++p) { a.ph_lo = p; a.ph_hi = p + 1; hipLaunchKernelGGL(fwd_kernel, dim3(grid), dim3(512), LDS_BYTES, stream, a); }
#else
    a.ph_lo = 0; a.ph_hi = DBG_HI;
    void* args[] = {&a};
    hipError_t e = hipLaunchCooperativeKernel((const void*)fwd_kernel, dim3(grid), dim3(512), args, LDS_BYTES, stream);
    if (e != hipSuccess) fprintf(stderr, "cooperative launch failed: %s (grid %d)\n", hipGetErrorString(e), grid);
#ifdef PROBE_LO
    (void)hipMemsetAsync((char*)d_ws + WS_BARRIER, 0, 16384, stream);
    Args a2 = a; a2.ph_lo = PROBE_LO; a2.ph_hi = PROBE_HI;
    void* args2[] = {&a2};
    (void)hipLaunchCooperativeKernel((const void*)fwd_kernel, dim3(grid), dim3(512), args2, LDS_BYTES, stream);
#endif
#endif
}
```

```cpp
#include <hip/hip_runtime.h>
#include <hip/hip_cooperative_groups.h>
#include <cstdio>
#include <cstdint>
namespace cg = cooperative_groups;
namespace pg8 {
#define PG8_LAS __attribute__((address_space(3)))
typedef unsigned short bf16_t;
typedef short bf16x8 __attribute__((ext_vector_type(8)));
typedef float f32x4 __attribute__((ext_vector_type(4)));
typedef unsigned u32x4 __attribute__((ext_vector_type(4)));
constexpr int BM = 256, BK = 64, HALF = 128, HTB = HALF * BK * 2  , STAGE_BYTES = 8 * HTB, NXCD = 8, WGM = 8;

__host__ __device__ __forceinline__ int lds_byte(int r, int c) { const int st = (r >> 4) * 2 + (c >> 5), rr = r & 15, cc = c & 31, ob = rr * 64 + cc * 2; return st * 1024 + (ob ^ (((ob >> 9) & 1) << 5)); }
__host__ __device__ __forceinline__ void stage_rc(int b, int& R, int& C) { const int st = b / 1024, sb = b % 1024, swz = sb ^ (((sb >> 9) & 1) << 5); R = (st >> 1) * 16 + swz / 64; C = (st & 1) * 32 + (swz % 64) / 2; }
__host__ __device__ __forceinline__ int perm32(int rho) { const int n = rho >> 4, i = rho & 15; return 8 * (i >> 2) + 4 * n + (i & 3); }

struct Unit { int pm, pn; };
struct Gemm { const bf16_t* A; const bf16_t* Bt; int M, N, K; };

struct StaticOrder {
    int nM, nN, nwg, G, c;
    __host__ __device__ void init(int M, int N, int G_, int c_) { nM = M / BM; nN = N / BM; nwg = nM * nN; G = G_; c = c_; }
    __host__ __device__ bool next(int i, Unit& u) const {
        const long L = (long)i * G + c; if (L >= nwg) return false;
        int wgid = (int)L; { const int q = nwg / NXCD, r = nwg % NXCD, xcd = wgid % NXCD, off = wgid / NXCD; wgid = (xcd < r ? xcd * (q + 1) : r * (q + 1) + (xcd - r) * q) + off; }
        const int nig = WGM * nN, gid = wgid / nig, fm = gid * WGM, gsz = (nM - fm) < WGM ? (nM - fm) : WGM;
        u.pm = fm + ((wgid % nig) % gsz); u.pn = (wgid % nig) / gsz; return true;
    }
    __device__ __forceinline__ void a_ready(const Unit&) const {}
    __device__ __forceinline__ void done(const Unit&) const {}
};

__device__ __forceinline__ unsigned cvt_pk_bf16(float lo, float hi) { unsigned r; asm volatile("v_cvt_pk_bf16_f32 %0, %1, %2" : "=v"(r) : "v"(lo), "v"(hi)); return r; }
typedef float f32x2 __attribute__((ext_vector_type(2)));
template <class Epi, class Sched, bool ALIGN_EPI = false, bool SP2 = false>
__device__ __forceinline__ void gemm_phase(PG8_LAS unsigned char* lds, const Gemm g, const Sched& S, const Epi& E) {
    const int tid = threadIdx.x, wid = __builtin_amdgcn_readfirstlane(tid >> 6), lane = tid & 63, wr = wid >> 2, wc = wid & 3, fr = lane & 15, fq = lane >> 4;
    const int K = g.K, nt = K / BK;
    unsigned voffA[2], voffB[2];
#pragma unroll
    for (int i = 0; i < 2; ++i) { int R, C; stage_rc(tid * 16 + i * 8192, R, C); const int Rb = Epi::PERM ? ((R & ~31) + perm32(R & 31)) : R;
        voffA[i] = (unsigned)(R * K + C) * 2u; voffB[i] = (unsigned)(Rb * K + C) * 2u; }
    const size_t kstep = (size_t)(BK * 2);
    const size_t hstep = (size_t)HALF * K * 2;
    const size_t tstep = 2 * hstep;
    const unsigned ldsw = (unsigned)wid * 1024u;
    const int aoff = lds_byte(wr * 64 + fr, fq * 8), boff = lds_byte(wc * 32 + fr, fq * 8);
#define PG8_SA(b, h) (((b) * 2 + (h)) * HTB)
#define PG8_SB(b, h) ((4 + (b) * 2 + (h)) * HTB)
#define PG8_STAGE(bufoff, gbase, voff) do { _Pragma("unroll") for (int _i = 0; _i < 2; ++_i) \
        __builtin_amdgcn_global_load_lds((const unsigned*)((const char*)(gbase) + (voff)[_i]), (PG8_LAS unsigned*)(lds + (bufoff) + ldsw + _i * 8192), 16, 0, 0); } while (0)
#define PG8_LDA(dst, b, h) do { _Pragma("unroll") for (int m = 0; m < 4; ++m) _Pragma("unroll") for (int k = 0; k < 2; ++k) dst[m][k] = *(const PG8_LAS bf16x8*)(lds + PG8_SA(b, h) + aoff + m * 2048 + k * 1024); } while (0)
#define PG8_LDB(dst, b, h) do { _Pragma("unroll") for (int n = 0; n < 2; ++n) _Pragma("unroll") for (int k = 0; k < 2; ++k) dst[n][k] = *(const PG8_LAS bf16x8*)(lds + PG8_SB(b, h) + boff + n * 2048 + k * 1024); } while (0)
#define PG8_MMA(ai, bj, At, Bt) do { __builtin_amdgcn_s_setprio(1); _Pragma("unroll") for (int m = 0; m < 4; ++m) _Pragma("unroll") for (int n = 0; n < 2; ++n) _Pragma("unroll") for (int k = 0; k < 2; ++k) \
        acc[ai][bj][m][n] = __builtin_amdgcn_mfma_f32_16x16x32_bf16(Bt[n][k], At[m][k], acc[ai][bj][m][n], 0, 0, 0); __builtin_amdgcn_s_setprio(0); } while (0)
#define PG8_WAIT_V(n) asm volatile("s_waitcnt vmcnt(" #n ")" ::: "memory")
#define PG8_WAIT_L(n) asm volatile("s_waitcnt lgkmcnt(" #n ")" ::: "memory")
#define PG8_BAR __builtin_amdgcn_s_barrier()
#define PG8_SCHED __builtin_amdgcn_sched_barrier(0)
    Unit cur, nxt; int ui = 0;
    if (!S.next(0, cur)) return;
    f32x4 acc[2][2][4][2];
#pragma unroll
    for (int a = 0; a < 2; ++a)
#pragma unroll
        for (int b = 0; b < 2; ++b)
#pragma unroll
            for (int m = 0; m < 4; ++m)
#pragma unroll
                for (int n = 0; n < 2; ++n) acc[a][b][m][n] = (f32x4){0.f, 0.f, 0.f, 0.f};
    bf16x8 At[4][2], B0[2][2], B1[2][2];
    const char* cA = (const char*)g.A + (size_t)cur.pm * tstep; const char* cB = (const char*)g.Bt + (size_t)cur.pn * tstep;
    S.a_ready(cur);
    if constexpr (SP2) {
        PG8_STAGE(PG8_SB(0, 0), cB, voffB); PG8_STAGE(PG8_SB(0, 1), cB + hstep, voffB); PG8_STAGE(PG8_SA(0, 0), cA, voffA); PG8_STAGE(PG8_SA(0, 1), cA + hstep, voffA);
        if (wr == 1) PG8_BAR;
        PG8_WAIT_V(2); PG8_BAR;
        PG8_STAGE(PG8_SB(1, 0), cB + kstep, voffB); PG8_STAGE(PG8_SA(1, 0), cA + kstep, voffA); PG8_STAGE(PG8_SB(1, 1), cB + hstep + kstep, voffB);
        PG8_WAIT_V(6); PG8_BAR;
    } else {
        PG8_STAGE(PG8_SB(0, 0), cB, voffB); PG8_STAGE(PG8_SA(0, 0), cA, voffA); PG8_STAGE(PG8_SB(0, 1), cB + hstep, voffB); PG8_STAGE(PG8_SA(0, 1), cA + hstep, voffA);
        if (wr == 1) PG8_BAR;
        PG8_WAIT_V(4); PG8_BAR;
        PG8_STAGE(PG8_SB(1, 0), cB + kstep, voffB); PG8_STAGE(PG8_SA(1, 0), cA + kstep, voffA); PG8_STAGE(PG8_SB(1, 1), cB + hstep + kstep, voffB);
        PG8_WAIT_V(6); PG8_BAR;
    }
    for (;;) {
        const bool has_next = S.next(ui + 1, nxt);
        const char* nA = has_next ? (const char*)g.A + (size_t)nxt.pm * tstep : cA; const char* nB = has_next ? (const char*)g.Bt + (size_t)nxt.pn * tstep : cB;
        for (int t = 0; t < nt; t += 2) {
            const bool last = (t == nt - 2);
            const char* a1 = cA + (size_t)(t + 1) * kstep;
            const char* a2 = last ? nA : cA + (size_t)(t + 2) * kstep; const char* b2 = last ? nB : cB + (size_t)(t + 2) * kstep;
            const char* a3 = a2 + kstep; const char* b3 = b2 + kstep;
            if (last && has_next) S.a_ready(nxt);
            if constexpr (SP2) {
            PG8_LDB(B0, 0, 0); PG8_LDB(B1, 0, 1); PG8_SCHED; PG8_LDA(At, 0, 0); PG8_STAGE(PG8_SA(1, 1), a1 + hstep, voffA);
            PG8_WAIT_V(8); PG8_WAIT_L(0); PG8_BAR; PG8_MMA(0, 0, At, B0); PG8_MMA(0, 1, At, B1); PG8_BAR; PG8_SCHED;
            PG8_LDA(At, 0, 1); PG8_STAGE(PG8_SB(0, 0), b2, voffB); PG8_STAGE(PG8_SB(0, 1), b2 + hstep, voffB); PG8_STAGE(PG8_SA(0, 0), a2, voffA);
            PG8_WAIT_V(8); PG8_WAIT_L(0); PG8_BAR; PG8_MMA(1, 0, At, B0); PG8_MMA(1, 1, At, B1); PG8_BAR; PG8_SCHED;
            PG8_LDB(B0, 1, 0); PG8_LDB(B1, 1, 1); PG8_SCHED; PG8_LDA(At, 1, 0); PG8_STAGE(PG8_SA(0, 1), a2 + hstep, voffA);
            PG8_WAIT_V(8); PG8_WAIT_L(0); PG8_BAR; PG8_MMA(0, 0, At, B0); PG8_MMA(0, 1, At, B1); PG8_BAR; PG8_SCHED;
            PG8_LDA(At, 1, 1); PG8_STAGE(PG8_SB(1, 0), b3, voffB); PG8_STAGE(PG8_SB(1, 1), b3 + hstep, voffB); PG8_STAGE(PG8_SA(1, 0), a3, voffA);
            PG8_WAIT_V(8); PG8_WAIT_L(0); PG8_BAR; PG8_MMA(1, 0, At, B0); PG8_MMA(1, 1, At, B1); PG8_BAR; PG8_SCHED;
            } else {
            PG8_LDB(B0, 0, 0); PG8_SCHED; PG8_LDA(At, 0, 0); PG8_STAGE(PG8_SA(1, 1), a1 + hstep, voffA);
            PG8_WAIT_L(8); PG8_BAR; PG8_WAIT_L(0); PG8_MMA(0, 0, At, B0); PG8_BAR; PG8_SCHED;
            PG8_LDB(B1, 0, 1); PG8_STAGE(PG8_SB(0, 0), b2, voffB);
            PG8_BAR; PG8_WAIT_L(0); PG8_MMA(0, 1, At, B1); PG8_BAR;
            PG8_LDA(At, 0, 1); PG8_STAGE(PG8_SA(0, 0), a2, voffA);
            PG8_BAR; PG8_WAIT_L(0); PG8_MMA(1, 0, At, B0); PG8_BAR; PG8_SCHED;
            PG8_STAGE(PG8_SB(0, 1), b2 + hstep, voffB);
            PG8_WAIT_V(6); PG8_BAR; PG8_MMA(1, 1, At, B1); PG8_BAR;
            PG8_LDB(B0, 1, 0); PG8_SCHED; PG8_LDA(At, 1, 0); PG8_STAGE(PG8_SA(0, 1), a2 + hstep, voffA);
            PG8_WAIT_L(8); PG8_BAR; PG8_WAIT_L(0); PG8_MMA(0, 0, At, B0); PG8_BAR; PG8_SCHED;
            PG8_LDB(B1, 1, 1); PG8_STAGE(PG8_SB(1, 0), b3, voffB);
            PG8_BAR; PG8_WAIT_L(0); PG8_MMA(0, 1, At, B1); PG8_BAR;
            PG8_LDA(At, 1, 1); PG8_STAGE(PG8_SA(1, 0), a3, voffA);
            PG8_BAR; PG8_WAIT_L(0); PG8_MMA(1, 0, At, B0); PG8_BAR; PG8_SCHED;
            PG8_STAGE(PG8_SB(1, 1), b3 + hstep, voffB);
            PG8_WAIT_V(6); PG8_BAR; PG8_MMA(1, 1, At, B1); PG8_BAR;
            }
        }
        if constexpr (ALIGN_EPI) { if (wr == 0) PG8_BAR; }
        if constexpr (!Epi::AFTER_DRAIN) { E(acc, cur, wr, wc, fr, fq); S.done(cur); }
        if (!has_next) break;
#pragma unroll
        for (int a = 0; a < 2; ++a)
#pragma unroll
            for (int b = 0; b < 2; ++b)
#pragma unroll
                for (int m = 0; m < 4; ++m)
#pragma unroll
                    for (int n = 0; n < 2; ++n) acc[a][b][m][n] = (f32x4){0.f, 0.f, 0.f, 0.f};
        cur = nxt; cA = nA; cB = nB; ++ui;
        if constexpr (ALIGN_EPI) { if (wr == 1) PG8_BAR; }
    }
    PG8_WAIT_V(0);
    if constexpr (!ALIGN_EPI) { if (wr == 0) PG8_BAR; }
    PG8_BAR;
    if constexpr (Epi::AFTER_DRAIN) { E.fused(acc, cur, wr, wc, fr, fq, lds, wid, lane); S.done(cur); }
#undef PG8_SA
#undef PG8_SB
#undef PG8_STAGE
#undef PG8_LDA
#undef PG8_LDB
#undef PG8_MMA
#undef PG8_WAIT_V
#undef PG8_WAIT_L
#undef PG8_BAR
#undef PG8_SCHED
}
}
namespace pg8 {
typedef unsigned u32x2 __attribute__((ext_vector_type(2)));
typedef float f32x2_t __attribute__((ext_vector_type(2))); typedef __bf16 bf16x2_t __attribute__((ext_vector_type(2)));
__device__ __forceinline__ unsigned cvtpk(float lo, float hi) { f32x2_t v = {lo, hi}; bf16x2_t b = __builtin_convertvector(v, bf16x2_t); return __builtin_bit_cast(unsigned, b); }
__device__ __forceinline__ float sigm(float x) { return __builtin_amdgcn_rcpf(1.0f + __expf(-x)); }
__device__ __forceinline__ float gelu_tanh(float x) { const float u = 1.5957691216057308f * (x + 0.044715f * x * x * x); return x * __builtin_amdgcn_rcpf(1.0f + __expf(-u)); }
__device__ __forceinline__ float bfw(unsigned w, int hi) { return __uint_as_float(hi ? (w & 0xffff0000u) : (w << 16)); }
__device__ __forceinline__ float logsig(float z) { return fminf(z, 0.f) - log1pf(__expf(-fabsf(z))); }
__device__ __forceinline__ float dpp_ror1(float v) { return __int_as_float(__builtin_amdgcn_update_dpp(__float_as_int(v), __float_as_int(v), 0x121, 0xf, 0xf, false)); }
__device__ __forceinline__ float dpp_ror2(float v) { return __int_as_float(__builtin_amdgcn_update_dpp(__float_as_int(v), __float_as_int(v), 0x122, 0xf, 0xf, false)); }

struct EpiProj {
    static constexpr bool PERM = true, AFTER_DRAIN = false;
    bf16_t* O; int ldc; const float* ss;
    __device__ __forceinline__ void operator()(const f32x4 (&acc)[2][2][4][2], const Unit& u, int wr, int wc, int fr, int fq) const {
        const int row0 = u.pm * BM + wr * 64 + fr, col0 = u.pn * BM + wc * 32 + 8 * fq;
#pragma unroll
        for (int ai = 0; ai < 2; ++ai)
#pragma unroll
            for (int m = 0; m < 4; ++m) {
                const int row = row0 + ai * HALF + m * 16;
                const float rs = rsqrtf(ss[row] * (1.0f / 1024.0f) + 1e-6f);
                bf16_t* rowp = O + (size_t)row * ldc + col0;
#pragma unroll
                for (int bj = 0; bj < 2; ++bj) {
                    const f32x4 v0 = acc[ai][bj][m][0] * rs, v1 = acc[ai][bj][m][1] * rs;
                    u32x4 w; w.x = cvt_pk_bf16(v0[0], v0[1]); w.y = cvt_pk_bf16(v0[2], v0[3]); w.z = cvt_pk_bf16(v1[0], v1[1]); w.w = cvt_pk_bf16(v1[2], v1[3]);
                    *(u32x4*)(rowp + bj * HALF) = w;
                }
            }
    }
};

struct EpiGates {
    static constexpr bool PERM = true, AFTER_DRAIN = false;
    const bf16_t* xc; bf16_t* loga; bf16_t* gi; const float* ga_b; const float* gx_b; const float* lam;
    __device__ __forceinline__ void operator()(const f32x4 (&acc)[2][2][4][2], const Unit& u, int wr, int wc, int fr, int fq) const {
        const int row0 = u.pm * BM + wr * 64 + fr, ch0 = u.pn * HALF + wc * 32 + 8 * fq;
        float gab[8], gxb[8], ls[8];
#pragma unroll
        for (int e = 0; e < 8; ++e) { gab[e] = ga_b[ch0 + e]; gxb[e] = gx_b[ch0 + e]; ls[e] = 8.0f * logsig(lam[ch0 + e]); }
#pragma unroll
        for (int ai = 0; ai < 2; ++ai)
#pragma unroll
            for (int m = 0; m < 4; ++m) {
                const int row = row0 + ai * HALF + m * 16;
                const u32x4 xv = *(const u32x4*)(xc + (size_t)row * 512 + ch0);
                float la[8], g[8];
#pragma unroll
                for (int n = 0; n < 2; ++n)
#pragma unroll
                    for (int e = 0; e < 4; ++e) {
                        const int idx = 4 * n + e;
                        const float r = acc[ai][0][m][n][e] + gab[idx], i = acc[ai][1][m][n][e] + gxb[idx];
                        la[idx] = sigm(r) * ls[idx];
                        g[idx] = sigm(i) * bfw(xv[idx >> 1], idx & 1);
                    }
                u32x4 w; w.x = cvt_pk_bf16(la[0], la[1]); w.y = cvt_pk_bf16(la[2], la[3]); w.z = cvt_pk_bf16(la[4], la[5]); w.w = cvt_pk_bf16(la[6], la[7]);
                *(u32x4*)(loga + (size_t)row * 512 + ch0) = w;
                u32x4 w2; w2.x = cvt_pk_bf16(g[0], g[1]); w2.y = cvt_pk_bf16(g[2], g[3]); w2.z = cvt_pk_bf16(g[4], g[5]); w2.w = cvt_pk_bf16(g[6], g[7]);
                *(u32x4*)(gi + (size_t)row * 512 + ch0) = w2;
            }
    }
};

struct EpiRes {
    static constexpr bool PERM = false, AFTER_DRAIN = false;
    const float* base; float* out; bf16_t* xb; float* ss;
    __device__ __forceinline__ void operator()(const f32x4 (&acc)[2][2][4][2], const Unit& u, int wr, int wc, int fr, int fq) const {
        const int row0 = u.pm * BM + wr * 64 + fr, col0 = u.pn * BM + wc * 32 + 4 * fq;
#pragma unroll
        for (int ai = 0; ai < 2; ++ai)
#pragma unroll
            for (int m = 0; m < 4; ++m) {
                const int row = row0 + ai * HALF + m * 16; float q = 0.f;
#pragma unroll
                for (int bj = 0; bj < 2; ++bj)
#pragma unroll
                    for (int n = 0; n < 2; ++n) {
                        const size_t off = (size_t)row * 1024 + col0 + bj * HALF + n * 16;
                        const f32x4 b = *(const f32x4*)(base + off);
                        const f32x4 o = b + acc[ai][bj][m][n];
                        *(f32x4*)(out + off) = o;
                        if (xb) { u32x2 w; w.x = cvt_pk_bf16(o[0], o[1]); w.y = cvt_pk_bf16(o[2], o[3]); *(u32x2*)(xb + off) = w; }
                        q += (o[0] * o[0] + o[1] * o[1]) + (o[2] * o[2] + o[3] * o[3]);
                    }
                if (ss) { q += __shfl_xor(q, 16); q += __shfl_xor(q, 32); if (fq == 0) atomicAdd(ss + row, q); }
            }
    }
};

struct EpiGlu {
    static constexpr bool PERM = true, AFTER_DRAIN = false;
    const bf16_t* ys; bf16_t* ycat; const float* bias;
    __device__ __forceinline__ void operator()(const f32x4 (&acc)[2][2][4][2], const Unit& u, int wr, int wc, int fr, int fq) const {
        const int row0 = u.pm * BM + wr * 64 + fr, col0 = u.pn * BM + wc * 32 + 8 * fq;
#pragma unroll
        for (int bj = 0; bj < 2; ++bj) {
            const int col = col0 + bj * HALF;
            float bs[8];
#pragma unroll
            for (int e = 0; e < 8; ++e) bs[e] = bias[col + e];
#pragma unroll
            for (int ai = 0; ai < 2; ++ai)
#pragma unroll
                for (int m = 0; m < 4; ++m) {
                    const int row = row0 + ai * HALF + m * 16;
                    const u32x4 yv = *(const u32x4*)(ys + (size_t)row * 512 + col);
                    float o[8];
#pragma unroll
                    for (int n = 0; n < 2; ++n)
#pragma unroll
                        for (int e = 0; e < 4; ++e) { const int idx = 4 * n + e; o[idx] = bfw(yv[idx >> 1], idx & 1) * sigm(acc[ai][bj][m][n][e] + bs[idx]); }
                    u32x4 w; w.x = cvt_pk_bf16(o[0], o[1]); w.y = cvt_pk_bf16(o[2], o[3]); w.z = cvt_pk_bf16(o[4], o[5]); w.w = cvt_pk_bf16(o[6], o[7]);
                    *(u32x4*)(ycat + (size_t)row * 1024 + col) = w;
                }
        }
    }
};

struct EpiFfn {
    static constexpr bool PERM = true, AFTER_DRAIN = false;
    bf16_t* U; const float* ss; const float* cw; const float* cb; float* edgeA; float* edgeL; float* tailA; PG8_LAS float* halo;
    __device__ __forceinline__ void operator()(const f32x4 (&acc)[2][2][4][2], const Unit& u, int wr, int wc, int fr, int fq) const {
        const int cl = wc * 32 + 8 * fq, ch0 = u.pn * HALF + cl;
        const int row0 = u.pm * BM + wr * 64 + fr;
        float w0[8], w1[8], w2[8], bb[8];
#pragma unroll
        for (int e = 0; e < 8; ++e) { w0[e] = cw[ch0 + e]; w1[e] = cw[3072 + ch0 + e]; w2[e] = cw[6144 + ch0 + e]; bb[e] = cb[ch0 + e]; }
        float rs[2][4];
#pragma unroll
        for (int ai = 0; ai < 2; ++ai)
#pragma unroll
            for (int m = 0; m < 4; ++m) rs[ai][m] = rsqrtf(ss[row0 + ai * HALF + m * 16] * (1.0f / 1024.0f) + 1e-6f);
        if (fr >= 14) {
#pragma unroll
            for (int ai = 0; ai < 2; ++ai) {
                PG8_LAS float* hp = halo + ((ai * 2 + wr) * 2 + (fr - 14)) * 128 + cl;
                *(PG8_LAS f32x4*)hp = acc[ai][0][3][0] * rs[ai][3];
                *(PG8_LAS f32x4*)(hp + 4) = acc[ai][0][3][1] * rs[ai][3];
            }
            if (wr == 1) {
                float* tp = tailA + (size_t)(u.pm * 2 + (fr - 14)) * 3072 + ch0;
                *(f32x4*)tp = acc[1][0][3][0] * rs[1][3]; *(f32x4*)(tp + 4) = acc[1][0][3][1] * rs[1][3];
            }
        }
        if (wr == 0 && fr < 2) {
            float* ea = edgeA + (size_t)(u.pm * 2 + fr) * 3072 + ch0; float* el = edgeL + (size_t)(u.pm * 2 + fr) * 3072 + ch0;
            *(f32x4*)ea = acc[0][0][0][0] * rs[0][0]; *(f32x4*)(ea + 4) = acc[0][0][0][1] * rs[0][0];
            *(f32x4*)el = acc[0][1][0][0] * rs[0][0]; *(f32x4*)(el + 4) = acc[0][1][0][1] * rs[0][0];
        }
        asm volatile("s_waitcnt lgkmcnt(0)" ::: "memory"); __builtin_amdgcn_s_barrier(); asm volatile("" ::: "memory");
#pragma unroll
        for (int ai = 0; ai < 2; ++ai) {
            f32x4 pv[2];
            if (ai == 0 && wr == 0) { pv[0] = (f32x4){0.f, 0.f, 0.f, 0.f}; pv[1] = pv[0]; }
            else {
                const int pai = (wr == 1) ? ai : 0, pwr = (wr == 1) ? 0 : 1;
                const PG8_LAS float* hp = halo + ((pai * 2 + pwr) * 2 + (fr & 1)) * 128 + cl;
                pv[0] = *(const PG8_LAS f32x4*)hp; pv[1] = *(const PG8_LAS f32x4*)(hp + 4);
            }
#pragma unroll
            for (int m = 0; m < 4; ++m) {
                const int row = row0 + ai * HALF + m * 16;
                f32x4 av[2]; av[0] = acc[ai][0][m][0] * rs[ai][m]; av[1] = acc[ai][0][m][1] * rs[ai][m];
                float o[8];
#pragma unroll
                for (int n = 0; n < 2; ++n)
#pragma unroll
                    for (int e = 0; e < 4; ++e) {
                        const int idx = 4 * n + e;
                        const float cur = av[n][e], prv = pv[n][e];
                        const float r1c = dpp_ror1(cur), r1p = dpp_ror1(prv), r2c = dpp_ror2(cur), r2p = dpp_ror2(prv);
                        const float t1 = (fr >= 1) ? r1c : r1p, t2 = (fr >= 2) ? r2c : r2p;
                        const float cv = w0[idx] * t2 + w1[idx] * t1 + w2[idx] * cur + bb[idx];
                        o[idx] = gelu_tanh(cv) * (acc[ai][1][m][n][e] * rs[ai][m]);
                    }
                u32x4 w; w.x = cvt_pk_bf16(o[0], o[1]); w.y = cvt_pk_bf16(o[2], o[3]); w.z = cvt_pk_bf16(o[4], o[5]); w.w = cvt_pk_bf16(o[6], o[7]);
                *(u32x4*)(U + (size_t)row * 3072 + ch0) = w;
                pv[0] = av[0]; pv[1] = av[1];
            }
        }
    }
};
}
#define LAS __attribute__((address_space(3)))
typedef unsigned short bf16;
typedef short bf16x8 __attribute__((ext_vector_type(8)));
typedef float f32x4 __attribute__((ext_vector_type(4)));
typedef unsigned u32x4 __attribute__((ext_vector_type(4)));
typedef unsigned u32x2 __attribute__((ext_vector_type(2)));
using pg8::cvt_pk_bf16; using pg8::sigm; using pg8::gelu_tanh; using pg8::bfw; using pg8::logsig;

constexpr int TT = 16384, SEQ = 8192, DM = 1024, DFF = 3072;
constexpr size_t MiB = 1u << 20;
constexpr size_t WS_SS = 0;
constexpr size_t WS_SUMA = 256 * 1024, WS_SUMB = 768 * 1024;
constexpr size_t WS_DECAY = 1280 * 1024;
constexpr size_t WS_BARRIER = 3 * 1024 * 1024;
constexpr size_t WS_ROPE = 1536 * 1024;
constexpr size_t WS_W_EIN = 4 * MiB, WS_W_EOUT = 9 * MiB, WS_W_GATE = 11 * MiB, WS_W_FIN0 = 12 * MiB, WS_W_FIN1 = 24 * MiB, WS_W_FOUT0 = 36 * MiB, WS_W_FOUT1 = 42 * MiB;
constexpr size_t WS_W_OIN = 48 * MiB, WS_W_GLU = 53 * MiB, WS_W_OOUT = 54 * MiB, WS_S5A = 56 * MiB, WS_S5F = 62 * MiB;
constexpr size_t WS_XB = 64 * MiB;
constexpr size_t WS_LOGA = 64 * MiB, WS_GI = 80 * MiB;
constexpr size_t WS_KDT = 64 * MiB, WS_VTG = 72 * MiB, WS_SX = 88 * MiB;
constexpr size_t WS_BIG = 96 * MiB;
constexpr size_t WS_XC = 224 * MiB, WS_KVS = 168 * MiB;
constexpr size_t WS_YCAT = 192 * MiB;
constexpr size_t WS_XLOC = 224 * MiB;
constexpr size_t WS_EDGEA = 240 * MiB, WS_EDGEL = 242 * MiB, WS_TAILA = 244 * MiB;
constexpr size_t WS_END = 256 * MiB;
constexpr int P0LD = 2568, P1LD = 2304;
constexpr int VTP = SEQ + 128;
constexpr int LDS_BYTES = 147456, HALO_OFF = 131072 + 1024;

__device__ __forceinline__ float wave_sum(float v) {
#pragma unroll
    for (int o = 1; o < 64; o <<= 1) v += __shfl_xor(v, o);
    return v;
}
__device__ __forceinline__ float bf2f(bf16 b) { return __uint_as_float((unsigned)b << 16); }
__device__ __forceinline__ bf16 f2bf(float f) { return (bf16)(cvt_pk_bf16(f, 0.f) & 0xffffu); }
__device__ __forceinline__ f32x4 mfma16(bf16x8 a, bf16x8 b, f32x4 c) { return __builtin_amdgcn_mfma_f32_16x16x32_bf16(a, b, c, 0, 0, 0); }
__device__ __forceinline__ bf16x8 ld8(const bf16* p) { return *(const bf16x8*)p; }
__device__ __forceinline__ void unpack8(u32x4 v, float* f) {
#pragma unroll
    for (int i = 0; i < 4; ++i) { f[2 * i] = __uint_as_float(v[i] << 16); f[2 * i + 1] = __uint_as_float(v[i] & 0xffff0000u); }
}
__device__ __forceinline__ u32x4 pack8v(const float* f) { u32x4 w; w.x = pg8::cvtpk(f[0], f[1]); w.y = pg8::cvtpk(f[2], f[3]); w.z = pg8::cvtpk(f[4], f[5]); w.w = pg8::cvtpk(f[6], f[7]); return w; }
__device__ __forceinline__ u32x4 pack8(const float* f) { u32x4 w; w.x = cvt_pk_bf16(f[0], f[1]); w.y = cvt_pk_bf16(f[2], f[3]); w.z = cvt_pk_bf16(f[4], f[5]); w.w = cvt_pk_bf16(f[6], f[7]); return w; }

struct Ctx { int tid, lane, wave, gw, ngw, gtid, ngt; LAS unsigned char* lds; };

struct TrDesc { const float* W; const float* gk; bf16* WT; int ldw, nsrc, ldt, k0, n0, dst_row0; };
__device__ __forceinline__ void tr_load(const TrDesc& t, int lane, float* v) {
    const int n = t.n0 + (lane & 31);
#pragma unroll
    for (int i = 0; i < 32; ++i) { const int kk = 2 * i + (lane >> 5); v[i] = (n < t.nsrc) ? t.W[(size_t)(t.k0 + kk) * t.ldw + n] : 0.f; }
}
__device__ __forceinline__ void tr_finish(const TrDesc& t, int lane, const float* v, LAS float* scr) {
#pragma unroll
    for (int i = 0; i < 32; ++i) { const int kk = 2 * i + (lane >> 5); float x = v[i]; if (t.gk) x *= t.gk[t.k0 + kk]; scr[kk * 33 + (lane & 31)] = x; }
    asm volatile("s_waitcnt lgkmcnt(0)" ::: "memory");
    const int c = lane & 7;
#pragma unroll
    for (int j = 0; j < 4; ++j) {
        const int n = (lane >> 3) + 8 * j; const LAS float* s = scr + (8 * c) * 33 + n;
        u32x4 o; o.x = cvt_pk_bf16(s[0], s[33]); o.y = cvt_pk_bf16(s[66], s[99]); o.z = cvt_pk_bf16(s[132], s[165]); o.w = cvt_pk_bf16(s[198], s[231]);
        *(u32x4*)(t.WT + (size_t)(t.dst_row0 + n) * t.ldt + t.k0 + 8 * c) = o;
    }
    asm volatile("s_waitcnt lgkmcnt(0)" ::: "memory");
}

struct S5P { float m, th, cr, ci, ar, ai; };
__device__ __forceinline__ S5P s5_params(const float* lam_re, const float* lam_im, const float* log_step, int g, int n) {
    const float step = expf(log_step[g]), lr = lam_re[g * 64 + n], li = lam_im[g * 64 + n];
    S5P p; p.m = lr * step; p.th = li * step;
    float sn, cs; sincosf(p.th, &sn, &cs);
    const float mag = expf(p.m), ar = mag * cs, ai = mag * sn, den = lr * lr + li * li;
    p.cr = ((ar - 1.0f) * lr + ai * li) / den; p.ci = (ai * lr - (ar - 1.0f) * li) / den; p.ar = ar; p.ai = ai;
    return p;
}
__device__ __forceinline__ void s5_pow(const S5P& p, float tau, float& pr, float& pi) {
    float sn, cs; sincosf(p.th * tau, &sn, &cs); const float mag = expf(p.m * tau); pr = mag * cs; pi = mag * sn;
}

__device__ __forceinline__ TrDesc tr_decode(const float* const* in, unsigned char* ws, int it) {
    constexpr int I_EIN = 16 * 80, I_EOUT = 16 * 32, I_FIN = 16 * 192, I_FOUT = 48 * 32, I_OIN = 16 * 72, I_GLU = 8 * 16;
    TrDesc t; int r = it;
    if (r < I_EIN) { const int kb = r / 80, nb = r % 80; t = TrDesc{in[2], in[1], (bf16*)(ws + WS_W_EIN), 2560, 2560, 1024, 64 * kb, 32 * nb, 32 * nb}; return t; } r -= I_EIN;
    if (r < I_EOUT) { const int kb = r / 32, nb = r % 32; t = TrDesc{in[12], nullptr, (bf16*)(ws + WS_W_EOUT), 1024, 1024, 1024, 64 * kb, 32 * nb, 32 * nb}; return t; } r -= I_EOUT;
    if (r < 2 * I_FIN) { const int l = r / I_FIN; r %= I_FIN; const int kb = r / 192, nb = r % 192, n0 = 32 * nb;
        const int dst = (n0 < 3072) ? (256 * (n0 / 128) + (n0 % 128)) : (256 * ((n0 - 3072) / 128) + 128 + ((n0 - 3072) % 128));
        t = TrDesc{in[30] + (size_t)l * 1024 * 6144, in[29] + l * 1024, (bf16*)(ws + (l ? WS_W_FIN1 : WS_W_FIN0)), 6144, 6144, 1024, 64 * kb, n0, dst}; return t; } r -= 2 * I_FIN;
    if (r < 2 * I_FOUT) { const int l = r / I_FOUT; r %= I_FOUT; const int kb = r / 32, nb = r % 32;
        t = TrDesc{in[33] + (size_t)l * 3072 * 1024, nullptr, (bf16*)(ws + (l ? WS_W_FOUT1 : WS_W_FOUT0)), 1024, 1024, 3072, 64 * kb, 32 * nb, 32 * nb}; return t; } r -= 2 * I_FOUT;
    if (r < I_OIN) { const int kb = r / 72, nb = r % 72; t = TrDesc{in[14], in[13], (bf16*)(ws + WS_W_OIN), 2064, 2064, 1024, 64 * kb, 32 * nb, 32 * nb}; return t; } r -= I_OIN;
    if (r < I_GLU) { const int kb = r / 16, nb = r % 16; t = TrDesc{in[23], nullptr, (bf16*)(ws + WS_W_GLU), 512, 512, 512, 64 * kb, 32 * nb, 32 * nb}; return t; } r -= I_GLU;
    { const int kb = r / 32, nb = r % 32; t = TrDesc{in[28], nullptr, (bf16*)(ws + WS_W_OOUT), 1024, 1024, 1024, 64 * kb, 32 * nb, 32 * nb}; return t; }
}
__device__ __forceinline__ void do_tr_items(const Ctx& c, const float* const* in, unsigned char* ws, int it_begin, int it_end, int widx, int nw) {
    LAS float* scr = (LAS float*)(c.lds + c.wave * 16384);
    int it = it_begin + widx;
    if (it >= it_end) return;
    TrDesc cur = tr_decode(in, ws, it); float v[32]; tr_load(cur, c.lane, v);
    for (;;) {
        const int nx = it + nw; const bool more = nx < it_end;
        TrDesc nxt = cur; float w[32];
        if (more) { nxt = tr_decode(in, ws, nx); tr_load(nxt, c.lane, w); }
        tr_finish(cur, c.lane, v, scr);
        if (!more) break;
        cur = nxt; it = nx;
#pragma unroll
        for (int i = 0; i < 32; ++i) v[i] = w[i];
    }
}
#ifndef DEFER_TR
#define DEFER_TR 0
#endif
#ifndef DEFER_P1
#define DEFER_P1 0
#endif
constexpr int TR_EIN0 = 0, TR_EOUT0 = 1280, TR_FIN00 = 1792, TR_FIN10 = 4864, TR_FOUT00 = 7936, TR_FOUT10 = 9472, TR_OIN0 = 11008, TR_GLU0 = 12160, TR_OOUT0 = 12288, TR_END = 12800;

__device__ __forceinline__ void phase_prologue(const Ctx& c, const float* const* in, unsigned char* ws) {
#if DEFER_TR
    do_tr_items(c, in, ws, TR_EIN0, TR_EOUT0, c.gw, c.ngw);
#elif DEFER_P1
    do_tr_items(c, in, ws, TR_EIN0, TR_EOUT0, c.gw, c.ngw); do_tr_items(c, in, ws, TR_FIN10, TR_END, c.gw, c.ngw);
#else
    do_tr_items(c, in, ws, TR_EIN0, TR_END, c.gw, c.ngw);
#endif
    {
        const float* x = in[0]; bf16* xb = (bf16*)(ws + WS_XB); float* ss = (float*)(ws + WS_SS);
        for (int m0 = c.gw; m0 < TT; m0 += 2 * c.ngw) {
            f32x4 v[2][4];
#pragma unroll
            for (int u = 0; u < 2; ++u) { const f32x4* xr = (const f32x4*)(x + (size_t)(m0 + u * c.ngw) * DM) + c.lane;
#pragma unroll
                for (int j = 0; j < 4; ++j) v[u][j] = xr[64 * j]; }
#pragma unroll
            for (int u = 0; u < 2; ++u) { const int m = m0 + u * c.ngw; float s = 0.f;
                u32x2* o8 = (u32x2*)(xb + (size_t)m * DM) + c.lane;
#pragma unroll
                for (int j = 0; j < 4; ++j) { const f32x4 q = v[u][j]; s += (q.x * q.x + q.y * q.y) + (q.z * q.z + q.w * q.w); u32x2 w; w.x = cvt_pk_bf16(q.x, q.y); w.y = cvt_pk_bf16(q.z, q.w); o8[64 * j] = w; }
                s = wave_sum(s);
                if (c.lane == 0) ss[m] = s; }
        }
        for (int i = c.gtid; i < 3 * TT; i += c.ngt) ss[TT + i] = 0.f;
    }
    {
        bf16* G = (bf16*)(ws + WS_W_GATE);
        for (int i = c.gtid; i < 1024 * 512; i += c.ngt) {
            const int R = i >> 9, k = i & 511, pn = R >> 8, half = (R >> 7) & 1, ch = 128 * pn + (R & 127), h = ch >> 6, j = ch & 63;
            float v = 0.f;
            if ((k >> 6) == h) v = (half ? in[7] : in[5])[(h * 64 + (k & 63)) * 64 + j];
            G[i] = f2bf(v);
        }
    }
    {
        float* RT = (float*)(ws + WS_ROPE);
        for (int i = c.gtid; i < SEQ * 8; i += c.ngt) {
            const int pos = i >> 3, e = i & 7;
            const float inv = powf(500000.0f, -(float)e * 0.125f);
            float sn, cs; sincosf((float)pos * inv, &sn, &cs);
            RT[pos * 16 + e] = cs; RT[pos * 16 + 8 + e] = sn;
        }
    }
}
__device__ __forceinline__ void phase_s5_mats(const Ctx& c, const float* const* in, unsigned char* ws) {
    {
        const float *lam_re = in[15], *lam_im = in[16], *b_re = in[17], *b_im = in[18], *c_re = in[19], *c_im = in[20], *lstep = in[22];
        bf16* AM = (bf16*)(ws + WS_S5A);
        bf16* FM = (bf16*)(ws + WS_S5F);
        for (int i = c.gtid; i < 32 * 256 * 4; i += c.ngt) {
            const int nq = i & 3, pp = (i >> 2) & 15, p = (i >> 6) & 15, g = i >> 10;
            float acc[16];
#pragma unroll
            for (int t = 0; t < 16; ++t) acc[t] = 0.f;
            for (int n = nq * 16; n < nq * 16 + 16; ++n) {
                const S5P sp = s5_params(lam_re, lam_im, lstep, g, n);
                const float br = b_re[(g * 64 + n) * 16 + pp], bi = b_im[(g * 64 + n) * 16 + pp];
                const float bbr = sp.cr * br - sp.ci * bi, bbi = sp.cr * bi + sp.ci * br;
                const float cr_ = c_re[(g * 16 + p) * 64 + n], ci_ = c_im[(g * 16 + p) * 64 + n];
                float zr = cr_ * bbr - ci_ * bbi, zi = cr_ * bbi + ci_ * bbr;
#pragma unroll
                for (int t = 0; t < 16; ++t) { acc[t] += zr; const float nr = zr * sp.ar - zi * sp.ai, ni = zr * sp.ai + zi * sp.ar; zr = nr; zi = ni; }
            }
            bf16* Ag = AM + (size_t)g * 256 * 384;
#pragma unroll
            for (int tau = 0; tau < 16; ++tau) {
                float v = acc[tau]; v += __shfl_xor(v, 1); v += __shfl_xor(v, 2);
                if ((tau & 3) == nq) {
                    const bf16 kv = f2bf(v);
                    for (int t = tau; t < 16; ++t) Ag[(t * 16 + p) * 384 + (t - tau) * 16 + pp] = kv;
                    if (tau >= 1) for (int t = 0; t + tau < 16; ++t) Ag[(t * 16 + p) * 384 + (t + tau) * 16 + pp] = 0;
                }
            }
        }
        for (int i = (c.gtid + c.ngt - c.ngt / 4) % c.ngt; i < 32 * 16 * 64; i += c.ngt) {
            const int g = i >> 10, p = (i >> 6) & 15, n = i & 63;
            const S5P sp = s5_params(lam_re, lam_im, lstep, g, n);
            const float cr_ = c_re[(g * 16 + p) * 64 + n], ci_ = c_im[(g * 16 + p) * 64 + n];
            float pr = sp.ar, pi = sp.ai;
            for (int t = 0; t < 16; ++t) {
                bf16* row = AM + ((size_t)g * 256 + t * 16 + p) * 384 + 256;
                row[n] = f2bf(cr_ * pr - ci_ * pi);
                row[64 + n] = f2bf(-(cr_ * pi + ci_ * pr));
                const float nr = pr * sp.ar - pi * sp.ai, ni = pr * sp.ai + pi * sp.ar; pr = nr; pi = ni;
            }
        }
        for (int i = (c.gtid + c.ngt - c.ngt / 2) % c.ngt; i < 32 * 64 * 16; i += c.ngt) {
            const int g = i >> 10, n = (i >> 4) & 63, pp = i & 15;
            const S5P sp = s5_params(lam_re, lam_im, lstep, g, n);
            const float br = b_re[(g * 64 + n) * 16 + pp], bi = b_im[(g * 64 + n) * 16 + pp];
            const float bbr = sp.cr * br - sp.ci * bi, bbi = sp.cr * bi + sp.ci * br;
            float pr = 1.f, pi = 0.f;
            for (int s = 15; s >= 0; --s) {
                FM[((size_t)g * 128 + n) * 256 + s * 16 + pp] = f2bf(pr * bbr - pi * bbi);
                FM[((size_t)g * 128 + 64 + n) * 256 + s * 16 + pp] = f2bf(pr * bbi + pi * bbr);
                const float nr = pr * sp.ar - pi * sp.ai, ni = pr * sp.ai + pi * sp.ar; pr = nr; pi = ni;
            }
        }
    }
}

__device__ __forceinline__ u32x4 vt_load(const bf16* src, int pitch, int coloff, int hd, int nh, int sh, int item, int lane) {
    const int cgp = item & 1023; int r = item >> 10; const int nblk = hd >> 6, dblk = r % nblk, bh = r / nblk, b = bh / nh, h = bh % nh;
    const int d = dblk * 64 + lane, Ld = SEQ >> sh;
    const bf16* s = src + (size_t)b * SEQ * pitch + coloff + h * hd + d;
    unsigned short v[8];
#pragma unroll
    for (int i = 0; i < 8; ++i) { const int col = cgp * 8 + i, rres = col / Ld, l = col - rres * Ld, t = (l << sh) + rres; v[i] = s[(size_t)t * pitch]; }
    u32x4 w; w.x = v[0] | ((unsigned)v[1] << 16); w.y = v[2] | ((unsigned)v[3] << 16); w.z = v[4] | ((unsigned)v[5] << 16); w.w = v[6] | ((unsigned)v[7] << 16);
    return w;
}
__device__ __forceinline__ void vt_store(u32x4 w, int hd, bf16* dst, int dpitch, int item, int lane) {
    const int cgp = item & 1023; int r = item >> 10; const int nblk = hd >> 6, dblk = r % nblk, bh = r / nblk;
    const int d = dblk * 64 + lane;
    *(u32x4*)(dst + ((size_t)bh * hd + d) * dpitch + cgp * 8) = w;
}
__device__ __forceinline__ void vt_store_blk(u32x4 w, bf16* dst, int item, int lane) {
    const int cgp = item & 1023, bh = item >> 10, dt = lane >> 4, dl = lane & 15, col0 = cgp * 8;
    *(u32x4*)(dst + ((size_t)((bh * 4 + dt) * 256 + (col0 >> 5))) * 512 + dl * 32 + (col0 & 31)) = w;
}
__device__ __forceinline__ void vt_run(const Ctx& c, const bf16* src, int pitch, int coloff, int hd, int nh, bf16* dst, int dpitch, int sh, int nitems) {
    for (int it0 = c.gw; it0 < nitems; it0 += 8 * c.ngw) {
        u32x4 w[8];
#pragma unroll
        for (int u = 0; u < 8; ++u) { const int it = it0 + u * c.ngw; if (it < nitems) w[u] = vt_load(src, pitch, coloff, hd, nh, sh, it, c.lane); }
#pragma unroll
        for (int u = 0; u < 8; ++u) { const int it = it0 + u * c.ngw; if (it < nitems) { if (dpitch == 0) vt_store_blk(w[u], dst, it, c.lane); else vt_store(w[u], hd, dst, dpitch, it, c.lane); } }
    }
}

__device__ __forceinline__ void vt32_load(const bf16* src, int sh, int item, int lane, u32x4* w) {
    const int kb = item & 255, bh = item >> 8, b = bh >> 3, h = bh & 7, Ld = SEQ >> sh;
    const bf16* s = src + (size_t)b * SEQ * P0LD + 2048 + h * 64 + lane;
    const int col0 = kb * 32, rres = col0 / Ld, l0 = col0 - rres * Ld;
    unsigned short v[32];
#pragma unroll
    for (int i = 0; i < 32; ++i) v[i] = s[(size_t)(((l0 + i) << sh) + rres) * P0LD];
#pragma unroll
    for (int q = 0; q < 4; ++q) { w[q].x = v[8 * q] | ((unsigned)v[8 * q + 1] << 16); w[q].y = v[8 * q + 2] | ((unsigned)v[8 * q + 3] << 16); w[q].z = v[8 * q + 4] | ((unsigned)v[8 * q + 5] << 16); w[q].w = v[8 * q + 6] | ((unsigned)v[8 * q + 7] << 16); }
}
__device__ __forceinline__ void vt32_store(const u32x4* w, bf16* dst, int p, int item, int lane) {
    const int kb = item & 255, bh = item >> 8;
    bf16* o = (p == 0) ? dst + ((size_t)bh * 64 + lane) * VTP + kb * 32 : dst + ((size_t)((bh * 4 + (lane >> 4)) * 256 + kb)) * 512 + (lane & 15) * 32;
#pragma unroll
    for (int q = 0; q < 4; ++q) *(u32x4*)(o + 8 * q) = w[q];
}
__device__ __forceinline__ void phase_prep0(const Ctx& c, const float* const* in, unsigned char* ws, float* dout) {
    bf16* P0 = (bf16*)(ws + WS_BIG); bf16* XC = (bf16*)(ws + WS_XC);
    const float* cw = in[3]; const float* cbias = in[4];
    for (int i0 = c.gtid; i0 < TT * 64; i0 += 2 * c.ngt) {
        u32x4 raw[2][4];
#pragma unroll
        for (int u = 0; u < 2; ++u) { const int i = i0 + u * c.ngt, t = i >> 6, c0 = (i & 63) * 8, tl = t & (SEQ - 1);
#pragma unroll
            for (int j = 0; j < 4; ++j) raw[u][j] = (tl - 3 + j >= 0) ? *(const u32x4*)(P0 + (size_t)(t - 3 + j) * P0LD + c0) : (u32x4){0u, 0u, 0u, 0u}; }
#pragma unroll
        for (int u = 0; u < 2; ++u) { const int i = i0 + u * c.ngt, t = i >> 6, c0 = (i & 63) * 8;
            float acc[8];
#pragma unroll
            for (int e = 0; e < 8; ++e) acc[e] = cbias[c0 + e];
#pragma unroll
            for (int j = 0; j < 4; ++j) { float v[8]; unpack8(raw[u][j], v);
#pragma unroll
                for (int e = 0; e < 8; ++e) acc[e] += cw[j * 512 + c0 + e] * v[e]; }
            *(u32x4*)(XC + (size_t)t * 512 + c0) = pack8(acc); }
    }
    for (int it0 = c.gw * 4; it0 < 2 * TT; it0 += c.ngw * 4) {
        const int sub = c.lane & 7;
        u32x4 raw[4];
#pragma unroll
        for (int u = 0; u < 4; ++u) { const int it = it0 + u, t = it >> 1, which = it & 1; raw[u] = *(const u32x4*)(P0 + (size_t)t * P0LD + 1024 + which * 512 + c.lane * 8); }
#pragma unroll
        for (int u = 0; u < 4; ++u) {
            const int it = it0 + u, t = it >> 1, which = it & 1;
            bf16* p = P0 + (size_t)t * P0LD + 1024 + which * 512 + c.lane * 8;
            float v[8]; unpack8(raw[u], v);
            float s = 0.f;
#pragma unroll
            for (int e = 0; e < 8; ++e) s += v[e] * v[e];
            s += __shfl_xor(s, 1); s += __shfl_xor(s, 2); s += __shfl_xor(s, 4);
            const float rs = rsqrtf(s * (1.0f / 64.0f) + 1e-6f);
            const float* gn = (which ? in[11] : in[10]) + sub * 8;
#pragma unroll
            for (int e = 0; e < 8; ++e) v[e] = v[e] * rs * gn[e];
            float oth[8];
#pragma unroll
            for (int e = 0; e < 8; ++e) oth[e] = __shfl_xor(v[e], 1);
            if (sub < 2) {
                const float* rt = (const float*)(ws + WS_ROPE) + (t & (SEQ - 1)) * 16;
                const f32x4 c0 = *(const f32x4*)rt, c1 = *(const f32x4*)(rt + 4), s0 = *(const f32x4*)(rt + 8), s1 = *(const f32x4*)(rt + 12);
#pragma unroll
                for (int e = 0; e < 8; ++e) {
                    const float cs = (e < 4) ? c0[e & 3] : c1[e & 3], sn = (e < 4) ? s0[e & 3] : s1[e & 3];
                    v[e] = (sub == 0) ? (v[e] * cs - oth[e] * sn) : (v[e] * cs + oth[e] * sn);
                }
            }
            *(u32x4*)p = pack8(v);
        }
    }
    bf16* VT3 = (bf16*)dout;
    for (int it0 = c.gw; it0 < 3 * 4096; it0 += 2 * c.ngw) {
        u32x4 w[2][4];
#pragma unroll
        for (int u = 0; u < 2; ++u) { const int it = it0 + u * c.ngw; if (it < 3 * 4096) vt32_load(P0, 2 * (it >> 12), it & 4095, c.lane, w[u]); }
#pragma unroll
        for (int u = 0; u < 2; ++u) { const int it = it0 + u * c.ngw; if (it < 3 * 4096) vt32_store(w[u], VT3 + (size_t)(it >> 12) * (16 * 64 * VTP), it >> 12, it & 4095, c.lane); }
    }
}

#define ATT_D 2
constexpr int ATT_KP = 144, ATT_VP = 784, ATT_KBYTES = 384 * ATT_KP, ATT_LDS = ATT_KBYTES + 64 * ATT_VP;
struct AttState { float m, l; f32x4 o[4]; };
__device__ __forceinline__ void attn_math(const bf16x8 kx0, const bf16x8 kx1, const bf16x8 ky0, const bf16x8 ky1, const bf16x8 (&vf)[4], const bf16x8 qf0, const bf16x8 qf1,
                                          int lq, int kb, AttState& st) {
    const float cs = 0.125f * 1.4426950408889634f;
    f32x4 sx = mfma16(kx0, qf0, (f32x4){0.f, 0.f, 0.f, 0.f}); sx = mfma16(kx1, qf1, sx);
    f32x4 sy = mfma16(ky0, qf0, (f32x4){0.f, 0.f, 0.f, 0.f}); sy = mfma16(ky1, qf1, sy);
    float mx = -1e30f;
#pragma unroll
    for (int r = 0; r < 4; ++r) {
        sx[r] = ((unsigned)(lq - (kb + r)) <= 128u) ? sx[r] : -1e30f; sy[r] = ((unsigned)(lq - (kb + 4 + r)) <= 128u) ? sy[r] : -1e30f;
        mx = fmaxf(mx, fmaxf(sx[r], sy[r]));
    }
    { auto rr = __builtin_amdgcn_permlane32_swap(__float_as_uint(mx), __float_as_uint(mx), false, false); mx = fmaxf(__uint_as_float(rr[0]), __uint_as_float(rr[1]));
      rr = __builtin_amdgcn_permlane16_swap(__float_as_uint(mx), __float_as_uint(mx), false, false); mx = fmaxf(__uint_as_float(rr[0]), __uint_as_float(rr[1]));
      rr = __builtin_amdgcn_permlane32_swap(__float_as_uint(mx), __float_as_uint(mx), false, false); mx = fmaxf(__uint_as_float(rr[0]), __uint_as_float(rr[1])); }
    const float mn = fmaxf(st.m, mx), alpha = __builtin_amdgcn_exp2f((st.m - mn) * cs); st.m = mn;
    const float mref = fmaxf(mn, -1e29f) * cs;
    float pe[8]; float ps = 0.f;
#pragma unroll
    for (int r = 0; r < 4; ++r) { pe[r] = __builtin_amdgcn_exp2f(sx[r] * cs - mref); pe[4 + r] = __builtin_amdgcn_exp2f(sy[r] * cs - mref); ps += pe[r] + pe[4 + r]; }
    st.l = st.l * alpha + ps;
    const u32x4 pw = pack8v(pe);
    const bf16x8 pf = __builtin_bit_cast(bf16x8, pw);
#pragma unroll
    for (int dt = 0; dt < 4; ++dt) { st.o[dt] = st.o[dt] * alpha; st.o[dt] = mfma16(vf[dt], pf, st.o[dt]); }
}
__device__ __forceinline__ void attn_stage_p1(const Ctx& c, const bf16* P0, const bf16* VT3, int b, int h, int lb) {
    const int tok0 = 256 * lb - 128;
    u32x4 kr[6], vr[6];
#pragma unroll
    for (int i = 0; i < 6; ++i) { const int p = c.tid + 512 * i, row = p >> 3, c16 = p & 7; int tk = tok0 + row; if (tk < 0) tk = 0;
        kr[i] = *(const u32x4*)(P0 + (size_t)(b * SEQ + tk) * P0LD + 1536 + h * 64 + c16 * 8); }
#pragma unroll
    for (int i = 0; i < 6; ++i) { const int p = c.tid + 512 * i, d = p / 48, c16 = p - d * 48; int tk = tok0 + c16 * 8; if (tk < 0) tk = 0;
        vr[i] = *(const u32x4*)(VT3 + ((size_t)((b * 8 + h) * 64 + d)) * VTP + tk); }
#pragma unroll
    for (int i = 0; i < 6; ++i) { const int p = c.tid + 512 * i, row = p >> 3, c16 = p & 7; *(LAS u32x4*)(c.lds + row * ATT_KP + c16 * 16) = kr[i]; }
#pragma unroll
    for (int i = 0; i < 6; ++i) { const int p = c.tid + 512 * i, d = p / 48, c16 = p - d * 48; *(LAS u32x4*)(c.lds + ATT_KBYTES + d * ATT_VP + c16 * 16) = vr[i]; }
}
template <bool P1_LDS>
__device__ __forceinline__ void attn_item(const Ctx& c, const bf16* P0, const bf16* VT3, bf16* ycat, int item, int lane) {
    const int lb = item & 31, r16 = (item >> 5) & 15, h = (item >> 9) & 7, b = item >> 12;
    const int qi = lane & 15, g = lane >> 4;
    const int tq = r16 + 16 * (16 * lb + qi);
    const bf16* qrow = P0 + (size_t)(b * SEQ + tq) * P0LD + 1024 + h * 64;
    const bf16x8 qf0 = ld8(qrow + 8 * g), qf1 = ld8(qrow + 32 + 8 * g);
    AttState st; st.m = -1e30f; st.l = 0.f;
#pragma unroll
    for (int dt = 0; dt < 4; ++dt) st.o[dt] = (f32x4){0.f, 0.f, 0.f, 0.f};
    const int rho_off = 8 * (qi >> 2) + (qi & 3);
    int sb0_[3], n_[3]; const bf16* kb_[3]; const bf16* vb_[3];
#pragma unroll
    for (int p = 0; p < 3; ++p) {
        const int sh = 2 * p, rres = r16 & ((1 << sh) - 1), Ld = SEQ >> sh;
        const int lq0 = (r16 + 256 * lb) >> sh, lq15 = (r16 + 256 * lb + 240) >> sh;
        int s0 = lq0 - 128; if (s0 < 0) s0 = 0; s0 &= ~31;
        sb0_[p] = s0; n_[p] = (((lq15 & ~31) - s0) >> 5) + 1;
        kb_[p] = P0 + (size_t)(b * SEQ + rres) * P0LD + 1536 + h * 64 + 8 * g;
        vb_[p] = (p == 0) ? VT3 + ((size_t)((b * 8 + h) * 64 + qi)) * VTP + 8 * g
                          : VT3 + (size_t)p * (16 * 64 * VTP) + ((size_t)((b * 8 + h) * 4) * 256 + ((rres * Ld) >> 5)) * 512 + qi * 32 + 8 * g;
    }
    if (P1_LDS) n_[0] = 0;
    const int n01 = n_[0] + n_[1], total = n01 + n_[2];
    bf16x8 rk[ATT_D][4], rv[ATT_D][4];
#define ATT_ISSUE(s_, buf) do { const int s__ = (s_); if (s__ < total) { \
        const int p_ = (s__ >= n_[0]) + (s__ >= n01); const int loc_ = s__ - (p_ == 0 ? 0 : (p_ == 1 ? n_[0] : n01)); \
        const int sb_ = (p_ == 0 ? sb0_[0] : (p_ == 1 ? sb0_[1] : sb0_[2])) + 32 * loc_; const int sh_ = 2 * p_; \
        const bf16* kbp = (p_ == 0 ? kb_[0] : (p_ == 1 ? kb_[1] : kb_[2])); const bf16* vbp = (p_ == 0 ? vb_[0] : (p_ == 1 ? vb_[1] : vb_[2])); \
        const bf16* kx = kbp + ((size_t)(sb_ + rho_off) << sh_) * P0LD; const bf16* ky = kx + ((size_t)4 << sh_) * P0LD; \
        rk[buf][0] = ld8(kx); rk[buf][1] = ld8(kx + 32); rk[buf][2] = ld8(ky); rk[buf][3] = ld8(ky + 32); \
        const size_t dstr_ = (p_ == 0) ? (size_t)16 * VTP : (size_t)256 * 512; const size_t soff_ = (p_ == 0) ? (size_t)sb_ : (size_t)(sb_ >> 5) * 512; \
        _Pragma("unroll") for (int dt = 0; dt < 4; ++dt) rv[buf][dt] = ld8(vbp + dt * dstr_ + soff_); } } while (0)
#pragma unroll
    for (int d = 0; d < ATT_D; ++d) ATT_ISSUE(d, d);
    if (P1_LDS) {
        const int w = c.wave, half = r16 >> 3, tok0 = 256 * lb - 128;
        const int tq1 = 256 * lb + 32 * w + 16 * (qi >> 3) + 8 * half + (qi & 7);
        const bf16* q1row = P0 + (size_t)(b * SEQ + tq1) * P0LD + 1024 + h * 64;
        const bf16x8 q1f0 = ld8(q1row + 8 * g), q1f1 = ld8(q1row + 32 + 8 * g);
        AttState s1; s1.m = -1e30f; s1.l = 0.f;
#pragma unroll
        for (int dt = 0; dt < 4; ++dt) s1.o[dt] = (f32x4){0.f, 0.f, 0.f, 0.f};
        const LAS unsigned char* kl = c.lds + rho_off * ATT_KP + 16 * g;
        const LAS unsigned char* vl = c.lds + ATT_KBYTES + qi * ATT_VP + 16 * g;
        LAS unsigned* ex = (LAS unsigned*)(c.lds + ATT_LDS);
        __syncthreads();
        for (int i = ((lb == 0 && w < 4) ? 4 : w); i <= w + 4; ++i) {
            const LAS unsigned char* kx = kl + 32 * i * ATT_KP;
            const bf16x8 kx0 = *(const LAS bf16x8*)kx, kx1 = *(const LAS bf16x8*)(kx + 64), ky0 = *(const LAS bf16x8*)(kx + 4 * ATT_KP), ky1 = *(const LAS bf16x8*)(kx + 4 * ATT_KP + 64);
            bf16x8 vf[4];
#pragma unroll
            for (int dt = 0; dt < 4; ++dt) vf[dt] = *(const LAS bf16x8*)(vl + dt * 16 * ATT_VP + 64 * i);
            attn_math(kx0, kx1, ky0, ky1, vf, q1f0, q1f1, tq1, tok0 + 32 * i + 8 * g, s1);
        }
        {
            LAS unsigned* e = ex + ((16 * w + qi) * 4 + g) * 10;
            e[0] = __float_as_uint(s1.m); e[1] = __float_as_uint(s1.l);
#pragma unroll
            for (int dt = 0; dt < 4; ++dt) { e[2 + 2 * dt] = pg8::cvtpk(s1.o[dt][0], s1.o[dt][1]); e[3 + 2 * dt] = pg8::cvtpk(s1.o[dt][2], s1.o[dt][3]); }
        }
        __syncthreads();
        {
            const LAS unsigned* e = ex + ((qi * 8 + (r16 & 7)) * 4 + g) * 10;
            st.m = __uint_as_float(e[0]); st.l = __uint_as_float(e[1]);
#pragma unroll
            for (int dt = 0; dt < 4; ++dt) { const unsigned a0 = e[2 + 2 * dt], a1 = e[3 + 2 * dt]; st.o[dt] = (f32x4){bfw(a0, 0), bfw(a0, 1), bfw(a1, 0), bfw(a1, 1)}; }
        }
    }
    for (int s0 = 0; s0 < total; s0 += ATT_D) {
#pragma unroll
        for (int j = 0; j < ATT_D; ++j) {
            const int s = s0 + j;
            if (s < total) {
                const int p = (s >= n_[0]) + (s >= n01), loc = s - (p == 0 ? 0 : (p == 1 ? n_[0] : n01));
                const int sb = (p == 0 ? sb0_[0] : (p == 1 ? sb0_[1] : sb0_[2])) + 32 * loc;
                attn_math(rk[j][0], rk[j][1], rk[j][2], rk[j][3], rv[j], qf0, qf1, tq >> (2 * p), sb + 8 * g, st);
                ATT_ISSUE(s + ATT_D, j);
            }
        }
    }
#undef ATT_ISSUE
    float l = st.l;
    l += __shfl_xor(l, 16); l += __shfl_xor(l, 32);
    const float inv = 1.0f / l;
    bf16* orow = ycat + (size_t)(b * SEQ + tq) * 1024 + 512 + h * 64 + 4 * g;
#pragma unroll
    for (int dt = 0; dt < 4; ++dt) { u32x2 w; w.x = cvt_pk_bf16(st.o[dt][0] * inv, st.o[dt][1] * inv); w.y = cvt_pk_bf16(st.o[dt][2] * inv, st.o[dt][3] * inv); *(u32x2*)(orow + 16 * dt) = w; }
}

__device__ __forceinline__ void lru_step(float la, float gi, float& h) { const float a = __expf(la), bq = __builtin_amdgcn_sqrtf(fmaxf(1.0f - a * a, 0.f)) * gi; h = a * h + bq; }
__device__ __forceinline__ void phase_lru_a(const Ctx& c, unsigned char* ws) {
    const bf16* __restrict__ LA = (const bf16*)(ws + WS_LOGA); const bf16* __restrict__ GI = (const bf16*)(ws + WS_GI);
    float* __restrict__ SA = (float*)(ws + WS_SUMA); float* __restrict__ SB = (float*)(ws + WS_SUMB);
    for (int ch = blockIdx.x; ch < 256; ch += gridDim.x) {
        const int t0 = ch * 64, cn = c.tid; float h = 0.f, P = 0.f;
#pragma unroll 1
        for (int tb = 0; tb < 64; tb += 32) {
            float la[32], gi[32];
#pragma unroll
            for (int t = 0; t < 32; ++t) { la[t] = bf2f(LA[(size_t)(t0 + tb + t) * 512 + cn]); gi[t] = bf2f(GI[(size_t)(t0 + tb + t) * 512 + cn]); }
#pragma unroll
            for (int t = 0; t < 32; ++t) { lru_step(la[t], gi[t], h); P += la[t]; }
        }
        SA[ch * 512 + cn] = __expf(P); SB[ch * 512 + cn] = h;
    }
}
__device__ __forceinline__ void phase_lru_b(const Ctx& c, unsigned char* ws) {
    const bf16* __restrict__ LA = (const bf16*)(ws + WS_LOGA); const bf16* __restrict__ GI = (const bf16*)(ws + WS_GI);
    const float* __restrict__ SA = (const float*)(ws + WS_SUMA); const float* __restrict__ SB = (const float*)(ws + WS_SUMB);
    const bf16* __restrict__ P0 = (const bf16*)(ws + WS_BIG); bf16* __restrict__ ycat = (bf16*)(ws + WS_YCAT);
    for (int ch = blockIdx.x; ch < 256; ch += gridDim.x) {
        const int t0 = ch * 64, cn = c.tid; float h = 0.f;
        bf16 la0[32], gi0[32], gl0[32];
#pragma unroll
        for (int t = 0; t < 32; ++t) { la0[t] = LA[(size_t)(t0 + t) * 512 + cn]; gi0[t] = GI[(size_t)(t0 + t) * 512 + cn]; gl0[t] = P0[(size_t)(t0 + t) * P0LD + 512 + cn]; }
        int j = ch & ~127;
        for (; j + 32 <= ch; j += 32) {
            float sa[32], sb[32];
#pragma unroll
            for (int k = 0; k < 32; ++k) { sa[k] = SA[(j + k) * 512 + cn]; sb[k] = SB[(j + k) * 512 + cn]; }
#pragma unroll
            for (int k = 0; k < 32; ++k) h = sa[k] * h + sb[k];
        }
        for (; j + 8 <= ch; j += 8) {
            float sa[8], sb[8];
#pragma unroll
            for (int k = 0; k < 8; ++k) { sa[k] = SA[(j + k) * 512 + cn]; sb[k] = SB[(j + k) * 512 + cn]; }
#pragma unroll
            for (int k = 0; k < 8; ++k) h = sa[k] * h + sb[k];
        }
        for (; j < ch; ++j) h = SA[j * 512 + cn] * h + SB[j * 512 + cn];
#pragma unroll
        for (int t = 0; t < 32; ++t) { lru_step(bf2f(la0[t]), bf2f(gi0[t]), h); ycat[(size_t)(t0 + t) * 1024 + cn] = f2bf(h * gelu_tanh(bf2f(gl0[t]))); }
#pragma unroll 1
        for (int tb = 32; tb < 64; tb += 32) {
            bf16 la[32], gi[32], gl[32];
#pragma unroll
            for (int t = 0; t < 32; ++t) { la[t] = LA[(size_t)(t0 + tb + t) * 512 + cn]; gi[t] = GI[(size_t)(t0 + tb + t) * 512 + cn]; gl[t] = P0[(size_t)(t0 + tb + t) * P0LD + 512 + cn]; }
#pragma unroll
            for (int t = 0; t < 32; ++t) { lru_step(bf2f(la[t]), bf2f(gi[t]), h); ycat[(size_t)(t0 + tb + t) * 1024 + cn] = f2bf(h * gelu_tanh(bf2f(gl[t]))); }
        }
    }
}

__device__ __forceinline__ void fixup_panel(const Ctx& c, unsigned char* ws, const float* cw, const float* cb, int pm) {
    if ((pm & 31) != 0) {
        const float* EA = (const float*)(ws + WS_EDGEA); const float* EL = (const float*)(ws + WS_EDGEL); const float* TA = (const float*)(ws + WS_TAILA);
        bf16* U = (bf16*)(ws + WS_BIG);
        for (int col = c.tid; col < 3072; col += 512) {
            const float tm2 = TA[(size_t)((pm - 1) * 2 + 0) * 3072 + col], tm1 = TA[(size_t)((pm - 1) * 2 + 1) * 3072 + col];
            const float a0 = EA[(size_t)(pm * 2) * 3072 + col], a1 = EA[(size_t)(pm * 2 + 1) * 3072 + col];
            const float l0 = EL[(size_t)(pm * 2) * 3072 + col], l1 = EL[(size_t)(pm * 2 + 1) * 3072 + col];
            const float w0 = cw[col], w1 = cw[3072 + col], w2 = cw[6144 + col], bb = cb[col];
            U[(size_t)(pm * 256) * 3072 + col] = f2bf(gelu_tanh(w0 * tm2 + w1 * tm1 + w2 * a0 + bb) * l0);
            U[(size_t)(pm * 256 + 1) * 3072 + col] = f2bf(gelu_tanh(w0 * tm1 + w1 * a0 + w2 * a1 + bb) * l1);
        }
    }
    asm volatile("s_waitcnt vmcnt(0)" ::: "memory");
    __syncthreads();
}
__device__ __forceinline__ void phase_fixup(const Ctx& c, unsigned char* ws, const float* cw, const float* cb) {
    const float* EA = (const float*)(ws + WS_EDGEA); const float* EL = (const float*)(ws + WS_EDGEL); const float* TA = (const float*)(ws + WS_TAILA);
    bf16* U = (bf16*)(ws + WS_BIG);
    for (int i = c.gtid; i < 64 * 3072; i += c.ngt) {
        const int pm = i / 3072, col = i % 3072;
        if ((pm & 31) == 0) continue;
        const float tm2 = TA[(size_t)((pm - 1) * 2 + 0) * 3072 + col], tm1 = TA[(size_t)((pm - 1) * 2 + 1) * 3072 + col];
        const float a0 = EA[(size_t)(pm * 2) * 3072 + col], a1 = EA[(size_t)(pm * 2 + 1) * 3072 + col];
        const float l0 = EL[(size_t)(pm * 2) * 3072 + col], l1 = EL[(size_t)(pm * 2 + 1) * 3072 + col];
        const float w0 = cw[col], w1 = cw[3072 + col], w2 = cw[6144 + col], bb = cb[col];
        U[(size_t)(pm * 256) * 3072 + col] = f2bf(gelu_tanh(w0 * tm2 + w1 * tm1 + w2 * a0 + bb) * l0);
        U[(size_t)(pm * 256 + 1) * 3072 + col] = f2bf(gelu_tanh(w0 * tm1 + w1 * a0 + w2 * a1 + bb) * l1);
    }
}
#define XB_TMO      128
#define XB_XCNT(j)  (256  + 64 * (j))
#define XB_XSUB(j)  (1280 + 64 * (j))
#define XB_XGEN(j)  (2304 + 64 * (j))
#define XB_TOP      3328
#define XB_TOPGEN   3392
#define XCD_BAR_WORDS 3456
#define XB_SPIN_CAP (1u << 18)

__device__ __forceinline__ unsigned xb_ld(unsigned* p)              { return __hip_atomic_load(p, __ATOMIC_RELAXED, __HIP_MEMORY_SCOPE_AGENT); }
__device__ __forceinline__ unsigned xb_add(unsigned* p, unsigned v) { return __hip_atomic_fetch_add(p, v, __ATOMIC_RELAXED, __HIP_MEMORY_SCOPE_AGENT); }
__device__ __forceinline__ unsigned xb_xcc_id() { return (unsigned)__builtin_amdgcn_s_getreg((3 << 11) | 20) & 0xFu; }
#define XB_SPIN(cond, bar) do { unsigned _sp = 0; while (cond) { __builtin_amdgcn_s_sleep(1); \
    if ((++_sp & 255u) == 0u) { if (xb_ld(&(bar)[XB_TMO])) break; if (_sp > XB_SPIN_CAP) { atomicAdd(&(bar)[XB_TMO], 1u); break; } } } } while (0)

struct XcdBarrier {
    unsigned* bar; unsigned x;
    volatile LAS unsigned* st;
};

__device__ __forceinline__ XcdBarrier xcd_barrier_post(unsigned* bar, volatile LAS unsigned* st) {
    XcdBarrier b; b.bar = bar; b.x = xb_xcc_id(); b.st = st;
    if (threadIdx.x == 0) (void)xb_add(&bar[XB_XCNT(b.x)], 1u);
    return b;
}
__device__ __forceinline__ void xcd_barrier_complete(unsigned* bar, unsigned x, unsigned& nloc, unsigned& nx) {
    const unsigned G = gridDim.x * gridDim.y * gridDim.z;
    unsigned sum, cnt, mine, sp = 0u;
    for (;;) {
        sum = 0u; cnt = 0u; mine = 0u;
#pragma unroll
        for (unsigned j = 0; j < 16; ++j) { const unsigned c = xb_ld(&bar[XB_XCNT(j)]); sum += c; cnt += (c > 0u) ? 1u : 0u; mine = (j == x) ? c : mine; }
        if (sum == G) break;
        __builtin_amdgcn_s_sleep(1);
        if ((++sp & 255u) == 0u) { if (xb_ld(&bar[XB_TMO])) break; if (sp > XB_SPIN_CAP) { atomicAdd(&bar[XB_TMO], 1u); break; } }
    }
    nloc = mine > 0u ? mine : 1u; nx = cnt > 0u ? cnt : 1u;
}

__device__ __forceinline__ void xcd_barrier(const XcdBarrier& b) {
    asm volatile("s_waitcnt vmcnt(0)" ::: "memory");
    __syncthreads();
    if (threadIdx.x == 0) {
        unsigned* bar = b.bar;
        __builtin_amdgcn_s_waitcnt(0);
        unsigned nloc = b.st[0], nx = b.st[1];
        if (nloc == 0u) { xcd_barrier_complete(bar, b.x, nloc, nx); b.st[0] = nloc; b.st[1] = nx; }
        const unsigned old = xb_add(&bar[XB_XSUB(b.x)], 1u);
        const unsigned gen = old / nloc;
        if (old + 1u == (gen + 1u) * nloc) {
            __builtin_amdgcn_fence(__ATOMIC_RELEASE, "agent");
            asm volatile("s_waitcnt vmcnt(0)" ::: "memory");
            const unsigned og = xb_add(&bar[XB_TOP], 1u);
            const unsigned tg = og / nx;
            if (og + 1u == (tg + 1u) * nx) xb_add(&bar[XB_TOPGEN], 1u);
            else XB_SPIN(xb_ld(&bar[XB_TOPGEN]) == tg, bar);
            __builtin_amdgcn_fence(__ATOMIC_ACQUIRE, "agent");
            xb_add(&bar[XB_XGEN(b.x)], 1u);
            asm volatile("s_waitcnt vmcnt(0)" ::: "memory");
        } else {
            XB_SPIN(xb_ld(&bar[XB_XGEN(b.x)]) == gen, bar);
            __builtin_amdgcn_fence(__ATOMIC_ACQUIRE, "agent");
            asm volatile("s_waitcnt vmcnt(0)" ::: "memory");
        }
    }
    __syncthreads();
}
__device__ __forceinline__ void gk_item(const bf16* XB, const bf16* Wt, const float* ss, bf16* P1, int item, int lane) {
    const int jl = lane & 15, gq = lane >> 4, tok = item * 16 + jl;
    const bf16* ap = Wt + (size_t)(2048 + jl) * 1024 + 8 * gq; const bf16* bp = XB + (size_t)tok * 1024 + 8 * gq;
    f32x4 acc0 = (f32x4){0.f, 0.f, 0.f, 0.f}, acc1 = acc0;
#pragma unroll 8
    for (int ks = 0; ks < 32; ks += 2) { acc0 = mfma16(ld8(ap + 32 * ks), ld8(bp + 32 * ks), acc0); acc1 = mfma16(ld8(ap + 32 * ks + 32), ld8(bp + 32 * ks + 32), acc1); }
    const float rs = rsqrtf(ss[tok] * (1.0f / 1024.0f) + 1e-6f);
    u32x2 w; w.x = cvt_pk_bf16((acc0[0] + acc1[0]) * rs, (acc0[1] + acc1[1]) * rs); w.y = cvt_pk_bf16((acc0[2] + acc1[2]) * rs, (acc0[3] + acc1[3]) * rs);
    *(u32x2*)(P1 + (size_t)tok * P1LD + 2048 + 4 * gq) = w;
}

__device__ __forceinline__ void phase_gla_prep(const Ctx& c, const float* const* in, unsigned char* ws) {
    bf16* P1 = (bf16*)(ws + WS_BIG); bf16* KDT = (bf16*)(ws + WS_KDT); float* DEC = (float*)(ws + WS_DECAY);
    const float* gkw = in[25]; const float* gkb = in[26];
    for (int i = blockIdx.x * 256 + c.tid; c.tid < 256 && i < 256 * 256; i += gridDim.x * 256) {
        const int chunk = i >> 8, chn = i & 255, t0 = chunk * 64, b = chunk >> 7, h = chn >> 6, d = chn & 63;
        float w[16];
#pragma unroll
        for (int k = 0; k < 16; ++k) w[k] = gkw[k * 256 + chn];
        const float bias = gkb[chn];
        float kin[64]; float bc = 0.f;
#pragma unroll
        for (int tb = 0; tb < 64; tb += 8) {
            u32x4 l0[8], l1[8]; bf16 qv[8], kv[8];
#pragma unroll
            for (int t = 0; t < 8; ++t) { const bf16* row = P1 + (size_t)(t0 + tb + t) * P1LD; l0[t] = *(const u32x4*)(row + 2048); l1[t] = *(const u32x4*)(row + 2056); qv[t] = row[512 + chn]; kv[t] = row[768 + chn]; }
#pragma unroll
            for (int t = 0; t < 8; ++t) {
                bf16* row = P1 + (size_t)(t0 + tb + t) * P1LD;
                float lr[16]; unpack8(l0[t], lr); unpack8(l1[t], lr + 8);
                float z = bias;
#pragma unroll
                for (int k = 0; k < 16; ++k) z += lr[k] * w[k];
                bc += logsig(z) * (1.0f / 16.0f);
                row[512 + chn] = f2bf(bf2f(qv[t]) * 0.125f * __expf(bc));
                kin[tb + t] = bf2f(kv[t]) * __expf(-bc);
                row[768 + chn] = f2bf(kin[tb + t]);
            }
        }
        const float eb = __expf(bc);
        DEC[chunk * 256 + chn] = eb;
        bf16* kd = KDT + ((size_t)((b * 4 + h) * 64 + d)) * SEQ + (t0 & (SEQ - 1));
#pragma unroll
        for (int t8 = 0; t8 < 8; ++t8) {
            float f[8];
#pragma unroll
            for (int e = 0; e < 8; ++e) f[e] = kin[t8 * 8 + e] * eb;
            *(u32x4*)(kd + t8 * 8) = pack8(f);
        }
    }
}

__device__ __forceinline__ void s5_bfrags(const bf16* P1, int g, int jb, int lane, bf16x8* bu) {
    const int jl = lane & 15, gq = lane >> 4;
#pragma unroll
    for (int ks = 0; ks < 8; ++ks) {
        const int s = 2 * ks + (gq >> 1), p0 = 8 * (gq & 1);
        bu[ks] = ld8(P1 + (size_t)((16 * jb + jl) * 16 + s) * P1LD + 16 * g + p0);
    }
}
__device__ __forceinline__ void s5a_item(const bf16* P1, const bf16* FM, float* XL, int item, int lane) {
    const int g = item >> 6, jb = item & 63, jl = lane & 15, gq = lane >> 4;
    bf16x8 bu[8]; s5_bfrags(P1, g, jb, lane, bu);
    const bf16* Fg = FM + (size_t)g * 128 * 256;
#pragma unroll
    for (int zt = 0; zt < 8; ++zt) {
        f32x4 acc = (f32x4){0.f, 0.f, 0.f, 0.f};
#pragma unroll
        for (int ks = 0; ks < 8; ++ks) acc = mfma16(ld8(Fg + (size_t)(16 * zt + jl) * 256 + 32 * ks + 8 * gq), bu[ks], acc);
        *(f32x4*)(XL + ((size_t)g * 1024 + 16 * jb + jl) * 128 + 16 * zt + 4 * gq) = acc;
    }
}
__device__ __forceinline__ void phase_s5_scan(const Ctx& c, const float* const* in, unsigned char* ws) {
    const float* __restrict__ XL = (const float*)(ws + WS_XLOC); bf16* __restrict__ SX = (bf16*)(ws + WS_SX);
    LAS float* ex = (LAS float*)c.lds;
    for (int bg = blockIdx.x; bg < 64; bg += gridDim.x) {
        const int b = bg >> 5, g = bg & 31, seg = c.wave, n = c.lane;
        const S5P sp = s5_params(in[15], in[16], in[22], g, n);
        float ar, ai; s5_pow(sp, 16.0f, ar, ai);
        float Ar, Ai; s5_pow(sp, 1024.0f, Ar, Ai);
        const size_t o0 = ((size_t)g * 1024 + b * 512 + seg * 64) * 128 + n;
        float xr = 0.f, xi = 0.f;
#pragma unroll 1
        for (int h2 = 0; h2 < 2; ++h2) {
            float cr[32], ci[32];
#pragma unroll
            for (int k = 0; k < 32; ++k) { cr[k] = XL[o0 + (size_t)(h2 * 32 + k) * 128]; ci[k] = XL[o0 + (size_t)(h2 * 32 + k) * 128 + 64]; }
#pragma unroll
            for (int k = 0; k < 32; ++k) { const float tr = ar * xr - ai * xi + cr[k], ti = ar * xi + ai * xr + ci[k]; xr = tr; xi = ti; }
        }
        ex[(seg * 64 + n) * 2] = xr; ex[(seg * 64 + n) * 2 + 1] = xi;
        __syncthreads();
        xr = 0.f; xi = 0.f;
        for (int j = 0; j < seg; ++j) { const float er = ex[(j * 64 + n) * 2], ei = ex[(j * 64 + n) * 2 + 1]; const float tr = Ar * xr - Ai * xi + er, ti = Ar * xi + Ai * xr + ei; xr = tr; xi = ti; }
#pragma unroll 1
        for (int h2 = 0; h2 < 2; ++h2) {
            float cr[32], ci[32];
#pragma unroll
            for (int k = 0; k < 32; ++k) { cr[k] = XL[o0 + (size_t)(h2 * 32 + k) * 128]; ci[k] = XL[o0 + (size_t)(h2 * 32 + k) * 128 + 64]; }
#pragma unroll
            for (int k = 0; k < 32; ++k) {
                SX[o0 + (size_t)(h2 * 32 + k) * 128] = f2bf(xr); SX[o0 + (size_t)(h2 * 32 + k) * 128 + 64] = f2bf(xi);
                const float tr = ar * xr - ai * xi + cr[k], ti = ar * xi + ai * xr + ci[k]; xr = tr; xi = ti;
            }
        }
        __syncthreads();
    }
}
__device__ __forceinline__ void s5c_item(const bf16* P1, const bf16* AM, const bf16* SX, const float* dvec, bf16* YS, int item, int lane) {
    const int g = item >> 6, jb = item & 63, jl = lane & 15, gq = lane >> 4;
    bf16x8 bu[12]; s5_bfrags(P1, g, jb, lane, bu);
#pragma unroll
    for (int ks = 0; ks < 4; ++ks) bu[8 + ks] = ld8(SX + ((size_t)g * 1024 + 16 * jb + jl) * 128 + 32 * ks + 8 * gq);
    const bf16* Ag = AM + (size_t)g * 256 * 384;
    float dv[4];
#pragma unroll
    for (int e = 0; e < 4; ++e) dv[e] = dvec[16 * g + 4 * gq + e];
#pragma unroll 4
    for (int rt = 0; rt < 16; ++rt) {
        f32x4 acc = (f32x4){0.f, 0.f, 0.f, 0.f};
#pragma unroll
        for (int ks = 0; ks < 12; ++ks) acc = mfma16(ld8(Ag + (size_t)(16 * rt + jl) * 384 + 32 * ks + 8 * gq), bu[ks], acc);
        const size_t tok = (size_t)(16 * jb + jl) * 16 + rt;
        const u32x2 uv = *(const u32x2*)(P1 + tok * P1LD + 16 * g + 4 * gq);
        float o[4];
#pragma unroll
        for (int e = 0; e < 4; ++e) { const float y = acc[e] + dv[e] * bfw(uv[e >> 1], e & 1); o[e] = gelu_tanh(y); }
        u32x2 w; w.x = cvt_pk_bf16(o[0], o[1]); w.y = cvt_pk_bf16(o[2], o[3]);
        *(u32x2*)(YS + tok * 512 + 16 * g + 4 * gq) = w;
    }
}

__device__ __forceinline__ void s5c_block(const Ctx& c, const bf16* P1, const bf16* AM, const bf16* SX, const float* dvec, bf16* YS, int g, int jb) {
    const int lane = c.lane, jl = lane & 15, gq = lane >> 4;
    bf16x8 bu[12]; s5_bfrags(P1, g, jb, lane, bu);
#pragma unroll
    for (int ks = 0; ks < 4; ++ks) bu[8 + ks] = ld8(SX + ((size_t)g * 1024 + 16 * jb + jl) * 128 + 32 * ks + 8 * gq);
    float dv[4];
#pragma unroll
    for (int e = 0; e < 4; ++e) dv[e] = dvec[16 * g + 4 * gq + e];
    const bf16* Ag = AM + (size_t)g * 256 * 384;
    for (int half = 0; half < 2; ++half) {
        __syncthreads();
        for (int p = c.tid; p < 128 * 48; p += 512) { const int row = p / 48, c16 = p - row * 48;
            *(LAS u32x4*)(c.lds + row * 784 + c16 * 16) = *(const u32x4*)(Ag + (size_t)(half * 128 + row) * 384 + c16 * 8); }
        __syncthreads();
#pragma unroll 2
        for (int r8 = 0; r8 < 8; ++r8) {
            const int rt = half * 8 + r8;
            f32x4 acc = (f32x4){0.f, 0.f, 0.f, 0.f};
#pragma unroll
            for (int ks = 0; ks < 12; ++ks) acc = mfma16(*(const LAS bf16x8*)(c.lds + (16 * r8 + jl) * 784 + 64 * ks + 16 * gq), bu[ks], acc);
            const size_t tok = (size_t)(16 * jb + jl) * 16 + rt;
            const u32x2 uv = *(const u32x2*)(P1 + tok * P1LD + 16 * g + 4 * gq);
            float o[4];
#pragma unroll
            for (int e = 0; e < 4; ++e) { const float y = acc[e] + dv[e] * bfw(uv[e >> 1], e & 1); o[e] = gelu_tanh(y); }
            u32x2 w; w.x = cvt_pk_bf16(o[0], o[1]); w.y = cvt_pk_bf16(o[2], o[3]);
            *(u32x2*)(YS + tok * 512 + 16 * g + 4 * gq) = w;
        }
    }
    __syncthreads();
}

__device__ __forceinline__ void gla_kv_item(const bf16* KDT, const bf16* VTG, bf16* KVS, int item, int lane) {
    const int cc = item & 127, h = (item >> 7) & 3, b = item >> 9, jl = lane & 15, gq = lane >> 4;
    const bf16* kd = KDT + ((size_t)((b * 4 + h) * 64 + jl)) * SEQ + 64 * cc + 8 * gq;
    const bf16* vt = VTG + ((size_t)((b * 4 + h) * 128 + jl)) * SEQ + 64 * cc + 8 * gq;
    bf16x8 af[4][2];
#pragma unroll
    for (int dt = 0; dt < 4; ++dt)
#pragma unroll
        for (int ks = 0; ks < 2; ++ks) af[dt][ks] = ld8(kd + (size_t)dt * 16 * SEQ + 32 * ks);
    bf16* out = KVS + ((size_t)(((b * 128 + cc) * 4 + h) * 128 + jl)) * 64 + 4 * gq;
#pragma unroll
    for (int et = 0; et < 8; ++et) {
        const bf16x8 b0 = ld8(vt + (size_t)et * 16 * SEQ), b1 = ld8(vt + (size_t)et * 16 * SEQ + 32);
#pragma unroll
        for (int dt = 0; dt < 4; ++dt) {
            f32x4 acc = mfma16(af[dt][0], b0, (f32x4){0.f, 0.f, 0.f, 0.f}); acc = mfma16(af[dt][1], b1, acc);
            u32x2 w; w.x = pg8::cvtpk(acc[0], acc[1]); w.y = pg8::cvtpk(acc[2], acc[3]);
            *(u32x2*)(out + (size_t)et * 16 * 64 + 16 * dt) = w;
        }
    }
}
__device__ __forceinline__ void phase_gla_scan(const Ctx& c, unsigned char* ws) {
    bf16* KVS = (bf16*)(ws + WS_KVS); const float* DEC = (const float*)(ws + WS_DECAY);
    for (int i = c.gtid; i < 2 * 4 * 128 * 64; i += c.ngt) {
        const int d = i & 63, e = (i >> 6) & 127, h = (i >> 13) & 3, b = i >> 15;
        float s = 0.f;
        bf16* p0 = KVS + ((size_t)((b * 128 * 4 + h) * 128 + e)) * 64 + d;
        const float* d0 = DEC + (b * 128) * 256 + h * 64 + d;
#pragma unroll 1
        for (int c0 = 0; c0 < 128; c0 += 43) {
            bf16 kv[43]; float dc[43];
#pragma unroll
            for (int k = 0; k < 43; ++k) if (c0 + k < 128) { kv[k] = p0[(size_t)(c0 + k) * (4 * 128 * 64)]; dc[k] = d0[(c0 + k) * 256]; }
#pragma unroll
            for (int k = 0; k < 43; ++k) if (c0 + k < 128) { p0[(size_t)(c0 + k) * (4 * 128 * 64)] = f2bf(s); s = dc[k] * s + bf2f(kv[k]); }
        }
    }
}
__device__ __forceinline__ void gla_out_item(const bf16* P1, const bf16* VTG, const bf16* KVS, const float* gnorm, bf16* ycat, int item, int lane) {
    const int tt = item & 3, cc = (item >> 2) & 127, h = (item >> 9) & 3, b = item >> 11, jl = lane & 15, gq = lane >> 4;
    const size_t tokc = (size_t)b * SEQ + 64 * cc;
    const bf16* qrow = P1 + (tokc + 16 * tt + jl) * P1LD + 512 + h * 64 + 8 * gq;
    const bf16x8 qf0 = ld8(qrow), qf1 = ld8(qrow + 32);
    f32x4 o[8];
#pragma unroll
    for (int et = 0; et < 8; ++et) o[et] = (f32x4){0.f, 0.f, 0.f, 0.f};
    {
        const bf16* sp = KVS + ((size_t)(((b * 128 + cc) * 4 + h) * 128 + jl)) * 64 + 8 * gq;
#pragma unroll
        for (int et = 0; et < 8; ++et) { o[et] = mfma16(ld8(sp + (size_t)et * 16 * 64), qf0, o[et]); o[et] = mfma16(ld8(sp + (size_t)et * 16 * 64 + 32), qf1, o[et]); }
    }
    const int tl = 16 * tt + jl, rho_off = 8 * (jl >> 2) + (jl & 3);
    const bf16* vt = VTG + ((size_t)((b * 4 + h) * 128 + jl)) * SEQ + 64 * cc + 8 * gq;
    for (int sp_ = 0; sp_ <= (tt >> 1); ++sp_) {
        const bf16* kx = P1 + (tokc + 32 * sp_ + rho_off) * P1LD + 768 + h * 64 + 8 * gq;
        const bf16* ky = kx + (size_t)4 * P1LD;
        f32x4 sx = mfma16(ld8(kx), qf0, (f32x4){0.f, 0.f, 0.f, 0.f}); sx = mfma16(ld8(kx + 32), qf1, sx);
        f32x4 sy = mfma16(ld8(ky), qf0, (f32x4){0.f, 0.f, 0.f, 0.f}); sy = mfma16(ld8(ky + 32), qf1, sy);
        const int kb = 32 * sp_ + 8 * gq;
        float pe[8];
#pragma unroll
        for (int r = 0; r < 4; ++r) { pe[r] = (kb + r <= tl) ? sx[r] : 0.f; pe[4 + r] = (kb + 4 + r <= tl) ? sy[r] : 0.f; }
        const u32x4 pw = pack8(pe); const bf16x8 pf = __builtin_bit_cast(bf16x8, pw);
#pragma unroll
        for (int et = 0; et < 8; ++et) o[et] = mfma16(ld8(vt + (size_t)et * 16 * SEQ + 32 * sp_), pf, o[et]);
    }
    float q = 0.f;
#pragma unroll
    for (int et = 0; et < 8; ++et) q += (o[et][0] * o[et][0] + o[et][1] * o[et][1]) + (o[et][2] * o[et][2] + o[et][3] * o[et][3]);
    q += __shfl_xor(q, 16); q += __shfl_xor(q, 32);
    const float rs = rsqrtf(q * (1.0f / 128.0f) + 1e-6f);
    const bf16* grow = P1 + (tokc + tl) * P1LD + 1536 + h * 128 + 4 * gq;
    bf16* orow = ycat + (tokc + tl) * 1024 + 512 + h * 128 + 4 * gq;
#pragma unroll
    for (int et = 0; et < 8; ++et) {
        const u32x2 gv = *(const u32x2*)(grow + 16 * et);
        const f32x4 gn = *(const f32x4*)(gnorm + 16 * et + 4 * gq);
        float r[4];
#pragma unroll
        for (int e = 0; e < 4; ++e) { const float gg = bfw(gv[e >> 1], e & 1); r[e] = (o[et][e] * rs * gn[e]) * (gg * sigm(gg)); }
        u32x2 w; w.x = cvt_pk_bf16(r[0], r[1]); w.y = cvt_pk_bf16(r[2], r[3]);
        *(u32x2*)(orow + 16 * et) = w;
    }
}

struct Args { const float* in[34]; float* out; unsigned char* ws; int ph_lo, ph_hi; };
constexpr int NPHASE = 19;

template <class Epi>
__device__ __forceinline__ void run_gemm(LAS unsigned char* lds, const bf16* A, const bf16* Bt, int M, int N, int K, const Epi& E) {
    pg8::Gemm g{A, Bt, M, N, K}; pg8::StaticOrder S; S.init(M, N, (int)gridDim.x, (int)blockIdx.x);
    pg8::gemm_phase<Epi, pg8::StaticOrder, true, true>(lds, g, S, E);
}

__global__ void __launch_bounds__(512, 2) fwd_kernel(Args a) {
    extern __shared__ __attribute__((aligned(16))) unsigned char lds_raw[];
    cg::grid_group grid = cg::this_grid();
    Ctx c; c.tid = threadIdx.x; c.lane = c.tid & 63; c.wave = __builtin_amdgcn_readfirstlane(c.tid >> 6);
    c.gw = blockIdx.x * 8 + c.wave; c.ngw = gridDim.x * 8; c.gtid = blockIdx.x * 512 + c.tid; c.ngt = gridDim.x * 512;
    c.lds = (LAS unsigned char*)lds_raw;
    unsigned char* ws = a.ws; const float* const* in = a.in;
    const int lo = a.ph_lo, hi = a.ph_hi;
#define IN(k) (lo <= (k) && (k) < hi)
#ifndef REP_MASK
#define REP_MASK 0
#endif
#define REPS(k) for (int r_ = 0; r_ < 1 + ((REP_MASK >> (k)) & 1); ++r_)
#define REPBAR() do { if (r_) xcd_barrier(bar); } while (0)
#define SYNC(k) do { if (IN(k) && IN((k) + 1)) { xcd_barrier(bar); } } while (0)
    volatile LAS unsigned* misc = (volatile LAS unsigned*)(c.lds + 131072);
    if (c.tid < 8) misc[c.tid] = 0u;
    __syncthreads();
    XcdBarrier bar = xcd_barrier_post((unsigned*)(ws + WS_BARRIER), misc);
    float* ss = (float*)(ws + WS_SS);
    bf16* XB = (bf16*)(ws + WS_XB); bf16* BIG = (bf16*)(ws + WS_BIG); bf16* YCAT = (bf16*)(ws + WS_YCAT);
    LAS float* halo = (LAS float*)(c.lds + HALO_OFF);

#ifdef TIMING_PROBE
    volatile LAS unsigned long long* tsl = (volatile LAS unsigned long long*)(c.lds + 131072 + 64);
#define STAMP(k) do { if (blockIdx.x == 0 && c.tid == 0) tsl[k] = __builtin_amdgcn_s_memrealtime(); } while (0)
#else
#define STAMP(k) do {} while (0)
#endif
    STAMP(0);
    if (IN(0)) REPS(0) { REPBAR(); phase_prologue(c, in, ws); if (!DEFER_TR) phase_s5_mats(c, in, ws); }
    SYNC(0); STAMP(1);
    if (IN(1)) REPS(1) { REPBAR(); { pg8::EpiProj E{BIG, P0LD, ss}; run_gemm(c.lds, XB, (const bf16*)(ws + WS_W_EIN), TT, 2560, 1024, E); }
        if ((DEFER_TR || DEFER_P1) && r_ == 0) { if (gridDim.x == 256) { if (blockIdx.x >= 128) do_tr_items(c, in, ws, TR_EOUT0, TR_FIN10, (blockIdx.x - 128) * 8 + c.wave, 1024); } else do_tr_items(c, in, ws, TR_EOUT0, TR_FIN10, c.gw, c.ngw); } }
    SYNC(1); STAMP(2);
    if (IN(2)) REPS(2) { REPBAR(); phase_prep0(c, in, ws, a.out); }
    SYNC(2); STAMP(3);
    if (IN(3)) REPS(3) { REPBAR(); { pg8::EpiGates E{(const bf16*)(ws + WS_XC), (bf16*)(ws + WS_LOGA), (bf16*)(ws + WS_GI), in[6], in[8], in[9]};
        run_gemm(c.lds, (const bf16*)(ws + WS_XC), (const bf16*)(ws + WS_W_GATE), TT, 1024, 512, E); } }
    SYNC(3); STAMP(4);
    if (IN(4)) REPS(4) { REPBAR();
        phase_lru_a(c, ws);
        if (gridDim.x == 256) {
            const int x = blockIdx.x & 7, j = blockIdx.x >> 3;
            for (int k = 0; k < 4; ++k) { const int bh = 2 * x + (k >> 1), r16 = 8 * (k & 1) + c.wave;
                if ((k & 1) == 0) { __syncthreads(); attn_stage_p1(c, BIG, (const bf16*)a.out, bh >> 3, bh & 7, j); __syncthreads(); }
                attn_item<true>(c, BIG, (const bf16*)a.out, YCAT, (bh << 9) | (r16 << 5) | j, c.lane); }
            __syncthreads();
        } else
        for (int it = c.gw; it < 2 * 8 * 16 * 32; it += c.ngw) attn_item<false>(c, BIG, (const bf16*)a.out, YCAT, it, c.lane);
    }
    SYNC(4); STAMP(5);
    if (IN(5)) REPS(5) { REPBAR(); phase_lru_b(c, ws); if (DEFER_TR && r_ == 0) { do_tr_items(c, in, ws, TR_FOUT00, TR_FOUT10, c.gw, c.ngw); do_tr_items(c, in, ws, TR_OIN0, TR_GLU0, c.gw, c.ngw); } }
    SYNC(5); STAMP(6);
#ifdef EXTRA_BARS
    for (int k_ = 0; k_ < EXTRA_BARS; ++k_) xcd_barrier(bar);
#endif
    if (IN(6)) REPS(6) { REPBAR(); { pg8::EpiRes E{in[0], a.out, XB, ss + TT}; run_gemm(c.lds, YCAT, (const bf16*)(ws + WS_W_EOUT), TT, 1024, 1024, E); } }
    SYNC(6); STAMP(7);
    if (IN(7)) REPS(7) { REPBAR(); { pg8::EpiFfn E{BIG, ss + TT, in[31], in[32], (float*)(ws + WS_EDGEA), (float*)(ws + WS_EDGEL), (float*)(ws + WS_TAILA), halo};
        run_gemm(c.lds, XB, (const bf16*)(ws + WS_W_FIN0), TT, 6144, 1024, E); } }
    SYNC(7); STAMP(8);
    const bool fuse_fix = (gridDim.x == 256) && !DEFER_TR;
    if (!fuse_fix) { if (IN(8)) REPS(8) { REPBAR(); phase_fixup(c, ws, in[31], in[32]); if (DEFER_TR && r_ == 0) phase_s5_mats(c, in, ws); }
    SYNC(8); } STAMP(9);
    if (IN(9)) REPS(9) { REPBAR(); if (fuse_fix) fixup_panel(c, ws, in[31], in[32], 8 * (blockIdx.x & 7) + ((blockIdx.x >> 3) & 7));
        { pg8::EpiRes E{a.out, a.out, XB, ss + 2 * TT}; run_gemm(c.lds, BIG, (const bf16*)(ws + WS_W_FOUT0), TT, 1024, 3072, E); } }
    SYNC(9); STAMP(10);
    if (IN(10)) REPS(10) { REPBAR(); { pg8::EpiProj E{BIG, P1LD, ss + 2 * TT}; run_gemm(c.lds, XB, (const bf16*)(ws + WS_W_OIN), TT, 2048, 1024, E); }
        for (int it = c.gw; it < TT / 16; it += c.ngw) gk_item(XB, (const bf16*)(ws + WS_W_OIN), ss + 2 * TT, BIG, it, c.lane);
        if (DEFER_TR && r_ == 0) { int widx = c.gw, nw = c.ngw; if (gridDim.x == 256) { widx = (blockIdx.x >= 64) ? (blockIdx.x - 64) * 8 + c.wave : -1; nw = 192 * 8; }
            if (widx >= 0) { do_tr_items(c, in, ws, TR_FIN10, TR_FOUT00, widx, nw); do_tr_items(c, in, ws, TR_FOUT10, TR_OIN0, widx, nw); do_tr_items(c, in, ws, TR_GLU0, TR_END, widx, nw); } } }
    SYNC(10); STAMP(11);
    if (IN(11)) REPS(11) { REPBAR();
        phase_gla_prep(c, in, ws);
        if (c.wave >= 4) {
            Ctx c2 = c; c2.gw = blockIdx.x * 4 + (c.wave - 4); c2.ngw = gridDim.x * 4;
            vt_run(c2, BIG, P1LD, 1024, 128, 4, (bf16*)(ws + WS_VTG), SEQ, 0, 8 * 2 * 1024);
            for (int it = c2.gw; it < 32 * 64; it += c2.ngw) s5a_item(BIG, (const bf16*)(ws + WS_S5F), (float*)(ws + WS_XLOC), it, c.lane);
        }
    }
    SYNC(11); STAMP(12);
    if (IN(12)) REPS(12) { REPBAR();
        phase_s5_scan(c, in, ws);
        for (int it = c.ngw - 1 - c.gw; it < 2 * 4 * 128; it += c.ngw) gla_kv_item((const bf16*)(ws + WS_KDT), (const bf16*)(ws + WS_VTG), (bf16*)(ws + WS_KVS), it, c.lane);
    }
    SYNC(12); STAMP(13);
    if (IN(13)) REPS(13) { REPBAR();
        phase_gla_scan(c, ws);
        if (gridDim.x == 256) s5c_block(c, BIG, (const bf16*)(ws + WS_S5A), (const bf16*)(ws + WS_SX), in[21], (bf16*)(ws + WS_XLOC), 31 - (blockIdx.x >> 3), (blockIdx.x & 7) * 8 + c.wave);
        else
        for (int it = c.ngw - 1 - c.gw; it < 32 * 64; it += c.ngw) s5c_item(BIG, (const bf16*)(ws + WS_S5A), (const bf16*)(ws + WS_SX), in[21], (bf16*)(ws + WS_XLOC), it, c.lane);
    }
    SYNC(13); STAMP(14);
    if (IN(14)) REPS(14) { REPBAR();
        { pg8::EpiGlu E{(const bf16*)(ws + WS_XLOC), YCAT, in[24]}; run_gemm(c.lds, (const bf16*)(ws + WS_XLOC), (const bf16*)(ws + WS_W_GLU), TT, 512, 512, E); }
        if (gridDim.x == 256) {
            if (blockIdx.x < 128) gla_out_item(BIG, (const bf16*)(ws + WS_VTG), (const bf16*)(ws + WS_KVS), in[27], YCAT, c.gw, c.lane);
            else for (int k = 0; k < 3; ++k) gla_out_item(BIG, (const bf16*)(ws + WS_VTG), (const bf16*)(ws + WS_KVS), in[27], YCAT, 1024 + ((blockIdx.x - 128) * 8 + c.wave) * 3 + k, c.lane);
        } else
        for (int it = c.ngw - 1 - c.gw; it < 2 * 4 * 128 * 4; it += c.ngw) gla_out_item(BIG, (const bf16*)(ws + WS_VTG), (const bf16*)(ws + WS_KVS), in[27], YCAT, it, c.lane);
    }
    SYNC(14); STAMP(15);
    if (IN(15)) REPS(15) { REPBAR(); { pg8::EpiRes E{a.out, a.out, XB, ss + 3 * TT}; run_gemm(c.lds, YCAT, (const bf16*)(ws + WS_W_OOUT), TT, 1024, 1024, E); } }
    SYNC(15); STAMP(16);
    if (IN(16)) REPS(16) { REPBAR(); { pg8::EpiFfn E{BIG, ss + 3 * TT, in[31] + 3 * 3072, in[32] + 3072, (float*)(ws + WS_EDGEA), (float*)(ws + WS_EDGEL), (float*)(ws + WS_TAILA), halo};
        run_gemm(c.lds, XB, (const bf16*)(ws + WS_W_FIN1), TT, 6144, 1024, E); } }
    SYNC(16); STAMP(17);
    if (!fuse_fix) { if (IN(17)) REPS(17) { REPBAR(); phase_fixup(c, ws, in[31] + 3 * 3072, in[32] + 3072); }
    SYNC(17); } STAMP(18);
    if (IN(18)) REPS(18) { REPBAR(); if (fuse_fix) fixup_panel(c, ws, in[31] + 3 * 3072, in[32] + 3072, 8 * (blockIdx.x & 7) + ((blockIdx.x >> 3) & 7));
        { pg8::EpiRes E{a.out, a.out, nullptr, nullptr}; run_gemm(c.lds, BIG, (const bf16*)(ws + WS_W_FOUT1), TT, 1024, 3072, E); } }
#ifdef TIMING_PROBE
    xcd_barrier(bar); STAMP(19);
    if (blockIdx.x == 0 && c.tid == 0) {
        const float d1 = (float)(tsl[TP_A_HI] - tsl[TP_A_LO]) * 0.01f, d2 = (float)(tsl[TP_B_HI] - tsl[TP_B_LO]) * 0.01f;
#ifdef TP_CALIB
        a.out[0] += 1000.0f;
#else
        a.out[0] += d1;
        for (int j = 1; j <= 10000; ++j) a.out[j] += 0.1f * d2;
#endif
    }
#endif
#ifdef DBG_PROBE
    { grid.sync();
      const bf16* pb = (const bf16*)(ws + (size_t)DBG_B0 * MiB); const size_t nb = (size_t)(DBG_B1 - DBG_B0) * MiB / 2;
      const float* pf = (const float*)(ws + (size_t)DBG_F0 * MiB); const size_t nf = (size_t)(DBG_F1 - DBG_F0) * MiB / 4;
      for (size_t i = c.gtid; i < (size_t)TT * DM; i += c.ngt) { float s = 0.f;
          for (size_t j = i; j < nb; j += (size_t)TT * DM) s += bf2f(pb[j]);
          for (size_t j = i; j < nf; j += (size_t)TT * DM) s += pf[j];
          a.out[i] += 1e-3f * s; } }
#endif
    if (hi < 7) { grid.sync(); for (int i = c.gtid; i < TT * DM / 4; i += c.ngt) ((f32x4*)a.out)[i] = ((const f32x4*)in[0])[i]; }
#undef IN
#undef SYNC
}

#ifndef DBG_HI
#define DBG_HI NPHASE
#endif
#ifndef MK_PER_PHASE
#define MK_PER_PHASE 0
#endif
extern "C" void kernel_launch(void* const* d_in, const int* in_sizes, int n_in, void* d_out, int out_size, void* d_ws, size_t ws_size, hipStream_t stream) {
    static int grid = 0;
    if (grid == 0) {
        if (n_in != 34 || out_size != TT * DM || ws_size < WS_END) { fprintf(stderr, "kernel_launch: unexpected shapes (n_in %d out %d ws %zu)\n", n_in, out_size, ws_size); grid = -1; return; }
        int dev = 0, cus = 0, per_cu = 0;
        hipGetDevice(&dev); hipDeviceGetAttribute(&cus, hipDeviceAttributeMultiprocessorCount, dev);
        if (hipFuncSetAttribute((const void*)fwd_kernel, hipFuncAttributeMaxDynamicSharedMemorySize, LDS_BYTES) != hipSuccess) { fprintf(stderr, "kernel_launch: hipFuncSetAttribute failed\n"); grid = -1; return; }
        if (hipOccupancyMaxActiveBlocksPerMultiprocessor(&per_cu, (const void*)fwd_kernel, 512, LDS_BYTES) != hipSuccess || per_cu < 1) { fprintf(stderr, "kernel_launch: occupancy query says %d\n", per_cu); per_cu = 1; }
        (void)hipGetLastError();
        grid = cus;
        if (grid > 256) grid = 256;
    }
    if (grid < 0) return;
    if (hipMemsetAsync((char*)d_ws + WS_BARRIER, 0, 16384, stream) != hipSuccess) { fprintf(stderr, "kernel_launch: memset failed\n"); return; }
    Args a{};
    for (int i = 0; i < 34; ++i) a.in[i] = (const float*)d_in[i];
    a.out = (float*)d_out; a.ws = (unsigned char*)d_ws;
#if MK_PER_PHASE
    for (int p = 0; p < NPHASE; ++p) { a.ph_lo = p; a.ph_hi = p + 1; hipLaunchKernelGGL(fwd_kernel, dim3(grid), dim3(512), LDS_BYTES, stream, a); }
#else
    a.ph_lo = 0; a.ph_hi = DBG_HI;
    void* args[] = {&a};
    hipError_t e = hipLaunchCooperativeKernel((const void*)fwd_kernel, dim3(grid), dim3(512), args, LDS_BYTES, stream);
    if (e != hipSuccess) fprintf(stderr, "cooperative launch failed: %s (grid %d)\n", hipGetErrorString(e), grid);
#ifdef PROBE_LO
    (void)hipMemsetAsync((char*)d_ws + WS_BARRIER, 0, 16384, stream);
    Args a2 = a; a2.ph_lo = PROBE_LO; a2.ph_hi = PROBE_HI;
    void* args2[] = {&a2};
    (void)hipLaunchCooperativeKernel((const void*)fwd_kernel, dim3(grid), dim3(512), args2, LDS_BYTES, stream);
#endif
#endif
}
```

```cpp
#include <hip/hip_runtime.h>
#include <hip/hip_cooperative_groups.h>
#include <cstdio>
#include <cstdint>
namespace cg = cooperative_groups;
namespace pg8 {
#define PG8_LAS __attribute__((address_space(3)))
typedef unsigned short bf16_t;
typedef short bf16x8 __attribute__((ext_vector_type(8)));
typedef float f32x4 __attribute__((ext_vector_type(4)));
typedef unsigned u32x4 __attribute__((ext_vector_type(4)));
constexpr int BM = 256, BK = 64, HALF = 128, HTB = HALF * BK * 2  , STAGE_BYTES = 8 * HTB, NXCD = 8, WGM = 8;

__host__ __device__ __forceinline__ int lds_byte(int r, int c) { const int st = (r >> 4) * 2 + (c >> 5), rr = r & 15, cc = c & 31, ob = rr * 64 + cc * 2; return st * 1024 + (ob ^ (((ob >> 9) & 1) << 5)); }
__host__ __device__ __forceinline__ void stage_rc(int b, int& R, int& C) { const int st = b / 1024, sb = b % 1024, swz = sb ^ (((sb >> 9) & 1) << 5); R = (st >> 1) * 16 + swz / 64; C = (st & 1) * 32 + (swz % 64) / 2; }
__host__ __device__ __forceinline__ int perm32(int rho) { const int n = rho >> 4, i = rho & 15; return 8 * (i >> 2) + 4 * n + (i & 3); }

struct Unit { int pm, pn; };
struct Gemm { const bf16_t* A; const bf16_t* Bt; int M, N, K; };

struct StaticOrder {
    int nM, nN, nwg, G, c;
    __host__ __device__ void init(int M, int N, int G_, int c_) { nM = M / BM; nN = N / BM; nwg = nM * nN; G = G_; c = c_; }
    __host__ __device__ bool next(int i, Unit& u) const {
        const long L = (long)i * G + c; if (L >= nwg) return false;
        int wgid = (int)L; { const int q = nwg / NXCD, r = nwg % NXCD, xcd = wgid % NXCD, off = wgid / NXCD; wgid = (xcd < r ? xcd * (q + 1) : r * (q + 1) + (xcd - r) * q) + off; }
        const int nig = WGM * nN, gid = wgid / nig, fm = gid * WGM, gsz = (nM - fm) < WGM ? (nM - fm) : WGM;
        u.pm = fm + ((wgid % nig) % gsz); u.pn = (wgid % nig) / gsz; return true;
    }
    __device__ __forceinline__ void a_ready(const Unit&) const {}
    __device__ __forceinline__ void done(const Unit&) const {}
};

__device__ __forceinline__ unsigned cvt_pk_bf16(float lo, float hi) { unsigned r; asm volatile("v_cvt_pk_bf16_f32 %0, %1, %2" : "=v"(r) : "v"(lo), "v"(hi)); return r; }
typedef float f32x2 __attribute__((ext_vector_type(2)));
template <class Epi, class Sched, bool ALIGN_EPI = false, bool SP2 = false>
__device__ __forceinline__ void gemm_phase(PG8_LAS unsigned char* lds, const Gemm g, const Sched& S, const Epi& E) {
    const int tid = threadIdx.x, wid = __builtin_amdgcn_readfirstlane(tid >> 6), lane = tid & 63, wr = wid >> 2, wc = wid & 3, fr = lane & 15, fq = lane >> 4;
    const int K = g.K, nt = K / BK;
    unsigned voffA[2], voffB[2];
#pragma unroll
    for (int i = 0; i < 2; ++i) { int R, C; stage_rc(tid * 16 + i * 8192, R, C); const int Rb = Epi::PERM ? ((R & ~31) + perm32(R & 31)) : R;
        voffA[i] = (unsigned)(R * K + C) * 2u; voffB[i] = (unsigned)(Rb * K + C) * 2u; }
    const size_t kstep = (size_t)(BK * 2);
    const size_t hstep = (size_t)HALF * K * 2;
    const size_t tstep = 2 * hstep;
    const unsigned ldsw = (unsigned)wid * 1024u;
    const int aoff = lds_byte(wr * 64 + fr, fq * 8), boff = lds_byte(wc * 32 + fr, fq * 8);
#define PG8_SA(b, h) (((b) * 2 + (h)) * HTB)
#define PG8_SB(b, h) ((4 + (b) * 2 + (h)) * HTB)
#define PG8_STAGE(bufoff, gbase, voff) do { _Pragma("unroll") for (int _i = 0; _i < 2; ++_i) \
        __builtin_amdgcn_global_load_lds((const unsigned*)((const char*)(gbase) + (voff)[_i]), (PG8_LAS unsigned*)(lds + (bufoff) + ldsw + _i * 8192), 16, 0, 0); } while (0)
#define PG8_LDA(dst, b, h) do { _Pragma("unroll") for (int m = 0; m < 4; ++m) _Pragma("unroll") for (int k = 0; k < 2; ++k) dst[m][k] = *(const PG8_LAS bf16x8*)(lds + PG8_SA(b, h) + aoff + m * 2048 + k * 1024); } while (0)
#define PG8_LDB(dst, b, h) do { _Pragma("unroll") for (int n = 0; n < 2; ++n) _Pragma("unroll") for (int k = 0; k < 2; ++k) dst[n][k] = *(const PG8_LAS bf16x8*)(lds + PG8_SB(b, h) + boff + n * 2048 + k * 1024); } while (0)
#define PG8_MMA(ai, bj, At, Bt) do { __builtin_amdgcn_s_setprio(1); _Pragma("unroll") for (int m = 0; m < 4; ++m) _Pragma("unroll") for (int n = 0; n < 2; ++n) _Pragma("unroll") for (int k = 0; k < 2; ++k) \
        acc[ai][bj][m][n] = __builtin_amdgcn_mfma_f32_16x16x32_bf16(Bt[n][k], At[m][k], acc[ai][bj][m][n], 0, 0, 0); __builtin_amdgcn_s_setprio(0); } while (0)
#define PG8_WAIT_V(n) asm volatile("s_waitcnt vmcnt(" #n ")" ::: "memory")
#define PG8_WAIT_L(n) asm volatile("s_waitcnt lgkmcnt(" #n ")" ::: "memory")
#define PG8_BAR __builtin_amdgcn_s_barrier()
#define PG8_SCHED __builtin_amdgcn_sched_barrier(0)
    Unit cur, nxt; int ui = 0;
    if (!S.next(0, cur)) return;
    f32x4 acc[2][2][4][2];
#pragma unroll
    for (int a = 0; a < 2; ++a)
#pragma unroll
        for (int b = 0; b < 2; ++b)
#pragma unroll
            for (int m = 0; m < 4; ++m)
#pragma unroll
                for (int n = 0; n < 2; ++n) acc[a][b][m][n] = (f32x4){0.f, 0.f, 0.f, 0.f};
    bf16x8 At[4][2], B0[2][2], B1[2][2];
    const char* cA = (const char*)g.A + (size_t)cur.pm * tstep; const char* cB = (const char*)g.Bt + (size_t)cur.pn * tstep;
    S.a_ready(cur);
    if constexpr (SP2) {
        PG8_STAGE(PG8_SB(0, 0), cB, voffB); PG8_STAGE(PG8_SB(0, 1), cB + hstep, voffB); PG8_STAGE(PG8_SA(0, 0), cA, voffA); PG8_STAGE(PG8_SA(0, 1), cA + hstep, voffA);
        if (wr == 1) PG8_BAR;
        PG8_WAIT_V(2); PG8_BAR;
        PG8_STAGE(PG8_SB(1, 0), cB + kstep, voffB); PG8_STAGE(PG8_SA(1, 0), cA + kstep, voffA); PG8_STAGE(PG8_SB(1, 1), cB + hstep + kstep, voffB);
        PG8_WAIT_V(6); PG8_BAR;
    } else {
        PG8_STAGE(PG8_SB(0, 0), cB, voffB); PG8_STAGE(PG8_SA(0, 0), cA, voffA); PG8_STAGE(PG8_SB(0, 1), cB + hstep, voffB); PG8_STAGE(PG8_SA(0, 1), cA + hstep, voffA);
        if (wr == 1) PG8_BAR;
        PG8_WAIT_V(4); PG8_BAR;
        PG8_STAGE(PG8_SB(1, 0), cB + kstep, voffB); PG8_STAGE(PG8_SA(1, 0), cA + kstep, voffA); PG8_STAGE(PG8_SB(1, 1), cB + hstep + kstep, voffB);
        PG8_WAIT_V(6); PG8_BAR;
    }
    for (;;) {
        const bool has_next = S.next(ui + 1, nxt);
        const char* nA = has_next ? (const char*)g.A + (size_t)nxt.pm * tstep : cA; const char* nB = has_next ? (const char*)g.Bt + (size_t)nxt.pn * tstep : cB;
        for (int t = 0; t < nt; t += 2) {
            const bool last = (t == nt - 2);
            const char* a1 = cA + (size_t)(t + 1) * kstep;
            const char* a2 = last ? nA : cA + (size_t)(t + 2) * kstep; const char* b2 = last ? nB : cB + (size_t)(t + 2) * kstep;
            const char* a3 = a2 + kstep; const char* b3 = b2 + kstep;
            if (last && has_next) S.a_ready(nxt);
            if constexpr (SP2) {
            PG8_LDB(B0, 0, 0); PG8_LDB(B1, 0, 1); PG8_SCHED; PG8_LDA(At, 0, 0); PG8_STAGE(PG8_SA(1, 1), a1 + hstep, voffA);
            PG8_WAIT_V(8); PG8_WAIT_L(0); PG8_BAR; PG8_MMA(0, 0, At, B0); PG8_MMA(0, 1, At, B1); PG8_BAR; PG8_SCHED;
            PG8_LDA(At, 0, 1); PG8_STAGE(PG8_SB(0, 0), b2, voffB); PG8_STAGE(PG8_SB(0, 1), b2 + hstep, voffB); PG8_STAGE(PG8_SA(0, 0), a2, voffA);
            PG8_WAIT_V(8); PG8_WAIT_L(0); PG8_BAR; PG8_MMA(1, 0, At, B0); PG8_MMA(1, 1, At, B1); PG8_BAR; PG8_SCHED;
            PG8_LDB(B0, 1, 0); PG8_LDB(B1, 1, 1); PG8_SCHED; PG8_LDA(At, 1, 0); PG8_STAGE(PG8_SA(0, 1), a2 + hstep, voffA);
            PG8_WAIT_V(8); PG8_WAIT_L(0); PG8_BAR; PG8_MMA(0, 0, At, B0); PG8_MMA(0, 1, At, B1); PG8_BAR; PG8_SCHED;
            PG8_LDA(At, 1, 1); PG8_STAGE(PG8_SB(1, 0), b3, voffB); PG8_STAGE(PG8_SB(1, 1), b3 + hstep, voffB); PG8_STAGE(PG8_SA(1, 0), a3, voffA);
            PG8_WAIT_V(8); PG8_WAIT_L(0); PG8_BAR; PG8_MMA(1, 0, At, B0); PG8_MMA(1, 1, At, B1); PG8_BAR; PG8_SCHED;
            } else {
            PG8_LDB(B0, 0, 0); PG8_SCHED; PG8_LDA(At, 0, 0); PG8_STAGE(PG8_SA(1, 1), a1 + hstep, voffA);
            PG8_WAIT_L(8); PG8_BAR; PG8_WAIT_L(0); PG8_MMA(0, 0, At, B0); PG8_BAR; PG8_SCHED;
            PG8_LDB(B1, 0, 1); PG8_STAGE(PG8_SB(0, 0), b2, voffB);
            PG8_BAR; PG8_WAIT_L(0); PG8_MMA(0, 1, At, B1); PG8_BAR;
            PG8_LDA(At, 0, 1); PG8_STAGE(PG8_SA(0, 0), a2, voffA);
            PG8_BAR; PG8_WAIT_L(0); PG8_MMA(1, 0, At, B0); PG8_BAR; PG8_SCHED;
            PG8_STAGE(PG8_SB(0, 1), b2 + hstep, voffB);
            PG8_WAIT_V(6); PG8_BAR; PG8_MMA(1, 1, At, B1); PG8_BAR;
            PG8_LDB(B0, 1, 0); PG8_SCHED; PG8_LDA(At, 1, 0); PG8_STAGE(PG8_SA(0, 1), a2 + hstep, voffA);
            PG8_WAIT_L(8); PG8_BAR; PG8_WAIT_L(0); PG8_MMA(0, 0, At, B0); PG8_BAR; PG8_SCHED;
            PG8_LDB(B1, 1, 1); PG8_STAGE(PG8_SB(1, 0), b3, voffB);
            PG8_BAR; PG8_WAIT_L(0); PG8_MMA(0, 1, At, B1); PG8_BAR;
            PG8_LDA(At, 1, 1); PG8_STAGE(PG8_SA(1, 0), a3, voffA);
            PG8_BAR; PG8_WAIT_L(0); PG8_MMA(1, 0, At, B0); PG8_BAR; PG8_SCHED;
            PG8_STAGE(PG8_SB(1, 1), b3 + hstep, voffB);
            PG8_WAIT_V(6); PG8_BAR; PG8_MMA(1, 1, At, B1); PG8_BAR;
            }
        }
        if constexpr (ALIGN_EPI) { if (wr == 0) PG8_BAR; }
        if constexpr (!Epi::AFTER_DRAIN) { E(acc, cur, wr, wc, fr, fq); S.done(cur); }
        if (!has_next) break;
#pragma unroll
        for (int a = 0; a < 2; ++a)
#pragma unroll
            for (int b = 0; b < 2; ++b)
#pragma unroll
                for (int m = 0; m < 4; ++m)
#pragma unroll
                    for (int n = 0; n < 2; ++n) acc[a][b][m][n] = (f32x4){0.f, 0.f, 0.f, 0.f};
        cur = nxt; cA = nA; cB = nB; ++ui;
        if constexpr (ALIGN_EPI) { if (wr == 1) PG8_BAR; }
    }
    PG8_WAIT_V(0);
    if constexpr (!ALIGN_EPI) { if (wr == 0) PG8_BAR; }
    PG8_BAR;
    if constexpr (Epi::AFTER_DRAIN) { E.fused(acc, cur, wr, wc, fr, fq, lds, wid, lane); S.done(cur); }
#undef PG8_SA
#undef PG8_SB
#undef PG8_STAGE
#undef PG8_LDA
#undef PG8_LDB
#undef PG8_MMA
#undef PG8_WAIT_V
#undef PG8_WAIT_L
#undef PG8_BAR
#undef PG8_SCHED
}
}
namespace pg8 {
typedef unsigned u32x2 __attribute__((ext_vector_type(2)));
typedef float f32x2_t __attribute__((ext_vector_type(2))); typedef __bf16 bf16x2_t __attribute__((ext_vector_type(2)));
__device__ __forceinline__ unsigned cvtpk(float lo, float hi) { f32x2_t v = {lo, hi}; bf16x2_t b = __builtin_convertvector(v, bf16x2_t); return __builtin_bit_cast(unsigned, b); }
__device__ __forceinline__ float sigm(float x) { return __builtin_amdgcn_rcpf(1.0f + __expf(-x)); }
__device__ __forceinline__ float gelu_tanh(float x) { const float u = 1.5957691216057308f * (x + 0.044715f * x * x * x); return x * __builtin_amdgcn_rcpf(1.0f + __expf(-u)); }
__device__ __forceinline__ float bfw(unsigned w, int hi) { return __uint_as_float(hi ? (w & 0xffff0000u) : (w << 16)); }
__device__ __forceinline__ float logsig(float z) { return fminf(z, 0.f) - log1pf(__expf(-fabsf(z))); }
__device__ __forceinline__ float dpp_ror1(float v) { return __int_as_float(__builtin_amdgcn_update_dpp(__float_as_int(v), __float_as_int(v), 0x121, 0xf, 0xf, false)); }
__device__ __forceinline__ float dpp_ror2(float v) { return __int_as_float(__builtin_amdgcn_update_dpp(__float_as_int(v), __float_as_int(v), 0x122, 0xf, 0xf, false)); }

struct EpiProj {
    static constexpr bool PERM = true, AFTER_DRAIN = false;
    bf16_t* O; int ldc; const float* ss;
    __device__ __forceinline__ void operator()(const f32x4 (&acc)[2][2][4][2], const Unit& u, int wr, int wc, int fr, int fq) const {
        const int row0 = u.pm * BM + wr * 64 + fr, col0 = u.pn * BM + wc * 32 + 8 * fq;
#pragma unroll
        for (int ai = 0; ai < 2; ++ai)
#pragma unroll
            for (int m = 0; m < 4; ++m) {
                const int row = row0 + ai * HALF + m * 16;
                const float rs = rsqrtf(ss[row] * (1.0f / 1024.0f) + 1e-6f);
                bf16_t* rowp = O + (size_t)row * ldc + col0;
#pragma unroll
                for (int bj = 0; bj < 2; ++bj) {
                    const f32x4 v0 = acc[ai][bj][m][0] * rs, v1 = acc[ai][bj][m][1] * rs;
                    u32x4 w; w.x = cvt_pk_bf16(v0[0], v0[1]); w.y = cvt_pk_bf16(v0[2], v0[3]); w.z = cvt_pk_bf16(v1[0], v1[1]); w.w = cvt_pk_bf16(v1[2], v1[3]);
                    *(u32x4*)(rowp + bj * HALF) = w;
                }
            }
    }
};

struct EpiGates {
    static constexpr bool PERM = true, AFTER_DRAIN = false;
    const bf16_t* xc; bf16_t* loga; bf16_t* gi; const float* ga_b; const float* gx_b; const float* lam;
    __device__ __forceinline__ void operator()(const f32x4 (&acc)[2][2][4][2], const Unit& u, int wr, int wc, int fr, int fq) const {
        const int row0 = u.pm * BM + wr * 64 + fr, ch0 = u.pn * HALF + wc * 32 + 8 * fq;
        float gab[8], gxb[8], ls[8];
#pragma unroll
        for (int e = 0; e < 8; ++e) { gab[e] = ga_b[ch0 + e]; gxb[e] = gx_b[ch0 + e]; ls[e] = 8.0f * logsig(lam[ch0 + e]); }
#pragma unroll
        for (int ai = 0; ai < 2; ++ai)
#pragma unroll
            for (int m = 0; m < 4; ++m) {
                const int row = row0 + ai * HALF + m * 16;
                const u32x4 xv = *(const u32x4*)(xc + (size_t)row * 512 + ch0);
                float la[8], g[8];
#pragma unroll
                for (int n = 0; n < 2; ++n)
#pragma unroll
                    for (int e = 0; e < 4; ++e) {
                        const int idx = 4 * n + e;
                        const float r = acc[ai][0][m][n][e] + gab[idx], i = acc[ai][1][m][n][e] + gxb[idx];
                        la[idx] = sigm(r) * ls[idx];
                        g[idx] = sigm(i) * bfw(xv[idx >> 1], idx & 1);
                    }
                u32x4 w; w.x = cvt_pk_bf16(la[0], la[1]); w.y = cvt_pk_bf16(la[2], la[3]); w.z = cvt_pk_bf16(la[4], la[5]); w.w = cvt_pk_bf16(la[6], la[7]);
                *(u32x4*)(loga + (size_t)row * 512 + ch0) = w;
                u32x4 w2; w2.x = cvt_pk_bf16(g[0], g[1]); w2.y = cvt_pk_bf16(g[2], g[3]); w2.z = cvt_pk_bf16(g[4], g[5]); w2.w = cvt_pk_bf16(g[6], g[7]);
                *(u32x4*)(gi + (size_t)row * 512 + ch0) = w2;
            }
    }
};

struct EpiRes {
    static constexpr bool PERM = false, AFTER_DRAIN = false;
    const float* base; float* out; bf16_t* xb; float* ss;
    __device__ __forceinline__ void operator()(const f32x4 (&acc)[2][2][4][2], const Unit& u, int wr, int wc, int fr, int fq) const {
        const int row0 = u.pm * BM + wr * 64 + fr, col0 = u.pn * BM + wc * 32 + 4 * fq;
#pragma unroll
        for (int ai = 0; ai < 2; ++ai)
#pragma unroll
            for (int m = 0; m < 4; ++m) {
                const int row = row0 + ai * HALF + m * 16; float q = 0.f;
#pragma unroll
                for (int bj = 0; bj < 2; ++bj)
#pragma unroll
                    for (int n = 0; n < 2; ++n) {
                        const size_t off = (size_t)row * 1024 + col0 + bj * HALF + n * 16;
                        const f32x4 b = *(const f32x4*)(base + off);
                        const f32x4 o = b + acc[ai][bj][m][n];
                        *(f32x4*)(out + off) = o;
                        if (xb) { u32x2 w; w.x = cvt_pk_bf16(o[0], o[1]); w.y = cvt_pk_bf16(o[2], o[3]); *(u32x2*)(xb + off) = w; }
                        q += (o[0] * o[0] + o[1] * o[1]) + (o[2] * o[2] + o[3] * o[3]);
                    }
                if (ss) { q += __shfl_xor(q, 16); q += __shfl_xor(q, 32); if (fq == 0) atomicAdd(ss + row, q); }
            }
    }
};

struct EpiGlu {
    static constexpr bool PERM = true, AFTER_DRAIN = false;
    const bf16_t* ys; bf16_t* ycat; const float* bias;
    __device__ __forceinline__ void operator()(const f32x4 (&acc)[2][2][4][2], const Unit& u, int wr, int wc, int fr, int fq) const {
        const int row0 = u.pm * BM + wr * 64 + fr, col0 = u.pn * BM + wc * 32 + 8 * fq;
#pragma unroll
        for (int bj = 0; bj < 2; ++bj) {
            const int col = col0 + bj * HALF;
            float bs[8];
#pragma unroll
            for (int e = 0; e < 8; ++e) bs[e] = bias[col + e];
#pragma unroll
            for (int ai = 0; ai < 2; ++ai)
#pragma unroll
                for (int m = 0; m < 4; ++m) {
                    const int row = row0 + ai * HALF + m * 16;
                    const u32x4 yv = *(const u32x4*)(ys + (size_t)row * 512 + col);
                    float o[8];
#pragma unroll
                    for (int n = 0; n < 2; ++n)
#pragma unroll
                        for (int e = 0; e < 4; ++e) { const int idx = 4 * n + e; o[idx] = bfw(yv[idx >> 1], idx & 1) * sigm(acc[ai][bj][m][n][e] + bs[idx]); }
                    u32x4 w; w.x = cvt_pk_bf16(o[0], o[1]); w.y = cvt_pk_bf16(o[2], o[3]); w.z = cvt_pk_bf16(o[4], o[5]); w.w = cvt_pk_bf16(o[6], o[7]);
                    *(u32x4*)(ycat + (size_t)row * 1024 + col) = w;
                }
        }
    }
};

struct EpiFfn {
    static constexpr bool PERM = true, AFTER_DRAIN = false;
    bf16_t* U; const float* ss; const float* cw; const float* cb; float* edgeA; float* edgeL; float* tailA; PG8_LAS float* halo;
    __device__ __forceinline__ void operator()(const f32x4 (&acc)[2][2][4][2], const Unit& u, int wr, int wc, int fr, int fq) const {
        const int cl = wc * 32 + 8 * fq, ch0 = u.pn * HALF + cl;
        const int row0 = u.pm * BM + wr * 64 + fr;
        float w0[8], w1[8], w2[8], bb[8];
#pragma unroll
        for (int e = 0; e < 8; ++e) { w0[e] = cw[ch0 + e]; w1[e] = cw[3072 + ch0 + e]; w2[e] = cw[6144 + ch0 + e]; bb[e] = cb[ch0 + e]; }
        float rs[2][4];
#pragma unroll
        for (int ai = 0; ai < 2; ++ai)
#pragma unroll
            for (int m = 0; m < 4; ++m) rs[ai][m] = rsqrtf(ss[row0 + ai * HALF + m * 16] * (1.0f / 1024.0f) + 1e-6f);
        if (fr >= 14) {
#pragma unroll
            for (int ai = 0; ai < 2; ++ai) {
                PG8_LAS float* hp = halo + ((ai * 2 + wr) * 2 + (fr - 14)) * 128 + cl;
                *(PG8_LAS f32x4*)hp = acc[ai][0][3][0] * rs[ai][3];
                *(PG8_LAS f32x4*)(hp + 4) = acc[ai][0][3][1] * rs[ai][3];
            }
            if (wr == 1) {
                float* tp = tailA + (size_t)(u.pm * 2 + (fr - 14)) * 3072 + ch0;
                *(f32x4*)tp = acc[1][0][3][0] * rs[1][3]; *(f32x4*)(tp + 4) = acc[1][0][3][1] * rs[1][3];
            }
        }
        if (wr == 0 && fr < 2) {
            float* ea = edgeA + (size_t)(u.pm * 2 + fr) * 3072 + ch0; float* el = edgeL + (size_t)(u.pm * 2 + fr) * 3072 + ch0;
            *(f32x4*)ea = acc[0][0][0][0] * rs[0][0]; *(f32x4*)(ea + 4) = acc[0][0][0][1] * rs[0][0];
            *(f32x4*)el = acc[0][1][0][0] * rs[0][0]; *(f32x4*)(el + 4) = acc[0][1][0][1] * rs[0][0];
        }
        asm volatile("s_waitcnt lgkmcnt(0)" ::: "memory"); __builtin_amdgcn_s_barrier(); asm volatile("" ::: "memory");
#pragma unroll
        for (int ai = 0; ai < 2; ++ai) {
            f32x4 pv[2];
            if (ai == 0 && wr == 0) { pv[0] = (f32x4){0.f, 0.f, 0.f, 0.f}; pv[1] = pv[0]; }
            else {
                const int pai = (wr == 1) ? ai : 0, pwr = (wr == 1) ? 0 : 1;
                const PG8_LAS float* hp = halo + ((pai * 2 + pwr) * 2 + (fr & 1)) * 128 + cl;
                pv[0] = *(const PG8_LAS f32x4*)hp; pv[1] = *(const PG8_LAS f32x4*)(hp + 4);
            }
#pragma unroll
            for (int m = 0; m < 4; ++m) {
                const int row = row0 + ai * HALF + m * 16;
                f32x4 av[2]; av[0] = acc[ai][0][m][0] * rs[ai][m]; av[1] = acc[ai][0][m][1] * rs[ai][m];
                float o[8];
#pragma unroll
                for (int n = 0; n < 2; ++n)
#pragma unroll
                    for (int e = 0; e < 4; ++e) {
                        const int idx = 4 * n + e;
                        const float cur = av[n][e], prv = pv[n][e];
                        const float r1c = dpp_ror1(cur), r1p = dpp_ror1(prv), r2c = dpp_ror2(cur), r2p = dpp_ror2(prv);
                        const float t1 = (fr >= 1) ? r1c : r1p, t2 = (fr >= 2) ? r2c : r2p;
                        const float cv = w0[idx] * t2 + w1[idx] * t1 + w2[idx] * cur + bb[idx];
                        o[idx] = gelu_tanh(cv) * (acc[ai][1][m][n][e] * rs[ai][m]);
                    }
                u32x4 w; w.x = cvt_pk_bf16(o[0], o[1]); w.y = cvt_pk_bf16(o[2], o[3]); w.z = cvt_pk_bf16(o[4], o[5]); w.w = cvt_pk_bf16(o[6], o[7]);
                *(u32x4*)(U + (size_t)row * 3072 + ch0) = w;
                pv[0] = av[0]; pv[1] = av[1];
            }
        }
    }
};
}
#define LAS __attribute__((address_space(3)))
typedef unsigned short bf16;
typedef short bf16x8 __attribute__((ext_vector_type(8)));
typedef float f32x4 __attribute__((ext_vector_type(4)));
typedef unsigned u32x4 __attribute__((ext_vector_type(4)));
typedef unsigned u32x2 __attribute__((ext_vector_type(2)));
using pg8::cvt_pk_bf16; using pg8::sigm; using pg8::gelu_tanh; using pg8::bfw; using pg8::logsig;

constexpr int TT = 16384, SEQ = 8192, DM = 1024, DFF = 3072;
constexpr size_t MiB = 1u << 20;
constexpr size_t WS_SS = 0;
constexpr size_t WS_SUMA = 256 * 1024, WS_SUMB = 768 * 1024;
constexpr size_t WS_DECAY = 1280 * 1024;
constexpr size_t WS_BARRIER = 3 * 1024 * 1024;
constexpr size_t WS_ROPE = 1536 * 1024;
constexpr size_t WS_W_EIN = 4 * MiB, WS_W_EOUT = 9 * MiB, WS_W_GATE = 11 * MiB, WS_W_FIN0 = 12 * MiB, WS_W_FIN1 = 24 * MiB, WS_W_FOUT0 = 36 * MiB, WS_W_FOUT1 = 42 * MiB;
constexpr size_t WS_W_OIN = 48 * MiB, WS_W_GLU = 53 * MiB, WS_W_OOUT = 54 * MiB, WS_S5A = 56 * MiB, WS_S5F = 62 * MiB;
constexpr size_t WS_XB = 64 * MiB;
constexpr size_t WS_LOGA = 64 * MiB, WS_GI = 80 * MiB;
constexpr size_t WS_KDT = 64 * MiB, WS_VTG = 72 * MiB, WS_SX = 88 * MiB;
constexpr size_t WS_BIG = 96 * MiB;
constexpr size_t WS_XC = 224 * MiB, WS_KVS = 168 * MiB;
constexpr size_t WS_YCAT = 192 * MiB;
constexpr size_t WS_XLOC = 224 * MiB;
constexpr size_t WS_EDGEA = 240 * MiB, WS_EDGEL = 242 * MiB, WS_TAILA = 244 * MiB;
constexpr size_t WS_END = 256 * MiB;
constexpr int P0LD = 2568, P1LD = 2304;
constexpr int VTP = SEQ + 128;
constexpr int LDS_BYTES = 147456, HALO_OFF = 131072 + 1024;

__device__ __forceinline__ float wave_sum(float v) {
#pragma unroll
    for (int o = 1; o < 64; o <<= 1) v += __shfl_xor(v, o);
    return v;
}
__device__ __forceinline__ float bf2f(bf16 b) { return __uint_as_float((unsigned)b << 16); }
__device__ __forceinline__ bf16 f2bf(float f) { return (bf16)(cvt_pk_bf16(f, 0.f) & 0xffffu); }
__device__ __forceinline__ f32x4 mfma16(bf16x8 a, bf16x8 b, f32x4 c) { return __builtin_amdgcn_mfma_f32_16x16x32_bf16(a, b, c, 0, 0, 0); }
__device__ __forceinline__ bf16x8 ld8(const bf16* p) { return *(const bf16x8*)p; }
__device__ __forceinline__ void unpack8(u32x4 v, float* f) {
#pragma unroll
    for (int i = 0; i < 4; ++i) { f[2 * i] = __uint_as_float(v[i] << 16); f[2 * i + 1] = __uint_as_float(v[i] & 0xffff0000u); }
}
__device__ __forceinline__ u32x4 pack8v(const float* f) { u32x4 w; w.x = pg8::cvtpk(f[0], f[1]); w.y = pg8::cvtpk(f[2], f[3]); w.z = pg8::cvtpk(f[4], f[5]); w.w = pg8::cvtpk(f[6], f[7]); return w; }
__device__ __forceinline__ u32x4 pack8(const float* f) { u32x4 w; w.x = cvt_pk_bf16(f[0], f[1]); w.y = cvt_pk_bf16(f[2], f[3]); w.z = cvt_pk_bf16(f[4], f[5]); w.w = cvt_pk_bf16(f[6], f[7]); return w; }

struct Ctx { int tid, lane, wave, gw, ngw, gtid, ngt; LAS unsigned char* lds; };

struct TrDesc { const float* W; const float* gk; bf16* WT; int ldw, nsrc, ldt, k0, n0, dst_row0; };
__device__ __forceinline__ void tr_load(const TrDesc& t, int lane, float* v) {
    const int n = t.n0 + (lane & 31);
#pragma unroll
    for (int i = 0; i < 32; ++i) { const int kk = 2 * i + (lane >> 5); v[i] = (n < t.nsrc) ? t.W[(size_t)(t.k0 + kk) * t.ldw + n] : 0.f; }
}
__device__ __forceinline__ void tr_finish(const TrDesc& t, int lane, const float* v, LAS float* scr) {
#pragma unroll
    for (int i = 0; i < 32; ++i) { const int kk = 2 * i + (lane >> 5); float x = v[i]; if (t.gk) x *= t.gk[t.k0 + kk]; scr[kk * 33 + (lane & 31)] = x; }
    asm volatile("s_waitcnt lgkmcnt(0)" ::: "memory");
    const int c = lane & 7;
#pragma unroll
    for (int j = 0; j < 4; ++j) {
        const int n = (lane >> 3) + 8 * j; const LAS float* s = scr + (8 * c) * 33 + n;
        u32x4 o; o.x = cvt_pk_bf16(s[0], s[33]); o.y = cvt_pk_bf16(s[66], s[99]); o.z = cvt_pk_bf16(s[132], s[165]); o.w = cvt_pk_bf16(s[198], s[231]);
        *(u32x4*)(t.WT + (size_t)(t.dst_row0 + n) * t.ldt + t.k0 + 8 * c) = o;
    }
    asm volatile("s_waitcnt lgkmcnt(0)" ::: "memory");
}

struct S5P { float m, th, cr, ci, ar, ai; };
__device__ __forceinline__ S5P s5_params(const float* lam_re, const float* lam_im, const float* log_step, int g, int n) {
    const float step = expf(log_step[g]), lr = lam_re[g * 64 + n], li = lam_im[g * 64 + n];
    S5P p; p.m = lr * step; p.th = li * step;
    float sn, cs; sincosf(p.th, &sn, &cs);
    const float mag = expf(p.m), ar = mag * cs, ai = mag * sn, den = lr * lr + li * li;
    p.cr = ((ar - 1.0f) * lr + ai * li) / den; p.ci = (ai * lr - (ar - 1.0f) * li) / den; p.ar = ar; p.ai = ai;
    return p;
}
__device__ __forceinline__ void s5_pow(const S5P& p, float tau, float& pr, float& pi) {
    float sn, cs; sincosf(p.th * tau, &sn, &cs); const float mag = expf(p.m * tau); pr = mag * cs; pi = mag * sn;
}

__device__ __forceinline__ TrDesc tr_decode(const float* const* in, unsigned char* ws, int it) {
    constexpr int I_EIN = 16 * 80, I_EOUT = 16 * 32, I_FIN = 16 * 192, I_FOUT = 48 * 32, I_OIN = 16 * 72, I_GLU = 8 * 16;
    TrDesc t; int r = it;
    if (r < I_EIN) { const int kb = r / 80, nb = r % 80; t = TrDesc{in[2], in[1], (bf16*)(ws + WS_W_EIN), 2560, 2560, 1024, 64 * kb, 32 * nb, 32 * nb}; return t; } r -= I_EIN;
    if (r < I_EOUT) { const int kb = r / 32, nb = r % 32; t = TrDesc{in[12], nullptr, (bf16*)(ws + WS_W_EOUT), 1024, 1024, 1024, 64 * kb, 32 * nb, 32 * nb}; return t; } r -= I_EOUT;
    if (r < 2 * I_FIN) { const int l = r / I_FIN; r %= I_FIN; const int kb = r / 192, nb = r % 192, n0 = 32 * nb;
        const int dst = (n0 < 3072) ? (256 * (n0 / 128) + (n0 % 128)) : (256 * ((n0 - 3072) / 128) + 128 + ((n0 - 3072) % 128));
        t = TrDesc{in[30] + (size_t)l * 1024 * 6144, in[29] + l * 1024, (bf16*)(ws + (l ? WS_W_FIN1 : WS_W_FIN0)), 6144, 6144, 1024, 64 * kb, n0, dst}; return t; } r -= 2 * I_FIN;
    if (r < 2 * I_FOUT) { const int l = r / I_FOUT; r %= I_FOUT; const int kb = r / 32, nb = r % 32;
        t = TrDesc{in[33] + (size_t)l * 3072 * 1024, nullptr, (bf16*)(ws + (l ? WS_W_FOUT1 : WS_W_FOUT0)), 1024, 1024, 3072, 64 * kb, 32 * nb, 32 * nb}; return t; } r -= 2 * I_FOUT;
    if (r < I_OIN) { const int kb = r / 72, nb = r % 72; t = TrDesc{in[14], in[13], (bf16*)(ws + WS_W_OIN), 2064, 2064, 1024, 64 * kb, 32 * nb, 32 * nb}; return t; } r -= I_OIN;
    if (r < I_GLU) { const int kb = r / 16, nb = r % 16; t = TrDesc{in[23], nullptr, (bf16*)(ws + WS_W_GLU), 512, 512, 512, 64 * kb, 32 * nb, 32 * nb}; return t; } r -= I_GLU;
    { const int kb = r / 32, nb = r % 32; t = TrDesc{in[28], nullptr, (bf16*)(ws + WS_W_OOUT), 1024, 1024, 1024, 64 * kb, 32 * nb, 32 * nb}; return t; }
}
__device__ __forceinline__ void do_tr_items(const Ctx& c, const float* const* in, unsigned char* ws, int it_begin, int it_end, int widx, int nw) {
    LAS float* scr = (LAS float*)(c.lds + c.wave * 16384);
    int it = it_begin + widx;
    if (it >= it_end) return;
    TrDesc cur = tr_decode(in, ws, it); float v[32]; tr_load(cur, c.lane, v);
    for (;;) {
        const int nx = it + nw; const bool more = nx < it_end;
        TrDesc nxt = cur; float w[32];
        if (more) { nxt = tr_decode(in, ws, nx); tr_load(nxt, c.lane, w); }
        tr_finish(cur, c.lane, v, scr);
        if (!more) break;
        cur = nxt; it = nx;
#pragma unroll
        for (int i = 0; i < 32; ++i) v[i] = w[i];
    }
}
#ifndef DEFER_TR
#define DEFER_TR 0
#endif
#ifndef DEFER_P1
#define DEFER_P1 0
#endif
constexpr int TR_EIN0 = 0, TR_EOUT0 = 1280, TR_FIN00 = 1792, TR_FIN10 = 4864, TR_FOUT00 = 7936, TR_FOUT10 = 9472, TR_OIN0 = 11008, TR_GLU0 = 12160, TR_OOUT0 = 12288, TR_END = 12800;

__device__ __forceinline__ void phase_prologue(const Ctx& c, const float* const* in, unsigned char* ws) {
#if DEFER_TR
    do_tr_items(c, in, ws, TR_EIN0, TR_EOUT0, c.gw, c.ngw);
#elif DEFER_P1
    do_tr_items(c, in, ws, TR_EIN0, TR_EOUT0, c.gw, c.ngw); do_tr_items(c, in, ws, TR_FIN10, TR_END, c.gw, c.ngw);
#else
    do_tr_items(c, in, ws, TR_EIN0, TR_END, c.gw, c.ngw);
#endif
    {
        const float* x = in[0]; bf16* xb = (bf16*)(ws + WS_XB); float* ss = (float*)(ws + WS_SS);
        for (int m0 = c.gw; m0 < TT; m0 += 2 * c.ngw) {
            f32x4 v[2][4];
#pragma unroll
            for (int u = 0; u < 2; ++u) { const f32x4* xr = (const f32x4*)(x + (size_t)(m0 + u * c.ngw) * DM) + c.lane;
#pragma unroll
                for (int j = 0; j < 4; ++j) v[u][j] = xr[64 * j]; }
#pragma unroll
            for (int u = 0; u < 2; ++u) { const int m = m0 + u * c.ngw; float s = 0.f;
                u32x2* o8 = (u32x2*)(xb + (size_t)m * DM) + c.lane;
#pragma unroll
                for (int j = 0; j < 4; ++j) { const f32x4 q = v[u][j]; s += (q.x * q.x + q.y * q.y) + (q.z * q.z + q.w * q.w); u32x2 w; w.x = cvt_pk_bf16(q.x, q.y); w.y = cvt_pk_bf16(q.z, q.w); o8[64 * j] = w; }
                s = wave_sum(s);
                if (c.lane == 0) ss[m] = s; }
        }
        for (int i = c.gtid; i < 3 * TT; i += c.ngt) ss[TT + i] = 0.f;
    }
    {
        bf16* G = (bf16*)(ws + WS_W_GATE);
        for (int i = c.gtid; i < 1024 * 512; i += c.ngt) {
            const int R = i >> 9, k = i & 511, pn = R >> 8, half = (R >> 7) & 1, ch = 128 * pn + (R & 127), h = ch >> 6, j = ch & 63;
            float v = 0.f;
            if ((k >> 6) == h) v = (half ? in[7] : in[5])[(h * 64 + (k & 63)) * 64 + j];
            G[i] = f2bf(v);
        }
    }
    {
        float* RT = (float*)(ws + WS_ROPE);
        for (int i = c.gtid; i < SEQ * 8; i += c.ngt) {
            const int pos = i >> 3, e = i & 7;
            const float inv = powf(500000.0f, -(float)e * 0.125f);
            float sn, cs; sincosf((float)pos * inv, &sn, &cs);
            RT[pos * 16 + e] = cs; RT[pos * 16 + 8 + e] = sn;
        }
    }
}
__device__ __forceinline__ void phase_s5_mats(const Ctx& c, const float* const* in, unsigned char* ws) {
    {
        const float *lam_re = in[15], *lam_im = in[16], *b_re = in[17], *b_im = in[18], *c_re = in[19], *c_im = in[20], *lstep = in[22];
        bf16* AM = (bf16*)(ws + WS_S5A);
        bf16* FM = (bf16*)(ws + WS_S5F);
        for (int i = c.gtid; i < 32 * 256 * 4; i += c.ngt) {
            const int nq = i & 3, pp = (i >> 2) & 15, p = (i >> 6) & 15, g = i >> 10;
            float acc[16];
#pragma unroll
            for (int t = 0; t < 16; ++t) acc[t] = 0.f;
            for (int n = nq * 16; n < nq * 16 + 16; ++n) {
                const S5P sp = s5_params(lam_re, lam_im, lstep, g, n);
                const float br = b_re[(g * 64 + n) * 16 + pp], bi = b_im[(g * 64 + n) * 16 + pp];
                const float bbr = sp.cr * br - sp.ci * bi, bbi = sp.cr * bi + sp.ci * br;
                const float cr_ = c_re[(g * 16 + p) * 64 + n], ci_ = c_im[(g * 16 + p) * 64 + n];
                float zr = cr_ * bbr - ci_ * bbi, zi = cr_ * bbi + ci_ * bbr;
#pragma unroll
                for (int t = 0; t < 16; ++t) { acc[t] += zr; const float nr = zr * sp.ar - zi * sp.ai, ni = zr * sp.ai + zi * sp.ar; zr = nr; zi = ni; }
            }
            bf16* Ag = AM + (size_t)g * 256 * 384;
#pragma unroll
            for (int tau = 0; tau < 16; ++tau) {
                float v = acc[tau]; v += __shfl_xor(v, 1); v += __shfl_xor(v, 2);
                if ((tau & 3) == nq) {
                    const bf16 kv = f2bf(v);
                    for (int t = tau; t < 16; ++t) Ag[(t * 16 + p) * 384 + (t - tau) * 16 + pp] = kv;
                    if (tau >= 1) for (int t = 0; t + tau < 16; ++t) Ag[(t * 16 + p) * 384 + (t + tau) * 16 + pp] = 0;
                }
            }
        }
        for (int i = (c.gtid + c.ngt - c.ngt / 4) % c.ngt; i < 32 * 16 * 64; i += c.ngt) {
            const int g = i >> 10, p = (i >> 6) & 15, n = i & 63;
            const S5P sp = s5_params(lam_re, lam_im, lstep, g, n);
            const float cr_ = c_re[(g * 16 + p) * 64 + n], ci_ = c_im[(g * 16 + p) * 64 + n];
            float pr = sp.ar, pi = sp.ai;
            for (int t = 0; t < 16; ++t) {
                bf16* row = AM + ((size_t)g * 256 + t * 16 + p) * 384 + 256;
                row[n] = f2bf(cr_ * pr - ci_ * pi);
                row[64 + n] = f2bf(-(cr_ * pi + ci_ * pr));
                const float nr = pr * sp.ar - pi * sp.ai, ni = pr * sp.ai + pi * sp.ar; pr = nr; pi = ni;
            }
        }
        for (int i = (c.gtid + c.ngt - c.ngt / 2) % c.ngt; i < 32 * 64 * 16; i += c.ngt) {
            const int g = i >> 10, n = (i >> 4) & 63, pp = i & 15;
            const S5P sp = s5_params(lam_re, lam_im, lstep, g, n);
            const float br = b_re[(g * 64 + n) * 16 + pp], bi = b_im[(g * 64 + n) * 16 + pp];
            const float bbr = sp.cr * br - sp.ci * bi, bbi = sp.cr * bi + sp.ci * br;
            float pr = 1.f, pi = 0.f;
            for (int s = 15; s >= 0; --s) {
                FM[((size_t)g * 128 + n) * 256 + s * 16 + pp] = f2bf(pr * bbr - pi * bbi);
                FM[((size_t)g * 128 + 64 + n) * 256 + s * 16 + pp] = f2bf(pr * bbi + pi * bbr);
                const float nr = pr * sp.ar - pi * sp.ai, ni = pr * sp.ai + pi * sp.ar; pr = nr; pi = ni;
            }
        }
    }
}

__device__ __forceinline__ u32x4 vt_load(const bf16* src, int pitch, int coloff, int hd, int nh, int sh, int item, int lane) {
    const int cgp = item & 1023; int r = item >> 10; const int nblk = hd >> 6, dblk = r % nblk, bh = r / nblk, b = bh / nh, h = bh % nh;
    const int d = dblk * 64 + lane, Ld = SEQ >> sh;
    const bf16* s = src + (size_t)b * SEQ * pitch + coloff + h * hd + d;
    unsigned short v[8];
#pragma unroll
    for (int i = 0; i < 8; ++i) { const int col = cgp * 8 + i, rres = col / Ld, l = col - rres * Ld, t = (l << sh) + rres; v[i] = s[(size_t)t * pitch]; }
    u32x4 w; w.x = v[0] | ((unsigned)v[1] << 16); w.y = v[2] | ((unsigned)v[3] << 16); w.z = v[4] | ((unsigned)v[5] << 16); w.w = v[6] | ((unsigned)v[7] << 16);
    return w;
}
__device__ __forceinline__ void vt_store(u32x4 w, int hd, bf16* dst, int dpitch, int item, int lane) {
    const int cgp = item & 1023; int r = item >> 10; const int nblk = hd >> 6, dblk = r % nblk, bh = r / nblk;
    const int d = dblk * 64 + lane;
    *(u32x4*)(dst + ((size_t)bh * hd + d) * dpitch + cgp * 8) = w;
}
__device__ __forceinline__ void vt_store_blk(u32x4 w, bf16* dst, int item, int lane) {
    const int cgp = item & 1023, bh = item >> 10, dt = lane >> 4, dl = lane & 15, col0 = cgp * 8;
    *(u32x4*)(dst + ((size_t)((bh * 4 + dt) * 256 + (col0 >> 5))) * 512 + dl * 32 + (col0 & 31)) = w;
}
__device__ __forceinline__ void vt_run(const Ctx& c, const bf16* src, int pitch, int coloff, int hd, int nh, bf16* dst, int dpitch, int sh, int nitems) {
    for (int it0 = c.gw; it0 < nitems; it0 += 8 * c.ngw) {
        u32x4 w[8];
#pragma unroll
        for (int u = 0; u < 8; ++u) { const int it = it0 + u * c.ngw; if (it < nitems) w[u] = vt_load(src, pitch, coloff, hd, nh, sh, it, c.lane); }
#pragma unroll
        for (int u = 0; u < 8; ++u) { const int it = it0 + u * c.ngw; if (it < nitems) { if (dpitch == 0) vt_store_blk(w[u], dst, it, c.lane); else vt_store(w[u], hd, dst, dpitch, it, c.lane); } }
    }
}

__device__ __forceinline__ void vt32_load(const bf16* src, int sh, int item, int lane, u32x4* w) {
    const int kb = item & 255, bh = item >> 8, b = bh >> 3, h = bh & 7, Ld = SEQ >> sh;
    const bf16* s = src + (size_t)b * SEQ * P0LD + 2048 + h * 64 + lane;
    const int col0 = kb * 32, rres = col0 / Ld, l0 = col0 - rres * Ld;
    unsigned short v[32];
#pragma unroll
    for (int i = 0; i < 32; ++i) v[i] = s[(size_t)(((l0 + i) << sh) + rres) * P0LD];
#pragma unroll
    for (int q = 0; q < 4; ++q) { w[q].x = v[8 * q] | ((unsigned)v[8 * q + 1] << 16); w[q].y = v[8 * q + 2] | ((unsigned)v[8 * q + 3] << 16); w[q].z = v[8 * q + 4] | ((unsigned)v[8 * q + 5] << 16); w[q].w = v[8 * q + 6] | ((unsigned)v[8 * q + 7] << 16); }
}
__device__ __forceinline__ void vt32_store(const u32x4* w, bf16* dst, int p, int item, int lane) {
    const int kb = item & 255, bh = item >> 8;
    bf16* o = (p == 0) ? dst + ((size_t)bh * 64 + lane) * VTP + kb * 32 : dst + ((size_t)((bh * 4 + (lane >> 4)) * 256 + kb)) * 512 + (lane & 15) * 32;
#pragma unroll
    for (int q = 0; q < 4; ++q) *(u32x4*)(o + 8 * q) = w[q];
}
__device__ __forceinline__ void phase_prep0(const Ctx& c, const float* const* in, unsigned char* ws, float* dout) {
    bf16* P0 = (bf16*)(ws + WS_BIG); bf16* XC = (bf16*)(ws + WS_XC);
    const float* cw = in[3]; const float* cbias = in[4];
    for (int i0 = c.gtid; i0 < TT * 64; i0 += 2 * c.ngt) {
        u32x4 raw[2][4];
#pragma unroll
        for (int u = 0; u < 2; ++u) { const int i = i0 + u * c.ngt, t = i >> 6, c0 = (i & 63) * 8, tl = t & (SEQ - 1);
#pragma unroll
            for (int j = 0; j < 4; ++j) raw[u][j] = (tl - 3 + j >= 0) ? *(const u32x4*)(P0 + (size_t)(t - 3 + j) * P0LD + c0) : (u32x4){0u, 0u, 0u, 0u}; }
#pragma unroll
        for (int u = 0; u < 2; ++u) { const int i = i0 + u * c.ngt, t = i >> 6, c0 = (i & 63) * 8;
            float acc[8];
#pragma unroll
            for (int e = 0; e < 8; ++e) acc[e] = cbias[c0 + e];
#pragma unroll
            for (int j = 0; j < 4; ++j) { float v[8]; unpack8(raw[u][j], v);
#pragma unroll
                for (int e = 0; e < 8; ++e) acc[e] += cw[j * 512 + c0 + e] * v[e]; }
            *(u32x4*)(XC + (size_t)t * 512 + c0) = pack8(acc); }
    }
    for (int it0 = c.gw * 4; it0 < 2 * TT; it0 += c.ngw * 4) {
        const int sub = c.lane & 7;
        u32x4 raw[4];
#pragma unroll
        for (int u = 0; u < 4; ++u) { const int it = it0 + u, t = it >> 1, which = it & 1; raw[u] = *(const u32x4*)(P0 + (size_t)t * P0LD + 1024 + which * 512 + c.lane * 8); }
#pragma unroll
        for (int u = 0; u < 4; ++u) {
            const int it = it0 + u, t = it >> 1, which = it & 1;
            bf16* p = P0 + (size_t)t * P0LD + 1024 + which * 512 + c.lane * 8;
            float v[8]; unpack8(raw[u], v);
            float s = 0.f;
#pragma unroll
            for (int e = 0; e < 8; ++e) s += v[e] * v[e];
            s += __shfl_xor(s, 1); s += __shfl_xor(s, 2); s += __shfl_xor(s, 4);
            const float rs = rsqrtf(s * (1.0f / 64.0f) + 1e-6f);
            const float* gn = (which ? in[11] : in[10]) + sub * 8;
#pragma unroll
            for (int e = 0; e < 8; ++e) v[e] = v[e] * rs * gn[e];
            float oth[8];
#pragma unroll
            for (int e = 0; e < 8; ++e) oth[e] = __shfl_xor(v[e], 1);
            if (sub < 2) {
                const float* rt = (const float*)(ws + WS_ROPE) + (t & (SEQ - 1)) * 16;
                const f32x4 c0 = *(const f32x4*)rt, c1 = *(const f32x4*)(rt + 4), s0 = *(const f32x4*)(rt + 8), s1 = *(const f32x4*)(rt + 12);
#pragma unroll
                for (int e = 0; e < 8; ++e) {
                    const float cs = (e < 4) ? c0[e & 3] : c1[e & 3], sn = (e < 4) ? s0[e & 3] : s1[e & 3];
                    v[e] = (sub == 0) ? (v[e] * cs - oth[e] * sn) : (v[e] * cs + oth[e] * sn);
                }
            }
            *(u32x4*)p = pack8(v);
        }
    }
    bf16* VT3 = (bf16*)dout;
    for (int it0 = c.gw; it0 < 3 * 4096; it0 += 2 * c.ngw) {
        u32x4 w[2][4];
#pragma unroll
        for (int u = 0; u < 2; ++u) { const int it = it0 + u * c.ngw; if (it < 3 * 4096) vt32_load(P0, 2 * (it >> 12), it & 4095, c.lane, w[u]); }
#pragma unroll
        for (int u = 0; u < 2; ++u) { const int it = it0 + u * c.ngw; if (it < 3 * 4096) vt32_store(w[u], VT3 + (size_t)(it >> 12) * (16 * 64 * VTP), it >> 12, it & 4095, c.lane); }
    }
}

#define ATT_D 2
constexpr int ATT_KP = 144, ATT_VP = 784, ATT_KBYTES = 384 * ATT_KP, ATT_LDS = ATT_KBYTES + 64 * ATT_VP;
struct AttState { float m, l; f32x4 o[4]; };
__device__ __forceinline__ void attn_math(const bf16x8 kx0, const bf16x8 kx1, const bf16x8 ky0, const bf16x8 ky1, const bf16x8 (&vf)[4], const bf16x8 qf0, const bf16x8 qf1,
                                          int lq, int kb, AttState& st) {
    const float cs = 0.125f * 1.4426950408889634f;
    __builtin_amdgcn_s_setprio(1);
    f32x4 sx = mfma16(kx0, qf0, (f32x4){0.f, 0.f, 0.f, 0.f}); sx = mfma16(kx1, qf1, sx);
    f32x4 sy = mfma16(ky0, qf0, (f32x4){0.f, 0.f, 0.f, 0.f}); sy = mfma16(ky1, qf1, sy);
    __builtin_amdgcn_s_setprio(0);
    float mx = -1e30f;
#pragma unroll
    for (int r = 0; r < 4; ++r) {
        sx[r] = ((unsigned)(lq - (kb + r)) <= 128u) ? sx[r] : -1e30f; sy[r] = ((unsigned)(lq - (kb + 4 + r)) <= 128u) ? sy[r] : -1e30f;
        mx = fmaxf(mx, fmaxf(sx[r], sy[r]));
    }
    { auto rr = __builtin_amdgcn_permlane32_swap(__float_as_uint(mx), __float_as_uint(mx), false, false); mx = fmaxf(__uint_as_float(rr[0]), __uint_as_float(rr[1]));
      rr = __builtin_amdgcn_permlane16_swap(__float_as_uint(mx), __float_as_uint(mx), false, false); mx = fmaxf(__uint_as_float(rr[0]), __uint_as_float(rr[1]));
      rr = __builtin_amdgcn_permlane32_swap(__float_as_uint(mx), __float_as_uint(mx), false, false); mx = fmaxf(__uint_as_float(rr[0]), __uint_as_float(rr[1])); }
    const float mn = fmaxf(st.m, mx), alpha = __builtin_amdgcn_exp2f((st.m - mn) * cs); st.m = mn;
    const float mref = fmaxf(mn, -1e29f) * cs;
    float pe[8]; float ps = 0.f;
#pragma unroll
    for (int r = 0; r < 4; ++r) { pe[r] = __builtin_amdgcn_exp2f(sx[r] * cs - mref); pe[4 + r] = __builtin_amdgcn_exp2f(sy[r] * cs - mref); ps += pe[r] + pe[4 + r]; }
    st.l = st.l * alpha + ps;
    const u32x4 pw = pack8v(pe);
    const bf16x8 pf = __builtin_bit_cast(bf16x8, pw);
#pragma unroll
    for (int dt = 0; dt < 4; ++dt) st.o[dt] = st.o[dt] * alpha;
    __builtin_amdgcn_s_setprio(1);
#pragma unroll
    for (int dt = 0; dt < 4; ++dt) st.o[dt] = mfma16(vf[dt], pf, st.o[dt]);
    __builtin_amdgcn_s_setprio(0);
}
__device__ __forceinline__ void attn_stage_p1(const Ctx& c, const bf16* P0, const bf16* VT3, int b, int h, int lb) {
    const int tok0 = 256 * lb - 128;
    u32x4 kr[6], vr[6];
#pragma unroll
    for (int i = 0; i < 6; ++i) { const int p = c.tid + 512 * i, row = p >> 3, c16 = p & 7; int tk = tok0 + row; if (tk < 0) tk = 0;
        kr[i] = *(const u32x4*)(P0 + (size_t)(b * SEQ + tk) * P0LD + 1536 + h * 64 + c16 * 8); }
#pragma unroll
    for (int i = 0; i < 6; ++i) { const int p = c.tid + 512 * i, d = p / 48, c16 = p - d * 48; int tk = tok0 + c16 * 8; if (tk < 0) tk = 0;
        vr[i] = *(const u32x4*)(VT3 + ((size_t)((b * 8 + h) * 64 + d)) * VTP + tk); }
#pragma unroll
    for (int i = 0; i < 6; ++i) { const int p = c.tid + 512 * i, row = p >> 3, c16 = p & 7; *(LAS u32x4*)(c.lds + row * ATT_KP + c16 * 16) = kr[i]; }
#pragma unroll
    for (int i = 0; i < 6; ++i) { const int p = c.tid + 512 * i, d = p / 48, c16 = p - d * 48; *(LAS u32x4*)(c.lds + ATT_KBYTES + d * ATT_VP + c16 * 16) = vr[i]; }
}
template <bool P1_LDS>
__device__ __forceinline__ void attn_item(const Ctx& c, const bf16* P0, const bf16* VT3, bf16* ycat, int item, int lane) {
    const int lb = item & 31, r16 = (item >> 5) & 15, h = (item >> 9) & 7, b = item >> 12;
    const int qi = lane & 15, g = lane >> 4;
    const int tq = r16 + 16 * (16 * lb + qi);
    const bf16* qrow = P0 + (size_t)(b * SEQ + tq) * P0LD + 1024 + h * 64;
    const bf16x8 qf0 = ld8(qrow + 8 * g), qf1 = ld8(qrow + 32 + 8 * g);
    AttState st; st.m = -1e30f; st.l = 0.f;
#pragma unroll
    for (int dt = 0; dt < 4; ++dt) st.o[dt] = (f32x4){0.f, 0.f, 0.f, 0.f};
    const int rho_off = 8 * (qi >> 2) + (qi & 3);
    int sb0_[3], n_[3]; const bf16* kb_[3]; const bf16* vb_[3];
#pragma unroll
    for (int p = 0; p < 3; ++p) {
        const int sh = 2 * p, rres = r16 & ((1 << sh) - 1), Ld = SEQ >> sh;
        const int lq0 = (r16 + 256 * lb) >> sh, lq15 = (r16 + 256 * lb + 240) >> sh;
        int s0 = lq0 - 128; if (s0 < 0) s0 = 0; s0 &= ~31;
        sb0_[p] = s0; n_[p] = (((lq15 & ~31) - s0) >> 5) + 1;
        kb_[p] = P0 + (size_t)(b * SEQ + rres) * P0LD + 1536 + h * 64 + 8 * g;
        vb_[p] = (p == 0) ? VT3 + ((size_t)((b * 8 + h) * 64 + qi)) * VTP + 8 * g
                          : VT3 + (size_t)p * (16 * 64 * VTP) + ((size_t)((b * 8 + h) * 4) * 256 + ((rres * Ld) >> 5)) * 512 + qi * 32 + 8 * g;
    }
    if (P1_LDS) n_[0] = 0;
    const int n01 = n_[0] + n_[1], total = n01 + n_[2];
    bf16x8 rk[ATT_D][4], rv[ATT_D][4];
#define ATT_ISSUE(s_, buf) do { const int s__ = (s_); if (s__ < total) { \
        const int p_ = (s__ >= n_[0]) + (s__ >= n01); const int loc_ = s__ - (p_ == 0 ? 0 : (p_ == 1 ? n_[0] : n01)); \
        const int sb_ = (p_ == 0 ? sb0_[0] : (p_ == 1 ? sb0_[1] : sb0_[2])) + 32 * loc_; const int sh_ = 2 * p_; \
        const bf16* kbp = (p_ == 0 ? kb_[0] : (p_ == 1 ? kb_[1] : kb_[2])); const bf16* vbp = (p_ == 0 ? vb_[0] : (p_ == 1 ? vb_[1] : vb_[2])); \
        const bf16* kx = kbp + ((size_t)(sb_ + rho_off) << sh_) * P0LD; const bf16* ky = kx + ((size_t)4 << sh_) * P0LD; \
        rk[buf][0] = ld8(kx); rk[buf][1] = ld8(kx + 32); rk[buf][2] = ld8(ky); rk[buf][3] = ld8(ky + 32); \
        const size_t dstr_ = (p_ == 0) ? (size_t)16 * VTP : (size_t)256 * 512; const size_t soff_ = (p_ == 0) ? (size_t)sb_ : (size_t)(sb_ >> 5) * 512; \
        _Pragma("unroll") for (int dt = 0; dt < 4; ++dt) rv[buf][dt] = ld8(vbp + dt * dstr_ + soff_); } } while (0)
#pragma unroll
    for (int d = 0; d < ATT_D; ++d) ATT_ISSUE(d, d);
    if (P1_LDS) {
        const int w = c.wave, half = r16 >> 3, tok0 = 256 * lb - 128;
        const int tq1 = 256 * lb + 32 * w + 16 * (qi >> 3) + 8 * half + (qi & 7);
        const bf16* q1row = P0 + (size_t)(b * SEQ + tq1) * P0LD + 1024 + h * 64;
        const bf16x8 q1f0 = ld8(q1row + 8 * g), q1f1 = ld8(q1row + 32 + 8 * g);
        AttState s1; s1.m = -1e30f; s1.l = 0.f;
#pragma unroll
        for (int dt = 0; dt < 4; ++dt) s1.o[dt] = (f32x4){0.f, 0.f, 0.f, 0.f};
        const LAS unsigned char* kl = c.lds + rho_off * ATT_KP + 16 * g;
        const LAS unsigned char* vl = c.lds + ATT_KBYTES + qi * ATT_VP + 16 * g;
        LAS unsigned* ex = (LAS unsigned*)(c.lds + ATT_LDS);
        __syncthreads();
        for (int i = ((lb == 0 && w < 4) ? 4 : w); i <= w + 4; ++i) {
            const LAS unsigned char* kx = kl + 32 * i * ATT_KP;
            const bf16x8 kx0 = *(const LAS bf16x8*)kx, kx1 = *(const LAS bf16x8*)(kx + 64), ky0 = *(const LAS bf16x8*)(kx + 4 * ATT_KP), ky1 = *(const LAS bf16x8*)(kx + 4 * ATT_KP + 64);
            bf16x8 vf[4];
#pragma unroll
            for (int dt = 0; dt < 4; ++dt) vf[dt] = *(const LAS bf16x8*)(vl + dt * 16 * ATT_VP + 64 * i);
            attn_math(kx0, kx1, ky0, ky1, vf, q1f0, q1f1, tq1, tok0 + 32 * i + 8 * g, s1);
        }
        {
            LAS unsigned* e = ex + ((16 * w + qi) * 4 + g) * 10;
            e[0] = __float_as_uint(s1.m); e[1] = __float_as_uint(s1.l);
#pragma unroll
            for (int dt = 0; dt < 4; ++dt) { e[2 + 2 * dt] = pg8::cvtpk(s1.o[dt][0], s1.o[dt][1]); e[3 + 2 * dt] = pg8::cvtpk(s1.o[dt][2], s1.o[dt][3]); }
        }
        __syncthreads();
        {
            const LAS unsigned* e = ex + ((qi * 8 + (r16 & 7)) * 4 + g) * 10;
            st.m = __uint_as_float(e[0]); st.l = __uint_as_float(e[1]);
#pragma unroll
            for (int dt = 0; dt < 4; ++dt) { const unsigned a0 = e[2 + 2 * dt], a1 = e[3 + 2 * dt]; st.o[dt] = (f32x4){bfw(a0, 0), bfw(a0, 1), bfw(a1, 0), bfw(a1, 1)}; }
        }
    }
    for (int s0 = 0; s0 < total; s0 += ATT_D) {
#pragma unroll
        for (int j = 0; j < ATT_D; ++j) {
            const int s = s0 + j;
            if (s < total) {
                const int p = (s >= n_[0]) + (s >= n01), loc = s - (p == 0 ? 0 : (p == 1 ? n_[0] : n01));
                const int sb = (p == 0 ? sb0_[0] : (p == 1 ? sb0_[1] : sb0_[2])) + 32 * loc;
                attn_math(rk[j][0], rk[j][1], rk[j][2], rk[j][3], rv[j], qf0, qf1, tq >> (2 * p), sb + 8 * g, st);
                ATT_ISSUE(s + ATT_D, j);
            }
        }
    }
#undef ATT_ISSUE
    float l = st.l;
    l += __shfl_xor(l, 16); l += __shfl_xor(l, 32);
    const float inv = 1.0f / l;
    bf16* orow = ycat + (size_t)(b * SEQ + tq) * 1024 + 512 + h * 64 + 4 * g;
#pragma unroll
    for (int dt = 0; dt < 4; ++dt) { u32x2 w; w.x = cvt_pk_bf16(st.o[dt][0] * inv, st.o[dt][1] * inv); w.y = cvt_pk_bf16(st.o[dt][2] * inv, st.o[dt][3] * inv); *(u32x2*)(orow + 16 * dt) = w; }
}

__device__ __forceinline__ void lru_step(float la, float gi, float& h) { const float a = __expf(la), bq = __builtin_amdgcn_sqrtf(fmaxf(1.0f - a * a, 0.f)) * gi; h = a * h + bq; }
__device__ __forceinline__ void phase_lru_a(const Ctx& c, unsigned char* ws) {
    const bf16* __restrict__ LA = (const bf16*)(ws + WS_LOGA); const bf16* __restrict__ GI = (const bf16*)(ws + WS_GI);
    float* __restrict__ SA = (float*)(ws + WS_SUMA); float* __restrict__ SB = (float*)(ws + WS_SUMB);
    for (int ch = blockIdx.x; ch < 256; ch += gridDim.x) {
        const int t0 = ch * 64, cn = c.tid; float h = 0.f, P = 0.f;
#pragma unroll 1
        for (int tb = 0; tb < 64; tb += 32) {
            float la[32], gi[32];
#pragma unroll
            for (int t = 0; t < 32; ++t) { la[t] = bf2f(LA[(size_t)(t0 + tb + t) * 512 + cn]); gi[t] = bf2f(GI[(size_t)(t0 + tb + t) * 512 + cn]); }
#pragma unroll
            for (int t = 0; t < 32; ++t) { lru_step(la[t], gi[t], h); P += la[t]; }
        }
        SA[ch * 512 + cn] = __expf(P); SB[ch * 512 + cn] = h;
    }
}
__device__ __forceinline__ void phase_lru_b(const Ctx& c, unsigned char* ws) {
    const bf16* __restrict__ LA = (const bf16*)(ws + WS_LOGA); const bf16* __restrict__ GI = (const bf16*)(ws + WS_GI);
    const float* __restrict__ SA = (const float*)(ws + WS_SUMA); const float* __restrict__ SB = (const float*)(ws + WS_SUMB);
    const bf16* __restrict__ P0 = (const bf16*)(ws + WS_BIG); bf16* __restrict__ ycat = (bf16*)(ws + WS_YCAT);
    for (int ch = blockIdx.x; ch < 256; ch += gridDim.x) {
        const int t0 = ch * 64, cn = c.tid; float h = 0.f;
        bf16 la0[32], gi0[32], gl0[32];
#pragma unroll
        for (int t = 0; t < 32; ++t) { la0[t] = LA[(size_t)(t0 + t) * 512 + cn]; gi0[t] = GI[(size_t)(t0 + t) * 512 + cn]; gl0[t] = P0[(size_t)(t0 + t) * P0LD + 512 + cn]; }
        int j = ch & ~127;
        for (; j + 32 <= ch; j += 32) {
            float sa[32], sb[32];
#pragma unroll
            for (int k = 0; k < 32; ++k) { sa[k] = SA[(j + k) * 512 + cn]; sb[k] = SB[(j + k) * 512 + cn]; }
#pragma unroll
            for (int k = 0; k < 32; ++k) h = sa[k] * h + sb[k];
        }
        for (; j + 8 <= ch; j += 8) {
            float sa[8], sb[8];
#pragma unroll
            for (int k = 0; k < 8; ++k) { sa[k] = SA[(j + k) * 512 + cn]; sb[k] = SB[(j + k) * 512 + cn]; }
#pragma unroll
            for (int k = 0; k < 8; ++k) h = sa[k] * h + sb[k];
        }
        for (; j < ch; ++j) h = SA[j * 512 + cn] * h + SB[j * 512 + cn];
#pragma unroll
        for (int t = 0; t < 32; ++t) { lru_step(bf2f(la0[t]), bf2f(gi0[t]), h); ycat[(size_t)(t0 + t) * 1024 + cn] = f2bf(h * gelu_tanh(bf2f(gl0[t]))); }
#pragma unroll 1
        for (int tb = 32; tb < 64; tb += 32) {
            bf16 la[32], gi[32], gl[32];
#pragma unroll
            for (int t = 0; t < 32; ++t) { la[t] = LA[(size_t)(t0 + tb + t) * 512 + cn]; gi[t] = GI[(size_t)(t0 + tb + t) * 512 + cn]; gl[t] = P0[(size_t)(t0 + tb + t) * P0LD + 512 + cn]; }
#pragma unroll
            for (int t = 0; t < 32; ++t) { lru_step(bf2f(la[t]), bf2f(gi[t]), h); ycat[(size_t)(t0 + tb + t) * 1024 + cn] = f2bf(h * gelu_tanh(bf2f(gl[t]))); }
        }
    }
}

__device__ __forceinline__ void fixup_panel(const Ctx& c, unsigned char* ws, const float* cw, const float* cb, int pm) {
    if ((pm & 31) != 0) {
        const float* EA = (const float*)(ws + WS_EDGEA); const float* EL = (const float*)(ws + WS_EDGEL); const float* TA = (const float*)(ws + WS_TAILA);
        bf16* U = (bf16*)(ws + WS_BIG);
        for (int col = c.tid; col < 3072; col += 512) {
            const float tm2 = TA[(size_t)((pm - 1) * 2 + 0) * 3072 + col], tm1 = TA[(size_t)((pm - 1) * 2 + 1) * 3072 + col];
            const float a0 = EA[(size_t)(pm * 2) * 3072 + col], a1 = EA[(size_t)(pm * 2 + 1) * 3072 + col];
            const float l0 = EL[(size_t)(pm * 2) * 3072 + col], l1 = EL[(size_t)(pm * 2 + 1) * 3072 + col];
            const float w0 = cw[col], w1 = cw[3072 + col], w2 = cw[6144 + col], bb = cb[col];
            U[(size_t)(pm * 256) * 3072 + col] = f2bf(gelu_tanh(w0 * tm2 + w1 * tm1 + w2 * a0 + bb) * l0);
            U[(size_t)(pm * 256 + 1) * 3072 + col] = f2bf(gelu_tanh(w0 * tm1 + w1 * a0 + w2 * a1 + bb) * l1);
        }
    }
    asm volatile("s_waitcnt vmcnt(0)" ::: "memory");
    __syncthreads();
}
__device__ __forceinline__ void phase_fixup(const Ctx& c, unsigned char* ws, const float* cw, const float* cb) {
    const float* EA = (const float*)(ws + WS_EDGEA); const float* EL = (const float*)(ws + WS_EDGEL); const float* TA = (const float*)(ws + WS_TAILA);
    bf16* U = (bf16*)(ws + WS_BIG);
    for (int i = c.gtid; i < 64 * 3072; i += c.ngt) {
        const int pm = i / 3072, col = i % 3072;
        if ((pm & 31) == 0) continue;
        const float tm2 = TA[(size_t)((pm - 1) * 2 + 0) * 3072 + col], tm1 = TA[(size_t)((pm - 1) * 2 + 1) * 3072 + col];
        const float a0 = EA[(size_t)(pm * 2) * 3072 + col], a1 = EA[(size_t)(pm * 2 + 1) * 3072 + col];
        const float l0 = EL[(size_t)(pm * 2) * 3072 + col], l1 = EL[(size_t)(pm * 2 + 1) * 3072 + col];
        const float w0 = cw[col], w1 = cw[3072 + col], w2 = cw[6144 + col], bb = cb[col];
        U[(size_t)(pm * 256) * 3072 + col] = f2bf(gelu_tanh(w0 * tm2 + w1 * tm1 + w2 * a0 + bb) * l0);
        U[(size_t)(pm * 256 + 1) * 3072 + col] = f2bf(gelu_tanh(w0 * tm1 + w1 * a0 + w2 * a1 + bb) * l1);
    }
}
#define XB_TMO      128
#define XB_XCNT(j)  (256  + 64 * (j))
#define XB_XSUB(j)  (1280 + 64 * (j))
#define XB_XGEN(j)  (2304 + 64 * (j))
#define XB_TOP      3328
#define XB_TOPGEN   3392
#define XCD_BAR_WORDS 3456
#define XB_SPIN_CAP (1u << 18)

__device__ __forceinline__ unsigned xb_ld(unsigned* p)              { return __hip_atomic_load(p, __ATOMIC_RELAXED, __HIP_MEMORY_SCOPE_AGENT); }
__device__ __forceinline__ unsigned xb_add(unsigned* p, unsigned v) { return __hip_atomic_fetch_add(p, v, __ATOMIC_RELAXED, __HIP_MEMORY_SCOPE_AGENT); }
__device__ __forceinline__ unsigned xb_xcc_id() { return (unsigned)__builtin_amdgcn_s_getreg((3 << 11) | 20) & 0xFu; }
#define XB_SPIN(cond, bar) do { unsigned _sp = 0; while (cond) { __builtin_amdgcn_s_sleep(1); \
    if ((++_sp & 255u) == 0u) { if (xb_ld(&(bar)[XB_TMO])) break; if (_sp > XB_SPIN_CAP) { atomicAdd(&(bar)[XB_TMO], 1u); break; } } } } while (0)

struct XcdBarrier {
    unsigned* bar; unsigned x;
    volatile LAS unsigned* st;
};

__device__ __forceinline__ XcdBarrier xcd_barrier_post(unsigned* bar, volatile LAS unsigned* st) {
    XcdBarrier b; b.bar = bar; b.x = xb_xcc_id(); b.st = st;
    if (threadIdx.x == 0) (void)xb_add(&bar[XB_XCNT(b.x)], 1u);
    return b;
}
__device__ __forceinline__ void xcd_barrier_complete(unsigned* bar, unsigned x, unsigned& nloc, unsigned& nx) {
    const unsigned G = gridDim.x * gridDim.y * gridDim.z;
    unsigned sum, cnt, mine, sp = 0u;
    for (;;) {
        sum = 0u; cnt = 0u; mine = 0u;
#pragma unroll
        for (unsigned j = 0; j < 16; ++j) { const unsigned c = xb_ld(&bar[XB_XCNT(j)]); sum += c; cnt += (c > 0u) ? 1u : 0u; mine = (j == x) ? c : mine; }
        if (sum == G) break;
        __builtin_amdgcn_s_sleep(1);
        if ((++sp & 255u) == 0u) { if (xb_ld(&bar[XB_TMO])) break; if (sp > XB_SPIN_CAP) { atomicAdd(&bar[XB_TMO], 1u); break; } }
    }
    nloc = mine > 0u ? mine : 1u; nx = cnt > 0u ? cnt : 1u;
}

__device__ __forceinline__ void xcd_barrier(const XcdBarrier& b) {
    asm volatile("s_waitcnt vmcnt(0)" ::: "memory");
    __syncthreads();
    if (threadIdx.x == 0) {
        unsigned* bar = b.bar;
        __builtin_amdgcn_s_waitcnt(0);
        unsigned nloc = b.st[0], nx = b.st[1];
        if (nloc == 0u) { xcd_barrier_complete(bar, b.x, nloc, nx); b.st[0] = nloc; b.st[1] = nx; }
        const unsigned old = xb_add(&bar[XB_XSUB(b.x)], 1u);
        const unsigned gen = old / nloc;
        if (old + 1u == (gen + 1u) * nloc) {
            __builtin_amdgcn_fence(__ATOMIC_RELEASE, "agent");
            asm volatile("s_waitcnt vmcnt(0)" ::: "memory");
            const unsigned og = xb_add(&bar[XB_TOP], 1u);
            const unsigned tg = og / nx;
            if (og + 1u == (tg + 1u) * nx) xb_add(&bar[XB_TOPGEN], 1u);
            else XB_SPIN(xb_ld(&bar[XB_TOPGEN]) == tg, bar);
            __builtin_amdgcn_fence(__ATOMIC_ACQUIRE, "agent");
            xb_add(&bar[XB_XGEN(b.x)], 1u);
            asm volatile("s_waitcnt vmcnt(0)" ::: "memory");
        } else {
            XB_SPIN(xb_ld(&bar[XB_XGEN(b.x)]) == gen, bar);
            __builtin_amdgcn_fence(__ATOMIC_ACQUIRE, "agent");
            asm volatile("s_waitcnt vmcnt(0)" ::: "memory");
        }
    }
    __syncthreads();
}
__device__ __forceinline__ void gk_item(const bf16* XB, const bf16* Wt, const float* ss, bf16* P1, int item, int lane) {
    const int jl = lane & 15, gq = lane >> 4, tok = item * 16 + jl;
    const bf16* ap = Wt + (size_t)(2048 + jl) * 1024 + 8 * gq; const bf16* bp = XB + (size_t)tok * 1024 + 8 * gq;
    f32x4 acc0 = (f32x4){0.f, 0.f, 0.f, 0.f}, acc1 = acc0;
#pragma unroll 8
    for (int ks = 0; ks < 32; ks += 2) { acc0 = mfma16(ld8(ap + 32 * ks), ld8(bp + 32 * ks), acc0); acc1 = mfma16(ld8(ap + 32 * ks + 32), ld8(bp + 32 * ks + 32), acc1); }
    const float rs = rsqrtf(ss[tok] * (1.0f / 1024.0f) + 1e-6f);
    u32x2 w; w.x = cvt_pk_bf16((acc0[0] + acc1[0]) * rs, (acc0[1] + acc1[1]) * rs); w.y = cvt_pk_bf16((acc0[2] + acc1[2]) * rs, (acc0[3] + acc1[3]) * rs);
    *(u32x2*)(P1 + (size_t)tok * P1LD + 2048 + 4 * gq) = w;
}

__device__ __forceinline__ void phase_gla_prep(const Ctx& c, const float* const* in, unsigned char* ws) {
    bf16* P1 = (bf16*)(ws + WS_BIG); bf16* KDT = (bf16*)(ws + WS_KDT); float* DEC = (float*)(ws + WS_DECAY);
    const float* gkw = in[25]; const float* gkb = in[26];
    for (int i = blockIdx.x * 256 + c.tid; c.tid < 256 && i < 256 * 256; i += gridDim.x * 256) {
        const int chunk = i >> 8, chn = i & 255, t0 = chunk * 64, b = chunk >> 7, h = chn >> 6, d = chn & 63;
        float w[16];
#pragma unroll
        for (int k = 0; k < 16; ++k) w[k] = gkw[k * 256 + chn];
        const float bias = gkb[chn];
        float kin[64]; float bc = 0.f;
#pragma unroll
        for (int tb = 0; tb < 64; tb += 8) {
            u32x4 l0[8], l1[8]; bf16 qv[8], kv[8];
#pragma unroll
            for (int t = 0; t < 8; ++t) { const bf16* row = P1 + (size_t)(t0 + tb + t) * P1LD; l0[t] = *(const u32x4*)(row + 2048); l1[t] = *(const u32x4*)(row + 2056); qv[t] = row[512 + chn]; kv[t] = row[768 + chn]; }
#pragma unroll
            for (int t = 0; t < 8; ++t) {
                bf16* row = P1 + (size_t)(t0 + tb + t) * P1LD;
                float lr[16]; unpack8(l0[t], lr); unpack8(l1[t], lr + 8);
                float z = bias;
#pragma unroll
                for (int k = 0; k < 16; ++k) z += lr[k] * w[k];
                bc += logsig(z) * (1.0f / 16.0f);
                row[512 + chn] = f2bf(bf2f(qv[t]) * 0.125f * __expf(bc));
                kin[tb + t] = bf2f(kv[t]) * __expf(-bc);
                row[768 + chn] = f2bf(kin[tb + t]);
            }
        }
        const float eb = __expf(bc);
        DEC[chunk * 256 + chn] = eb;
        bf16* kd = KDT + ((size_t)((b * 4 + h) * 64 + d)) * SEQ + (t0 & (SEQ - 1));
#pragma unroll
        for (int t8 = 0; t8 < 8; ++t8) {
            float f[8];
#pragma unroll
            for (int e = 0; e < 8; ++e) f[e] = kin[t8 * 8 + e] * eb;
            *(u32x4*)(kd + t8 * 8) = pack8(f);
        }
    }
}

__device__ __forceinline__ void s5_bfrags(const bf16* P1, int g, int jb, int lane, bf16x8* bu) {
    const int jl = lane & 15, gq = lane >> 4;
#pragma unroll
    for (int ks = 0; ks < 8; ++ks) {
        const int s = 2 * ks + (gq >> 1), p0 = 8 * (gq & 1);
        bu[ks] = ld8(P1 + (size_t)((16 * jb + jl) * 16 + s) * P1LD + 16 * g + p0);
    }
}
__device__ __forceinline__ void s5a_item(const bf16* P1, const bf16* FM, float* XL, int item, int lane) {
    const int g = item >> 6, jb = item & 63, jl = lane & 15, gq = lane >> 4;
    bf16x8 bu[8]; s5_bfrags(P1, g, jb, lane, bu);
    const bf16* Fg = FM + (size_t)g * 128 * 256;
#pragma unroll
    for (int zt = 0; zt < 8; ++zt) {
        f32x4 acc = (f32x4){0.f, 0.f, 0.f, 0.f};
#pragma unroll
        for (int ks = 0; ks < 8; ++ks) acc = mfma16(ld8(Fg + (size_t)(16 * zt + jl) * 256 + 32 * ks + 8 * gq), bu[ks], acc);
        *(f32x4*)(XL + ((size_t)g * 1024 + 16 * jb + jl) * 128 + 16 * zt + 4 * gq) = acc;
    }
}
__device__ __forceinline__ void phase_s5_scan(const Ctx& c, const float* const* in, unsigned char* ws) {
    const float* __restrict__ XL = (const float*)(ws + WS_XLOC); bf16* __restrict__ SX = (bf16*)(ws + WS_SX);
    LAS float* ex = (LAS float*)c.lds;
    for (int bg = blockIdx.x; bg < 64; bg += gridDim.x) {
        const int b = bg >> 5, g = bg & 31, seg = c.wave, n = c.lane;
        const S5P sp = s5_params(in[15], in[16], in[22], g, n);
        float ar, ai; s5_pow(sp, 16.0f, ar, ai);
        float Ar, Ai; s5_pow(sp, 1024.0f, Ar, Ai);
        const size_t o0 = ((size_t)g * 1024 + b * 512 + seg * 64) * 128 + n;
        float xr = 0.f, xi = 0.f;
#pragma unroll 1
        for (int h2 = 0; h2 < 2; ++h2) {
            float cr[32], ci[32];
#pragma unroll
            for (int k = 0; k < 32; ++k) { cr[k] = XL[o0 + (size_t)(h2 * 32 + k) * 128]; ci[k] = XL[o0 + (size_t)(h2 * 32 + k) * 128 + 64]; }
#pragma unroll
            for (int k = 0; k < 32; ++k) { const float tr = ar * xr - ai * xi + cr[k], ti = ar * xi + ai * xr + ci[k]; xr = tr; xi = ti; }
        }
        ex[(seg * 64 + n) * 2] = xr; ex[(seg * 64 + n) * 2 + 1] = xi;
        __syncthreads();
        xr = 0.f; xi = 0.f;
        for (int j = 0; j < seg; ++j) { const float er = ex[(j * 64 + n) * 2], ei = ex[(j * 64 + n) * 2 + 1]; const float tr = Ar * xr - Ai * xi + er, ti = Ar * xi + Ai * xr + ei; xr = tr; xi = ti; }
#pragma unroll 1
        for (int h2 = 0; h2 < 2; ++h2) {
            float cr[32], ci[32];
#pragma unroll
            for (int k = 0; k < 32; ++k) { cr[k] = XL[o0 + (size_t)(h2 * 32 + k) * 128]; ci[k] = XL[o0 + (size_t)(h2 * 32 + k) * 128 + 64]; }
#pragma unroll
            for (int k = 0; k < 32; ++k) {
                SX[o0 + (size_t)(h2 * 32 + k) * 128] = f2bf(xr); SX[o0 + (size_t)(h2 * 32 + k) * 128 + 64] = f2bf(xi);
                const float tr = ar * xr - ai * xi + cr[k], ti = ar * xi + ai * xr + ci[k]; xr = tr; xi = ti;
            }
        }
        __syncthreads();
    }
}
__device__ __forceinline__ void s5c_item(const bf16* P1, const bf16* AM, const bf16* SX, const float* dvec, bf16* YS, int item, int lane) {
    const int g = item >> 6, jb = item & 63, jl = lane & 15, gq = lane >> 4;
    bf16x8 bu[12]; s5_bfrags(P1, g, jb, lane, bu);
#pragma unroll
    for (int ks = 0; ks < 4; ++ks) bu[8 + ks] = ld8(SX + ((size_t)g * 1024 + 16 * jb + jl) * 128 + 32 * ks + 8 * gq);
    const bf16* Ag = AM + (size_t)g * 256 * 384;
    float dv[4];
#pragma unroll
    for (int e = 0; e < 4; ++e) dv[e] = dvec[16 * g + 4 * gq + e];
#pragma unroll 4
    for (int rt = 0; rt < 16; ++rt) {
        f32x4 acc = (f32x4){0.f, 0.f, 0.f, 0.f};
#pragma unroll
        for (int ks = 0; ks < 12; ++ks) acc = mfma16(ld8(Ag + (size_t)(16 * rt + jl) * 384 + 32 * ks + 8 * gq), bu[ks], acc);
        const size_t tok = (size_t)(16 * jb + jl) * 16 + rt;
        const u32x2 uv = *(const u32x2*)(P1 + tok * P1LD + 16 * g + 4 * gq);
        float o[4];
#pragma unroll
        for (int e = 0; e < 4; ++e) { const float y = acc[e] + dv[e] * bfw(uv[e >> 1], e & 1); o[e] = gelu_tanh(y); }
        u32x2 w; w.x = cvt_pk_bf16(o[0], o[1]); w.y = cvt_pk_bf16(o[2], o[3]);
        *(u32x2*)(YS + tok * 512 + 16 * g + 4 * gq) = w;
    }
}

__device__ __forceinline__ void s5c_block(const Ctx& c, const bf16* P1, const bf16* AM, const bf16* SX, const float* dvec, bf16* YS, int g, int jb) {
    const int lane = c.lane, jl = lane & 15, gq = lane >> 4;
    bf16x8 bu[12]; s5_bfrags(P1, g, jb, lane, bu);
#pragma unroll
    for (int ks = 0; ks < 4; ++ks) bu[8 + ks] = ld8(SX + ((size_t)g * 1024 + 16 * jb + jl) * 128 + 32 * ks + 8 * gq);
    float dv[4];
#pragma unroll
    for (int e = 0; e < 4; ++e) dv[e] = dvec[16 * g + 4 * gq + e];
    const bf16* Ag = AM + (size_t)g * 256 * 384;
    for (int half = 0; half < 2; ++half) {
        __syncthreads();
        for (int p = c.tid; p < 128 * 48; p += 512) { const int row = p / 48, c16 = p - row * 48;
            *(LAS u32x4*)(c.lds + row * 784 + c16 * 16) = *(const u32x4*)(Ag + (size_t)(half * 128 + row) * 384 + c16 * 8); }
        __syncthreads();
#pragma unroll 2
        for (int r8 = 0; r8 < 8; ++r8) {
            const int rt = half * 8 + r8;
            f32x4 acc = (f32x4){0.f, 0.f, 0.f, 0.f};
#pragma unroll
            for (int ks = 0; ks < 12; ++ks) acc = mfma16(*(const LAS bf16x8*)(c.lds + (16 * r8 + jl) * 784 + 64 * ks + 16 * gq), bu[ks], acc);
            const size_t tok = (size_t)(16 * jb + jl) * 16 + rt;
            const u32x2 uv = *(const u32x2*)(P1 + tok * P1LD + 16 * g + 4 * gq);
            float o[4];
#pragma unroll
            for (int e = 0; e < 4; ++e) { const float y = acc[e] + dv[e] * bfw(uv[e >> 1], e & 1); o[e] = gelu_tanh(y); }
            u32x2 w; w.x = cvt_pk_bf16(o[0], o[1]); w.y = cvt_pk_bf16(o[2], o[3]);
            *(u32x2*)(YS + tok * 512 + 16 * g + 4 * gq) = w;
        }
    }
    __syncthreads();
}

__device__ __forceinline__ void gla_kv_item(const bf16* KDT, const bf16* VTG, bf16* KVS, int item, int lane) {
    const int cc = item & 127, h = (item >> 7) & 3, b = item >> 9, jl = lane & 15, gq = lane >> 4;
    const bf16* kd = KDT + ((size_t)((b * 4 + h) * 64 + jl)) * SEQ + 64 * cc + 8 * gq;
    const bf16* vt = VTG + ((size_t)((b * 4 + h) * 128 + jl)) * SEQ + 64 * cc + 8 * gq;
    bf16x8 af[4][2];
#pragma unroll
    for (int dt = 0; dt < 4; ++dt)
#pragma unroll
        for (int ks = 0; ks < 2; ++ks) af[dt][ks] = ld8(kd + (size_t)dt * 16 * SEQ + 32 * ks);
    bf16* out = KVS + ((size_t)(((b * 128 + cc) * 4 + h) * 128 + jl)) * 64 + 4 * gq;
#pragma unroll
    for (int et = 0; et < 8; ++et) {
        const bf16x8 b0 = ld8(vt + (size_t)et * 16 * SEQ), b1 = ld8(vt + (size_t)et * 16 * SEQ + 32);
#pragma unroll
        for (int dt = 0; dt < 4; ++dt) {
            f32x4 acc = mfma16(af[dt][0], b0, (f32x4){0.f, 0.f, 0.f, 0.f}); acc = mfma16(af[dt][1], b1, acc);
            u32x2 w; w.x = pg8::cvtpk(acc[0], acc[1]); w.y = pg8::cvtpk(acc[2], acc[3]);
            *(u32x2*)(out + (size_t)et * 16 * 64 + 16 * dt) = w;
        }
    }
}
__device__ __forceinline__ void phase_gla_scan(const Ctx& c, unsigned char* ws) {
    bf16* KVS = (bf16*)(ws + WS_KVS); const float* DEC = (const float*)(ws + WS_DECAY);
    for (int i = c.gtid; i < 2 * 4 * 128 * 64; i += c.ngt) {
        const int d = i & 63, e = (i >> 6) & 127, h = (i >> 13) & 3, b = i >> 15;
        float s = 0.f;
        bf16* p0 = KVS + ((size_t)((b * 128 * 4 + h) * 128 + e)) * 64 + d;
        const float* d0 = DEC + (b * 128) * 256 + h * 64 + d;
#pragma unroll 1
        for (int c0 = 0; c0 < 128; c0 += 43) {
            bf16 kv[43]; float dc[43];
#pragma unroll
            for (int k = 0; k < 43; ++k) if (c0 + k < 128) { kv[k] = p0[(size_t)(c0 + k) * (4 * 128 * 64)]; dc[k] = d0[(c0 + k) * 256]; }
#pragma unroll
            for (int k = 0; k < 43; ++k) if (c0 + k < 128) { p0[(size_t)(c0 + k) * (4 * 128 * 64)] = f2bf(s); s = dc[k] * s + bf2f(kv[k]); }
        }
    }
}
__device__ __forceinline__ void gla_out_item(const bf16* P1, const bf16* VTG, const bf16* KVS, const float* gnorm, bf16* ycat, int item, int lane) {
    const int tt = item & 3, cc = (item >> 2) & 127, h = (item >> 9) & 3, b = item >> 11, jl = lane & 15, gq = lane >> 4;
    const size_t tokc = (size_t)b * SEQ + 64 * cc;
    const bf16* qrow = P1 + (tokc + 16 * tt + jl) * P1LD + 512 + h * 64 + 8 * gq;
    const bf16x8 qf0 = ld8(qrow), qf1 = ld8(qrow + 32);
    f32x4 o[8];
#pragma unroll
    for (int et = 0; et < 8; ++et) o[et] = (f32x4){0.f, 0.f, 0.f, 0.f};
    {
        const bf16* sp = KVS + ((size_t)(((b * 128 + cc) * 4 + h) * 128 + jl)) * 64 + 8 * gq;
#pragma unroll
        for (int et = 0; et < 8; ++et) { o[et] = mfma16(ld8(sp + (size_t)et * 16 * 64), qf0, o[et]); o[et] = mfma16(ld8(sp + (size_t)et * 16 * 64 + 32), qf1, o[et]); }
    }
    const int tl = 16 * tt + jl, rho_off = 8 * (jl >> 2) + (jl & 3);
    const bf16* vt = VTG + ((size_t)((b * 4 + h) * 128 + jl)) * SEQ + 64 * cc + 8 * gq;
    for (int sp_ = 0; sp_ <= (tt >> 1); ++sp_) {
        const bf16* kx = P1 + (tokc + 32 * sp_ + rho_off) * P1LD + 768 + h * 64 + 8 * gq;
        const bf16* ky = kx + (size_t)4 * P1LD;
        f32x4 sx = mfma16(ld8(kx), qf0, (f32x4){0.f, 0.f, 0.f, 0.f}); sx = mfma16(ld8(kx + 32), qf1, sx);
        f32x4 sy = mfma16(ld8(ky), qf0, (f32x4){0.f, 0.f, 0.f, 0.f}); sy = mfma16(ld8(ky + 32), qf1, sy);
        const int kb = 32 * sp_ + 8 * gq;
        float pe[8];
#pragma unroll
        for (int r = 0; r < 4; ++r) { pe[r] = (kb + r <= tl) ? sx[r] : 0.f; pe[4 + r] = (kb + 4 + r <= tl) ? sy[r] : 0.f; }
        const u32x4 pw = pack8(pe); const bf16x8 pf = __builtin_bit_cast(bf16x8, pw);
#pragma unroll
        for (int et = 0; et < 8; ++et) o[et] = mfma16(ld8(vt + (size_t)et * 16 * SEQ + 32 * sp_), pf, o[et]);
    }
    float q = 0.f;
#pragma unroll
    for (int et = 0; et < 8; ++et) q += (o[et][0] * o[et][0] + o[et][1] * o[et][1]) + (o[et][2] * o[et][2] + o[et][3] * o[et][3]);
    q += __shfl_xor(q, 16); q += __shfl_xor(q, 32);
    const float rs = rsqrtf(q * (1.0f / 128.0f) + 1e-6f);
    const bf16* grow = P1 + (tokc + tl) * P1LD + 1536 + h * 128 + 4 * gq;
    bf16* orow = ycat + (tokc + tl) * 1024 + 512 + h * 128 + 4 * gq;
#pragma unroll
    for (int et = 0; et < 8; ++et) {
        const u32x2 gv = *(const u32x2*)(grow + 16 * et);
        const f32x4 gn = *(const f32x4*)(gnorm + 16 * et + 4 * gq);
        float r[4];
#pragma unroll
        for (int e = 0; e < 4; ++e) { const float gg = bfw(gv[e >> 1], e & 1); r[e] = (o[et][e] * rs * gn[e]) * (gg * sigm(gg)); }
        u32x2 w; w.x = cvt_pk_bf16(r[0], r[1]); w.y = cvt_pk_bf16(r[2], r[3]);
        *(u32x2*)(orow + 16 * et) = w;
    }
}

struct Args { const float* in[34]; float* out; unsigned char* ws; int ph_lo, ph_hi; };
constexpr int NPHASE = 19;

template <class Epi>
__device__ __forceinline__ void run_gemm(LAS unsigned char* lds, const bf16* A, const bf16* Bt, int M, int N, int K, const Epi& E) {
    pg8::Gemm g{A, Bt, M, N, K}; pg8::StaticOrder S; S.init(M, N, (int)gridDim.x, (int)blockIdx.x);
    pg8::gemm_phase<Epi, pg8::StaticOrder, true, true>(lds, g, S, E);
}

__global__ void __launch_bounds__(512, 2) fwd_kernel(Args a) {
    extern __shared__ __attribute__((aligned(16))) unsigned char lds_raw[];
    cg::grid_group grid = cg::this_grid();
    Ctx c; c.tid = threadIdx.x; c.lane = c.tid & 63; c.wave = __builtin_amdgcn_readfirstlane(c.tid >> 6);
    c.gw = blockIdx.x * 8 + c.wave; c.ngw = gridDim.x * 8; c.gtid = blockIdx.x * 512 + c.tid; c.ngt = gridDim.x * 512;
    c.lds = (LAS unsigned char*)lds_raw;
    unsigned char* ws = a.ws; const float* const* in = a.in;
    const int lo = a.ph_lo, hi = a.ph_hi;
#define IN(k) (lo <= (k) && (k) < hi)
#ifndef REP_MASK
#define REP_MASK 0
#endif
#define REPS(k) for (int r_ = 0; r_ < 1 + ((REP_MASK >> (k)) & 1); ++r_)
#define REPBAR() do { if (r_) xcd_barrier(bar); } while (0)
#define SYNC(k) do { if (IN(k) && IN((k) + 1)) { xcd_barrier(bar); } } while (0)
    volatile LAS unsigned* misc = (volatile LAS unsigned*)(c.lds + 131072);
    if (c.tid < 8) misc[c.tid] = 0u;
    __syncthreads();
    XcdBarrier bar = xcd_barrier_post((unsigned*)(ws + WS_BARRIER), misc);
    float* ss = (float*)(ws + WS_SS);
    bf16* XB = (bf16*)(ws + WS_XB); bf16* BIG = (bf16*)(ws + WS_BIG); bf16* YCAT = (bf16*)(ws + WS_YCAT);
    LAS float* halo = (LAS float*)(c.lds + HALO_OFF);

#ifdef TIMING_PROBE
    volatile LAS unsigned long long* tsl = (volatile LAS unsigned long long*)(c.lds + 131072 + 64);
#define STAMP(k) do { if (blockIdx.x == 0 && c.tid == 0) tsl[k] = __builtin_amdgcn_s_memrealtime(); } while (0)
#else
#define STAMP(k) do {} while (0)
#endif
    STAMP(0);
    if (IN(0)) REPS(0) { REPBAR(); phase_prologue(c, in, ws); if (!DEFER_TR) phase_s5_mats(c, in, ws); }
    SYNC(0); STAMP(1);
    if (IN(1)) REPS(1) { REPBAR(); { pg8::EpiProj E{BIG, P0LD, ss}; run_gemm(c.lds, XB, (const bf16*)(ws + WS_W_EIN), TT, 2560, 1024, E); }
        if ((DEFER_TR || DEFER_P1) && r_ == 0) { if (gridDim.x == 256) { if (blockIdx.x >= 128) do_tr_items(c, in, ws, TR_EOUT0, TR_FIN10, (blockIdx.x - 128) * 8 + c.wave, 1024); } else do_tr_items(c, in, ws, TR_EOUT0, TR_FIN10, c.gw, c.ngw); } }
    SYNC(1); STAMP(2);
    if (IN(2)) REPS(2) { REPBAR(); phase_prep0(c, in, ws, a.out); }
    SYNC(2); STAMP(3);
    if (IN(3)) REPS(3) { REPBAR(); { pg8::EpiGates E{(const bf16*)(ws + WS_XC), (bf16*)(ws + WS_LOGA), (bf16*)(ws + WS_GI), in[6], in[8], in[9]};
        run_gemm(c.lds, (const bf16*)(ws + WS_XC), (const bf16*)(ws + WS_W_GATE), TT, 1024, 512, E); } }
    SYNC(3); STAMP(4);
    if (IN(4)) REPS(4) { REPBAR();
        phase_lru_a(c, ws);
        if (gridDim.x == 256) {
            const int x = blockIdx.x & 7, j = blockIdx.x >> 3;
            for (int k = 0; k < 4; ++k) { const int bh = 2 * x + (k >> 1), r16 = 8 * (k & 1) + c.wave;
                if ((k & 1) == 0) { __syncthreads(); attn_stage_p1(c, BIG, (const bf16*)a.out, bh >> 3, bh & 7, j); __syncthreads(); }
                attn_item<true>(c, BIG, (const bf16*)a.out, YCAT, (bh << 9) | (r16 << 5) | j, c.lane); }
            __syncthreads();
        } else
        for (int it = c.gw; it < 2 * 8 * 16 * 32; it += c.ngw) attn_item<false>(c, BIG, (const bf16*)a.out, YCAT, it, c.lane);
    }
    SYNC(4); STAMP(5);
    if (IN(5)) REPS(5) { REPBAR(); phase_lru_b(c, ws); if (DEFER_TR && r_ == 0) { do_tr_items(c, in, ws, TR_FOUT00, TR_FOUT10, c.gw, c.ngw); do_tr_items(c, in, ws, TR_OIN0, TR_GLU0, c.gw, c.ngw); } }
    SYNC(5); STAMP(6);
#ifdef EXTRA_BARS
    for (int k_ = 0; k_ < EXTRA_BARS; ++k_) xcd_barrier(bar);
#endif
    if (IN(6)) REPS(6) { REPBAR(); { pg8::EpiRes E{in[0], a.out, XB, ss + TT}; run_gemm(c.lds, YCAT, (const bf16*)(ws + WS_W_EOUT), TT, 1024, 1024, E); } }
    SYNC(6); STAMP(7);
    if (IN(7)) REPS(7) { REPBAR(); { pg8::EpiFfn E{BIG, ss + TT, in[31], in[32], (float*)(ws + WS_EDGEA), (float*)(ws + WS_EDGEL), (float*)(ws + WS_TAILA), halo};
        run_gemm(c.lds, XB, (const bf16*)(ws + WS_W_FIN0), TT, 6144, 1024, E); } }
    SYNC(7); STAMP(8);
    const bool fuse_fix = (gridDim.x == 256) && !DEFER_TR;
    if (!fuse_fix) { if (IN(8)) REPS(8) { REPBAR(); phase_fixup(c, ws, in[31], in[32]); if (DEFER_TR && r_ == 0) phase_s5_mats(c, in, ws); }
    SYNC(8); } STAMP(9);
    if (IN(9)) REPS(9) { REPBAR(); if (fuse_fix) fixup_panel(c, ws, in[31], in[32], 8 * (blockIdx.x & 7) + ((blockIdx.x >> 3) & 7));
        { pg8::EpiRes E{a.out, a.out, XB, ss + 2 * TT}; run_gemm(c.lds, BIG, (const bf16*)(ws + WS_W_FOUT0), TT, 1024, 3072, E); } }
    SYNC(9); STAMP(10);
    if (IN(10)) REPS(10) { REPBAR(); { pg8::EpiProj E{BIG, P1LD, ss + 2 * TT}; run_gemm(c.lds, XB, (const bf16*)(ws + WS_W_OIN), TT, 2048, 1024, E); }
        for (int it = c.gw; it < TT / 16; it += c.ngw) gk_item(XB, (const bf16*)(ws + WS_W_OIN), ss + 2 * TT, BIG, it, c.lane);
        if (DEFER_TR && r_ == 0) { int widx = c.gw, nw = c.ngw; if (gridDim.x == 256) { widx = (blockIdx.x >= 64) ? (blockIdx.x - 64) * 8 + c.wave : -1; nw = 192 * 8; }
            if (widx >= 0) { do_tr_items(c, in, ws, TR_FIN10, TR_FOUT00, widx, nw); do_tr_items(c, in, ws, TR_FOUT10, TR_OIN0, widx, nw); do_tr_items(c, in, ws, TR_GLU0, TR_END, widx, nw); } } }
    SYNC(10); STAMP(11);
    if (IN(11)) REPS(11) { REPBAR();
        phase_gla_prep(c, in, ws);
        if (c.wave >= 4) {
            Ctx c2 = c; c2.gw = blockIdx.x * 4 + (c.wave - 4); c2.ngw = gridDim.x * 4;
            vt_run(c2, BIG, P1LD, 1024, 128, 4, (bf16*)(ws + WS_VTG), SEQ, 0, 8 * 2 * 1024);
            for (int it = c2.gw; it < 32 * 64; it += c2.ngw) s5a_item(BIG, (const bf16*)(ws + WS_S5F), (float*)(ws + WS_XLOC), it, c.lane);
        }
    }
    SYNC(11); STAMP(12);
    if (IN(12)) REPS(12) { REPBAR();
        phase_s5_scan(c, in, ws);
        for (int it = c.ngw - 1 - c.gw; it < 2 * 4 * 128; it += c.ngw) gla_kv_item((const bf16*)(ws + WS_KDT), (const bf16*)(ws + WS_VTG), (bf16*)(ws + WS_KVS), it, c.lane);
    }
    SYNC(12); STAMP(13);
    if (IN(13)) REPS(13) { REPBAR();
        phase_gla_scan(c, ws);
        if (gridDim.x == 256) s5c_block(c, BIG, (const bf16*)(ws + WS_S5A), (const bf16*)(ws + WS_SX), in[21], (bf16*)(ws + WS_XLOC), 31 - (blockIdx.x >> 3), (blockIdx.x & 7) * 8 + c.wave);
        else
        for (int it = c.ngw - 1 - c.gw; it < 32 * 64; it += c.ngw) s5c_item(BIG, (const bf16*)(ws + WS_S5A), (const bf16*)(ws + WS_SX), in[21], (bf16*)(ws + WS_XLOC), it, c.lane);
    }
    SYNC(13); STAMP(14);
    if (IN(14)) REPS(14) { REPBAR();
        { pg8::EpiGlu E{(const bf16*)(ws + WS_XLOC), YCAT, in[24]}; run_gemm(c.lds, (const bf16*)(ws + WS_XLOC), (const bf16*)(ws + WS_W_GLU), TT, 512, 512, E); }
        if (gridDim.x == 256) {
            if (blockIdx.x < 128) gla_out_item(BIG, (const bf16*)(ws + WS_VTG), (const bf16*)(ws + WS_KVS), in[27], YCAT, c.gw, c.lane);
            else for (int k = 0; k < 3; ++k) gla_out_item(BIG, (const bf16*)(ws + WS_VTG), (const bf16*)(ws + WS_KVS), in[27], YCAT, 1024 + ((blockIdx.x - 128) * 8 + c.wave) * 3 + k, c.lane);
        } else
        for (int it = c.ngw - 1 - c.gw; it < 2 * 4 * 128 * 4; it += c.ngw) gla_out_item(BIG, (const bf16*)(ws + WS_VTG), (const bf16*)(ws + WS_KVS), in[27], YCAT, it, c.lane);
    }
    SYNC(14); STAMP(15);
    if (IN(15)) REPS(15) { REPBAR(); { pg8::EpiRes E{a.out, a.out, XB, ss + 3 * TT}; run_gemm(c.lds, YCAT, (const bf16*)(ws + WS_W_OOUT), TT, 1024, 1024, E); } }
    SYNC(15); STAMP(16);
    if (IN(16)) REPS(16) { REPBAR(); { pg8::EpiFfn E{BIG, ss + 3 * TT, in[31] + 3 * 3072, in[32] + 3072, (float*)(ws + WS_EDGEA), (float*)(ws + WS_EDGEL), (float*)(ws + WS_TAILA), halo};
        run_gemm(c.lds, XB, (const bf16*)(ws + WS_W_FIN1), TT, 6144, 1024, E); } }
    SYNC(16); STAMP(17);
    if (!fuse_fix) { if (IN(17)) REPS(17) { REPBAR(); phase_fixup(c, ws, in[31] + 3 * 3072, in[32] + 3072); }
    SYNC(17); } STAMP(18);
    if (IN(18)) REPS(18) { REPBAR(); if (fuse_fix) fixup_panel(c, ws, in[31] + 3 * 3072, in[32] + 3072, 8 * (blockIdx.x & 7) + ((blockIdx.x >> 3) & 7));
        { pg8::EpiRes E{a.out, a.out, nullptr, nullptr}; run_gemm(c.lds, BIG, (const bf16*)(ws + WS_W_FOUT1), TT, 1024, 3072, E); } }
#ifdef TIMING_PROBE
    xcd_barrier(bar); STAMP(19);
    if (blockIdx.x == 0 && c.tid == 0) {
        const float d1 = (float)(tsl[TP_A_HI] - tsl[TP_A_LO]) * 0.01f, d2 = (float)(tsl[TP_B_HI] - tsl[TP_B_LO]) * 0.01f;
#ifdef TP_CALIB
        a.out[0] += 1000.0f;
#else
        a.out[0] += d1;
        for (int j = 1; j <= 10000; ++j) a.out[j] += 0.1f * d2;
#endif
    }
#endif
#ifdef DBG_PROBE
    { grid.sync();
      const bf16* pb = (const bf16*)(ws + (size_t)DBG_B0 * MiB); const size_t nb = (size_t)(DBG_B1 - DBG_B0) * MiB / 2;
      const float* pf = (const float*)(ws + (size_t)DBG_F0 * MiB); const size_t nf = (size_t)(DBG_F1 - DBG_F0) * MiB / 4;
      for (size_t i = c.gtid; i < (size_t)TT * DM; i += c.ngt) { float s = 0.f;
          for (size_t j = i; j < nb; j += (size_t)TT * DM) s += bf2f(pb[j]);
          for (size_t j = i; j < nf; j += (size_t)TT * DM) s += pf[j];
          a.out[i] += 1e-3f * s; } }
#endif
    if (hi < 7) { grid.sync(); for (int i = c.gtid; i < TT * DM / 4; i += c.ngt) ((f32x4*)a.out)[i] = ((const f32x4*)in[0])[i]; }
#undef IN
#undef SYNC
}

#ifndef DBG_HI
#define DBG_HI NPHASE
#endif
#ifndef MK_PER_PHASE
#define MK_PER_PHASE 0
#endif
extern "C" void kernel_launch(void* const* d_in, const int* in_sizes, int n_in, void* d_out, int out_size, void* d_ws, size_t ws_size, hipStream_t stream) {
    static int grid = 0;
    if (grid == 0) {
        if (n_in != 34 || out_size != TT * DM || ws_size < WS_END) { fprintf(stderr, "kernel_launch: unexpected shapes (n_in %d out %d ws %zu)\n", n_in, out_size, ws_size); grid = -1; return; }
        int dev = 0, cus = 0, per_cu = 0;
        hipGetDevice(&dev); hipDeviceGetAttribute(&cus, hipDeviceAttributeMultiprocessorCount, dev);
        if (hipFuncSetAttribute((const void*)fwd_kernel, hipFuncAttributeMaxDynamicSharedMemorySize, LDS_BYTES) != hipSuccess) { fprintf(stderr, "kernel_launch: hipFuncSetAttribute failed\n"); grid = -1; return; }
        if (hipOccupancyMaxActiveBlocksPerMultiprocessor(&per_cu, (const void*)fwd_kernel, 512, LDS_BYTES) != hipSuccess || per_cu < 1) { fprintf(stderr, "kernel_launch: occupancy query says %d\n", per_cu); per_cu = 1; }
        (void)hipGetLastError();
        grid = cus;
        if (grid > 256) grid = 256;
    }
    if (grid < 0) return;
    if (hipMemsetAsync((char*)d_ws + WS_BARRIER, 0, 16384, stream) != hipSuccess) { fprintf(stderr, "kernel_launch: memset failed\n"); return; }
    Args a{};
    for (int i = 0; i < 34; ++i) a.in[i] = (const float*)d_in[i];
    a.out = (float*)d_out; a.ws = (unsigned char*)d_ws;
#if MK_PER_PHASE
    for (int p = 0; p < NPHASE; ++p) { a.ph_lo = p; a.ph_hi = p + 1; hipLaunchKernelGGL(fwd_kernel, dim3(grid), dim3(512), LDS_BYTES, stream, a); }
#else
    a.ph_lo = 0; a.ph_hi = DBG_HI;
    void* args[] = {&a};
    hipError_t e = hipLaunchCooperativeKernel((const void*)fwd_kernel, dim3(grid), dim3(512), args, LDS_BYTES, stream);
    if (e != hipSuccess) fprintf(stderr, "cooperative launch failed: %s (grid %d)\n", hipGetErrorString(e), grid);
#ifdef PROBE_LO
    (void)hipMemsetAsync((char*)d_ws + WS_BARRIER, 0, 16384, stream);
    Args a2 = a; a2.ph_lo = PROBE_LO; a2.ph_hi = PROBE_HI;
    void* args2[] = {&a2};
    (void)hipLaunchCooperativeKernel((const void*)fwd_kernel, dim3(grid), dim3(512), args2, LDS_BYTES, stream);
#endif
#endif
}
```

```cpp
#include <hip/hip_runtime.h>
#include <hip/hip_cooperative_groups.h>
#include <cstdio>
#include <cstdint>
namespace cg = cooperative_groups;
namespace pg8 {
#define PG8_LAS __attribute__((address_space(3)))
typedef unsigned short bf16_t;
typedef short bf16x8 __attribute__((ext_vector_type(8)));
typedef float f32x4 __attribute__((ext_vector_type(4)));
typedef unsigned u32x4 __attribute__((ext_vector_type(4)));
constexpr int BM = 256, BK = 64, HALF = 128, HTB = HALF * BK * 2  , STAGE_BYTES = 8 * HTB, NXCD = 8, WGM = 8;

__host__ __device__ __forceinline__ int lds_byte(int r, int c) { const int st = (r >> 4) * 2 + (c >> 5), rr = r & 15, cc = c & 31, ob = rr * 64 + cc * 2; return st * 1024 + (ob ^ (((ob >> 9) & 1) << 5)); }
__host__ __device__ __forceinline__ void stage_rc(int b, int& R, int& C) { const int st = b / 1024, sb = b % 1024, swz = sb ^ (((sb >> 9) & 1) << 5); R = (st >> 1) * 16 + swz / 64; C = (st & 1) * 32 + (swz % 64) / 2; }
__host__ __device__ __forceinline__ int perm32(int rho) { const int n = rho >> 4, i = rho & 15; return 8 * (i >> 2) + 4 * n + (i & 3); }

struct Unit { int pm, pn; };
struct Gemm { const bf16_t* A; const bf16_t* Bt; int M, N, K; };

struct StaticOrder {
    int nM, nN, nwg, G, c;
    __host__ __device__ void init(int M, int N, int G_, int c_) { nM = M / BM; nN = N / BM; nwg = nM * nN; G = G_; c = c_; }
    __host__ __device__ bool next(int i, Unit& u) const {
        const long L = (long)i * G + c; if (L >= nwg) return false;
        int wgid = (int)L; { const int q = nwg / NXCD, r = nwg % NXCD, xcd = wgid % NXCD, off = wgid / NXCD; wgid = (xcd < r ? xcd * (q + 1) : r * (q + 1) + (xcd - r) * q) + off; }
        const int nig = WGM * nN, gid = wgid / nig, fm = gid * WGM, gsz = (nM - fm) < WGM ? (nM - fm) : WGM;
        u.pm = fm + ((wgid % nig) % gsz); u.pn = (wgid % nig) / gsz; return true;
    }
    __device__ __forceinline__ void a_ready(const Unit&) const {}
    __device__ __forceinline__ void done(const Unit&) const {}
};

__device__ __forceinline__ unsigned cvt_pk_bf16(float lo, float hi) { unsigned r; asm volatile("v_cvt_pk_bf16_f32 %0, %1, %2" : "=v"(r) : "v"(lo), "v"(hi)); return r; }
typedef float f32x2 __attribute__((ext_vector_type(2)));
template <class Epi, class Sched, bool ALIGN_EPI = false, bool SP2 = false>
__device__ __forceinline__ void gemm_phase(PG8_LAS unsigned char* lds, const Gemm g, const Sched& S, const Epi& E) {
    const int tid = threadIdx.x, wid = __builtin_amdgcn_readfirstlane(tid >> 6), lane = tid & 63, wr = wid >> 2, wc = wid & 3, fr = lane & 15, fq = lane >> 4;
    const int K = g.K, nt = K / BK;
    unsigned voffA[2], voffB[2];
#pragma unroll
    for (int i = 0; i < 2; ++i) { int R, C; stage_rc(tid * 16 + i * 8192, R, C); const int Rb = Epi::PERM ? ((R & ~31) + perm32(R & 31)) : R;
        voffA[i] = (unsigned)(R * K + C) * 2u; voffB[i] = (unsigned)(Rb * K + C) * 2u; }
    const size_t kstep = (size_t)(BK * 2);
    const size_t hstep = (size_t)HALF * K * 2;
    const size_t tstep = 2 * hstep;
    const unsigned ldsw = (unsigned)wid * 1024u;
    const int aoff = lds_byte(wr * 64 + fr, fq * 8), boff = lds_byte(wc * 32 + fr, fq * 8);
#define PG8_SA(b, h) (((b) * 2 + (h)) * HTB)
#define PG8_SB(b, h) ((4 + (b) * 2 + (h)) * HTB)
#define PG8_STAGE(bufoff, gbase, voff) do { _Pragma("unroll") for (int _i = 0; _i < 2; ++_i) \
        __builtin_amdgcn_global_load_lds((const unsigned*)((const char*)(gbase) + (voff)[_i]), (PG8_LAS unsigned*)(lds + (bufoff) + ldsw + _i * 8192), 16, 0, 0); } while (0)
#define PG8_LDA(dst, b, h) do { _Pragma("unroll") for (int m = 0; m < 4; ++m) _Pragma("unroll") for (int k = 0; k < 2; ++k) dst[m][k] = *(const PG8_LAS bf16x8*)(lds + PG8_SA(b, h) + aoff + m * 2048 + k * 1024); } while (0)
#define PG8_LDB(dst, b, h) do { _Pragma("unroll") for (int n = 0; n < 2; ++n) _Pragma("unroll") for (int k = 0; k < 2; ++k) dst[n][k] = *(const PG8_LAS bf16x8*)(lds + PG8_SB(b, h) + boff + n * 2048 + k * 1024); } while (0)
#define PG8_MMA(ai, bj, At, Bt) do { __builtin_amdgcn_s_setprio(1); _Pragma("unroll") for (int m = 0; m < 4; ++m) _Pragma("unroll") for (int n = 0; n < 2; ++n) _Pragma("unroll") for (int k = 0; k < 2; ++k) \
        acc[ai][bj][m][n] = __builtin_amdgcn_mfma_f32_16x16x32_bf16(Bt[n][k], At[m][k], acc[ai][bj][m][n], 0, 0, 0); __builtin_amdgcn_s_setprio(0); } while (0)
#define PG8_WAIT_V(n) asm volatile("s_waitcnt vmcnt(" #n ")" ::: "memory")
#define PG8_WAIT_L(n) asm volatile("s_waitcnt lgkmcnt(" #n ")" ::: "memory")
#define PG8_BAR __builtin_amdgcn_s_barrier()
#define PG8_SCHED __builtin_amdgcn_sched_barrier(0)
    Unit cur, nxt; int ui = 0;
    if (!S.next(0, cur)) return;
    f32x4 acc[2][2][4][2];
#pragma unroll
    for (int a = 0; a < 2; ++a)
#pragma unroll
        for (int b = 0; b < 2; ++b)
#pragma unroll
            for (int m = 0; m < 4; ++m)
#pragma unroll
                for (int n = 0; n < 2; ++n) acc[a][b][m][n] = (f32x4){0.f, 0.f, 0.f, 0.f};
    bf16x8 At[4][2], B0[2][2], B1[2][2];
    const char* cA = (const char*)g.A + (size_t)cur.pm * tstep; const char* cB = (const char*)g.Bt + (size_t)cur.pn * tstep;
    S.a_ready(cur);
    if constexpr (SP2) {
        PG8_STAGE(PG8_SB(0, 0), cB, voffB); PG8_STAGE(PG8_SB(0, 1), cB + hstep, voffB); PG8_STAGE(PG8_SA(0, 0), cA, voffA); PG8_STAGE(PG8_SA(0, 1), cA + hstep, voffA);
        if (wr == 1) PG8_BAR;
        PG8_WAIT_V(2); PG8_BAR;
        PG8_STAGE(PG8_SB(1, 0), cB + kstep, voffB); PG8_STAGE(PG8_SA(1, 0), cA + kstep, voffA); PG8_STAGE(PG8_SB(1, 1), cB + hstep + kstep, voffB);
        PG8_WAIT_V(6); PG8_BAR;
    } else {
        PG8_STAGE(PG8_SB(0, 0), cB, voffB); PG8_STAGE(PG8_SA(0, 0), cA, voffA); PG8_STAGE(PG8_SB(0, 1), cB + hstep, voffB); PG8_STAGE(PG8_SA(0, 1), cA + hstep, voffA);
        if (wr == 1) PG8_BAR;
        PG8_WAIT_V(4); PG8_BAR;
        PG8_STAGE(PG8_SB(1, 0), cB + kstep, voffB); PG8_STAGE(PG8_SA(1, 0), cA + kstep, voffA); PG8_STAGE(PG8_SB(1, 1), cB + hstep + kstep, voffB);
        PG8_WAIT_V(6); PG8_BAR;
    }
    for (;;) {
        const bool has_next = S.next(ui + 1, nxt);
        const char* nA = has_next ? (const char*)g.A + (size_t)nxt.pm * tstep : cA; const char* nB = has_next ? (const char*)g.Bt + (size_t)nxt.pn * tstep : cB;
        for (int t = 0; t < nt; t += 2) {
            const bool last = (t == nt - 2);
            const char* a1 = cA + (size_t)(t + 1) * kstep;
            const char* a2 = last ? nA : cA + (size_t)(t + 2) * kstep; const char* b2 = last ? nB : cB + (size_t)(t + 2) * kstep;
            const char* a3 = a2 + kstep; const char* b3 = b2 + kstep;
            if (last && has_next) S.a_ready(nxt);
            if constexpr (SP2) {
            PG8_LDB(B0, 0, 0); PG8_LDB(B1, 0, 1); PG8_SCHED; PG8_LDA(At, 0, 0); PG8_STAGE(PG8_SA(1, 1), a1 + hstep, voffA);
            PG8_WAIT_V(8); PG8_WAIT_L(0); PG8_BAR; PG8_MMA(0, 0, At, B0); PG8_MMA(0, 1, At, B1); PG8_BAR; PG8_SCHED;
            PG8_LDA(At, 0, 1); PG8_STAGE(PG8_SB(0, 0), b2, voffB); PG8_STAGE(PG8_SB(0, 1), b2 + hstep, voffB); PG8_STAGE(PG8_SA(0, 0), a2, voffA);
            PG8_WAIT_V(8); PG8_WAIT_L(0); PG8_BAR; PG8_MMA(1, 0, At, B0); PG8_MMA(1, 1, At, B1); PG8_BAR; PG8_SCHED;
            PG8_LDB(B0, 1, 0); PG8_LDB(B1, 1, 1); PG8_SCHED; PG8_LDA(At, 1, 0); PG8_STAGE(PG8_SA(0, 1), a2 + hstep, voffA);
            PG8_WAIT_V(8); PG8_WAIT_L(0); PG8_BAR; PG8_MMA(0, 0, At, B0); PG8_MMA(0, 1, At, B1); PG8_BAR; PG8_SCHED;
            PG8_LDA(At, 1, 1); PG8_STAGE(PG8_SB(1, 0), b3, voffB); PG8_STAGE(PG8_SB(1, 1), b3 + hstep, voffB); PG8_STAGE(PG8_SA(1, 0), a3, voffA);
            PG8_WAIT_V(8); PG8_WAIT_L(0); PG8_BAR; PG8_MMA(1, 0, At, B0); PG8_MMA(1, 1, At, B1); PG8_BAR; PG8_SCHED;
            } else {
            PG8_LDB(B0, 0, 0); PG8_SCHED; PG8_LDA(At, 0, 0); PG8_STAGE(PG8_SA(1, 1), a1 + hstep, voffA);
            PG8_WAIT_L(8); PG8_BAR; PG8_WAIT_L(0); PG8_MMA(0, 0, At, B0); PG8_BAR; PG8_SCHED;
            PG8_LDB(B1, 0, 1); PG8_STAGE(PG8_SB(0, 0), b2, voffB);
            PG8_BAR; PG8_WAIT_L(0); PG8_MMA(0, 1, At, B1); PG8_BAR;
            PG8_LDA(At, 0, 1); PG8_STAGE(PG8_SA(0, 0), a2, voffA);
            PG8_BAR; PG8_WAIT_L(0); PG8_MMA(1, 0, At, B0); PG8_BAR; PG8_SCHED;
            PG8_STAGE(PG8_SB(0, 1), b2 + hstep, voffB);
            PG8_WAIT_V(6); PG8_BAR; PG8_MMA(1, 1, At, B1); PG8_BAR;
            PG8_LDB(B0, 1, 0); PG8_SCHED; PG8_LDA(At, 1, 0); PG8_STAGE(PG8_SA(0, 1), a2 + hstep, voffA);
            PG8_WAIT_L(8); PG8_BAR; PG8_WAIT_L(0); PG8_MMA(0, 0, At, B0); PG8_BAR; PG8_SCHED;
            PG8_LDB(B1, 1, 1); PG8_STAGE(PG8_SB(1, 0), b3, voffB);
            PG8_BAR; PG8_WAIT_L(0); PG8_MMA(0, 1, At, B1); PG8_BAR;
            PG8_LDA(At, 1, 1); PG8_STAGE(PG8_SA(1, 0), a3, voffA);
            PG8_BAR; PG8_WAIT_L(0); PG8_MMA(1, 0, At, B0); PG8_BAR; PG8_SCHED;
            PG8_STAGE(PG8_SB(1, 1), b3 + hstep, voffB);
            PG8_WAIT_V(6); PG8_BAR; PG8_MMA(1, 1, At, B1); PG8_BAR;
            }
        }
        if constexpr (ALIGN_EPI) { if (wr == 0) PG8_BAR; }
        if constexpr (!Epi::AFTER_DRAIN) { E(acc, cur, wr, wc, fr, fq); S.done(cur); }
        if (!has_next) break;
#pragma unroll
        for (int a = 0; a < 2; ++a)
#pragma unroll
            for (int b = 0; b < 2; ++b)
#pragma unroll
                for (int m = 0; m < 4; ++m)
#pragma unroll
                    for (int n = 0; n < 2; ++n) acc[a][b][m][n] = (f32x4){0.f, 0.f, 0.f, 0.f};
        cur = nxt; cA = nA; cB = nB; ++ui;
        if constexpr (ALIGN_EPI) { if (wr == 1) PG8_BAR; }
    }
    PG8_WAIT_V(0);
    if constexpr (!ALIGN_EPI) { if (wr == 0) PG8_BAR; }
    PG8_BAR;
    if constexpr (Epi::AFTER_DRAIN) { E.fused(acc, cur, wr, wc, fr, fq, lds, wid, lane); S.done(cur); }
#undef PG8_SA
#undef PG8_SB
#undef PG8_STAGE
#undef PG8_LDA
#undef PG8_LDB
#undef PG8_MMA
#undef PG8_WAIT_V
#undef PG8_WAIT_L
#undef PG8_BAR
#undef PG8_SCHED
}
}
namespace pg8 {
typedef unsigned u32x2 __attribute__((ext_vector_type(2)));
typedef float f32x2_t __attribute__((ext_vector_type(2))); typedef __bf16 bf16x2_t __attribute__((ext_vector_type(2)));
__device__ __forceinline__ unsigned cvtpk(float lo, float hi) { f32x2_t v = {lo, hi}; bf16x2_t b = __builtin_convertvector(v, bf16x2_t); return __builtin_bit_cast(unsigned, b); }
__device__ __forceinline__ float sigm(float x) { return __builtin_amdgcn_rcpf(1.0f + __expf(-x)); }
__device__ __forceinline__ float gelu_tanh(float x) { const float u = 1.5957691216057308f * (x + 0.044715f * x * x * x); return x * __builtin_amdgcn_rcpf(1.0f + __expf(-u)); }
__device__ __forceinline__ float bfw(unsigned w, int hi) { return __uint_as_float(hi ? (w & 0xffff0000u) : (w << 16)); }
__device__ __forceinline__ float logsig(float z) { return fminf(z, 0.f) - log1pf(__expf(-fabsf(z))); }
__device__ __forceinline__ float dpp_ror1(float v) { return __int_as_float(__builtin_amdgcn_update_dpp(__float_as_int(v), __float_as_int(v), 0x121, 0xf, 0xf, false)); }
__device__ __forceinline__ float dpp_ror2(float v) { return __int_as_float(__builtin_amdgcn_update_dpp(__float_as_int(v), __float_as_int(v), 0x122, 0xf, 0xf, false)); }

struct EpiProj {
    static constexpr bool PERM = true, AFTER_DRAIN = false;
    bf16_t* O; int ldc; const float* ss;
    __device__ __forceinline__ void operator()(const f32x4 (&acc)[2][2][4][2], const Unit& u, int wr, int wc, int fr, int fq) const {
        const int row0 = u.pm * BM + wr * 64 + fr, col0 = u.pn * BM + wc * 32 + 8 * fq;
#pragma unroll
        for (int ai = 0; ai < 2; ++ai)
#pragma unroll
            for (int m = 0; m < 4; ++m) {
                const int row = row0 + ai * HALF + m * 16;
                const float rs = rsqrtf(ss[row] * (1.0f / 1024.0f) + 1e-6f);
                bf16_t* rowp = O + (size_t)row * ldc + col0;
#pragma unroll
                for (int bj = 0; bj < 2; ++bj) {
                    const f32x4 v0 = acc[ai][bj][m][0] * rs, v1 = acc[ai][bj][m][1] * rs;
                    u32x4 w; w.x = cvt_pk_bf16(v0[0], v0[1]); w.y = cvt_pk_bf16(v0[2], v0[3]); w.z = cvt_pk_bf16(v1[0], v1[1]); w.w = cvt_pk_bf16(v1[2], v1[3]);
                    *(u32x4*)(rowp + bj * HALF) = w;
                }
            }
    }
};

struct EpiGates {
    static constexpr bool PERM = true, AFTER_DRAIN = false;
    const bf16_t* xc; bf16_t* loga; bf16_t* gi; const float* ga_b; const float* gx_b; const float* lam;
    __device__ __forceinline__ void operator()(const f32x4 (&acc)[2][2][4][2], const Unit& u, int wr, int wc, int fr, int fq) const {
        const int row0 = u.pm * BM + wr * 64 + fr, ch0 = u.pn * HALF + wc * 32 + 8 * fq;
        float gab[8], gxb[8], ls[8];
#pragma unroll
        for (int e = 0; e < 8; ++e) { gab[e] = ga_b[ch0 + e]; gxb[e] = gx_b[ch0 + e]; ls[e] = 8.0f * logsig(lam[ch0 + e]); }
#pragma unroll
        for (int ai = 0; ai < 2; ++ai)
#pragma unroll
            for (int m = 0; m < 4; ++m) {
                const int row = row0 + ai * HALF + m * 16;
                const u32x4 xv = *(const u32x4*)(xc + (size_t)row * 512 + ch0);
                float la[8], g[8];
#pragma unroll
                for (int n = 0; n < 2; ++n)
#pragma unroll
                    for (int e = 0; e < 4; ++e) {
                        const int idx = 4 * n + e;
                        const float r = acc[ai][0][m][n][e] + gab[idx], i = acc[ai][1][m][n][e] + gxb[idx];
                        la[idx] = sigm(r) * ls[idx];
                        g[idx] = sigm(i) * bfw(xv[idx >> 1], idx & 1);
                    }
                u32x4 w; w.x = cvt_pk_bf16(la[0], la[1]); w.y = cvt_pk_bf16(la[2], la[3]); w.z = cvt_pk_bf16(la[4], la[5]); w.w = cvt_pk_bf16(la[6], la[7]);
                *(u32x4*)(loga + (size_t)row * 512 + ch0) = w;
                u32x4 w2; w2.x = cvt_pk_bf16(g[0], g[1]); w2.y = cvt_pk_bf16(g[2], g[3]); w2.z = cvt_pk_bf16(g[4], g[5]); w2.w = cvt_pk_bf16(g[6], g[7]);
                *(u32x4*)(gi + (size_t)row * 512 + ch0) = w2;
            }
    }
};

struct EpiRes {
    static constexpr bool PERM = false, AFTER_DRAIN = false;
    const float* base; float* out; bf16_t* xb; float* ss;
    __device__ __forceinline__ void operator()(const f32x4 (&acc)[2][2][4][2], const Unit& u, int wr, int wc, int fr, int fq) const {
        const int row0 = u.pm * BM + wr * 64 + fr, col0 = u.pn * BM + wc * 32 + 4 * fq;
#pragma unroll
        for (int ai = 0; ai < 2; ++ai)
#pragma unroll
            for (int m = 0; m < 4; ++m) {
                const int row = row0 + ai * HALF + m * 16; float q = 0.f;
#pragma unroll
                for (int bj = 0; bj < 2; ++bj)
#pragma unroll
                    for (int n = 0; n < 2; ++n) {
                        const size_t off = (size_t)row * 1024 + col0 + bj * HALF + n * 16;
                        const f32x4 b = *(const f32x4*)(base + off);
                        const f32x4 o = b + acc[ai][bj][m][n];
                        *(f32x4*)(out + off) = o;
                        if (xb) { u32x2 w; w.x = cvt_pk_bf16(o[0], o[1]); w.y = cvt_pk_bf16(o[2], o[3]); *(u32x2*)(xb + off) = w; }
                        q += (o[0] * o[0] + o[1] * o[1]) + (o[2] * o[2] + o[3] * o[3]);
                    }
                if (ss) { q += __shfl_xor(q, 16); q += __shfl_xor(q, 32); if (fq == 0) atomicAdd(ss + row, q); }
            }
    }
};

struct EpiGlu {
    static constexpr bool PERM = true, AFTER_DRAIN = false;
    const bf16_t* ys; bf16_t* ycat; const float* bias;
    __device__ __forceinline__ void operator()(const f32x4 (&acc)[2][2][4][2], const Unit& u, int wr, int wc, int fr, int fq) const {
        const int row0 = u.pm * BM + wr * 64 + fr, col0 = u.pn * BM + wc * 32 + 8 * fq;
#pragma unroll
        for (int bj = 0; bj < 2; ++bj) {
            const int col = col0 + bj * HALF;
            float bs[8];
#pragma unroll
            for (int e = 0; e < 8; ++e) bs[e] = bias[col + e];
#pragma unroll
            for (int ai = 0; ai < 2; ++ai)
#pragma unroll
                for (int m = 0; m < 4; ++m) {
                    const int row = row0 + ai * HALF + m * 16;
                    const u32x4 yv = *(const u32x4*)(ys + (size_t)row * 512 + col);
                    float o[8];
#pragma unroll
                    for (int n = 0; n < 2; ++n)
#pragma unroll
                        for (int e = 0; e < 4; ++e) { const int idx = 4 * n + e; o[idx] = bfw(yv[idx >> 1], idx & 1) * sigm(acc[ai][bj][m][n][e] + bs[idx]); }
                    u32x4 w; w.x = cvt_pk_bf16(o[0], o[1]); w.y = cvt_pk_bf16(o[2], o[3]); w.z = cvt_pk_bf16(o[4], o[5]); w.w = cvt_pk_bf16(o[6], o[7]);
                    *(u32x4*)(ycat + (size_t)row * 1024 + col) = w;
                }
        }
    }
};

struct EpiFfn {
    static constexpr bool PERM = true, AFTER_DRAIN = false;
    bf16_t* U; const float* ss; const float* cw; const float* cb; float* edgeA; float* edgeL; float* tailA; PG8_LAS float* halo;
    __device__ __forceinline__ void operator()(const f32x4 (&acc)[2][2][4][2], const Unit& u, int wr, int wc, int fr, int fq) const {
        const int cl = wc * 32 + 8 * fq, ch0 = u.pn * HALF + cl;
        const int row0 = u.pm * BM + wr * 64 + fr;
        float w0[8], w1[8], w2[8], bb[8];
#pragma unroll
        for (int e = 0; e < 8; ++e) { w0[e] = cw[ch0 + e]; w1[e] = cw[3072 + ch0 + e]; w2[e] = cw[6144 + ch0 + e]; bb[e] = cb[ch0 + e]; }
        float rs[2][4];
#pragma unroll
        for (int ai = 0; ai < 2; ++ai)
#pragma unroll
            for (int m = 0; m < 4; ++m) rs[ai][m] = rsqrtf(ss[row0 + ai * HALF + m * 16] * (1.0f / 1024.0f) + 1e-6f);
        if (fr >= 14) {
#pragma unroll
            for (int ai = 0; ai < 2; ++ai) {
                PG8_LAS float* hp = halo + ((ai * 2 + wr) * 2 + (fr - 14)) * 128 + cl;
                *(PG8_LAS f32x4*)hp = acc[ai][0][3][0] * rs[ai][3];
                *(PG8_LAS f32x4*)(hp + 4) = acc[ai][0][3][1] * rs[ai][3];
            }
            if (wr == 1) {
                float* tp = tailA + (size_t)(u.pm * 2 + (fr - 14)) * 3072 + ch0;
                *(f32x4*)tp = acc[1][0][3][0] * rs[1][3]; *(f32x4*)(tp + 4) = acc[1][0][3][1] * rs[1][3];
            }
        }
        if (wr == 0 && fr < 2) {
            float* ea = edgeA + (size_t)(u.pm * 2 + fr) * 3072 + ch0; float* el = edgeL + (size_t)(u.pm * 2 + fr) * 3072 + ch0;
            *(f32x4*)ea = acc[0][0][0][0] * rs[0][0]; *(f32x4*)(ea + 4) = acc[0][0][0][1] * rs[0][0];
            *(f32x4*)el = acc[0][1][0][0] * rs[0][0]; *(f32x4*)(el + 4) = acc[0][1][0][1] * rs[0][0];
        }
        asm volatile("s_waitcnt lgkmcnt(0)" ::: "memory"); __builtin_amdgcn_s_barrier(); asm volatile("" ::: "memory");
#pragma unroll
        for (int ai = 0; ai < 2; ++ai) {
            f32x4 pv[2];
            if (ai == 0 && wr == 0) { pv[0] = (f32x4){0.f, 0.f, 0.f, 0.f}; pv[1] = pv[0]; }
            else {
                const int pai = (wr == 1) ? ai : 0, pwr = (wr == 1) ? 0 : 1;
                const PG8_LAS float* hp = halo + ((pai * 2 + pwr) * 2 + (fr & 1)) * 128 + cl;
                pv[0] = *(const PG8_LAS f32x4*)hp; pv[1] = *(const PG8_LAS f32x4*)(hp + 4);
            }
#pragma unroll
            for (int m = 0; m < 4; ++m) {
                const int row = row0 + ai * HALF + m * 16;
                f32x4 av[2]; av[0] = acc[ai][0][m][0] * rs[ai][m]; av[1] = acc[ai][0][m][1] * rs[ai][m];
                float o[8];
#pragma unroll
                for (int n = 0; n < 2; ++n)
#pragma unroll
                    for (int e = 0; e < 4; ++e) {
                        const int idx = 4 * n + e;
                        const float cur = av[n][e], prv = pv[n][e];
                        const float r1c = dpp_ror1(cur), r1p = dpp_ror1(prv), r2c = dpp_ror2(cur), r2p = dpp_ror2(prv);
                        const float t1 = (fr >= 1) ? r1c : r1p, t2 = (fr >= 2) ? r2c : r2p;
                        const float cv = w0[idx] * t2 + w1[idx] * t1 + w2[idx] * cur + bb[idx];
                        o[idx] = gelu_tanh(cv) * (acc[ai][1][m][n][e] * rs[ai][m]);
                    }
                u32x4 w; w.x = cvt_pk_bf16(o[0], o[1]); w.y = cvt_pk_bf16(o[2], o[3]); w.z = cvt_pk_bf16(o[4], o[5]); w.w = cvt_pk_bf16(o[6], o[7]);
                *(u32x4*)(U + (size_t)row * 3072 + ch0) = w;
                pv[0] = av[0]; pv[1] = av[1];
            }
        }
    }
};
}
#define LAS __attribute__((address_space(3)))
typedef unsigned short bf16;
typedef short bf16x8 __attribute__((ext_vector_type(8)));
typedef float f32x4 __attribute__((ext_vector_type(4)));
typedef unsigned u32x4 __attribute__((ext_vector_type(4)));
typedef unsigned u32x2 __attribute__((ext_vector_type(2)));
using pg8::cvt_pk_bf16; using pg8::sigm; using pg8::gelu_tanh; using pg8::bfw; using pg8::logsig;

constexpr int TT = 16384, SEQ = 8192, DM = 1024, DFF = 3072;
constexpr size_t MiB = 1u << 20;
constexpr size_t WS_SS = 0;
constexpr size_t WS_SUMA = 256 * 1024, WS_SUMB = 768 * 1024;
constexpr size_t WS_DECAY = 1280 * 1024;
constexpr size_t WS_BARRIER = 3 * 1024 * 1024;
constexpr size_t WS_ROPE = 1536 * 1024;
constexpr size_t WS_W_EIN = 4 * MiB, WS_W_EOUT = 9 * MiB, WS_W_GATE = 11 * MiB, WS_W_FIN0 = 12 * MiB, WS_W_FIN1 = 24 * MiB, WS_W_FOUT0 = 36 * MiB, WS_W_FOUT1 = 42 * MiB;
constexpr size_t WS_W_OIN = 48 * MiB, WS_W_GLU = 53 * MiB, WS_W_OOUT = 54 * MiB, WS_S5A = 56 * MiB, WS_S5F = 62 * MiB;
constexpr size_t WS_XB = 64 * MiB;
constexpr size_t WS_LOGA = 64 * MiB, WS_GI = 80 * MiB;
constexpr size_t WS_KDT = 64 * MiB, WS_VTG = 72 * MiB, WS_SX = 88 * MiB;
constexpr size_t WS_BIG = 96 * MiB;
constexpr size_t WS_XC = 224 * MiB, WS_KVS = 168 * MiB;
constexpr size_t WS_YCAT = 192 * MiB;
constexpr size_t WS_XLOC = 224 * MiB;
constexpr size_t WS_EDGEA = 240 * MiB, WS_EDGEL = 242 * MiB, WS_TAILA = 244 * MiB;
constexpr size_t WS_END = 256 * MiB;
constexpr int P0LD = 2568, P1LD = 2304;
constexpr int VTP = SEQ + 128;
constexpr int LDS_BYTES = 147456, HALO_OFF = 131072 + 1024;

__device__ __forceinline__ float wave_sum(float v) {
#pragma unroll
    for (int o = 1; o < 64; o <<= 1) v += __shfl_xor(v, o);
    return v;
}
__device__ __forceinline__ float bf2f(bf16 b) { return __uint_as_float((unsigned)b << 16); }
__device__ __forceinline__ bf16 f2bf(float f) { return (bf16)(cvt_pk_bf16(f, 0.f) & 0xffffu); }
__device__ __forceinline__ f32x4 mfma16(bf16x8 a, bf16x8 b, f32x4 c) { return __builtin_amdgcn_mfma_f32_16x16x32_bf16(a, b, c, 0, 0, 0); }
__device__ __forceinline__ bf16x8 ld8(const bf16* p) { return *(const bf16x8*)p; }
__device__ __forceinline__ void unpack8(u32x4 v, float* f) {
#pragma unroll
    for (int i = 0; i < 4; ++i) { f[2 * i] = __uint_as_float(v[i] << 16); f[2 * i + 1] = __uint_as_float(v[i] & 0xffff0000u); }
}
__device__ __forceinline__ u32x4 pack8v(const float* f) { u32x4 w; w.x = pg8::cvtpk(f[0], f[1]); w.y = pg8::cvtpk(f[2], f[3]); w.z = pg8::cvtpk(f[4], f[5]); w.w = pg8::cvtpk(f[6], f[7]); return w; }
__device__ __forceinline__ u32x4 pack8(const float* f) { u32x4 w; w.x = cvt_pk_bf16(f[0], f[1]); w.y = cvt_pk_bf16(f[2], f[3]); w.z = cvt_pk_bf16(f[4], f[5]); w.w = cvt_pk_bf16(f[6], f[7]); return w; }

struct Ctx { int tid, lane, wave, gw, ngw, gtid, ngt; LAS unsigned char* lds; };

struct TrDesc { const float* W; const float* gk; bf16* WT; int ldw, nsrc, ldt, k0, n0, dst_row0; };
__device__ __forceinline__ void tr_load(const TrDesc& t, int lane, float* v) {
    const int n = t.n0 + (lane & 31);
#pragma unroll
    for (int i = 0; i < 32; ++i) { const int kk = 2 * i + (lane >> 5); v[i] = (n < t.nsrc) ? __builtin_nontemporal_load(t.W + (size_t)(t.k0 + kk) * t.ldw + n) : 0.f; }
}
__device__ __forceinline__ void tr_finish(const TrDesc& t, int lane, const float* v, LAS float* scr) {
#pragma unroll
    for (int i = 0; i < 32; ++i) { const int kk = 2 * i + (lane >> 5); float x = v[i]; if (t.gk) x *= t.gk[t.k0 + kk]; scr[kk * 33 + (lane & 31)] = x; }
    asm volatile("s_waitcnt lgkmcnt(0)" ::: "memory");
    const int c = lane & 7;
#pragma unroll
    for (int j = 0; j < 4; ++j) {
        const int n = (lane >> 3) + 8 * j; const LAS float* s = scr + (8 * c) * 33 + n;
        u32x4 o; o.x = cvt_pk_bf16(s[0], s[33]); o.y = cvt_pk_bf16(s[66], s[99]); o.z = cvt_pk_bf16(s[132], s[165]); o.w = cvt_pk_bf16(s[198], s[231]);
        *(u32x4*)(t.WT + (size_t)(t.dst_row0 + n) * t.ldt + t.k0 + 8 * c) = o;
    }
    asm volatile("s_waitcnt lgkmcnt(0)" ::: "memory");
}

struct S5P { float m, th, cr, ci, ar, ai; };
__device__ __forceinline__ S5P s5_params(const float* lam_re, const float* lam_im, const float* log_step, int g, int n) {
    const float step = expf(log_step[g]), lr = lam_re[g * 64 + n], li = lam_im[g * 64 + n];
    S5P p; p.m = lr * step; p.th = li * step;
    float sn, cs; sincosf(p.th, &sn, &cs);
    const float mag = expf(p.m), ar = mag * cs, ai = mag * sn, den = lr * lr + li * li;
    p.cr = ((ar - 1.0f) * lr + ai * li) / den; p.ci = (ai * lr - (ar - 1.0f) * li) / den; p.ar = ar; p.ai = ai;
    return p;
}
__device__ __forceinline__ void s5_pow(const S5P& p, float tau, float& pr, float& pi) {
    float sn, cs; sincosf(p.th * tau, &sn, &cs); const float mag = expf(p.m * tau); pr = mag * cs; pi = mag * sn;
}

__device__ __forceinline__ TrDesc tr_decode(const float* const* in, unsigned char* ws, int it) {
    constexpr int I_EIN = 16 * 80, I_EOUT = 16 * 32, I_FIN = 16 * 192, I_FOUT = 48 * 32, I_OIN = 16 * 72, I_GLU = 8 * 16;
    TrDesc t; int r = it;
    if (r < I_EIN) { const int kb = r / 80, nb = r % 80; t = TrDesc{in[2], in[1], (bf16*)(ws + WS_W_EIN), 2560, 2560, 1024, 64 * kb, 32 * nb, 32 * nb}; return t; } r -= I_EIN;
    if (r < I_EOUT) { const int kb = r / 32, nb = r % 32; t = TrDesc{in[12], nullptr, (bf16*)(ws + WS_W_EOUT), 1024, 1024, 1024, 64 * kb, 32 * nb, 32 * nb}; return t; } r -= I_EOUT;
    if (r < 2 * I_FIN) { const int l = r / I_FIN; r %= I_FIN; const int kb = r / 192, nb = r % 192, n0 = 32 * nb;
        const int dst = (n0 < 3072) ? (256 * (n0 / 128) + (n0 % 128)) : (256 * ((n0 - 3072) / 128) + 128 + ((n0 - 3072) % 128));
        t = TrDesc{in[30] + (size_t)l * 1024 * 6144, in[29] + l * 1024, (bf16*)(ws + (l ? WS_W_FIN1 : WS_W_FIN0)), 6144, 6144, 1024, 64 * kb, n0, dst}; return t; } r -= 2 * I_FIN;
    if (r < 2 * I_FOUT) { const int l = r / I_FOUT; r %= I_FOUT; const int kb = r / 32, nb = r % 32;
        t = TrDesc{in[33] + (size_t)l * 3072 * 1024, nullptr, (bf16*)(ws + (l ? WS_W_FOUT1 : WS_W_FOUT0)), 1024, 1024, 3072, 64 * kb, 32 * nb, 32 * nb}; return t; } r -= 2 * I_FOUT;
    if (r < I_OIN) { const int kb = r / 72, nb = r % 72; t = TrDesc{in[14], in[13], (bf16*)(ws + WS_W_OIN), 2064, 2064, 1024, 64 * kb, 32 * nb, 32 * nb}; return t; } r -= I_OIN;
    if (r < I_GLU) { const int kb = r / 16, nb = r % 16; t = TrDesc{in[23], nullptr, (bf16*)(ws + WS_W_GLU), 512, 512, 512, 64 * kb, 32 * nb, 32 * nb}; return t; } r -= I_GLU;
    { const int kb = r / 32, nb = r % 32; t = TrDesc{in[28], nullptr, (bf16*)(ws + WS_W_OOUT), 1024, 1024, 1024, 64 * kb, 32 * nb, 32 * nb}; return t; }
}
__device__ __forceinline__ void do_tr_items(const Ctx& c, const float* const* in, unsigned char* ws, int it_begin, int it_end, int widx, int nw) {
    LAS float* scr = (LAS float*)(c.lds + c.wave * 16384);
    int it = it_begin + widx;
    if (it >= it_end) return;
    TrDesc cur = tr_decode(in, ws, it); float v[32]; tr_load(cur, c.lane, v);
    for (;;) {
        const int nx = it + nw; const bool more = nx < it_end;
        TrDesc nxt = cur; float w[32];
        if (more) { nxt = tr_decode(in, ws, nx); tr_load(nxt, c.lane, w); }
        tr_finish(cur, c.lane, v, scr);
        if (!more) break;
        cur = nxt; it = nx;
#pragma unroll
        for (int i = 0; i < 32; ++i) v[i] = w[i];
    }
}
#ifndef DEFER_TR
#define DEFER_TR 0
#endif
#ifndef DEFER_P1
#define DEFER_P1 0
#endif
constexpr int TR_EIN0 = 0, TR_EOUT0 = 1280, TR_FIN00 = 1792, TR_FIN10 = 4864, TR_FOUT00 = 7936, TR_FOUT10 = 9472, TR_OIN0 = 11008, TR_GLU0 = 12160, TR_OOUT0 = 12288, TR_END = 12800;

__device__ __forceinline__ void phase_prologue(const Ctx& c, const float* const* in, unsigned char* ws) {
#if DEFER_TR
    do_tr_items(c, in, ws, TR_EIN0, TR_EOUT0, c.gw, c.ngw);
#elif DEFER_P1
    do_tr_items(c, in, ws, TR_EIN0, TR_EOUT0, c.gw, c.ngw); do_tr_items(c, in, ws, TR_FIN10, TR_END, c.gw, c.ngw);
#else
    do_tr_items(c, in, ws, TR_EIN0, TR_END, c.gw, c.ngw);
#endif
    {
        const float* x = in[0]; bf16* xb = (bf16*)(ws + WS_XB); float* ss = (float*)(ws + WS_SS);
        for (int m0 = c.gw; m0 < TT; m0 += 2 * c.ngw) {
            f32x4 v[2][4];
#pragma unroll
            for (int u = 0; u < 2; ++u) { const f32x4* xr = (const f32x4*)(x + (size_t)(m0 + u * c.ngw) * DM) + c.lane;
#pragma unroll
                for (int j = 0; j < 4; ++j) v[u][j] = __builtin_nontemporal_load(xr + 64 * j); }
#pragma unroll
            for (int u = 0; u < 2; ++u) { const int m = m0 + u * c.ngw; float s = 0.f;
                u32x2* o8 = (u32x2*)(xb + (size_t)m * DM) + c.lane;
#pragma unroll
                for (int j = 0; j < 4; ++j) { const f32x4 q = v[u][j]; s += (q.x * q.x + q.y * q.y) + (q.z * q.z + q.w * q.w); u32x2 w; w.x = cvt_pk_bf16(q.x, q.y); w.y = cvt_pk_bf16(q.z, q.w); o8[64 * j] = w; }
                s = wave_sum(s);
                if (c.lane == 0) ss[m] = s; }
        }
        for (int i = c.gtid; i < 3 * TT; i += c.ngt) ss[TT + i] = 0.f;
    }
    {
        bf16* G = (bf16*)(ws + WS_W_GATE);
        for (int i = c.gtid; i < 1024 * 512; i += c.ngt) {
            const int R = i >> 9, k = i & 511, pn = R >> 8, half = (R >> 7) & 1, ch = 128 * pn + (R & 127), h = ch >> 6, j = ch & 63;
            float v = 0.f;
            if ((k >> 6) == h) v = (half ? in[7] : in[5])[(h * 64 + (k & 63)) * 64 + j];
            G[i] = f2bf(v);
        }
    }
    {
        float* RT = (float*)(ws + WS_ROPE);
        for (int i = c.gtid; i < SEQ * 8; i += c.ngt) {
            const int pos = i >> 3, e = i & 7;
            const float inv = powf(500000.0f, -(float)e * 0.125f);
            float sn, cs; sincosf((float)pos * inv, &sn, &cs);
            RT[pos * 16 + e] = cs; RT[pos * 16 + 8 + e] = sn;
        }
    }
}
__device__ __forceinline__ void phase_s5_mats(const Ctx& c, const float* const* in, unsigned char* ws) {
    {
        const float *lam_re = in[15], *lam_im = in[16], *b_re = in[17], *b_im = in[18], *c_re = in[19], *c_im = in[20], *lstep = in[22];
        bf16* AM = (bf16*)(ws + WS_S5A);
        bf16* FM = (bf16*)(ws + WS_S5F);
        for (int i = c.gtid; i < 32 * 256 * 4; i += c.ngt) {
            const int nq = i & 3, pp = (i >> 2) & 15, p = (i >> 6) & 15, g = i >> 10;
            float acc[16];
#pragma unroll
            for (int t = 0; t < 16; ++t) acc[t] = 0.f;
            for (int n = nq * 16; n < nq * 16 + 16; ++n) {
                const S5P sp = s5_params(lam_re, lam_im, lstep, g, n);
                const float br = b_re[(g * 64 + n) * 16 + pp], bi = b_im[(g * 64 + n) * 16 + pp];
                const float bbr = sp.cr * br - sp.ci * bi, bbi = sp.cr * bi + sp.ci * br;
                const float cr_ = c_re[(g * 16 + p) * 64 + n], ci_ = c_im[(g * 16 + p) * 64 + n];
                float zr = cr_ * bbr - ci_ * bbi, zi = cr_ * bbi + ci_ * bbr;
#pragma unroll
                for (int t = 0; t < 16; ++t) { acc[t] += zr; const float nr = zr * sp.ar - zi * sp.ai, ni = zr * sp.ai + zi * sp.ar; zr = nr; zi = ni; }
            }
            bf16* Ag = AM + (size_t)g * 256 * 384;
#pragma unroll
            for (int tau = 0; tau < 16; ++tau) {
                float v = acc[tau]; v += __shfl_xor(v, 1); v += __shfl_xor(v, 2);
                if ((tau & 3) == nq) {
                    const bf16 kv = f2bf(v);
                    for (int t = tau; t < 16; ++t) Ag[(t * 16 + p) * 384 + (t - tau) * 16 + pp] = kv;
                    if (tau >= 1) for (int t = 0; t + tau < 16; ++t) Ag[(t * 16 + p) * 384 + (t + tau) * 16 + pp] = 0;
                }
            }
        }
        for (int i = (c.gtid + c.ngt - c.ngt / 4) % c.ngt; i < 32 * 16 * 64; i += c.ngt) {
            const int g = i >> 10, p = (i >> 6) & 15, n = i & 63;
            const S5P sp = s5_params(lam_re, lam_im, lstep, g, n);
            const float cr_ = c_re[(g * 16 + p) * 64 + n], ci_ = c_im[(g * 16 + p) * 64 + n];
            float pr = sp.ar, pi = sp.ai;
            for (int t = 0; t < 16; ++t) {
                bf16* row = AM + ((size_t)g * 256 + t * 16 + p) * 384 + 256;
                row[n] = f2bf(cr_ * pr - ci_ * pi);
                row[64 + n] = f2bf(-(cr_ * pi + ci_ * pr));
                const float nr = pr * sp.ar - pi * sp.ai, ni = pr * sp.ai + pi * sp.ar; pr = nr; pi = ni;
            }
        }
        for (int i = (c.gtid + c.ngt - c.ngt / 2) % c.ngt; i < 32 * 64 * 16; i += c.ngt) {
            const int g = i >> 10, n = (i >> 4) & 63, pp = i & 15;
            const S5P sp = s5_params(lam_re, lam_im, lstep, g, n);
            const float br = b_re[(g * 64 + n) * 16 + pp], bi = b_im[(g * 64 + n) * 16 + pp];
            const float bbr = sp.cr * br - sp.ci * bi, bbi = sp.cr * bi + sp.ci * br;
            float pr = 1.f, pi = 0.f;
            for (int s = 15; s >= 0; --s) {
                FM[((size_t)g * 128 + n) * 256 + s * 16 + pp] = f2bf(pr * bbr - pi * bbi);
                FM[((size_t)g * 128 + 64 + n) * 256 + s * 16 + pp] = f2bf(pr * bbi + pi * bbr);
                const float nr = pr * sp.ar - pi * sp.ai, ni = pr * sp.ai + pi * sp.ar; pr = nr; pi = ni;
            }
        }
    }
}

__device__ __forceinline__ u32x4 vt_load(const bf16* src, int pitch, int coloff, int hd, int nh, int sh, int item, int lane) {
    const int cgp = item & 1023; int r = item >> 10; const int nblk = hd >> 6, dblk = r % nblk, bh = r / nblk, b = bh / nh, h = bh % nh;
    const int d = dblk * 64 + lane, Ld = SEQ >> sh;
    const bf16* s = src + (size_t)b * SEQ * pitch + coloff + h * hd + d;
    unsigned short v[8];
#pragma unroll
    for (int i = 0; i < 8; ++i) { const int col = cgp * 8 + i, rres = col / Ld, l = col - rres * Ld, t = (l << sh) + rres; v[i] = s[(size_t)t * pitch]; }
    u32x4 w; w.x = v[0] | ((unsigned)v[1] << 16); w.y = v[2] | ((unsigned)v[3] << 16); w.z = v[4] | ((unsigned)v[5] << 16); w.w = v[6] | ((unsigned)v[7] << 16);
    return w;
}
__device__ __forceinline__ void vt_store(u32x4 w, int hd, bf16* dst, int dpitch, int item, int lane) {
    const int cgp = item & 1023; int r = item >> 10; const int nblk = hd >> 6, dblk = r % nblk, bh = r / nblk;
    const int d = dblk * 64 + lane;
    *(u32x4*)(dst + ((size_t)bh * hd + d) * dpitch + cgp * 8) = w;
}
__device__ __forceinline__ void vt_store_blk(u32x4 w, bf16* dst, int item, int lane) {
    const int cgp = item & 1023, bh = item >> 10, dt = lane >> 4, dl = lane & 15, col0 = cgp * 8;
    *(u32x4*)(dst + ((size_t)((bh * 4 + dt) * 256 + (col0 >> 5))) * 512 + dl * 32 + (col0 & 31)) = w;
}
__device__ __forceinline__ void vt_run(const Ctx& c, const bf16* src, int pitch, int coloff, int hd, int nh, bf16* dst, int dpitch, int sh, int nitems) {
    for (int it0 = c.gw; it0 < nitems; it0 += 8 * c.ngw) {
        u32x4 w[8];
#pragma unroll
        for (int u = 0; u < 8; ++u) { const int it = it0 + u * c.ngw; if (it < nitems) w[u] = vt_load(src, pitch, coloff, hd, nh, sh, it, c.lane); }
#pragma unroll
        for (int u = 0; u < 8; ++u) { const int it = it0 + u * c.ngw; if (it < nitems) { if (dpitch == 0) vt_store_blk(w[u], dst, it, c.lane); else vt_store(w[u], hd, dst, dpitch, it, c.lane); } }
    }
}

__device__ __forceinline__ void vt32_load(const bf16* src, int sh, int item, int lane, u32x4* w) {
    const int kb = item & 255, bh = item >> 8, b = bh >> 3, h = bh & 7, Ld = SEQ >> sh;
    const bf16* s = src + (size_t)b * SEQ * P0LD + 2048 + h * 64 + lane;
    const int col0 = kb * 32, rres = col0 / Ld, l0 = col0 - rres * Ld;
    unsigned short v[32];
#pragma unroll
    for (int i = 0; i < 32; ++i) v[i] = s[(size_t)(((l0 + i) << sh) + rres) * P0LD];
#pragma unroll
    for (int q = 0; q < 4; ++q) { w[q].x = v[8 * q] | ((unsigned)v[8 * q + 1] << 16); w[q].y = v[8 * q + 2] | ((unsigned)v[8 * q + 3] << 16); w[q].z = v[8 * q + 4] | ((unsigned)v[8 * q + 5] << 16); w[q].w = v[8 * q + 6] | ((unsigned)v[8 * q + 7] << 16); }
}
__device__ __forceinline__ void vt32_store(const u32x4* w, bf16* dst, int p, int item, int lane) {
    const int kb = item & 255, bh = item >> 8;
    bf16* o = (p == 0) ? dst + ((size_t)bh * 64 + lane) * VTP + kb * 32 : dst + ((size_t)((bh * 4 + (lane >> 4)) * 256 + kb)) * 512 + (lane & 15) * 32;
#pragma unroll
    for (int q = 0; q < 4; ++q) *(u32x4*)(o + 8 * q) = w[q];
}
__device__ __forceinline__ void phase_prep0(const Ctx& c, const float* const* in, unsigned char* ws, float* dout) {
    bf16* P0 = (bf16*)(ws + WS_BIG); bf16* XC = (bf16*)(ws + WS_XC);
    const float* cw = in[3]; const float* cbias = in[4];
    for (int i0 = c.gtid; i0 < TT * 64; i0 += 2 * c.ngt) {
        u32x4 raw[2][4];
#pragma unroll
        for (int u = 0; u < 2; ++u) { const int i = i0 + u * c.ngt, t = i >> 6, c0 = (i & 63) * 8, tl = t & (SEQ - 1);
#pragma unroll
            for (int j = 0; j < 4; ++j) raw[u][j] = (tl - 3 + j >= 0) ? *(const u32x4*)(P0 + (size_t)(t - 3 + j) * P0LD + c0) : (u32x4){0u, 0u, 0u, 0u}; }
#pragma unroll
        for (int u = 0; u < 2; ++u) { const int i = i0 + u * c.ngt, t = i >> 6, c0 = (i & 63) * 8;
            float acc[8];
#pragma unroll
            for (int e = 0; e < 8; ++e) acc[e] = cbias[c0 + e];
#pragma unroll
            for (int j = 0; j < 4; ++j) { float v[8]; unpack8(raw[u][j], v);
#pragma unroll
                for (int e = 0; e < 8; ++e) acc[e] += cw[j * 512 + c0 + e] * v[e]; }
            *(u32x4*)(XC + (size_t)t * 512 + c0) = pack8(acc); }
    }
    for (int it0 = c.gw * 4; it0 < 2 * TT; it0 += c.ngw * 4) {
        const int sub = c.lane & 7;
        u32x4 raw[4];
#pragma unroll
        for (int u = 0; u < 4; ++u) { const int it = it0 + u, t = it >> 1, which = it & 1; raw[u] = *(const u32x4*)(P0 + (size_t)t * P0LD + 1024 + which * 512 + c.lane * 8); }
#pragma unroll
        for (int u = 0; u < 4; ++u) {
            const int it = it0 + u, t = it >> 1, which = it & 1;
            bf16* p = P0 + (size_t)t * P0LD + 1024 + which * 512 + c.lane * 8;
            float v[8]; unpack8(raw[u], v);
            float s = 0.f;
#pragma unroll
            for (int e = 0; e < 8; ++e) s += v[e] * v[e];
            s += __shfl_xor(s, 1); s += __shfl_xor(s, 2); s += __shfl_xor(s, 4);
            const float rs = rsqrtf(s * (1.0f / 64.0f) + 1e-6f);
            const float* gn = (which ? in[11] : in[10]) + sub * 8;
#pragma unroll
            for (int e = 0; e < 8; ++e) v[e] = v[e] * rs * gn[e];
            float oth[8];
#pragma unroll
            for (int e = 0; e < 8; ++e) oth[e] = __shfl_xor(v[e], 1);
            if (sub < 2) {
                const float* rt = (const float*)(ws + WS_ROPE) + (t & (SEQ - 1)) * 16;
                const f32x4 c0 = *(const f32x4*)rt, c1 = *(const f32x4*)(rt + 4), s0 = *(const f32x4*)(rt + 8), s1 = *(const f32x4*)(rt + 12);
#pragma unroll
                for (int e = 0; e < 8; ++e) {
                    const float cs = (e < 4) ? c0[e & 3] : c1[e & 3], sn = (e < 4) ? s0[e & 3] : s1[e & 3];
                    v[e] = (sub == 0) ? (v[e] * cs - oth[e] * sn) : (v[e] * cs + oth[e] * sn);
                }
            }
            *(u32x4*)p = pack8(v);
        }
    }
    bf16* VT3 = (bf16*)dout;
    for (int it0 = c.gw; it0 < 3 * 4096; it0 += 2 * c.ngw) {
        u32x4 w[2][4];
#pragma unroll
        for (int u = 0; u < 2; ++u) { const int it = it0 + u * c.ngw; if (it < 3 * 4096) vt32_load(P0, 2 * (it >> 12), it & 4095, c.lane, w[u]); }
#pragma unroll
        for (int u = 0; u < 2; ++u) { const int it = it0 + u * c.ngw; if (it < 3 * 4096) vt32_store(w[u], VT3 + (size_t)(it >> 12) * (16 * 64 * VTP), it >> 12, it & 4095, c.lane); }
    }
}

#define ATT_D 2
constexpr int ATT_KP = 144, ATT_VP = 784, ATT_KBYTES = 384 * ATT_KP, ATT_LDS = ATT_KBYTES + 64 * ATT_VP;
struct AttState { float m, l; f32x4 o[4]; };
__device__ __forceinline__ void attn_math(const bf16x8 kx0, const bf16x8 kx1, const bf16x8 ky0, const bf16x8 ky1, const bf16x8 (&vf)[4], const bf16x8 qf0, const bf16x8 qf1,
                                          int lq, int kb, AttState& st) {
    const float cs = 0.125f * 1.4426950408889634f;
    __builtin_amdgcn_s_setprio(1);
    f32x4 sx = mfma16(kx0, qf0, (f32x4){0.f, 0.f, 0.f, 0.f}); sx = mfma16(kx1, qf1, sx);
    f32x4 sy = mfma16(ky0, qf0, (f32x4){0.f, 0.f, 0.f, 0.f}); sy = mfma16(ky1, qf1, sy);
    __builtin_amdgcn_s_setprio(0);
    float mx = -1e30f;
#pragma unroll
    for (int r = 0; r < 4; ++r) {
        sx[r] = ((unsigned)(lq - (kb + r)) <= 128u) ? sx[r] : -1e30f; sy[r] = ((unsigned)(lq - (kb + 4 + r)) <= 128u) ? sy[r] : -1e30f;
        mx = fmaxf(mx, fmaxf(sx[r], sy[r]));
    }
    { auto rr = __builtin_amdgcn_permlane32_swap(__float_as_uint(mx), __float_as_uint(mx), false, false); mx = fmaxf(__uint_as_float(rr[0]), __uint_as_float(rr[1]));
      rr = __builtin_amdgcn_permlane16_swap(__float_as_uint(mx), __float_as_uint(mx), false, false); mx = fmaxf(__uint_as_float(rr[0]), __uint_as_float(rr[1]));
      rr = __builtin_amdgcn_permlane32_swap(__float_as_uint(mx), __float_as_uint(mx), false, false); mx = fmaxf(__uint_as_float(rr[0]), __uint_as_float(rr[1])); }
    const float mn = fmaxf(st.m, mx), alpha = __builtin_amdgcn_exp2f((st.m - mn) * cs); st.m = mn;
    const float mref = fmaxf(mn, -1e29f) * cs;
    float pe[8]; float ps = 0.f;
#pragma unroll
    for (int r = 0; r < 4; ++r) { pe[r] = __builtin_amdgcn_exp2f(sx[r] * cs - mref); pe[4 + r] = __builtin_amdgcn_exp2f(sy[r] * cs - mref); ps += pe[r] + pe[4 + r]; }
    st.l = st.l * alpha + ps;
    const u32x4 pw = pack8v(pe);
    const bf16x8 pf = __builtin_bit_cast(bf16x8, pw);
#pragma unroll
    for (int dt = 0; dt < 4; ++dt) st.o[dt] = st.o[dt] * alpha;
    __builtin_amdgcn_s_setprio(1);
#pragma unroll
    for (int dt = 0; dt < 4; ++dt) st.o[dt] = mfma16(vf[dt], pf, st.o[dt]);
    __builtin_amdgcn_s_setprio(0);
}
__device__ __forceinline__ void attn_stage_p1(const Ctx& c, const bf16* P0, const bf16* VT3, int b, int h, int lb) {
    const int tok0 = 256 * lb - 128;
    u32x4 kr[6], vr[6];
#pragma unroll
    for (int i = 0; i < 6; ++i) { const int p = c.tid + 512 * i, row = p >> 3, c16 = p & 7; int tk = tok0 + row; if (tk < 0) tk = 0;
        kr[i] = *(const u32x4*)(P0 + (size_t)(b * SEQ + tk) * P0LD + 1536 + h * 64 + c16 * 8); }
#pragma unroll
    for (int i = 0; i < 6; ++i) { const int p = c.tid + 512 * i, d = p / 48, c16 = p - d * 48; int tk = tok0 + c16 * 8; if (tk < 0) tk = 0;
        vr[i] = *(const u32x4*)(VT3 + ((size_t)((b * 8 + h) * 64 + d)) * VTP + tk); }
#pragma unroll
    for (int i = 0; i < 6; ++i) { const int p = c.tid + 512 * i, row = p >> 3, c16 = p & 7; *(LAS u32x4*)(c.lds + row * ATT_KP + c16 * 16) = kr[i]; }
#pragma unroll
    for (int i = 0; i < 6; ++i) { const int p = c.tid + 512 * i, d = p / 48, c16 = p - d * 48; *(LAS u32x4*)(c.lds + ATT_KBYTES + d * ATT_VP + c16 * 16) = vr[i]; }
}
template <bool P1_LDS>
__device__ __forceinline__ void attn_item(const Ctx& c, const bf16* P0, const bf16* VT3, bf16* ycat, int item, int lane) {
    const int lb = item & 31, r16 = (item >> 5) & 15, h = (item >> 9) & 7, b = item >> 12;
    const int qi = lane & 15, g = lane >> 4;
    const int tq = r16 + 16 * (16 * lb + qi);
    const bf16* qrow = P0 + (size_t)(b * SEQ + tq) * P0LD + 1024 + h * 64;
    const bf16x8 qf0 = ld8(qrow + 8 * g), qf1 = ld8(qrow + 32 + 8 * g);
    AttState st; st.m = -1e30f; st.l = 0.f;
#pragma unroll
    for (int dt = 0; dt < 4; ++dt) st.o[dt] = (f32x4){0.f, 0.f, 0.f, 0.f};
    const int rho_off = 8 * (qi >> 2) + (qi & 3);
    int sb0_[3], n_[3]; const bf16* kb_[3]; const bf16* vb_[3];
#pragma unroll
    for (int p = 0; p < 3; ++p) {
        const int sh = 2 * p, rres = r16 & ((1 << sh) - 1), Ld = SEQ >> sh;
        const int lq0 = (r16 + 256 * lb) >> sh, lq15 = (r16 + 256 * lb + 240) >> sh;
        int s0 = lq0 - 128; if (s0 < 0) s0 = 0; s0 &= ~31;
        sb0_[p] = s0; n_[p] = (((lq15 & ~31) - s0) >> 5) + 1;
        kb_[p] = P0 + (size_t)(b * SEQ + rres) * P0LD + 1536 + h * 64 + 8 * g;
        vb_[p] = (p == 0) ? VT3 + ((size_t)((b * 8 + h) * 64 + qi)) * VTP + 8 * g
                          : VT3 + (size_t)p * (16 * 64 * VTP) + ((size_t)((b * 8 + h) * 4) * 256 + ((rres * Ld) >> 5)) * 512 + qi * 32 + 8 * g;
    }
    if (P1_LDS) n_[0] = 0;
    const int n01 = n_[0] + n_[1], total = n01 + n_[2];
    bf16x8 rk[ATT_D][4], rv[ATT_D][4];
#define ATT_ISSUE(s_, buf) do { const int s__ = (s_); if (s__ < total) { \
        const int p_ = (s__ >= n_[0]) + (s__ >= n01); const int loc_ = s__ - (p_ == 0 ? 0 : (p_ == 1 ? n_[0] : n01)); \
        const int sb_ = (p_ == 0 ? sb0_[0] : (p_ == 1 ? sb0_[1] : sb0_[2])) + 32 * loc_; const int sh_ = 2 * p_; \
        const bf16* kbp = (p_ == 0 ? kb_[0] : (p_ == 1 ? kb_[1] : kb_[2])); const bf16* vbp = (p_ == 0 ? vb_[0] : (p_ == 1 ? vb_[1] : vb_[2])); \
        const bf16* kx = kbp + ((size_t)(sb_ + rho_off) << sh_) * P0LD; const bf16* ky = kx + ((size_t)4 << sh_) * P0LD; \
        rk[buf][0] = ld8(kx); rk[buf][1] = ld8(kx + 32); rk[buf][2] = ld8(ky); rk[buf][3] = ld8(ky + 32); \
        const size_t dstr_ = (p_ == 0) ? (size_t)16 * VTP : (size_t)256 * 512; const size_t soff_ = (p_ == 0) ? (size_t)sb_ : (size_t)(sb_ >> 5) * 512; \
        _Pragma("unroll") for (int dt = 0; dt < 4; ++dt) rv[buf][dt] = ld8(vbp + dt * dstr_ + soff_); } } while (0)
#pragma unroll
    for (int d = 0; d < ATT_D; ++d) ATT_ISSUE(d, d);
    if (P1_LDS) {
        const int w = c.wave, half = r16 >> 3, tok0 = 256 * lb - 128;
        const int tq1 = 256 * lb + 32 * w + 16 * (qi >> 3) + 8 * half + (qi & 7);
        const bf16* q1row = P0 + (size_t)(b * SEQ + tq1) * P0LD + 1024 + h * 64;
        const bf16x8 q1f0 = ld8(q1row + 8 * g), q1f1 = ld8(q1row + 32 + 8 * g);
        AttState s1; s1.m = -1e30f; s1.l = 0.f;
#pragma unroll
        for (int dt = 0; dt < 4; ++dt) s1.o[dt] = (f32x4){0.f, 0.f, 0.f, 0.f};
        const LAS unsigned char* kl = c.lds + rho_off * ATT_KP + 16 * g;
        const LAS unsigned char* vl = c.lds + ATT_KBYTES + qi * ATT_VP + 16 * g;
        LAS unsigned* ex = (LAS unsigned*)(c.lds + ATT_LDS);
        __syncthreads();
        for (int i = ((lb == 0 && w < 4) ? 4 : w); i <= w + 4; ++i) {
            const LAS unsigned char* kx = kl + 32 * i * ATT_KP;
            const bf16x8 kx0 = *(const LAS bf16x8*)kx, kx1 = *(const LAS bf16x8*)(kx + 64), ky0 = *(const LAS bf16x8*)(kx + 4 * ATT_KP), ky1 = *(const LAS bf16x8*)(kx + 4 * ATT_KP + 64);
            bf16x8 vf[4];
#pragma unroll
            for (int dt = 0; dt < 4; ++dt) vf[dt] = *(const LAS bf16x8*)(vl + dt * 16 * ATT_VP + 64 * i);
            attn_math(kx0, kx1, ky0, ky1, vf, q1f0, q1f1, tq1, tok0 + 32 * i + 8 * g, s1);
        }
        {
            LAS unsigned* e = ex + ((16 * w + qi) * 4 + g) * 10;
            e[0] = __float_as_uint(s1.m); e[1] = __float_as_uint(s1.l);
#pragma unroll
            for (int dt = 0; dt < 4; ++dt) { e[2 + 2 * dt] = pg8::cvtpk(s1.o[dt][0], s1.o[dt][1]); e[3 + 2 * dt] = pg8::cvtpk(s1.o[dt][2], s1.o[dt][3]); }
        }
        __syncthreads();
        {
            const LAS unsigned* e = ex + ((qi * 8 + (r16 & 7)) * 4 + g) * 10;
            st.m = __uint_as_float(e[0]); st.l = __uint_as_float(e[1]);
#pragma unroll
            for (int dt = 0; dt < 4; ++dt) { const unsigned a0 = e[2 + 2 * dt], a1 = e[3 + 2 * dt]; st.o[dt] = (f32x4){bfw(a0, 0), bfw(a0, 1), bfw(a1, 0), bfw(a1, 1)}; }
        }
    }
    for (int s0 = 0; s0 < total; s0 += ATT_D) {
#pragma unroll
        for (int j = 0; j < ATT_D; ++j) {
            const int s = s0 + j;
            if (s < total) {
                const int p = (s >= n_[0]) + (s >= n01), loc = s - (p == 0 ? 0 : (p == 1 ? n_[0] : n01));
                const int sb = (p == 0 ? sb0_[0] : (p == 1 ? sb0_[1] : sb0_[2])) + 32 * loc;
                attn_math(rk[j][0], rk[j][1], rk[j][2], rk[j][3], rv[j], qf0, qf1, tq >> (2 * p), sb + 8 * g, st);
                ATT_ISSUE(s + ATT_D, j);
            }
        }
    }
#undef ATT_ISSUE
    float l = st.l;
    l += __shfl_xor(l, 16); l += __shfl_xor(l, 32);
    const float inv = 1.0f / l;
    bf16* orow = ycat + (size_t)(b * SEQ + tq) * 1024 + 512 + h * 64 + 4 * g;
#pragma unroll
    for (int dt = 0; dt < 4; ++dt) { u32x2 w; w.x = cvt_pk_bf16(st.o[dt][0] * inv, st.o[dt][1] * inv); w.y = cvt_pk_bf16(st.o[dt][2] * inv, st.o[dt][3] * inv); *(u32x2*)(orow + 16 * dt) = w; }
}

__device__ __forceinline__ void lru_step(float la, float gi, float& h) { const float a = __expf(la), bq = __builtin_amdgcn_sqrtf(fmaxf(1.0f - a * a, 0.f)) * gi; h = a * h + bq; }
__device__ __forceinline__ void phase_lru_a(const Ctx& c, unsigned char* ws) {
    const bf16* __restrict__ LA = (const bf16*)(ws + WS_LOGA); const bf16* __restrict__ GI = (const bf16*)(ws + WS_GI);
    float* __restrict__ SA = (float*)(ws + WS_SUMA); float* __restrict__ SB = (float*)(ws + WS_SUMB);
    for (int ch = blockIdx.x; ch < 256; ch += gridDim.x) {
        const int t0 = ch * 64, cn = c.tid; float h = 0.f, P = 0.f;
#pragma unroll 1
        for (int tb = 0; tb < 64; tb += 32) {
            float la[32], gi[32];
#pragma unroll
            for (int t = 0; t < 32; ++t) { la[t] = bf2f(LA[(size_t)(t0 + tb + t) * 512 + cn]); gi[t] = bf2f(GI[(size_t)(t0 + tb + t) * 512 + cn]); }
#pragma unroll
            for (int t = 0; t < 32; ++t) { lru_step(la[t], gi[t], h); P += la[t]; }
        }
        SA[ch * 512 + cn] = __expf(P); SB[ch * 512 + cn] = h;
    }
}
__device__ __forceinline__ void phase_lru_b(const Ctx& c, unsigned char* ws) {
    const bf16* __restrict__ LA = (const bf16*)(ws + WS_LOGA); const bf16* __restrict__ GI = (const bf16*)(ws + WS_GI);
    const float* __restrict__ SA = (const float*)(ws + WS_SUMA); const float* __restrict__ SB = (const float*)(ws + WS_SUMB);
    const bf16* __restrict__ P0 = (const bf16*)(ws + WS_BIG); bf16* __restrict__ ycat = (bf16*)(ws + WS_YCAT);
    for (int ch = blockIdx.x; ch < 256; ch += gridDim.x) {
        const int t0 = ch * 64, cn = c.tid; float h = 0.f;
        bf16 la0[32], gi0[32], gl0[32];
#pragma unroll
        for (int t = 0; t < 32; ++t) { la0[t] = LA[(size_t)(t0 + t) * 512 + cn]; gi0[t] = GI[(size_t)(t0 + t) * 512 + cn]; gl0[t] = P0[(size_t)(t0 + t) * P0LD + 512 + cn]; }
        int j = ch & ~127;
        for (; j + 32 <= ch; j += 32) {
            float sa[32], sb[32];
#pragma unroll
            for (int k = 0; k < 32; ++k) { sa[k] = SA[(j + k) * 512 + cn]; sb[k] = SB[(j + k) * 512 + cn]; }
#pragma unroll
            for (int k = 0; k < 32; ++k) h = sa[k] * h + sb[k];
        }
        for (; j + 8 <= ch; j += 8) {
            float sa[8], sb[8];
#pragma unroll
            for (int k = 0; k < 8; ++k) { sa[k] = SA[(j + k) * 512 + cn]; sb[k] = SB[(j + k) * 512 + cn]; }
#pragma unroll
            for (int k = 0; k < 8; ++k) h = sa[k] * h + sb[k];
        }
        for (; j < ch; ++j) h = SA[j * 512 + cn] * h + SB[j * 512 + cn];
#pragma unroll
        for (int t = 0; t < 32; ++t) { lru_step(bf2f(la0[t]), bf2f(gi0[t]), h); ycat[(size_t)(t0 + t) * 1024 + cn] = f2bf(h * gelu_tanh(bf2f(gl0[t]))); }
#pragma unroll 1
        for (int tb = 32; tb < 64; tb += 32) {
            bf16 la[32], gi[32], gl[32];
#pragma unroll
            for (int t = 0; t < 32; ++t) { la[t] = LA[(size_t)(t0 + tb + t) * 512 + cn]; gi[t] = GI[(size_t)(t0 + tb + t) * 512 + cn]; gl[t] = P0[(size_t)(t0 + tb + t) * P0LD + 512 + cn]; }
#pragma unroll
            for (int t = 0; t < 32; ++t) { lru_step(bf2f(la[t]), bf2f(gi[t]), h); ycat[(size_t)(t0 + tb + t) * 1024 + cn] = f2bf(h * gelu_tanh(bf2f(gl[t]))); }
        }
    }
}

__device__ __forceinline__ void fixup_panel(const Ctx& c, unsigned char* ws, const float* cw, const float* cb, int pm) {
    if ((pm & 31) != 0) {
        const float* EA = (const float*)(ws + WS_EDGEA); const float* EL = (const float*)(ws + WS_EDGEL); const float* TA = (const float*)(ws + WS_TAILA);
        bf16* U = (bf16*)(ws + WS_BIG);
        for (int col = c.tid; col < 3072; col += 512) {
            const float tm2 = TA[(size_t)((pm - 1) * 2 + 0) * 3072 + col], tm1 = TA[(size_t)((pm - 1) * 2 + 1) * 3072 + col];
            const float a0 = EA[(size_t)(pm * 2) * 3072 + col], a1 = EA[(size_t)(pm * 2 + 1) * 3072 + col];
            const float l0 = EL[(size_t)(pm * 2) * 3072 + col], l1 = EL[(size_t)(pm * 2 + 1) * 3072 + col];
            const float w0 = cw[col], w1 = cw[3072 + col], w2 = cw[6144 + col], bb = cb[col];
            U[(size_t)(pm * 256) * 3072 + col] = f2bf(gelu_tanh(w0 * tm2 + w1 * tm1 + w2 * a0 + bb) * l0);
            U[(size_t)(pm * 256 + 1) * 3072 + col] = f2bf(gelu_tanh(w0 * tm1 + w1 * a0 + w2 * a1 + bb) * l1);
        }
    }
    asm volatile("s_waitcnt vmcnt(0)" ::: "memory");
    __syncthreads();
}
__device__ __forceinline__ void phase_fixup(const Ctx& c, unsigned char* ws, const float* cw, const float* cb) {
    const float* EA = (const float*)(ws + WS_EDGEA); const float* EL = (const float*)(ws + WS_EDGEL); const float* TA = (const float*)(ws + WS_TAILA);
    bf16* U = (bf16*)(ws + WS_BIG);
    for (int i = c.gtid; i < 64 * 3072; i += c.ngt) {
        const int pm = i / 3072, col = i % 3072;
        if ((pm & 31) == 0) continue;
        const float tm2 = TA[(size_t)((pm - 1) * 2 + 0) * 3072 + col], tm1 = TA[(size_t)((pm - 1) * 2 + 1) * 3072 + col];
        const float a0 = EA[(size_t)(pm * 2) * 3072 + col], a1 = EA[(size_t)(pm * 2 + 1) * 3072 + col];
        const float l0 = EL[(size_t)(pm * 2) * 3072 + col], l1 = EL[(size_t)(pm * 2 + 1) * 3072 + col];
        const float w0 = cw[col], w1 = cw[3072 + col], w2 = cw[6144 + col], bb = cb[col];
        U[(size_t)(pm * 256) * 3072 + col] = f2bf(gelu_tanh(w0 * tm2 + w1 * tm1 + w2 * a0 + bb) * l0);
        U[(size_t)(pm * 256 + 1) * 3072 + col] = f2bf(gelu_tanh(w0 * tm1 + w1 * a0 + w2 * a1 + bb) * l1);
    }
}
#define XB_TMO      128
#define XB_XCNT(j)  (256  + 64 * (j))
#define XB_XSUB(j)  (1280 + 64 * (j))
#define XB_XGEN(j)  (2304 + 64 * (j))
#define XB_TOP      3328
#define XB_TOPGEN   3392
#define XCD_BAR_WORDS 3456
#define XB_SPIN_CAP (1u << 18)

__device__ __forceinline__ unsigned xb_ld(unsigned* p)              { return __hip_atomic_load(p, __ATOMIC_RELAXED, __HIP_MEMORY_SCOPE_AGENT); }
__device__ __forceinline__ unsigned xb_add(unsigned* p, unsigned v) { return __hip_atomic_fetch_add(p, v, __ATOMIC_RELAXED, __HIP_MEMORY_SCOPE_AGENT); }
__device__ __forceinline__ unsigned xb_xcc_id() { return (unsigned)__builtin_amdgcn_s_getreg((3 << 11) | 20) & 0xFu; }
#define XB_SPIN(cond, bar) do { unsigned _sp = 0; while (cond) { __builtin_amdgcn_s_sleep(1); \
    if ((++_sp & 255u) == 0u) { if (xb_ld(&(bar)[XB_TMO])) break; if (_sp > XB_SPIN_CAP) { atomicAdd(&(bar)[XB_TMO], 1u); break; } } } } while (0)

struct XcdBarrier {
    unsigned* bar; unsigned x;
    volatile LAS unsigned* st;
};

__device__ __forceinline__ XcdBarrier xcd_barrier_post(unsigned* bar, volatile LAS unsigned* st) {
    XcdBarrier b; b.bar = bar; b.x = xb_xcc_id(); b.st = st;
    if (threadIdx.x == 0) (void)xb_add(&bar[XB_XCNT(b.x)], 1u);
    return b;
}
__device__ __forceinline__ void xcd_barrier_complete(unsigned* bar, unsigned x, unsigned& nloc, unsigned& nx) {
    const unsigned G = gridDim.x * gridDim.y * gridDim.z;
    unsigned sum, cnt, mine, sp = 0u;
    for (;;) {
        sum = 0u; cnt = 0u; mine = 0u;
#pragma unroll
        for (unsigned j = 0; j < 16; ++j) { const unsigned c = xb_ld(&bar[XB_XCNT(j)]); sum += c; cnt += (c > 0u) ? 1u : 0u; mine = (j == x) ? c : mine; }
        if (sum == G) break;
        __builtin_amdgcn_s_sleep(1);
        if ((++sp & 255u) == 0u) { if (xb_ld(&bar[XB_TMO])) break; if (sp > XB_SPIN_CAP) { atomicAdd(&bar[XB_TMO], 1u); break; } }
    }
    nloc = mine > 0u ? mine : 1u; nx = cnt > 0u ? cnt : 1u;
}

__device__ __forceinline__ void xcd_barrier(const XcdBarrier& b) {
    asm volatile("s_waitcnt vmcnt(0)" ::: "memory");
    __syncthreads();
    if (threadIdx.x == 0) {
        unsigned* bar = b.bar;
        __builtin_amdgcn_s_waitcnt(0);
        unsigned nloc = b.st[0], nx = b.st[1];
        if (nloc == 0u) { xcd_barrier_complete(bar, b.x, nloc, nx); b.st[0] = nloc; b.st[1] = nx; }
        const unsigned old = xb_add(&bar[XB_XSUB(b.x)], 1u);
        const unsigned gen = old / nloc;
        if (old + 1u == (gen + 1u) * nloc) {
            __builtin_amdgcn_fence(__ATOMIC_RELEASE, "agent");
            asm volatile("s_waitcnt vmcnt(0)" ::: "memory");
            const unsigned og = xb_add(&bar[XB_TOP], 1u);
            const unsigned tg = og / nx;
            if (og + 1u == (tg + 1u) * nx) xb_add(&bar[XB_TOPGEN], 1u);
            else XB_SPIN(xb_ld(&bar[XB_TOPGEN]) == tg, bar);
            __builtin_amdgcn_fence(__ATOMIC_ACQUIRE, "agent");
            xb_add(&bar[XB_XGEN(b.x)], 1u);
            asm volatile("s_waitcnt vmcnt(0)" ::: "memory");
        } else {
            XB_SPIN(xb_ld(&bar[XB_XGEN(b.x)]) == gen, bar);
            __builtin_amdgcn_fence(__ATOMIC_ACQUIRE, "agent");
            asm volatile("s_waitcnt vmcnt(0)" ::: "memory");
        }
    }
    __syncthreads();
}
__device__ __forceinline__ void gk_item(const bf16* XB, const bf16* Wt, const float* ss, bf16* P1, int item, int lane) {
    const int jl = lane & 15, gq = lane >> 4, tok = item * 16 + jl;
    const bf16* ap = Wt + (size_t)(2048 + jl) * 1024 + 8 * gq; const bf16* bp = XB + (size_t)tok * 1024 + 8 * gq;
    f32x4 acc0 = (f32x4){0.f, 0.f, 0.f, 0.f}, acc1 = acc0;
#pragma unroll 8
    for (int ks = 0; ks < 32; ks += 2) { acc0 = mfma16(ld8(ap + 32 * ks), ld8(bp + 32 * ks), acc0); acc1 = mfma16(ld8(ap + 32 * ks + 32), ld8(bp + 32 * ks + 32), acc1); }
    const float rs = rsqrtf(ss[tok] * (1.0f / 1024.0f) + 1e-6f);
    u32x2 w; w.x = cvt_pk_bf16((acc0[0] + acc1[0]) * rs, (acc0[1] + acc1[1]) * rs); w.y = cvt_pk_bf16((acc0[2] + acc1[2]) * rs, (acc0[3] + acc1[3]) * rs);
    *(u32x2*)(P1 + (size_t)tok * P1LD + 2048 + 4 * gq) = w;
}

__device__ __forceinline__ void phase_gla_prep(const Ctx& c, const float* const* in, unsigned char* ws) {
    bf16* P1 = (bf16*)(ws + WS_BIG); bf16* KDT = (bf16*)(ws + WS_KDT); float* DEC = (float*)(ws + WS_DECAY);
    const float* gkw = in[25]; const float* gkb = in[26];
    for (int i = blockIdx.x * 256 + c.tid; c.tid < 256 && i < 256 * 256; i += gridDim.x * 256) {
        const int chunk = i >> 8, chn = i & 255, t0 = chunk * 64, b = chunk >> 7, h = chn >> 6, d = chn & 63;
        float w[16];
#pragma unroll
        for (int k = 0; k < 16; ++k) w[k] = gkw[k * 256 + chn];
        const float bias = gkb[chn];
        float kin[64]; float bc = 0.f;
#pragma unroll
        for (int tb = 0; tb < 64; tb += 8) {
            u32x4 l0[8], l1[8]; bf16 qv[8], kv[8];
#pragma unroll
            for (int t = 0; t < 8; ++t) { const bf16* row = P1 + (size_t)(t0 + tb + t) * P1LD; l0[t] = *(const u32x4*)(row + 2048); l1[t] = *(const u32x4*)(row + 2056); qv[t] = row[512 + chn]; kv[t] = row[768 + chn]; }
#pragma unroll
            for (int t = 0; t < 8; ++t) {
                bf16* row = P1 + (size_t)(t0 + tb + t) * P1LD;
                float lr[16]; unpack8(l0[t], lr); unpack8(l1[t], lr + 8);
                float z = bias;
#pragma unroll
                for (int k = 0; k < 16; ++k) z += lr[k] * w[k];
                bc += logsig(z) * (1.0f / 16.0f);
                row[512 + chn] = f2bf(bf2f(qv[t]) * 0.125f * __expf(bc));
                kin[tb + t] = bf2f(kv[t]) * __expf(-bc);
                row[768 + chn] = f2bf(kin[tb + t]);
            }
        }
        const float eb = __expf(bc);
        DEC[chunk * 256 + chn] = eb;
        bf16* kd = KDT + ((size_t)((b * 4 + h) * 64 + d)) * SEQ + (t0 & (SEQ - 1));
#pragma unroll
        for (int t8 = 0; t8 < 8; ++t8) {
            float f[8];
#pragma unroll
            for (int e = 0; e < 8; ++e) f[e] = kin[t8 * 8 + e] * eb;
            *(u32x4*)(kd + t8 * 8) = pack8(f);
        }
    }
}

__device__ __forceinline__ void s5_bfrags(const bf16* P1, int g, int jb, int lane, bf16x8* bu) {
    const int jl = lane & 15, gq = lane >> 4;
#pragma unroll
    for (int ks = 0; ks < 8; ++ks) {
        const int s = 2 * ks + (gq >> 1), p0 = 8 * (gq & 1);
        bu[ks] = ld8(P1 + (size_t)((16 * jb + jl) * 16 + s) * P1LD + 16 * g + p0);
    }
}
__device__ __forceinline__ void s5a_item(const bf16* P1, const bf16* FM, float* XL, int item, int lane) {
    const int g = item >> 6, jb = item & 63, jl = lane & 15, gq = lane >> 4;
    bf16x8 bu[8]; s5_bfrags(P1, g, jb, lane, bu);
    const bf16* Fg = FM + (size_t)g * 128 * 256;
#pragma unroll
    for (int zt = 0; zt < 8; ++zt) {
        f32x4 acc = (f32x4){0.f, 0.f, 0.f, 0.f};
#pragma unroll
        for (int ks = 0; ks < 8; ++ks) acc = mfma16(ld8(Fg + (size_t)(16 * zt + jl) * 256 + 32 * ks + 8 * gq), bu[ks], acc);
        *(f32x4*)(XL + ((size_t)g * 1024 + 16 * jb + jl) * 128 + 16 * zt + 4 * gq) = acc;
    }
}
__device__ __forceinline__ void phase_s5_scan(const Ctx& c, const float* const* in, unsigned char* ws) {
    const float* __restrict__ XL = (const float*)(ws + WS_XLOC); bf16* __restrict__ SX = (bf16*)(ws + WS_SX);
    LAS float* ex = (LAS float*)c.lds;
    for (int bg = blockIdx.x; bg < 64; bg += gridDim.x) {
        const int b = bg >> 5, g = bg & 31, seg = c.wave, n = c.lane;
        const S5P sp = s5_params(in[15], in[16], in[22], g, n);
        float ar, ai; s5_pow(sp, 16.0f, ar, ai);
        float Ar, Ai; s5_pow(sp, 1024.0f, Ar, Ai);
        const size_t o0 = ((size_t)g * 1024 + b * 512 + seg * 64) * 128 + n;
        float xr = 0.f, xi = 0.f;
#pragma unroll 1
        for (int h2 = 0; h2 < 2; ++h2) {
            float cr[32], ci[32];
#pragma unroll
            for (int k = 0; k < 32; ++k) { cr[k] = XL[o0 + (size_t)(h2 * 32 + k) * 128]; ci[k] = XL[o0 + (size_t)(h2 * 32 + k) * 128 + 64]; }
#pragma unroll
            for (int k = 0; k < 32; ++k) { const float tr = ar * xr - ai * xi + cr[k], ti = ar * xi + ai * xr + ci[k]; xr = tr; xi = ti; }
        }
        ex[(seg * 64 + n) * 2] = xr; ex[(seg * 64 + n) * 2 + 1] = xi;
        __syncthreads();
        xr = 0.f; xi = 0.f;
        for (int j = 0; j < seg; ++j) { const float er = ex[(j * 64 + n) * 2], ei = ex[(j * 64 + n) * 2 + 1]; const float tr = Ar * xr - Ai * xi + er, ti = Ar * xi + Ai * xr + ei; xr = tr; xi = ti; }
#pragma unroll 1
        for (int h2 = 0; h2 < 2; ++h2) {
            float cr[32], ci[32];
#pragma unroll
            for (int k = 0; k < 32; ++k) { cr[k] = XL[o0 + (size_t)(h2 * 32 + k) * 128]; ci[k] = XL[o0 + (size_t)(h2 * 32 + k) * 128 + 64]; }
#pragma unroll
            for (int k = 0; k < 32; ++k) {
                SX[o0 + (size_t)(h2 * 32 + k) * 128] = f2bf(xr); SX[o0 + (size_t)(h2 * 32 + k) * 128 + 64] = f2bf(xi);
                const float tr = ar * xr - ai * xi + cr[k], ti = ar * xi + ai * xr + ci[k]; xr = tr; xi = ti;
            }
        }
        __syncthreads();
    }
}
__device__ __forceinline__ void s5c_item(const bf16* P1, const bf16* AM, const bf16* SX, const float* dvec, bf16* YS, int item, int lane) {
    const int g = item >> 6, jb = item & 63, jl = lane & 15, gq = lane >> 4;
    bf16x8 bu[12]; s5_bfrags(P1, g, jb, lane, bu);
#pragma unroll
    for (int ks = 0; ks < 4; ++ks) bu[8 + ks] = ld8(SX + ((size_t)g * 1024 + 16 * jb + jl) * 128 + 32 * ks + 8 * gq);
    const bf16* Ag = AM + (size_t)g * 256 * 384;
    float dv[4];
#pragma unroll
    for (int e = 0; e < 4; ++e) dv[e] = dvec[16 * g + 4 * gq + e];
#pragma unroll 4
    for (int rt = 0; rt < 16; ++rt) {
        f32x4 acc = (f32x4){0.f, 0.f, 0.f, 0.f};
#pragma unroll
        for (int ks = 0; ks < 12; ++ks) acc = mfma16(ld8(Ag + (size_t)(16 * rt + jl) * 384 + 32 * ks + 8 * gq), bu[ks], acc);
        const size_t tok = (size_t)(16 * jb + jl) * 16 + rt;
        const u32x2 uv = *(const u32x2*)(P1 + tok * P1LD + 16 * g + 4 * gq);
        float o[4];
#pragma unroll
        for (int e = 0; e < 4; ++e) { const float y = acc[e] + dv[e] * bfw(uv[e >> 1], e & 1); o[e] = gelu_tanh(y); }
        u32x2 w; w.x = cvt_pk_bf16(o[0], o[1]); w.y = cvt_pk_bf16(o[2], o[3]);
        *(u32x2*)(YS + tok * 512 + 16 * g + 4 * gq) = w;
    }
}

__device__ __forceinline__ void s5c_block(const Ctx& c, const bf16* P1, const bf16* AM, const bf16* SX, const float* dvec, bf16* YS, int g, int jb) {
    const int lane = c.lane, jl = lane & 15, gq = lane >> 4;
    bf16x8 bu[12]; s5_bfrags(P1, g, jb, lane, bu);
#pragma unroll
    for (int ks = 0; ks < 4; ++ks) bu[8 + ks] = ld8(SX + ((size_t)g * 1024 + 16 * jb + jl) * 128 + 32 * ks + 8 * gq);
    float dv[4];
#pragma unroll
    for (int e = 0; e < 4; ++e) dv[e] = dvec[16 * g + 4 * gq + e];
    const bf16* Ag = AM + (size_t)g * 256 * 384;
    for (int half = 0; half < 2; ++half) {
        __syncthreads();
        for (int p = c.tid; p < 128 * 48; p += 512) { const int row = p / 48, c16 = p - row * 48;
            *(LAS u32x4*)(c.lds + row * 784 + c16 * 16) = *(const u32x4*)(Ag + (size_t)(half * 128 + row) * 384 + c16 * 8); }
        __syncthreads();
#pragma unroll 2
        for (int r8 = 0; r8 < 8; ++r8) {
            const int rt = half * 8 + r8;
            f32x4 acc = (f32x4){0.f, 0.f, 0.f, 0.f};
#pragma unroll
            for (int ks = 0; ks < 12; ++ks) acc = mfma16(*(const LAS bf16x8*)(c.lds + (16 * r8 + jl) * 784 + 64 * ks + 16 * gq), bu[ks], acc);
            const size_t tok = (size_t)(16 * jb + jl) * 16 + rt;
            const u32x2 uv = *(const u32x2*)(P1 + tok * P1LD + 16 * g + 4 * gq);
            float o[4];
#pragma unroll
            for (int e = 0; e < 4; ++e) { const float y = acc[e] + dv[e] * bfw(uv[e >> 1], e & 1); o[e] = gelu_tanh(y); }
            u32x2 w; w.x = cvt_pk_bf16(o[0], o[1]); w.y = cvt_pk_bf16(o[2], o[3]);
            *(u32x2*)(YS + tok * 512 + 16 * g + 4 * gq) = w;
        }
    }
    __syncthreads();
}

__device__ __forceinline__ void gla_kv_item(const bf16* KDT, const bf16* VTG, bf16* KVS, int item, int lane) {
    const int cc = item & 127, h = (item >> 7) & 3, b = item >> 9, jl = lane & 15, gq = lane >> 4;
    const bf16* kd = KDT + ((size_t)((b * 4 + h) * 64 + jl)) * SEQ + 64 * cc + 8 * gq;
    const bf16* vt = VTG + ((size_t)((b * 4 + h) * 128 + jl)) * SEQ + 64 * cc + 8 * gq;
    bf16x8 af[4][2];
#pragma unroll
    for (int dt = 0; dt < 4; ++dt)
#pragma unroll
        for (int ks = 0; ks < 2; ++ks) af[dt][ks] = ld8(kd + (size_t)dt * 16 * SEQ + 32 * ks);
    bf16* out = KVS + ((size_t)(((b * 128 + cc) * 4 + h) * 128 + jl)) * 64 + 4 * gq;
#pragma unroll
    for (int et = 0; et < 8; ++et) {
        const bf16x8 b0 = ld8(vt + (size_t)et * 16 * SEQ), b1 = ld8(vt + (size_t)et * 16 * SEQ + 32);
#pragma unroll
        for (int dt = 0; dt < 4; ++dt) {
            f32x4 acc = mfma16(af[dt][0], b0, (f32x4){0.f, 0.f, 0.f, 0.f}); acc = mfma16(af[dt][1], b1, acc);
            u32x2 w; w.x = pg8::cvtpk(acc[0], acc[1]); w.y = pg8::cvtpk(acc[2], acc[3]);
            *(u32x2*)(out + (size_t)et * 16 * 64 + 16 * dt) = w;
        }
    }
}
__device__ __forceinline__ void phase_gla_scan(const Ctx& c, unsigned char* ws) {
    bf16* KVS = (bf16*)(ws + WS_KVS); const float* DEC = (const float*)(ws + WS_DECAY);
    for (int i = c.gtid; i < 2 * 4 * 128 * 64; i += c.ngt) {
        const int d = i & 63, e = (i >> 6) & 127, h = (i >> 13) & 3, b = i >> 15;
        float s = 0.f;
        bf16* p0 = KVS + ((size_t)((b * 128 * 4 + h) * 128 + e)) * 64 + d;
        const float* d0 = DEC + (b * 128) * 256 + h * 64 + d;
#pragma unroll 1
        for (int c0 = 0; c0 < 128; c0 += 43) {
            bf16 kv[43]; float dc[43];
#pragma unroll
            for (int k = 0; k < 43; ++k) if (c0 + k < 128) { kv[k] = p0[(size_t)(c0 + k) * (4 * 128 * 64)]; dc[k] = d0[(c0 + k) * 256]; }
#pragma unroll
            for (int k = 0; k < 43; ++k) if (c0 + k < 128) { p0[(size_t)(c0 + k) * (4 * 128 * 64)] = f2bf(s); s = dc[k] * s + bf2f(kv[k]); }
        }
    }
}
__device__ __forceinline__ void gla_out_item(const bf16* P1, const bf16* VTG, const bf16* KVS, const float* gnorm, bf16* ycat, int item, int lane) {
    const int tt = item & 3, cc = (item >> 2) & 127, h = (item >> 9) & 3, b = item >> 11, jl = lane & 15, gq = lane >> 4;
    const size_t tokc = (size_t)b * SEQ + 64 * cc;
    const bf16* qrow = P1 + (tokc + 16 * tt + jl) * P1LD + 512 + h * 64 + 8 * gq;
    const bf16x8 qf0 = ld8(qrow), qf1 = ld8(qrow + 32);
    f32x4 o[8];
#pragma unroll
    for (int et = 0; et < 8; ++et) o[et] = (f32x4){0.f, 0.f, 0.f, 0.f};
    {
        const bf16* sp = KVS + ((size_t)(((b * 128 + cc) * 4 + h) * 128 + jl)) * 64 + 8 * gq;
#pragma unroll
        for (int et = 0; et < 8; ++et) { o[et] = mfma16(ld8(sp + (size_t)et * 16 * 64), qf0, o[et]); o[et] = mfma16(ld8(sp + (size_t)et * 16 * 64 + 32), qf1, o[et]); }
    }
    const int tl = 16 * tt + jl, rho_off = 8 * (jl >> 2) + (jl & 3);
    const bf16* vt = VTG + ((size_t)((b * 4 + h) * 128 + jl)) * SEQ + 64 * cc + 8 * gq;
    for (int sp_ = 0; sp_ <= (tt >> 1); ++sp_) {
        const bf16* kx = P1 + (tokc + 32 * sp_ + rho_off) * P1LD + 768 + h * 64 + 8 * gq;
        const bf16* ky = kx + (size_t)4 * P1LD;
        f32x4 sx = mfma16(ld8(kx), qf0, (f32x4){0.f, 0.f, 0.f, 0.f}); sx = mfma16(ld8(kx + 32), qf1, sx);
        f32x4 sy = mfma16(ld8(ky), qf0, (f32x4){0.f, 0.f, 0.f, 0.f}); sy = mfma16(ld8(ky + 32), qf1, sy);
        const int kb = 32 * sp_ + 8 * gq;
        float pe[8];
#pragma unroll
        for (int r = 0; r < 4; ++r) { pe[r] = (kb + r <= tl) ? sx[r] : 0.f; pe[4 + r] = (kb + 4 + r <= tl) ? sy[r] : 0.f; }
        const u32x4 pw = pack8(pe); const bf16x8 pf = __builtin_bit_cast(bf16x8, pw);
#pragma unroll
        for (int et = 0; et < 8; ++et) o[et] = mfma16(ld8(vt + (size_t)et * 16 * SEQ + 32 * sp_), pf, o[et]);
    }
    float q = 0.f;
#pragma unroll
    for (int et = 0; et < 8; ++et) q += (o[et][0] * o[et][0] + o[et][1] * o[et][1]) + (o[et][2] * o[et][2] + o[et][3] * o[et][3]);
    q += __shfl_xor(q, 16); q += __shfl_xor(q, 32);
    const float rs = rsqrtf(q * (1.0f / 128.0f) + 1e-6f);
    const bf16* grow = P1 + (tokc + tl) * P1LD + 1536 + h * 128 + 4 * gq;
    bf16* orow = ycat + (tokc + tl) * 1024 + 512 + h * 128 + 4 * gq;
#pragma unroll
    for (int et = 0; et < 8; ++et) {
        const u32x2 gv = *(const u32x2*)(grow + 16 * et);
        const f32x4 gn = *(const f32x4*)(gnorm + 16 * et + 4 * gq);
        float r[4];
#pragma unroll
        for (int e = 0; e < 4; ++e) { const float gg = bfw(gv[e >> 1], e & 1); r[e] = (o[et][e] * rs * gn[e]) * (gg * sigm(gg)); }
        u32x2 w; w.x = cvt_pk_bf16(r[0], r[1]); w.y = cvt_pk_bf16(r[2], r[3]);
        *(u32x2*)(orow + 16 * et) = w;
    }
}

struct Args { const float* in[34]; float* out; unsigned char* ws; int ph_lo, ph_hi; };
constexpr int NPHASE = 19;

template <class Epi>
__device__ __forceinline__ void run_gemm(LAS unsigned char* lds, const bf16* A, const bf16* Bt, int M, int N, int K, const Epi& E) {
    pg8::Gemm g{A, Bt, M, N, K}; pg8::StaticOrder S; S.init(M, N, (int)gridDim.x, (int)blockIdx.x);
    pg8::gemm_phase<Epi, pg8::StaticOrder, true, true>(lds, g, S, E);
}

__global__ void __launch_bounds__(512, 2) fwd_kernel(Args a) {
    extern __shared__ __attribute__((aligned(16))) unsigned char lds_raw[];
    cg::grid_group grid = cg::this_grid();
    Ctx c; c.tid = threadIdx.x; c.lane = c.tid & 63; c.wave = __builtin_amdgcn_readfirstlane(c.tid >> 6);
    c.gw = blockIdx.x * 8 + c.wave; c.ngw = gridDim.x * 8; c.gtid = blockIdx.x * 512 + c.tid; c.ngt = gridDim.x * 512;
    c.lds = (LAS unsigned char*)lds_raw;
    unsigned char* ws = a.ws; const float* const* in = a.in;
    const int lo = a.ph_lo, hi = a.ph_hi;
#define IN(k) (lo <= (k) && (k) < hi)
#ifndef REP_MASK
#define REP_MASK 0
#endif
#define REPS(k) for (int r_ = 0; r_ < 1 + ((REP_MASK >> (k)) & 1); ++r_)
#define REPBAR() do { if (r_) xcd_barrier(bar); } while (0)
#define SYNC(k) do { if (IN(k) && IN((k) + 1)) { xcd_barrier(bar); } } while (0)
    volatile LAS unsigned* misc = (volatile LAS unsigned*)(c.lds + 131072);
    if (c.tid < 8) misc[c.tid] = 0u;
    __syncthreads();
    XcdBarrier bar = xcd_barrier_post((unsigned*)(ws + WS_BARRIER), misc);
    float* ss = (float*)(ws + WS_SS);
    bf16* XB = (bf16*)(ws + WS_XB); bf16* BIG = (bf16*)(ws + WS_BIG); bf16* YCAT = (bf16*)(ws + WS_YCAT);
    LAS float* halo = (LAS float*)(c.lds + HALO_OFF);

#ifdef TIMING_PROBE
    volatile LAS unsigned long long* tsl = (volatile LAS unsigned long long*)(c.lds + 131072 + 64);
#define STAMP(k) do { if (blockIdx.x == 0 && c.tid == 0) tsl[k] = __builtin_amdgcn_s_memrealtime(); } while (0)
#else
#define STAMP(k) do {} while (0)
#endif
    STAMP(0);
    if (IN(0)) REPS(0) { REPBAR(); phase_prologue(c, in, ws); if (!DEFER_TR) phase_s5_mats(c, in, ws); }
    SYNC(0); STAMP(1);
    if (IN(1)) REPS(1) { REPBAR(); { pg8::EpiProj E{BIG, P0LD, ss}; run_gemm(c.lds, XB, (const bf16*)(ws + WS_W_EIN), TT, 2560, 1024, E); }
        if ((DEFER_TR || DEFER_P1) && r_ == 0) { if (gridDim.x == 256) { if (blockIdx.x >= 128) do_tr_items(c, in, ws, TR_EOUT0, TR_FIN10, (blockIdx.x - 128) * 8 + c.wave, 1024); } else do_tr_items(c, in, ws, TR_EOUT0, TR_FIN10, c.gw, c.ngw); } }
    SYNC(1); STAMP(2);
    if (IN(2)) REPS(2) { REPBAR(); phase_prep0(c, in, ws, a.out); }
    SYNC(2); STAMP(3);
    if (IN(3)) REPS(3) { REPBAR(); { pg8::EpiGates E{(const bf16*)(ws + WS_XC), (bf16*)(ws + WS_LOGA), (bf16*)(ws + WS_GI), in[6], in[8], in[9]};
        run_gemm(c.lds, (const bf16*)(ws + WS_XC), (const bf16*)(ws + WS_W_GATE), TT, 1024, 512, E); } }
    SYNC(3); STAMP(4);
    if (IN(4)) REPS(4) { REPBAR();
        phase_lru_a(c, ws);
        if (gridDim.x == 256) {
            const int x = blockIdx.x & 7, j = blockIdx.x >> 3;
            for (int k = 0; k < 4; ++k) { const int bh = 2 * x + (k >> 1), r16 = 8 * (k & 1) + c.wave;
                if ((k & 1) == 0) { __syncthreads(); attn_stage_p1(c, BIG, (const bf16*)a.out, bh >> 3, bh & 7, j); __syncthreads(); }
                attn_item<true>(c, BIG, (const bf16*)a.out, YCAT, (bh << 9) | (r16 << 5) | j, c.lane); }
            __syncthreads();
        } else
        for (int it = c.gw; it < 2 * 8 * 16 * 32; it += c.ngw) attn_item<false>(c, BIG, (const bf16*)a.out, YCAT, it, c.lane);
    }
    SYNC(4); STAMP(5);
    if (IN(5)) REPS(5) { REPBAR(); phase_lru_b(c, ws); if (DEFER_TR && r_ == 0) { do_tr_items(c, in, ws, TR_FOUT00, TR_FOUT10, c.gw, c.ngw); do_tr_items(c, in, ws, TR_OIN0, TR_GLU0, c.gw, c.ngw); } }
    SYNC(5); STAMP(6);
#ifdef EXTRA_BARS
    for (int k_ = 0; k_ < EXTRA_BARS; ++k_) xcd_barrier(bar);
#endif
    if (IN(6)) REPS(6) { REPBAR(); { pg8::EpiRes E{in[0], a.out, XB, ss + TT}; run_gemm(c.lds, YCAT, (const bf16*)(ws + WS_W_EOUT), TT, 1024, 1024, E); } }
    SYNC(6); STAMP(7);
    if (IN(7)) REPS(7) { REPBAR(); { pg8::EpiFfn E{BIG, ss + TT, in[31], in[32], (float*)(ws + WS_EDGEA), (float*)(ws + WS_EDGEL), (float*)(ws + WS_TAILA), halo};
        run_gemm(c.lds, XB, (const bf16*)(ws + WS_W_FIN0), TT, 6144, 1024, E); } }
    SYNC(7); STAMP(8);
    const bool fuse_fix = (gridDim.x == 256) && !DEFER_TR;
    if (!fuse_fix) { if (IN(8)) REPS(8) { REPBAR(); phase_fixup(c, ws, in[31], in[32]); if (DEFER_TR && r_ == 0) phase_s5_mats(c, in, ws); }
    SYNC(8); } STAMP(9);
    if (IN(9)) REPS(9) { REPBAR(); if (fuse_fix) fixup_panel(c, ws, in[31], in[32], 8 * (blockIdx.x & 7) + ((blockIdx.x >> 3) & 7));
        { pg8::EpiRes E{a.out, a.out, XB, ss + 2 * TT}; run_gemm(c.lds, BIG, (const bf16*)(ws + WS_W_FOUT0), TT, 1024, 3072, E); } }
    SYNC(9); STAMP(10);
    if (IN(10)) REPS(10) { REPBAR(); { pg8::EpiProj E{BIG, P1LD, ss + 2 * TT}; run_gemm(c.lds, XB, (const bf16*)(ws + WS_W_OIN), TT, 2048, 1024, E); }
        for (int it = c.gw; it < TT / 16; it += c.ngw) gk_item(XB, (const bf16*)(ws + WS_W_OIN), ss + 2 * TT, BIG, it, c.lane);
        if (DEFER_TR && r_ == 0) { int widx = c.gw, nw = c.ngw; if (gridDim.x == 256) { widx = (blockIdx.x >= 64) ? (blockIdx.x - 64) * 8 + c.wave : -1; nw = 192 * 8; }
            if (widx >= 0) { do_tr_items(c, in, ws, TR_FIN10, TR_FOUT00, widx, nw); do_tr_items(c, in, ws, TR_FOUT10, TR_OIN0, widx, nw); do_tr_items(c, in, ws, TR_GLU0, TR_END, widx, nw); } } }
    SYNC(10); STAMP(11);
    if (IN(11)) REPS(11) { REPBAR();
        phase_gla_prep(c, in, ws);
        if (c.wave >= 4) {
            Ctx c2 = c; c2.gw = blockIdx.x * 4 + (c.wave - 4); c2.ngw = gridDim.x * 4;
            vt_run(c2, BIG, P1LD, 1024, 128, 4, (bf16*)(ws + WS_VTG), SEQ, 0, 8 * 2 * 1024);
            for (int it = c2.gw; it < 32 * 64; it += c2.ngw) s5a_item(BIG, (const bf16*)(ws + WS_S5F), (float*)(ws + WS_XLOC), it, c.lane);
        }
    }
    SYNC(11); STAMP(12);
    if (IN(12)) REPS(12) { REPBAR();
        phase_s5_scan(c, in, ws);
        for (int it = c.ngw - 1 - c.gw; it < 2 * 4 * 128; it += c.ngw) gla_kv_item((const bf16*)(ws + WS_KDT), (const bf16*)(ws + WS_VTG), (bf16*)(ws + WS_KVS), it, c.lane);
    }
    SYNC(12); STAMP(13);
    if (IN(13)) REPS(13) { REPBAR();
        phase_gla_scan(c, ws);
        if (gridDim.x == 256) s5c_block(c, BIG, (const bf16*)(ws + WS_S5A), (const bf16*)(ws + WS_SX), in[21], (bf16*)(ws + WS_XLOC), 31 - (blockIdx.x >> 3), (blockIdx.x & 7) * 8 + c.wave);
        else
        for (int it = c.ngw - 1 - c.gw; it < 32 * 64; it += c.ngw) s5c_item(BIG, (const bf16*)(ws + WS_S5A), (const bf16*)(ws + WS_SX), in[21], (bf16*)(ws + WS_XLOC), it, c.lane);
    }
    SYNC(13); STAMP(14);
    if (IN(14)) REPS(14) { REPBAR();
        { pg8::EpiGlu E{(const bf16*)(ws + WS_XLOC), YCAT, in[24]}; run_gemm(c.lds, (const bf16*)(ws + WS_XLOC), (const bf16*)(ws + WS_W_GLU), TT, 512, 512, E); }
        if (gridDim.x == 256) {
            if (blockIdx.x < 128) gla_out_item(BIG, (const bf16*)(ws + WS_VTG), (const bf16*)(ws + WS_KVS), in[27], YCAT, c.gw, c.lane);
            else for (int k = 0; k < 3; ++k) gla_out_item(BIG, (const bf16*)(ws + WS_VTG), (const bf16*)(ws + WS_KVS), in[27], YCAT, 1024 + ((blockIdx.x - 128) * 8 + c.wave) * 3 + k, c.lane);
        } else
        for (int it = c.ngw - 1 - c.gw; it < 2 * 4 * 128 * 4; it += c.ngw) gla_out_item(BIG, (const bf16*)(ws + WS_VTG), (const bf16*)(ws + WS_KVS), in[27], YCAT, it, c.lane);
    }
    SYNC(14); STAMP(15);
    if (IN(15)) REPS(15) { REPBAR(); { pg8::EpiRes E{a.out, a.out, XB, ss + 3 * TT}; run_gemm(c.lds, YCAT, (const bf16*)(ws + WS_W_OOUT), TT, 1024, 1024, E); } }
    SYNC(15); STAMP(16);
    if (IN(16)) REPS(16) { REPBAR(); { pg8::EpiFfn E{BIG, ss + 3 * TT, in[31] + 3 * 3072, in[32] + 3072, (float*)(ws + WS_EDGEA), (float*)(ws + WS_EDGEL), (float*)(ws + WS_TAILA), halo};
        run_gemm(c.lds, XB, (const bf16*)(ws + WS_W_FIN1), TT, 6144, 1024, E); } }
    SYNC(16); STAMP(17);
    if (!fuse_fix) { if (IN(17)) REPS(17) { REPBAR(); phase_fixup(c, ws, in[31] + 3 * 3072, in[32] + 3072); }
    SYNC(17); } STAMP(18);
    if (IN(18)) REPS(18) { REPBAR(); if (fuse_fix) fixup_panel(c, ws, in[31] + 3 * 3072, in[32] + 3072, 8 * (blockIdx.x & 7) + ((blockIdx.x >> 3) & 7));
        { pg8::EpiRes E{a.out, a.out, nullptr, nullptr}; run_gemm(c.lds, BIG, (const bf16*)(ws + WS_W_FOUT1), TT, 1024, 3072, E); } }
#ifdef TIMING_PROBE
    xcd_barrier(bar); STAMP(19);
    if (blockIdx.x == 0 && c.tid == 0) {
        const float d1 = (float)(tsl[TP_A_HI] - tsl[TP_A_LO]) * 0.01f, d2 = (float)(tsl[TP_B_HI] - tsl[TP_B_LO]) * 0.01f;
#ifdef TP_CALIB
        a.out[0] += 1000.0f;
#else
        a.out[0] += d1;
        for (int j = 1; j <= 10000; ++j) a.out[j] += 0.1f * d2;
#endif
    }
#endif
#ifdef DBG_PROBE
    { grid.sync();
      const bf16* pb = (const bf16*)(ws + (size_t)DBG_B0 * MiB); const size_t nb = (size_t)(DBG_B1 - DBG_B0) * MiB / 2;
      const float* pf = (const float*)(ws + (size_t)DBG_F0 * MiB); const size_t nf = (size_t)(DBG_F1 - DBG_F0) * MiB / 4;
      for (size_t i = c.gtid; i < (size_t)TT * DM; i += c.ngt) { float s = 0.f;
          for (size_t j = i; j < nb; j += (size_t)TT * DM) s += bf2f(pb[j]);
          for (size_t j = i; j < nf; j += (size_t)TT * DM) s += pf[j];
          a.out[i] += 1e-3f * s; } }
#endif
    if (hi < 7) { grid.sync(); for (int i = c.gtid; i < TT * DM / 4; i += c.ngt) ((f32x4*)a.out)[i] = ((const f32x4*)in[0])[i]; }
#undef IN
#undef SYNC
}

#ifndef DBG_HI
#define DBG_HI NPHASE
#endif
#ifndef MK_PER_PHASE
#define MK_PER_PHASE 0
#endif
extern "C" void kernel_launch(void* const* d_in, const int* in_sizes, int n_in, void* d_out, int out_size, void* d_ws, size_t ws_size, hipStream_t stream) {
    static int grid = 0;
    if (grid == 0) {
        if (n_in != 34 || out_size != TT * DM || ws_size < WS_END) { fprintf(stderr, "kernel_launch: unexpected shapes (n_in %d out %d ws %zu)\n", n_in, out_size, ws_size); grid = -1; return; }
        int dev = 0, cus = 0, per_cu = 0;
        hipGetDevice(&dev); hipDeviceGetAttribute(&cus, hipDeviceAttributeMultiprocessorCount, dev);
        if (hipFuncSetAttribute((const void*)fwd_kernel, hipFuncAttributeMaxDynamicSharedMemorySize, LDS_BYTES) != hipSuccess) { fprintf(stderr, "kernel_launch: hipFuncSetAttribute failed\n"); grid = -1; return; }
        if (hipOccupancyMaxActiveBlocksPerMultiprocessor(&per_cu, (const void*)fwd_kernel, 512, LDS_BYTES) != hipSuccess || per_cu < 1) { fprintf(stderr, "kernel_launch: occupancy query says %d\n", per_cu); per_cu = 1; }
        (void)hipGetLastError();
        grid = cus;
        if (grid > 256) grid = 256;
    }
    if (grid < 0) return;
    if (hipMemsetAsync((char*)d_ws + WS_BARRIER, 0, 16384, stream) != hipSuccess) { fprintf(stderr, "kernel_launch: memset failed\n"); return; }
    Args a{};
    for (int i = 0; i < 34; ++i) a.in[i] = (const float*)d_in[i];
    a.out = (float*)d_out; a.ws = (unsigned char*)d_ws;
#if MK_PER_PHASE
    for (int p = 0; p < NPHASE; ++p) { a.ph_lo = p; a.ph_hi = p + 1; hipLaunchKernelGGL(fwd_kernel, dim3(grid), dim3(512), LDS_BYTES, stream, a); }
#else
    a.ph_lo = 0; a.ph_hi = DBG_HI;
    void* args[] = {&a};
    hipError_t e = hipLaunchCooperativeKernel((const void*)fwd_kernel, dim3(grid), dim3(512), args, LDS_BYTES, stream);
    if (e != hipSuccess) fprintf(stderr, "cooperative launch failed: %s (grid %d)\n", hipGetErrorString(e), grid);
#ifdef PROBE_LO
    (void)hipMemsetAsync((char*)d_ws + WS_BARRIER, 0, 16384, stream);
    Args a2 = a; a2.ph_lo = PROBE_LO; a2.ph_hi = PROBE_HI;
    void* args2[] = {&a2};
    (void)hipLaunchCooperativeKernel((const void*)fwd_kernel, dim3(grid), dim3(512), args2, LDS_BYTES, stream);
#endif
#endif
}
```
